# Optimizing an MI355X kernel written in HIP

```python
import math
import jax
import jax.numpy as jnp
from jax import lax
import numpy as np

D_MODEL = 1024
BATCH = 8
SEQ = 2048
DEPTH = 2

GRID_W = 64
CTX_LEN = 256

N_EVEN = (DEPTH + 1) // 2
N_ODD = DEPTH // 2

DEEPNORM_ALPHA = (2.0 * DEPTH) ** 0.25
OUT_INIT_SCALE = (8.0 * DEPTH) ** -0.25
LN_EPS = 1e-5
RMS_EPS = 1e-6

DN_HEADS = 4
DN_DK = 128
DN_DV = 128
DN_CHUNK = 64
SHORT_CONV = 4
DN_QK = DN_HEADS * DN_DK
DN_VAL = DN_HEADS * DN_DV
DN_QKV = 2 * DN_QK + DN_VAL
DN_GATES = 2 * 2 * DN_HEADS
DN_IN = DN_QKV + DN_VAL + DN_GATES

HY_WIDTH = D_MODEL // 2
HY_SHORT = 3
HY_EMB = 33
HY_FFN = 64
HY_INNER = 2
HY_TARGET = 1e-2
HY_FAST_PCT = 0.3
HY_SLOW_PCT = 1.5
HY_MIN_DECAY = math.log(HY_TARGET) / HY_SLOW_PCT
HY_MAX_DECAY = math.log(HY_TARGET) / HY_FAST_PCT
HY_IN = 3 * HY_WIDTH

EVEN_IN = DN_IN + HY_IN
EVEN_MIX = DN_VAL + HY_WIDTH

LRU_WIDTH = D_MODEL
LRU_HEADS = 4
LRU_BLOCK = LRU_WIDTH // LRU_HEADS
LRU_C = 8.0
LRU_CONV = 4
LRU_MIN_RAD = 0.9
LRU_MAX_RAD = 0.999

N_EXPERTS = 32
TOP_K = 4
D_FF = D_MODEL
SWIGLU_ALPHA = 1.702
SWIGLU_LIMIT = 7.0

kernel_name = 'hybrid_deltanet_hyena_rglru_moe_prefix'


def layer_norm(x, g, b):
    xf = x.astype(jnp.float32)
    mu = jnp.mean(xf, axis=-1, keepdims=True)
    var = jnp.mean(jnp.square(xf - mu), axis=-1, keepdims=True)
    return ((xf - mu) * lax.rsqrt(var + LN_EPS) * g + b).astype(x.dtype)


def l2norm(t):
    return t * lax.rsqrt(jnp.sum(t * t, axis=-1, keepdims=True) + RMS_EPS)


def depthwise_conv(x, w, pad_left):
    width = w.shape[0]
    length = x.shape[1]
    xp = jnp.pad(x, ((0, 0), (pad_left, width - 1 - pad_left), (0, 0)))
    out = xp[:, 0:length] * w[0]
    for i in range(1, width):
        out = out + xp[:, i:i + length] * w[i]
    return out


def sincos_2d(rows, cols, dim):
    quarter = dim // 4
    omega = 1.0 / (10000.0 ** (jnp.arange(quarter, dtype=jnp.float32) / quarter))
    def emb1d(n):
        ang = jnp.arange(n, dtype=jnp.float32)[:, None] * omega
        return jnp.concatenate([jnp.sin(ang), jnp.cos(ang)], axis=-1)
    er = jnp.broadcast_to(emb1d(rows)[:, None], (rows, cols, dim // 2))
    ec = jnp.broadcast_to(emb1d(cols)[None], (rows, cols, dim // 2))
    return jnp.concatenate([er, ec], axis=-1).reshape(rows * cols, dim)


def gated_delta_chunked(q, k, v, g, beta, s0):
    bsz, heads, length, dk = k.shape
    dv = v.shape[-1]
    csz = DN_CHUNK
    n = length // csz
    q, k, v = (t.reshape(bsz, heads, n, csz, -1) for t in (q, k, v))
    g = jnp.cumsum(g.reshape(bsz, heads, n, csz), axis=-1)
    beta = beta.reshape(bsz, heads, n, csz)
    incl = jnp.tril(jnp.ones((csz, csz), dtype=bool))
    strict = jnp.tril(jnp.ones((csz, csz), dtype=bool), -1)
    gdiff = g[..., :, None] - g[..., None, :]
    decay = jnp.where(incl, jnp.exp(jnp.where(incl, gdiff, 0.0)), 0.0)
    k_beta = k * beta[..., None]
    a_strict = jnp.where(strict, jnp.einsum('bhnid,bhnjd->bhnij', k_beta, k) * decay, 0.0)
    eye = jnp.eye(csz, dtype=jnp.float32)
    t_inv = lax.linalg.triangular_solve(eye + a_strict, jnp.broadcast_to(eye, a_strict.shape),
                                        left_side=True, lower=True, unit_diagonal=True)
    u = jnp.einsum('bhnij,bhnjd->bhnid', t_inv, v * beta[..., None])
    w = jnp.einsum('bhnij,bhnjd->bhnid', t_inv, k_beta * jnp.exp(g)[..., None])
    attn = jnp.where(incl, jnp.einsum('bhnid,bhnjd->bhnij', q, k) * decay, 0.0)
    q_dec = q * jnp.exp(g)[..., None]
    k_dec = k * jnp.exp(g[..., -1:] - g)[..., None]
    g_last = jnp.exp(g[..., -1])

    def step(state, xs):
        q_c, k_c, u_c, w_c, attn_c, gl_c = xs
        v_new = u_c - jnp.einsum('bhcd,bhde->bhce', w_c, state)
        o_c = jnp.einsum('bhcd,bhde->bhce', q_c, state) + jnp.einsum('bhij,bhje->bhie', attn_c, v_new)
        state = state * gl_c[..., None, None] + jnp.einsum('bhcd,bhce->bhde', k_c, v_new)
        return state, o_c

    xs = tuple(jnp.moveaxis(t, 2, 0) for t in (q_dec, k_dec, u, w, attn, g_last))
    s_final, o = lax.scan(step, s0, xs)
    return jnp.moveaxis(o, 0, 2).reshape(bsz, heads, length, dv), s_final


def _dn_prepare(p, conv_w, a_log, dt_bias):
    bsz, length, _ = p.shape
    qkv, z, gates = jnp.split(p, [DN_QKV, DN_QKV + DN_VAL], axis=-1)
    qkv = jax.nn.silu(depthwise_conv(qkv, conv_w, SHORT_CONV // 2).astype(jnp.float32))
    q, k, v = jnp.split(qkv, [DN_QK, 2 * DN_QK], axis=-1)
    to_heads = lambda t: t.reshape(bsz, length, DN_HEADS, -1).transpose(0, 2, 1, 3)
    q = l2norm(to_heads(q)) * (DN_DK ** -0.5)
    k = l2norm(to_heads(k))
    v = to_heads(v)
    gates = jnp.moveaxis(gates.astype(jnp.float32).reshape(bsz, length, 2, 2, DN_HEADS), 1, -1)
    dirs = []
    for d in range(2):
        g = -jnp.exp(a_log[d].astype(jnp.float32))[:, None] * jax.nn.softplus(gates[:, d, 0] + dt_bias[d][:, None])
        beta = jax.nn.sigmoid(gates[:, d, 1])
        dirs.append((g, beta))
    return q, k, v, z, dirs


def _dn_direction(q, k, v, g, beta, s0, reverse):
    if reverse:
        q, k, v = (jnp.flip(t, 2) for t in (q, k, v))
        g, beta = jnp.flip(g, -1), jnp.flip(beta, -1)
    o, s = gated_delta_chunked(q, k, v, g, beta, s0)
    if reverse:
        o = jnp.flip(o, 2)
    return o, s


def _gated_rmsnorm(o, z, gain):
    bsz, heads, length, dv = o.shape
    o = o.transpose(0, 2, 1, 3)
    o = o * lax.rsqrt(jnp.mean(o * o, axis=-1, keepdims=True) + RMS_EPS) * gain
    o = o * jax.nn.silu(z.astype(jnp.float32).reshape(bsz, length, heads, dv))
    return o.reshape(bsz, length, heads * dv)


def deltanet_mixer(p_lat, p_ctx, conv_w, a_log, dt_bias, norm_g, need_ctx):
    ql, kl, vl, zl, dirs_l = _dn_prepare(p_lat, conv_w, a_log, dt_bias)
    qc, kc, vc, zc, dirs_c = _dn_prepare(p_ctx, conv_w, a_log, dt_bias)
    s0 = jnp.zeros((p_ctx.shape[0], DN_HEADS, DN_DK, DN_DV), jnp.float32)
    o_lat = jnp.zeros_like(vl)
    o_ctx = jnp.zeros_like(vc)
    for d, reverse in enumerate((False, True)):
        oc, sc = _dn_direction(qc, kc, vc, dirs_c[d][0], dirs_c[d][1], s0, reverse)
        ol, _ = _dn_direction(ql, kl, vl, dirs_l[d][0], dirs_l[d][1], sc, reverse)
        o_lat = o_lat + ol
        if need_ctx:
            o_ctx = o_ctx + oc
    y_lat = _gated_rmsnorm(o_lat, zl, norm_g).astype(p_lat.dtype)
    y_ctx = _gated_rmsnorm(o_ctx, zc, norm_g).astype(p_ctx.dtype) if need_ctx else None
    return y_lat, y_ctx


def hyena_filter(length, w_in, b_in, w_mid, b_mid, w_out, freq):
    f32 = jnp.float32
    t = jnp.linspace(0.0, 1.0, length, dtype=f32)[:, None]
    bands = (HY_EMB - 1) // 2
    wpos = 2.0 * math.pi * jnp.arange(length, dtype=f32)[:, None] / length
    fb = jnp.linspace(1e-4, bands - 1, bands, dtype=f32)[None]
    z = jnp.concatenate([t, jnp.cos(fb * wpos), -jnp.sin(fb * wpos)], axis=-1)
    freq = freq.astype(f32)
    h = jnp.sin(freq * (z @ w_in.astype(f32) + b_in))
    for i in range(HY_INNER):
        h = jnp.sin(freq * (h @ w_mid[i].astype(f32) + b_mid[i]))
    h = (h @ w_out.astype(f32)).reshape(length, 2, HY_WIDTH)
    deltas = jnp.abs(jnp.linspace(HY_MIN_DECAY, HY_MAX_DECAY, HY_WIDTH, dtype=f32))
    h = h * jnp.exp(-t * deltas)[:, None, :]
    return h[:, 0], h[:, 1]


def centred_long_conv(u, h_fwd, h_bwd):
    length, chans = h_fwd.shape
    kern = jnp.concatenate([h_fwd, jnp.zeros((1, chans), h_fwd.dtype), h_bwd[:0:-1]], axis=0)
    uf = jnp.fft.rfft(u, n=2 * length, axis=1)
    kf = jnp.fft.rfft(kern, n=2 * length, axis=0)
    return jnp.fft.irfft(uf * kf[None], n=2 * length, axis=1)[:, :length]


def hyena_seq(p, conv_w, conv_b, filt, skip):
    length = p.shape[1]
    uc = (depthwise_conv(p, conv_w, HY_SHORT // 2) + conv_b).astype(jnp.float32)
    x0, x1, v = jnp.split(uc, 3, axis=-1)
    h_fwd, h_bwd = hyena_filter(length, *filt)
    v = v * x1
    v = centred_long_conv(v, h_fwd, h_bwd) + v * skip
    return (x0 * v).astype(p.dtype)


def even_mixer(u_lat, u_ctx, w_in, w_out, dn_conv_w, dn_a_log, dn_dt_bias, dn_norm_g,
               hy_conv_w, hy_conv_b, hy_filt, hy_skip, need_ctx):
    p_lat = u_lat @ w_in
    p_ctx = u_ctx @ w_in
    dn_lat, dn_ctx = deltanet_mixer(p_lat[..., :DN_IN], p_ctx[..., :DN_IN], dn_conv_w, dn_a_log,
                                    dn_dt_bias, dn_norm_g, need_ctx)
    hy_lat = hyena_seq(p_lat[..., DN_IN:], hy_conv_w, hy_conv_b, hy_filt, hy_skip)
    y_lat = jnp.concatenate([dn_lat, hy_lat], axis=-1) @ w_out
    y_ctx = None
    if need_ctx:
        hy_ctx = hyena_seq(p_ctx[..., DN_IN:], hy_conv_w, hy_conv_b, hy_filt, hy_skip)
        y_ctx = jnp.concatenate([dn_ctx, hy_ctx], axis=-1) @ w_out
    return y_lat, y_ctx


def rglru_coeffs(xb, wa, ba, wx, bx, a_param):
    bsz, length, width = xb.shape
    xh = xb.reshape(bsz, length, LRU_HEADS, LRU_BLOCK)
    r = jax.nn.sigmoid(jnp.einsum('blhi,hij->blhj', xh, wa.astype(jnp.float32)).reshape(bsz, length, width) + ba)
    i = jax.nn.sigmoid(jnp.einsum('blhi,hij->blhj', xh, wx.astype(jnp.float32)).reshape(bsz, length, width) + bx)
    log_a = -LRU_C * r * jax.nn.softplus(a_param.astype(jnp.float32))
    a = jnp.exp(log_a)
    b = jnp.sqrt(-jnp.expm1(2.0 * log_a)) * (i * xb)
    return a, b


def _scan_combine(left, right):
    a1, b1 = left
    a2, b2 = right
    return a1 * a2, a2 * b1 + b2


def linear_scan(a, b, h0, reverse):
    if reverse:
        a, b = jnp.flip(a, 1), jnp.flip(b, 1)
    a_cum, b_cum = lax.associative_scan(_scan_combine, (a, b), axis=1)
    h = a_cum * h0[:, None] + b_cum
    h_last = h[:, -1]
    if reverse:
        h = jnp.flip(h, 1)
    return h, h_last


def odd_mixer(u_lat, u_ctx, w_in, b_in, conv_w, conv_b, wa, ba, wx, bx, a_param, w_out, b_out, need_ctx):
    def branches(u):
        xb, yb = jnp.split(u @ w_in + b_in, 2, axis=-1)
        xb = (depthwise_conv(xb, conv_w, LRU_CONV // 2) + conv_b).astype(jnp.float32)
        return xb, yb
    x_lat, gate_lat = branches(u_lat)
    x_ctx, gate_ctx = branches(u_ctx)
    zero = jnp.zeros((u_ctx.shape[0], LRU_WIDTH), jnp.float32)
    h_lat = jnp.zeros_like(x_lat)
    h_ctx = jnp.zeros_like(x_ctx)
    for d, reverse in enumerate((False, True)):
        a_c, b_c = rglru_coeffs(x_ctx, wa[d], ba[d], wx[d], bx[d], a_param[d])
        hc, hc_last = linear_scan(a_c, b_c, zero, reverse)
        a_l, b_l = rglru_coeffs(x_lat, wa[d], ba[d], wx[d], bx[d], a_param[d])
        hl, _ = linear_scan(a_l, b_l, hc_last, reverse)
        h_lat = h_lat + hl
        if need_ctx:
            h_ctx = h_ctx + hc
    y_lat = (h_lat * jax.nn.gelu(gate_lat.astype(jnp.float32))).astype(u_lat.dtype) @ w_out + b_out
    y_ctx = None
    if need_ctx:
        y_ctx = (h_ctx * jax.nn.gelu(gate_ctx.astype(jnp.float32))).astype(u_ctx.dtype) @ w_out + b_out
    return y_lat, y_ctx


def moe_ffn(h, router_w, router_b, w1, b1, w2, b2):
    logits = (h @ router_w + router_b).astype(jnp.float32)
    top_v, top_i = lax.top_k(logits, TOP_K)
    wts = jax.nn.softmax(top_v, axis=-1)
    gate = jnp.einsum('tk,tke->te', wts, jax.nn.one_hot(top_i, N_EXPERTS, dtype=jnp.float32))
    out = jnp.zeros(h.shape, jnp.float32)
    for e in range(N_EXPERTS):
        gu = h @ w1[e] + b1[e]
        glu = jnp.minimum(gu[:, 0::2], SWIGLU_LIMIT)
        lin = jnp.clip(gu[:, 1::2], -SWIGLU_LIMIT, SWIGLU_LIMIT)
        act = glu * jax.nn.sigmoid(SWIGLU_ALPHA * glu) * (lin + 1.0)
        out = out + gate[:, e:e + 1] * (act @ w2[e] + b2[e])
    return out.astype(h.dtype)


def setup_inputs(seed: int = 0) -> dict:
    key = jax.random.key(seed)
    keys = list(jax.random.split(key, 48))
    def nrm(shape, scale):
        return jax.random.normal(keys.pop(), shape, jnp.float32) * scale
    def unif(shape, lo, hi):
        return jax.random.uniform(keys.pop(), shape, jnp.float32, lo, hi)
    d = D_MODEL
    ne, no = N_EVEN, N_ODD
    dt = jnp.exp(unif((ne, 2, DN_HEADS), math.log(1e-3), math.log(1e-1)))
    rad2 = unif((no, 2, LRU_WIDTH), LRU_MIN_RAD ** 2, LRU_MAX_RAD ** 2)
    return {
        'x': nrm((BATCH, SEQ, d), 1.0),
        'c': nrm((BATCH, d), 1.0),
        'ctx': nrm((BATCH, CTX_LEN, d), 1.0),
        'c_ctx': nrm((d,), 1.0),
        'ada_w': nrm((DEPTH, d, 6 * d), 0.5 * d ** -0.5),
        'ada_b': nrm((DEPTH, 6 * d), 0.02),
        'ln_g': 1.0 + nrm((DEPTH, 2, d), 0.02),
        'ln_b': nrm((DEPTH, 2, d), 0.02),
        'ev_w_in': nrm((ne, d, EVEN_IN), d ** -0.5),
        'ev_w_out': nrm((ne, EVEN_MIX, d), OUT_INIT_SCALE * EVEN_MIX ** -0.5),
        'dn_conv_w': nrm((ne, SHORT_CONV, DN_QKV), SHORT_CONV ** -0.5),
        'dn_a_log': jnp.log(unif((ne, 2, DN_HEADS), 1.0, 16.0)),
        'dn_dt_bias': dt + jnp.log(-jnp.expm1(-dt)),
        'dn_norm_g': 1.0 + nrm((ne, DN_DV), 0.02),
        'hy_conv_w': nrm((ne, HY_SHORT, HY_IN), HY_SHORT ** -0.5),
        'hy_conv_b': nrm((ne, HY_IN), 0.02),
        'hy_w_in': nrm((ne, HY_EMB, HY_FFN), HY_EMB ** -0.5),
        'hy_b_in': nrm((ne, HY_FFN), 0.02),
        'hy_w_mid': nrm((ne, HY_INNER, HY_FFN, HY_FFN), HY_FFN ** -0.5),
        'hy_b_mid': nrm((ne, HY_INNER, HY_FFN), 0.02),
        'hy_w_out': nrm((ne, HY_FFN, 2 * HY_WIDTH), 0.1 * HY_FFN ** -0.5),
        'hy_freq': 1.0 + nrm((ne, HY_FFN), 0.1),
        'hy_skip': nrm((ne, HY_WIDTH), 0.1),
        'od_w_in': nrm((no, d, 2 * LRU_WIDTH), d ** -0.5),
        'od_b_in': nrm((no, 2 * LRU_WIDTH), 0.02),
        'lru_conv_w': nrm((no, LRU_CONV, LRU_WIDTH), LRU_CONV ** -0.5),
        'lru_conv_b': nrm((no, LRU_WIDTH), 0.02),
        'lru_wa': nrm((no, 2, LRU_HEADS, LRU_BLOCK, LRU_BLOCK), LRU_BLOCK ** -0.5),
        'lru_ba': nrm((no, 2, LRU_WIDTH), 0.02),
        'lru_wx': nrm((no, 2, LRU_HEADS, LRU_BLOCK, LRU_BLOCK), LRU_BLOCK ** -0.5),
        'lru_bx': nrm((no, 2, LRU_WIDTH), 0.02),
        'lru_a_param': jnp.log(jnp.expm1(-0.5 * jnp.log(rad2))),
        'od_w_out': nrm((no, LRU_WIDTH, d), OUT_INIT_SCALE * LRU_WIDTH ** -0.5),
        'od_b_out': nrm((no, d), 0.02),
        'router_w': nrm((DEPTH, d, N_EXPERTS), d ** -0.5),
        'router_b': nrm((DEPTH, N_EXPERTS), 0.01),
        'moe_w1': nrm((DEPTH, N_EXPERTS, d, 2 * D_FF), d ** -0.5),
        'moe_b1': nrm((DEPTH, N_EXPERTS, 2 * D_FF), 0.02),
        'moe_w2': nrm((DEPTH, N_EXPERTS, D_FF, d), OUT_INIT_SCALE * D_FF ** -0.5),
        'moe_b2': nrm((DEPTH, N_EXPERTS, d), 0.02),
    }


def reference(x, c, ctx, c_ctx, ada_w, ada_b, ln_g, ln_b, ev_w_in, ev_w_out, dn_conv_w, dn_a_log,
              dn_dt_bias, dn_norm_g, hy_conv_w, hy_conv_b, hy_w_in, hy_b_in, hy_w_mid, hy_b_mid,
              hy_w_out, hy_freq, hy_skip, od_w_in, od_b_in, lru_conv_w, lru_conv_b, lru_wa, lru_ba,
              lru_wx, lru_bx, lru_a_param, od_w_out, od_b_out, router_w, router_b, moe_w1, moe_b1,
              moe_w2, moe_b2):
    bsz, length, dim = x.shape
    rows = length // GRID_W
    pos = sincos_2d(rows, GRID_W, dim).astype(x.dtype)
    hc = ctx
    for layer in range(DEPTH):
        last = layer == DEPTH - 1
        j = layer // 2
        mod_lat = jax.nn.silu(c) @ ada_w[layer] + ada_b[layer]
        mod_ctx = jax.nn.silu(c_ctx) @ ada_w[layer] + ada_b[layer]
        sh1, sc1, g1, sh2, sc2, g2 = jnp.split(mod_lat[:, None, :], 6, axis=-1)
        csh1, csc1, cg1, csh2, csc2, cg2 = jnp.split(mod_ctx, 6, axis=-1)
        u_lat = x * (1.0 + sc1) + sh1 + pos
        u_ctx = hc * (1.0 + csc1) + csh1
        if layer % 2 == 0:
            y_lat, y_ctx = even_mixer(u_lat, u_ctx, ev_w_in[j], ev_w_out[j], dn_conv_w[j], dn_a_log[j],
                                      dn_dt_bias[j], dn_norm_g[j], hy_conv_w[j], hy_conv_b[j],
                                      (hy_w_in[j], hy_b_in[j], hy_w_mid[j], hy_b_mid[j], hy_w_out[j], hy_freq[j]),
                                      hy_skip[j], not last)
        else:
            y_lat, y_ctx = odd_mixer(u_lat, u_ctx, od_w_in[j], od_b_in[j], lru_conv_w[j], lru_conv_b[j],
                                     lru_wa[j], lru_ba[j], lru_wx[j], lru_bx[j], lru_a_param[j],
                                     od_w_out[j], od_b_out[j], not last)
        x = layer_norm(DEEPNORM_ALPHA * x + g1 * y_lat, ln_g[layer, 0], ln_b[layer, 0])
        v_lat = (x * (1.0 + sc2) + sh2).reshape(bsz * length, dim)
        if last:
            f_lat = moe_ffn(v_lat, router_w[layer], router_b[layer], moe_w1[layer], moe_b1[layer],
                            moe_w2[layer], moe_b2[layer])
        else:
            hc = layer_norm(DEEPNORM_ALPHA * hc + cg1 * y_ctx, ln_g[layer, 0], ln_b[layer, 0])
            v_ctx = (hc * (1.0 + csc2) + csh2).reshape(-1, dim)
            f_all = moe_ffn(jnp.concatenate([v_lat, v_ctx], axis=0), router_w[layer], router_b[layer],
                            moe_w1[layer], moe_b1[layer], moe_w2[layer], moe_b2[layer])
            f_lat = f_all[:bsz * length]
            hc = layer_norm(DEEPNORM_ALPHA * hc + cg2 * f_all[bsz * length:].reshape(hc.shape),
                            ln_g[layer, 1], ln_b[layer, 1])
        x = layer_norm(DEEPNORM_ALPHA * x + g2 * f_lat.reshape(bsz, length, dim), ln_g[layer, 1], ln_b[layer, 1])
    return x
```

```cpp
#include <hip/hip_runtime.h>
#include <cstdio>
#include <cstdint>

#ifndef MK_ONE_LAUNCH
#define MK_ONE_LAUNCH 0
#endif

#define LAS __attribute__((address_space(3)))
#define DI __device__ __forceinline__
typedef unsigned short bf16_t;
typedef float f32x4 __attribute__((ext_vector_type(4)));
typedef float f32x2 __attribute__((ext_vector_type(2)));
typedef unsigned u32x4 __attribute__((ext_vector_type(4)));
typedef unsigned u32x2 __attribute__((ext_vector_type(2)));

constexpr int DM = 1024, NB = 8, SEQ = 2048, CTXL = 256;
constexpr int TL = NB * SEQ;
constexpr int TC = NB * CTXL;
constexpr int TT = TL + TC;
constexpr int EVEN_IN = 3600, DN_GATE_COL = 2048, HY_COL = 2064;
constexpr int NP0 = 3584;
constexpr int MIXW = 1024;
constexpr int NEXP = 32, TOPK = 4;
constexpr int MOE_ROWS = 82176;
constexpr float ALPHA = 1.4142135623730951f;
constexpr float LN_EPS = 1e-5f, RMS_EPS = 1e-6f;

constexpr size_t al(size_t x) { return (x + 255) & ~(size_t)255; }
constexpr size_t WS_CTL   = 0;
constexpr size_t WS_MOD   = 65536;
constexpr size_t WS_POS   = WS_MOD + al((size_t)2 * 9 * 6144 * 4);
constexpr size_t WS_HFL   = WS_POS + (size_t)SEQ * DM * 4;
constexpr size_t WS_HBL   = WS_HFL + (size_t)SEQ * 512 * 4;
constexpr size_t WS_HFC   = WS_HBL + (size_t)SEQ * 512 * 4;
constexpr size_t WS_HBC   = WS_HFC + (size_t)CTXL * 512 * 4;
constexpr size_t WS_WEVIN = WS_HBC + (size_t)CTXL * 512 * 4;
constexpr size_t WS_WEVOUT= WS_WEVIN + (size_t)NP0 * DM * 2;
constexpr size_t WS_WODIN = WS_WEVOUT + (size_t)DM * MIXW * 2;
constexpr size_t WS_WODOUT= WS_WODIN + (size_t)2048 * DM * 2;
constexpr size_t WS_WM1   = WS_WODOUT + (size_t)DM * DM * 2;
constexpr size_t WS_WM2   = WS_WM1 + (size_t)64 * 2048 * DM * 2;
constexpr size_t WS_X1    = WS_WM2 + (size_t)64 * DM * DM * 2;
constexpr size_t WS_X2    = WS_X1 + (size_t)TT * DM * 4;
constexpr size_t WS_VB    = WS_X2 + (size_t)TT * DM * 4;
constexpr size_t WS_RI    = WS_VB + (size_t)TT * DM * 2;
constexpr size_t WS_RW    = WS_RI + (size_t)TT * 16;
constexpr size_t WS_SP    = WS_RW + (size_t)TT * 16;
constexpr size_t WS_TILEE = WS_SP + (size_t)TT * 16;
constexpr size_t WS_VBG   = WS_TILEE + 4096;
constexpr size_t WS_ACT   = WS_VBG + (size_t)MOE_ROWS * DM * 2;
constexpr size_t WS_YS    = WS_ACT + (size_t)MOE_ROWS * DM * 2;
constexpr size_t WS_ARENA = WS_YS + (size_t)MOE_ROWS * DM * 2;
constexpr size_t A0_U     = WS_ARENA;
constexpr size_t A0_P     = A0_U + (size_t)TT * DM * 2;
constexpr size_t A0_GATES = A0_P + (size_t)TT * NP0 * 2;
constexpr size_t A0_QN    = A0_GATES + (size_t)TT * 64;
constexpr size_t A0_KN    = A0_QN + (size_t)TT * 512 * 4;
constexpr size_t A0_VV    = A0_KN + (size_t)TT * 512 * 4;
constexpr size_t A0_GG    = A0_VV + (size_t)TT * 512 * 4;
constexpr size_t A0_BB    = A0_GG + (size_t)2 * TT * 16;
constexpr size_t A0_OD    = A0_BB + (size_t)2 * TT * 16;
constexpr size_t A0_VX    = A0_OD + (size_t)2 * TT * 512 * 4;
constexpr size_t A0_X0    = A0_VX + (size_t)TT * 512 * 4;
constexpr size_t A0_YH    = A0_X0 + (size_t)TT * 512 * 4;
constexpr size_t A0_MIX   = A0_YH + (size_t)TT * 512 * 4;
constexpr size_t A0_Y     = A0_MIX + (size_t)TT * MIXW * 2;
constexpr size_t A0_END   = A0_Y + (size_t)TT * DM * 4;
constexpr size_t A1_U     = WS_ARENA;
constexpr size_t A1_P     = A1_U + (size_t)TT * DM * 2;
constexpr size_t A1_XC    = A1_P + (size_t)TT * 2048 * 4;
constexpr size_t A1_LA    = A1_XC + (size_t)TT * DM * 4;
constexpr size_t A1_LB    = A1_LA + (size_t)2 * TT * DM * 4;
constexpr size_t A1_HS    = A1_LB + (size_t)2 * TT * DM * 4;
constexpr size_t A1_HG    = A1_HS + (size_t)2 * TL * DM * 4;
constexpr size_t A1_Y     = A1_HG + (size_t)TL * DM * 2;
constexpr size_t A1_END   = A1_Y + (size_t)TL * DM * 4;
constexpr size_t WS_END   = (A0_END > A1_END ? A0_END : A1_END);

constexpr int CW_BAR = 0;
constexpr int CW_CNT = 4096;
constexpr int CW_CUR = 4096 + 64;
constexpr int CW_NT  = 4096 + 128;
constexpr size_t CTL_BYTES = 65536;

DI float bf2f(bf16_t b) { return __uint_as_float(((unsigned)b) << 16); }
DI bf16_t f2bf(float f) { unsigned u = __float_as_uint(f); u += 0x7FFFu + ((u >> 16) & 1u); return (bf16_t)(u >> 16); }
DI unsigned pk2(float lo, float hi) { return (unsigned)f2bf(lo) | ((unsigned)f2bf(hi) << 16); }
DI float sigm(float x) { return 1.0f / (1.0f + __expf(-x)); }
DI float silu_(float x) { return x * sigm(x); }
DI float softplus_(float x) { return fmaxf(x, 0.f) + log1pf(__expf(-fabsf(x))); }
DI float gelu_tanh(float x) { return 0.5f * x * (1.0f + tanhf(0.7978845608028654f * (x + 0.044715f * x * x * x))); }
DI float wsum(float v) { v += __shfl_xor(v, 32); v += __shfl_xor(v, 16); v += __shfl_xor(v, 8); v += __shfl_xor(v, 4); v += __shfl_xor(v, 2); v += __shfl_xor(v, 1); return v; }

DI int row_of(int b, int d, int p) {
    if (p < CTXL) return TL + b * CTXL + (d ? (CTXL - 1 - p) : p);
    const int q = p - CTXL; return b * SEQ + (d ? (SEQ - 1 - q) : q);
}
static_assert(WS_END <= (size_t)2147483648ull, "workspace map exceeds 4x the largest tensor");
#define XB_TMO      128
#define XB_XCNT(j)  (256  + 64 * (j))
#define XB_XSUB(j)  (1280 + 64 * (j))
#define XB_XGEN(j)  (2304 + 64 * (j))
#define XB_TOP      3328
#define XB_TOPGEN   3392
#define XCD_BAR_WORDS 3456
#define XB_SPIN_CAP (1u << 18)

__device__ __forceinline__ unsigned xb_ld(unsigned* p)              { return __hip_atomic_load(p, __ATOMIC_RELAXED, __HIP_MEMORY_SCOPE_AGENT); }
__device__ __forceinline__ unsigned xb_add(unsigned* p, unsigned v) { return __hip_atomic_fetch_add(p, v, __ATOMIC_RELAXED, __HIP_MEMORY_SCOPE_AGENT); }
__device__ __forceinline__ unsigned xb_xcc_id() { return (unsigned)__builtin_amdgcn_s_getreg((3 << 11) | 20) & 0xFu; }
#define XB_SPIN(cond, bar) do { unsigned _sp = 0; while (cond) { __builtin_amdgcn_s_sleep(1); \
    if ((++_sp & 255u) == 0u) { if (xb_ld(&(bar)[XB_TMO])) break; if (_sp > XB_SPIN_CAP) { atomicAdd(&(bar)[XB_TMO], 1u); break; } } } } while (0)

struct XcdBarrier {
    unsigned* bar; unsigned x;
    volatile LAS unsigned* st;
};

__device__ __forceinline__ XcdBarrier xcd_barrier_post(unsigned* bar, volatile LAS unsigned* st) {
    XcdBarrier b; b.bar = bar; b.x = xb_xcc_id(); b.st = st;
    if (threadIdx.x == 0) (void)xb_add(&bar[XB_XCNT(b.x)], 1u);
    return b;
}
__device__ __forceinline__ void xcd_barrier_complete(unsigned* bar, unsigned x, unsigned& nloc, unsigned& nx) {
    const unsigned G = gridDim.x * gridDim.y * gridDim.z;
    unsigned sum, cnt, mine, sp = 0u;
    for (;;) {
        sum = 0u; cnt = 0u; mine = 0u;
#pragma unroll
        for (unsigned j = 0; j < 16; ++j) { const unsigned c = xb_ld(&bar[XB_XCNT(j)]); sum += c; cnt += (c > 0u) ? 1u : 0u; mine = (j == x) ? c : mine; }
        if (sum == G) break;
        __builtin_amdgcn_s_sleep(1);
        if ((++sp & 255u) == 0u) { if (xb_ld(&bar[XB_TMO])) break; if (sp > XB_SPIN_CAP) { atomicAdd(&bar[XB_TMO], 1u); break; } }
    }
    nloc = mine > 0u ? mine : 1u; nx = cnt > 0u ? cnt : 1u;
}

__device__ __forceinline__ void xcd_barrier(const XcdBarrier& b) {
    asm volatile("s_waitcnt vmcnt(0)" ::: "memory");
    __syncthreads();
    if (threadIdx.x == 0) {
        unsigned* bar = b.bar;
        __builtin_amdgcn_s_waitcnt(0);
        unsigned nloc = b.st[0], nx = b.st[1];
        if (nloc == 0u) { xcd_barrier_complete(bar, b.x, nloc, nx); b.st[0] = nloc; b.st[1] = nx; }
        const unsigned old = xb_add(&bar[XB_XSUB(b.x)], 1u);
        const unsigned gen = old / nloc;
        if (old + 1u == (gen + 1u) * nloc) {
            __builtin_amdgcn_fence(__ATOMIC_RELEASE, "agent");
            asm volatile("s_waitcnt vmcnt(0)" ::: "memory");
            const unsigned og = xb_add(&bar[XB_TOP], 1u);
            const unsigned tg = og / nx;
            if (og + 1u == (tg + 1u) * nx) xb_add(&bar[XB_TOPGEN], 1u);
            else XB_SPIN(xb_ld(&bar[XB_TOPGEN]) == tg, bar);
            __builtin_amdgcn_fence(__ATOMIC_ACQUIRE, "agent");
            xb_add(&bar[XB_XGEN(b.x)], 1u);
            asm volatile("s_waitcnt vmcnt(0)" ::: "memory");
        } else {
            XB_SPIN(xb_ld(&bar[XB_XGEN(b.x)]) == gen, bar);
            __builtin_amdgcn_fence(__ATOMIC_ACQUIRE, "agent");
            asm volatile("s_waitcnt vmcnt(0)" ::: "memory");
        }
    }
    __syncthreads();
}

namespace pg8 {
typedef short bf16x8 __attribute__((ext_vector_type(8)));
constexpr int BM = 256, BK = 64, HALF = 128, HTB = HALF * BK * 2, STAGE_BYTES = 8 * HTB, NXCD = 8, WGM = 8;

__host__ __device__ __forceinline__ int lds_byte(int r, int c) { const int st = (r >> 4) * 2 + (c >> 5), rr = r & 15, cc = c & 31, ob = rr * 64 + cc * 2; return st * 1024 + (ob ^ (((ob >> 9) & 1) << 5)); }
__host__ __device__ __forceinline__ void stage_rc(int b, int& R, int& C) { const int st = b / 1024, sb = b % 1024, swz = sb ^ (((sb >> 9) & 1) << 5); R = (st >> 1) * 16 + swz / 64; C = (st & 1) * 32 + (swz % 64) / 2; }
__host__ __device__ __forceinline__ int perm32(int rho) { const int n = rho >> 4, i = rho & 15; return 8 * (i >> 2) + 4 * n + (i & 3); }

struct Unit { int pm, pn, e; };
struct Gemm { const bf16_t* A; const bf16_t* Bt; int M, N, K; };

struct StaticOrder {
    int nM, nN, nwg, G, c;
    __device__ void init(int M, int N, int G_, int c_) { nM = M / BM; nN = N / BM; nwg = nM * nN; G = G_; c = c_; }
    __device__ bool next(int i, Unit& u) const {
        const long L = (long)i * G + c; if (L >= nwg) return false;
        int wgid = (int)L; { const int q = nwg / NXCD, r = nwg % NXCD, xcd = wgid % NXCD, off = wgid / NXCD; wgid = (xcd < r ? xcd * (q + 1) : r * (q + 1) + (xcd - r) * q) + off; }
        const int nig = WGM * nN, gid = wgid / nig, fm = gid * WGM, gsz = (nM - fm) < WGM ? (nM - fm) : WGM;
        u.pm = fm + ((wgid % nig) % gsz); u.pn = (wgid % nig) / gsz; u.e = 0; return true;
    }
    __device__ __forceinline__ const char* a_ptr(const Gemm& g, const Unit& u) const { return (const char*)g.A + (size_t)u.pm * BM * g.K * 2; }
    __device__ __forceinline__ const char* b_ptr(const Gemm& g, const Unit& u) const { return (const char*)g.Bt + (size_t)u.pn * BM * g.K * 2; }
};
struct MoeOrder {
    const int* tile_e; int ntm, nN, G, c;
    __device__ bool next(int i, Unit& u) const {
        const long L = (long)i * G + c; if (L >= (long)ntm * nN) return false;
        u.pm = (int)(L / nN); u.pn = (int)(L % nN); u.e = tile_e[u.pm]; return true;
    }
    __device__ __forceinline__ const char* a_ptr(const Gemm& g, const Unit& u) const { return (const char*)g.A + (size_t)u.pm * BM * g.K * 2; }
    __device__ __forceinline__ const char* b_ptr(const Gemm& g, const Unit& u) const { return (const char*)g.Bt + ((size_t)u.e * g.N + (size_t)u.pn * BM) * g.K * 2; }
};

__device__ __forceinline__ unsigned cvt_pk_bf16(float lo, float hi) { unsigned r; asm volatile("v_cvt_pk_bf16_f32 %0, %1, %2" : "=v"(r) : "v"(lo), "v"(hi)); return r; }

struct EpiF32 {
    static constexpr bool PERM = false;
    float* C; int ldc; const float* bias;
    __device__ __forceinline__ void operator()(const f32x4 (&acc)[2][2][4][2], const Unit& u, int wr, int wc, int fr, int fq) const {
        const int row0 = u.pm * BM + wr * 64 + fr, col0 = u.pn * BM + wc * 32 + 4 * fq;
        f32x4 bv[2][2];
#pragma unroll
        for (int bj = 0; bj < 2; ++bj)
#pragma unroll
            for (int n = 0; n < 2; ++n) bv[bj][n] = bias ? *(const f32x4*)(bias + col0 + bj * HALF + n * 16) : (f32x4){0.f, 0.f, 0.f, 0.f};
#pragma unroll
        for (int ai = 0; ai < 2; ++ai)
#pragma unroll
            for (int m = 0; m < 4; ++m) { float* rowp = C + (size_t)(row0 + ai * HALF + m * 16) * ldc + col0;
#pragma unroll
                for (int bj = 0; bj < 2; ++bj)
#pragma unroll
                    for (int n = 0; n < 2; ++n) *(f32x4*)(rowp + bj * HALF + n * 16) = acc[ai][bj][m][n] + bv[bj][n]; }
    }
};
struct EpiBf16 {
    static constexpr bool PERM = true;
    bf16_t* O; int ldc; const float* bias; int bias_estride;
    __device__ __forceinline__ void operator()(const f32x4 (&acc)[2][2][4][2], const Unit& u, int wr, int wc, int fr, int fq) const {
        const int row0 = u.pm * BM + wr * 64 + fr; const int col0 = u.pn * BM + wc * 32 + 8 * fq;
        f32x4 bv[2][2];
#pragma unroll
        for (int bj = 0; bj < 2; ++bj)
#pragma unroll
            for (int n = 0; n < 2; ++n) bv[bj][n] = bias ? *(const f32x4*)(bias + (size_t)u.e * bias_estride + col0 + bj * HALF + 4 * n) : (f32x4){0.f, 0.f, 0.f, 0.f};
#pragma unroll
        for (int ai = 0; ai < 2; ++ai)
#pragma unroll
            for (int m = 0; m < 4; ++m) { bf16_t* rowp = O + (size_t)(row0 + ai * HALF + m * 16) * ldc + col0;
#pragma unroll
                for (int bj = 0; bj < 2; ++bj) { const f32x4 v0 = acc[ai][bj][m][0] + bv[bj][0], v1 = acc[ai][bj][m][1] + bv[bj][1];
                    u32x4 w; w.x = cvt_pk_bf16(v0[0], v0[1]); w.y = cvt_pk_bf16(v0[2], v0[3]); w.z = cvt_pk_bf16(v1[0], v1[1]); w.w = cvt_pk_bf16(v1[2], v1[3]);
                    *(u32x4*)(rowp + bj * HALF) = w; } }
    }
};
__device__ __forceinline__ float swiglu_(float g, float l) {
    const float glu = fminf(g, 7.0f), lin = fminf(fmaxf(l, -7.0f), 7.0f);
    return glu * __builtin_amdgcn_rcpf(1.0f + __expf(-1.702f * glu)) * (lin + 1.0f);
}
struct EpiSwiglu {
    static constexpr bool PERM = true;
    bf16_t* O; int ldo; const float* bias; int bias_estride;
    __device__ __forceinline__ void operator()(const f32x4 (&acc)[2][2][4][2], const Unit& u, int wr, int wc, int fr, int fq) const {
        const int row0 = u.pm * BM + wr * 64 + fr; const int col0 = u.pn * BM + wc * 32 + 8 * fq;
        f32x4 bv[2][2];
#pragma unroll
        for (int bj = 0; bj < 2; ++bj)
#pragma unroll
            for (int n = 0; n < 2; ++n) bv[bj][n] = *(const f32x4*)(bias + (size_t)u.e * bias_estride + col0 + bj * HALF + 4 * n);
#pragma unroll
        for (int ai = 0; ai < 2; ++ai)
#pragma unroll
            for (int m = 0; m < 4; ++m) { bf16_t* rowp = O + (size_t)(row0 + ai * HALF + m * 16) * ldo + (col0 >> 1);
#pragma unroll
                for (int bj = 0; bj < 2; ++bj) { const f32x4 v0 = acc[ai][bj][m][0] + bv[bj][0], v1 = acc[ai][bj][m][1] + bv[bj][1];
                    u32x2 w; w.x = cvt_pk_bf16(swiglu_(v0[0], v0[1]), swiglu_(v0[2], v0[3])); w.y = cvt_pk_bf16(swiglu_(v1[0], v1[1]), swiglu_(v1[2], v1[3]));
                    *(u32x2*)(rowp + bj * (HALF / 2)) = w; } }
    }
};

template <class Epi, class Sched>
__device__ __forceinline__ void gemm_phase(LAS unsigned char* lds, const Gemm g, const Sched& S, const Epi& E) {
    const int tid = threadIdx.x, wid = __builtin_amdgcn_readfirstlane(tid >> 6), lane = tid & 63, wr = wid >> 2, wc = wid & 3, fr = lane & 15, fq = lane >> 4;
    const int K = g.K, nt = K / BK;
    unsigned voffA[2], voffB[2];
#pragma unroll
    for (int i = 0; i < 2; ++i) { int R, C; stage_rc(tid * 16 + i * 8192, R, C); const int Rb = Epi::PERM ? ((R & ~31) + perm32(R & 31)) : R;
        voffA[i] = (unsigned)(R * K + C) * 2u; voffB[i] = (unsigned)(Rb * K + C) * 2u; }
    const size_t kstep = (size_t)(BK * 2);
    const size_t hstep = (size_t)HALF * K * 2;
    const unsigned ldsw = (unsigned)wid * 1024u;
    const int aoff = lds_byte(wr * 64 + fr, fq * 8), boff = lds_byte(wc * 32 + fr, fq * 8);
#define PG8_SA(b, h) (((b) * 2 + (h)) * HTB)
#define PG8_SB(b, h) ((4 + (b) * 2 + (h)) * HTB)
#define PG8_STAGE(bufoff, gbase, voff) do { _Pragma("unroll") for (int _i = 0; _i < 2; ++_i) \
        __builtin_amdgcn_global_load_lds((const unsigned*)((const char*)(gbase) + (voff)[_i]), (LAS unsigned*)(lds + (bufoff) + ldsw + _i * 8192), 16, 0, 0); } while (0)
#define PG8_LDA(dst, b, h) do { _Pragma("unroll") for (int m = 0; m < 4; ++m) _Pragma("unroll") for (int k = 0; k < 2; ++k) dst[m][k] = *(const LAS bf16x8*)(lds + PG8_SA(b, h) + aoff + m * 2048 + k * 1024); } while (0)
#define PG8_LDB(dst, b, h) do { _Pragma("unroll") for (int n = 0; n < 2; ++n) _Pragma("unroll") for (int k = 0; k < 2; ++k) dst[n][k] = *(const LAS bf16x8*)(lds + PG8_SB(b, h) + boff + n * 2048 + k * 1024); } while (0)
#define PG8_MMA(ai, bj, At, Bt) do { __builtin_amdgcn_s_setprio(1); _Pragma("unroll") for (int m = 0; m < 4; ++m) _Pragma("unroll") for (int n = 0; n < 2; ++n) _Pragma("unroll") for (int k = 0; k < 2; ++k) \
        acc[ai][bj][m][n] = __builtin_amdgcn_mfma_f32_16x16x32_bf16(Bt[n][k], At[m][k], acc[ai][bj][m][n], 0, 0, 0); __builtin_amdgcn_s_setprio(0); } while (0)
#define PG8_WAIT_V(n) asm volatile("s_waitcnt vmcnt(" #n ")" ::: "memory")
#define PG8_WAIT_L(n) asm volatile("s_waitcnt lgkmcnt(" #n ")" ::: "memory")
#define PG8_BAR __builtin_amdgcn_s_barrier()
#define PG8_SCHED __builtin_amdgcn_sched_barrier(0)
    Unit cur, nxt; int ui = 0;
    if (!S.next(0, cur)) return;
    f32x4 acc[2][2][4][2];
#pragma unroll
    for (int a = 0; a < 2; ++a)
#pragma unroll
        for (int b = 0; b < 2; ++b)
#pragma unroll
            for (int m = 0; m < 4; ++m)
#pragma unroll
                for (int n = 0; n < 2; ++n) acc[a][b][m][n] = (f32x4){0.f, 0.f, 0.f, 0.f};
    bf16x8 At[4][2], B0[2][2], B1[2][2];
    const char* cA = S.a_ptr(g, cur); const char* cB = S.b_ptr(g, cur);
    PG8_STAGE(PG8_SB(0, 0), cB, voffB); PG8_STAGE(PG8_SA(0, 0), cA, voffA); PG8_STAGE(PG8_SB(0, 1), cB + hstep, voffB); PG8_STAGE(PG8_SA(0, 1), cA + hstep, voffA);
    if (wr == 1) PG8_BAR;
    PG8_WAIT_V(4); PG8_BAR;
    PG8_STAGE(PG8_SB(1, 0), cB + kstep, voffB); PG8_STAGE(PG8_SA(1, 0), cA + kstep, voffA); PG8_STAGE(PG8_SB(1, 1), cB + hstep + kstep, voffB);
    PG8_WAIT_V(6); PG8_BAR;
    for (;;) {
        const bool has_next = S.next(ui + 1, nxt);
        const char* nA = has_next ? S.a_ptr(g, nxt) : cA; const char* nB = has_next ? S.b_ptr(g, nxt) : cB;
        for (int t = 0; t < nt; t += 2) {
            const bool last = (t == nt - 2);
            const char* a1 = cA + (size_t)(t + 1) * kstep;
            const char* a2 = last ? nA : cA + (size_t)(t + 2) * kstep; const char* b2 = last ? nB : cB + (size_t)(t + 2) * kstep;
            const char* a3 = a2 + kstep; const char* b3 = b2 + kstep;
            PG8_LDB(B0, 0, 0); PG8_SCHED; PG8_LDA(At, 0, 0); PG8_STAGE(PG8_SA(1, 1), a1 + hstep, voffA);
            PG8_WAIT_L(8); PG8_BAR; PG8_WAIT_L(0); PG8_MMA(0, 0, At, B0); PG8_BAR; PG8_SCHED;
            PG8_LDB(B1, 0, 1); PG8_STAGE(PG8_SB(0, 0), b2, voffB);
            PG8_BAR; PG8_WAIT_L(0); PG8_MMA(0, 1, At, B1); PG8_BAR;
            PG8_LDA(At, 0, 1); PG8_STAGE(PG8_SA(0, 0), a2, voffA);
            PG8_BAR; PG8_WAIT_L(0); PG8_MMA(1, 0, At, B0); PG8_BAR; PG8_SCHED;
            PG8_STAGE(PG8_SB(0, 1), b2 + hstep, voffB);
            PG8_WAIT_V(6); PG8_BAR; PG8_MMA(1, 1, At, B1); PG8_BAR;
            PG8_LDB(B0, 1, 0); PG8_SCHED; PG8_LDA(At, 1, 0); PG8_STAGE(PG8_SA(0, 1), a2 + hstep, voffA);
            PG8_WAIT_L(8); PG8_BAR; PG8_WAIT_L(0); PG8_MMA(0, 0, At, B0); PG8_BAR; PG8_SCHED;
            PG8_LDB(B1, 1, 1); PG8_STAGE(PG8_SB(1, 0), b3, voffB);
            PG8_BAR; PG8_WAIT_L(0); PG8_MMA(0, 1, At, B1); PG8_BAR;
            PG8_LDA(At, 1, 1); PG8_STAGE(PG8_SA(1, 0), a3, voffA);
            PG8_BAR; PG8_WAIT_L(0); PG8_MMA(1, 0, At, B0); PG8_BAR; PG8_SCHED;
            PG8_STAGE(PG8_SB(1, 1), b3 + hstep, voffB);
            PG8_WAIT_V(6); PG8_BAR; PG8_MMA(1, 1, At, B1); PG8_BAR;
        }
        E(acc, cur, wr, wc, fr, fq);
        if (!has_next) break;
#pragma unroll
        for (int a = 0; a < 2; ++a)
#pragma unroll
            for (int b = 0; b < 2; ++b)
#pragma unroll
                for (int m = 0; m < 4; ++m)
#pragma unroll
                    for (int n = 0; n < 2; ++n) acc[a][b][m][n] = (f32x4){0.f, 0.f, 0.f, 0.f};
        cur = nxt; cA = nA; cB = nB; ++ui;
    }
    PG8_WAIT_V(0);
    if (wr == 0) PG8_BAR;
    PG8_BAR;
#undef PG8_SA
#undef PG8_SB
#undef PG8_STAGE
#undef PG8_LDA
#undef PG8_LDB
#undef PG8_MMA
#undef PG8_WAIT_V
#undef PG8_WAIT_L
#undef PG8_BAR
#undef PG8_SCHED
}
}
constexpr int NTHR = 512;
constexpr int LDS_MAIN = 131072;
constexpr int LDS_BYTES = LDS_MAIN + 256;
struct Args { const float* in[40]; float* out; unsigned char* ws; int ph_lo, ph_hi; };

struct Fr {
    const Args* a; LAS unsigned char* lds; unsigned char* ws; int tid, lane, wave, G, bid; int gwave, nwaves;
};
#define WSP(T, off) ((T*)(F.ws + (off)))
#define INP(i) (F.a->in[i])

DI void tconv(const Fr& F, const float* src, size_t sbs, int ld, int col0, int K, int N, bf16_t* dst, size_t dbs, int nb) {
    LAS float* tile = (LAS float*)F.lds;
    const int tk = K / 64, tn = N / 64, per = tk * tn; const long total = (long)nb * per;
    for (long u = F.bid; u < total; u += F.G) {
        const int b = (int)(u / per), r = (int)(u % per), kt = r / tn, nt_ = r % tn;
        const float* s = src + (size_t)b * sbs + (size_t)(kt * 64) * ld + col0 + nt_ * 64;
        { const int rr = F.tid >> 4, c4 = (F.tid & 15) * 4;
#pragma unroll
          for (int h = 0; h < 2; ++h) { const f32x4 v = *(const f32x4*)(s + (size_t)(rr + 32 * h) * ld + c4); LAS float* tp = tile + (rr + 32 * h) * 65 + c4; tp[0] = v[0]; tp[1] = v[1]; tp[2] = v[2]; tp[3] = v[3]; } }
        __syncthreads();
        { const int n = F.tid >> 3, k8 = (F.tid & 7) * 8; float v[8];
#pragma unroll
          for (int j = 0; j < 8; ++j) v[j] = tile[(k8 + j) * 65 + n];
          u32x4 w; w.x = pk2(v[0], v[1]); w.y = pk2(v[2], v[3]); w.z = pk2(v[4], v[5]); w.w = pk2(v[6], v[7]);
          *(u32x4*)(dst + (size_t)b * dbs + (size_t)(nt_ * 64 + n) * K + kt * 64 + k8) = w; }
        __syncthreads();
    }
}

#ifndef MK_P0_MASK
#define MK_P0_MASK 31
#endif
DI void p0_prologue(const Fr& F) {
    if (MK_P0_MASK & 1) {
    tconv(F, INP(8), 0, EVEN_IN, 0, DM, 2048, WSP(bf16_t, WS_WEVIN), 0, 1);
    tconv(F, INP(8), 0, EVEN_IN, HY_COL, DM, 1536, WSP(bf16_t, WS_WEVIN) + (size_t)2048 * DM, 0, 1);
    tconv(F, INP(9), 0, DM, 0, MIXW, DM, WSP(bf16_t, WS_WEVOUT), 0, 1);
    tconv(F, INP(23), 0, 2048, 0, DM, 2048, WSP(bf16_t, WS_WODIN), 0, 1);
    tconv(F, INP(32), 0, DM, 0, DM, DM, WSP(bf16_t, WS_WODOUT), 0, 1);
    }
    if (MK_P0_MASK & 2) {
    tconv(F, INP(36), (size_t)DM * 2048, 2048, 0, DM, 2048, WSP(bf16_t, WS_WM1), (size_t)2048 * DM, 64);
    tconv(F, INP(38), (size_t)DM * DM, DM, 0, DM, DM, WSP(bf16_t, WS_WM2), (size_t)DM * DM, 64);
    }
    if (MK_P0_MASK & 4) {
        LAS float* sl = (LAS float*)F.lds;
        LAS float* part = sl + 9 * 1024;
        for (int i = F.tid; i < 9 * 1024; i += NTHR) { const int r = i >> 10, k = i & 1023; const float v = (r < 8) ? INP(1)[r * DM + k] : INP(3)[k]; sl[i] = silu_(v); }
        __syncthreads();
        float* MOD = WSP(float, WS_MOD);
        for (int u = F.bid; u < 192; u += F.G) {
            const int l = u / 96, n0 = (u % 96) * 64;
            const float* W = INP(4) + (size_t)l * DM * 6144 + n0 + F.lane;
            float acc[9];
#pragma unroll
            for (int r = 0; r < 9; ++r) acc[r] = 0.f;
#pragma unroll 2
            for (int k = F.wave * 128; k < F.wave * 128 + 128; ++k) { const float w = W[(size_t)k * 6144];
#pragma unroll
                for (int r = 0; r < 9; ++r) acc[r] += sl[r * 1024 + k] * w; }
#pragma unroll
            for (int r = 0; r < 9; ++r) part[(F.wave * 9 + r) * 64 + F.lane] = acc[r];
            __syncthreads();
            for (int i = F.tid; i < 9 * 64; i += NTHR) { const int r = i >> 6, ln = i & 63; float s = INP(5)[(size_t)l * 6144 + n0 + ln];
#pragma unroll
                for (int w = 0; w < 8; ++w) s += part[(w * 9 + r) * 64 + ln];
                MOD[((size_t)l * 9 + r) * 6144 + n0 + ln] = s; }
            __syncthreads();
        }
    }
    if (MK_P0_MASK & 8) {
        float* POS = WSP(float, WS_POS);
        for (int i = F.bid * NTHR + F.tid; i < SEQ * DM; i += F.G * NTHR) {
            const int t = i >> 10, d = i & 1023, q = d >> 8, fi = d & 255;
            const float omega = 1.0f / powf(10000.0f, (float)fi / 256.0f);
            const float p = (q < 2) ? (float)(t >> 6) : (float)(t & 63);
            const float ang = p * omega;
            POS[i] = (q & 1) ? cosf(ang) : sinf(ang);
        }
    }
    if (MK_P0_MASK & 16) {
        LAS float* z = (LAS float*)F.lds; LAS float* h1 = z + 64; LAS float* h2 = h1 + 64; LAS float* h3 = h2 + 64;
        const float MIN_DECAY = -3.0701134573253942f, MAX_DECAY = -15.350567286626972f;
        for (int u = F.bid; u < SEQ + CTXL; u += F.G) {
            const bool isc = u >= SEQ; const int L = isc ? CTXL : SEQ, i = isc ? u - SEQ : u;
            const float t = (float)i / (float)(L - 1);
            const float wpos = 6.283185307179586f * (float)i / (float)L;
            if (F.tid == 0) z[0] = t;
            if (F.tid < 16) { const float fb = 1e-4f + (float)F.tid * ((15.0f - 1e-4f) / 15.0f); z[1 + F.tid] = cosf(fb * wpos); z[17 + F.tid] = -sinf(fb * wpos); }
            __syncthreads();
            if (F.tid < 64) { float s = INP(17)[F.tid];
_Pragma("unroll 3") for (int e = 0; e < 33; ++e) s += z[e] * INP(16)[e * 64 + F.tid]; h1[F.tid] = sinf(INP(21)[F.tid] * s); }
            __syncthreads();
            if (F.tid < 64) { float s = INP(19)[F.tid];
_Pragma("unroll 4") for (int e = 0; e < 64; ++e) s += h1[e] * INP(18)[e * 64 + F.tid]; h2[F.tid] = sinf(INP(21)[F.tid] * s); }
            __syncthreads();
            if (F.tid < 64) { float s = INP(19)[64 + F.tid];
_Pragma("unroll 4") for (int e = 0; e < 64; ++e) s += h2[e] * INP(18)[4096 + e * 64 + F.tid]; h3[F.tid] = sinf(INP(21)[F.tid] * s); }
            __syncthreads();
#pragma unroll 1
            for (int cc = 0; cc < 2; ++cc) { const int col = F.tid + cc * NTHR; float s = 0.f;
_Pragma("unroll 4") for (int e = 0; e < 64; ++e) s += h3[e] * INP(20)[e * 1024 + col];
                const int c = col & 511; const float delta = fabsf(MIN_DECAY + (float)c * ((MAX_DECAY - MIN_DECAY) / 511.0f));
                s *= expf(-t * delta);
                float* dst = (col < 512) ? (isc ? WSP(float, WS_HFC) : WSP(float, WS_HFL)) : (isc ? WSP(float, WS_HBC) : WSP(float, WS_HBL));
                dst[(size_t)i * 512 + c] = s; }
            __syncthreads();
        }
    }
}

DI void p1_mod0(const Fr& F) {
    LAS float* wgt = (LAS float*)F.lds;
    for (int i = F.tid; i < 16 * 1024; i += NTHR) { const int k = i >> 4, g = i & 15; wgt[g * 1024 + k] = INP(8)[(size_t)k * EVEN_IN + DN_GATE_COL + g]; }
    __syncthreads();
    const float* MOD = WSP(float, WS_MOD); const float* POS = WSP(float, WS_POS);
    bf16_t* U = WSP(bf16_t, A0_U); float* GATES = WSP(float, A0_GATES);
    for (int row = F.gwave; row < TT; row += F.nwaves) {
        const bool isc = row >= TL; const int b = isc ? (row - TL) >> 8 : row >> 11; const int t = isc ? 0 : (row & 2047);
        const float* xin = isc ? INP(2) + (size_t)(row - TL) * DM : INP(0) + (size_t)row * DM;
        const float* md = MOD + (size_t)(isc ? 8 : b) * 6144;
        float ga[16];
#pragma unroll
        for (int g = 0; g < 16; ++g) ga[g] = 0.f;
#pragma unroll 1
        for (int i = 0; i < 4; ++i) {
            const int k = i * 256 + F.lane * 4;
            const f32x4 xv = *(const f32x4*)(xin + k), sh = *(const f32x4*)(md + k), sc = *(const f32x4*)(md + 1024 + k);
            f32x4 u = xv * (sc + 1.0f) + sh;
            if (!isc) u += *(const f32x4*)(POS + (size_t)t * DM + k);
            u32x2 w; w.x = pk2(u[0], u[1]); w.y = pk2(u[2], u[3]);
            *(u32x2*)(U + (size_t)row * DM + k) = w;
#pragma unroll
            for (int g = 0; g < 16; ++g) { const f32x4 wv = *(const LAS f32x4*)(wgt + g * 1024 + k); ga[g] += u[0] * wv[0] + u[1] * wv[1] + u[2] * wv[2] + u[3] * wv[3]; }
        }
#pragma unroll
        for (int g = 0; g < 16; ++g) ga[g] = wsum(ga[g]);
        float mine = 0.f;
#pragma unroll
        for (int g = 0; g < 16; ++g) mine = (F.lane == g) ? ga[g] : mine;
        if (F.lane < 16) GATES[(size_t)row * 16 + F.lane] = mine;
    }
}

DI void p3_prep(const Fr& F) {
    const bf16_t* P = WSP(bf16_t, A0_P); const float* GATES = WSP(float, A0_GATES);
    float* QN = WSP(float, A0_QN); float* KN = WSP(float, A0_KN); float* VV = WSP(float, A0_VV);
    float* GG = WSP(float, A0_GG); float* BB = WSP(float, A0_BB);
    const float* cw = INP(10);
    for (int u = F.gwave; u < TT * 4; u += F.nwaves) {
        const int row = u >> 2, h = u & 3;
        const bool isc = row >= TL; const int t = isc ? ((row - TL) & 255) : (row & 2047); const int L = isc ? CTXL : SEQ;
#pragma unroll
        for (int s = 0; s < 3; ++s) {
            const int col = s * 512 + h * 128 + F.lane * 2;
            float a0 = 0.f, a1 = 0.f;
#pragma unroll
            for (int i = 0; i < 4; ++i) { const int tt = t - 2 + i; if (tt >= 0 && tt < L) { const unsigned pv = *(const unsigned*)(P + (size_t)(row - 2 + i) * NP0 + col);
                a0 += cw[i * 1536 + col] * bf2f((bf16_t)(pv & 0xffff)); a1 += cw[i * 1536 + col + 1] * bf2f((bf16_t)(pv >> 16)); } }
            a0 = silu_(a0); a1 = silu_(a1);
            if (s < 2) { const float ss = wsum(a0 * a0 + a1 * a1); float r = rsqrtf(ss + RMS_EPS); if (s == 0) r *= 0.08838834764831845f; a0 *= r; a1 *= r; }
            float* dst = (s == 0 ? QN : (s == 1 ? KN : VV)) + (size_t)row * 512 + h * 128 + F.lane * 2;
            *(f32x2*)dst = (f32x2){a0, a1};
        }
        if (F.lane < 2) { const int d = F.lane;
            const float gd = GATES[(size_t)row * 16 + d * 8 + h], gb = GATES[(size_t)row * 16 + d * 8 + 4 + h];
            GG[((size_t)d * TT + row) * 4 + h] = -expf(INP(11)[d * 4 + h]) * softplus_(gd + INP(12)[d * 4 + h]);
            BB[((size_t)d * TT + row) * 4 + h] = sigm(gb); }
    }
    float* VX = WSP(float, A0_VX); float* X0 = WSP(float, A0_X0);
    const float* hw = INP(14); const float* hb = INP(15);
    for (int i = F.bid * NTHR + F.tid; i < TT * 512; i += F.G * NTHR) {
        const int row = i >> 9, c = i & 511;
        const bool isc = row >= TL; const int t = isc ? ((row - TL) & 255) : (row & 2047); const int L = isc ? CTXL : SEQ;
        float r3[3];
#pragma unroll
        for (int s = 0; s < 3; ++s) { const int ch = s * 512 + c; float a = hb[ch];
#pragma unroll
            for (int j = 0; j < 3; ++j) { const int tt = t - 1 + j; if (tt >= 0 && tt < L) a += hw[j * 1536 + ch] * bf2f(P[(size_t)(row - 1 + j) * NP0 + 2048 + ch]); }
            r3[s] = a; }
        X0[i] = r3[0]; VX[i] = r3[2] * r3[1];
    }
}

DI void dn_chain(const Fr& F, int unit) {
    const int b = unit >> 3, h = (unit >> 1) & 3, d = unit & 1;
    const float* QN = WSP(float, A0_QN); const float* KN = WSP(float, A0_KN); const float* VV = WSP(float, A0_VV);
    const float* GG = WSP(float, A0_GG) + (size_t)d * TT * 4; const float* BB = WSP(float, A0_BB) + (size_t)d * TT * 4;
    float* OD = WSP(float, A0_OD) + (size_t)d * TT * 512;
    LAS float* qs = (LAS float*)F.lds; LAS float* ks = qs + 128; LAS float* vs = ks + 128; LAS float* red1 = vs + 128; LAS float* red2 = red1 + 512; LAS float* scal = red2 + 512;
    const int dv = F.tid & 127, kb = F.tid >> 7;
    float S[32];
#pragma unroll
    for (int i = 0; i < 32; ++i) S[i] = 0.f;
    for (int p = 0; p < CTXL + SEQ; ++p) {
        const int row = row_of(b, d, p);
        if (F.tid < 128) qs[F.tid] = QN[(size_t)row * 512 + h * 128 + F.tid];
        else if (F.tid < 256) ks[F.tid - 128] = KN[(size_t)row * 512 + h * 128 + F.tid - 128];
        else if (F.tid < 384) vs[F.tid - 256] = VV[(size_t)row * 512 + h * 128 + F.tid - 256];
        else if (F.tid == 384) scal[0] = expf(GG[(size_t)row * 4 + h]);
        else if (F.tid == 385) scal[1] = BB[(size_t)row * 4 + h];
        __syncthreads();
        float part = 0.f;
#pragma unroll
        for (int i = 0; i < 32; ++i) part += ks[kb * 32 + i] * S[i];
        red1[kb * 128 + dv] = part;
        __syncthreads();
        const float kS = red1[dv] + red1[128 + dv] + red1[256 + dv] + red1[384 + dv];
        const float eg = scal[0], beta = scal[1];
        const float delta = beta * (vs[dv] - eg * kS);
        float op = 0.f;
#pragma unroll
        for (int i = 0; i < 32; ++i) { S[i] = eg * S[i] + ks[kb * 32 + i] * delta; op += qs[kb * 32 + i] * S[i]; }
        red2[kb * 128 + dv] = op;
        __syncthreads();
        if (kb == 0) OD[(size_t)row * 512 + h * 128 + dv] = red2[dv] + red2[128 + dv] + red2[256 + dv] + red2[384 + dv];
    }
    __syncthreads();
}
DI void hy_conv_unit(const Fr& F, int unit) {
    const bool isc = unit >= 2048; const int v = isc ? unit - 2048 : unit;
    const int ntt = isc ? 4 : 32, L = isc ? CTXL : SEQ;
    const int tt = v % ntt, cb = (v / ntt) & 7, b = v / (ntt * 8);
    const float* HF = isc ? WSP(float, WS_HFC) : WSP(float, WS_HFL); const float* HB = isc ? WSP(float, WS_HBC) : WSP(float, WS_HBL);
    const size_t base = isc ? (size_t)TL + (size_t)b * CTXL : (size_t)b * SEQ;
    const float* VX = WSP(float, A0_VX) + base * 512; float* YH = WSP(float, A0_YH) + base * 512;
    const int c = cb * 64 + (F.tid & 63), T0 = tt * 64 + (F.tid >> 6) * 8;
    float acc[8];
#pragma unroll
    for (int j = 0; j < 8; ++j) acc[j] = 0.f;
    for (int S0 = 0; S0 < L; S0 += 8) {
        const int lb = T0 - S0 - 7; float hwv[15], vv[8];
#pragma unroll
        for (int m = 0; m < 15; ++m) { const int lag = lb + m; hwv[m] = (lag >= 0) ? HF[(size_t)lag * 512 + c] : HB[(size_t)(-lag) * 512 + c]; }
#pragma unroll
        for (int i = 0; i < 8; ++i) vv[i] = VX[(size_t)(S0 + i) * 512 + c];
#pragma unroll
        for (int j = 0; j < 8; ++j)
#pragma unroll
            for (int i = 0; i < 8; ++i) acc[j] += hwv[j - i + 7] * vv[i];
    }
#pragma unroll
    for (int j = 0; j < 8; ++j) YH[(size_t)(T0 + j) * 512 + c] = acc[j];
}
DI void p4_mix_core(const Fr& F) {
    for (int u = F.bid; u < 64 + 2048 + 256; u += F.G) { if (u < 64) dn_chain(F, u); else hy_conv_unit(F, u - 64); }
}

DI void p5_mix(const Fr& F) {
    const float* OD = WSP(float, A0_OD); const bf16_t* P = WSP(bf16_t, A0_P); bf16_t* MIX = WSP(bf16_t, A0_MIX);
    const float* YH = WSP(float, A0_YH); const float* VX = WSP(float, A0_VX); const float* X0 = WSP(float, A0_X0);
    for (int row = F.gwave; row < TT; row += F.nwaves) {
#pragma unroll
        for (int h = 0; h < 4; ++h) {
            const int col = h * 128 + F.lane * 2;
            const f32x2 o0 = *(const f32x2*)(OD + (size_t)row * 512 + col), o1 = *(const f32x2*)(OD + ((size_t)TT + row) * 512 + col);
            const float a0 = o0[0] + o1[0], a1 = o0[1] + o1[1];
            const float ss = wsum(a0 * a0 + a1 * a1); const float r = rsqrtf(ss * (1.0f / 128.0f) + RMS_EPS);
            const unsigned zv = *(const unsigned*)(P + (size_t)row * NP0 + 1536 + col);
            const float z0 = bf2f((bf16_t)(zv & 0xffff)), z1 = bf2f((bf16_t)(zv >> 16));
            const float g0 = INP(13)[F.lane * 2], g1 = INP(13)[F.lane * 2 + 1];
            *(unsigned*)(MIX + (size_t)row * MIXW + col) = pk2(a0 * r * g0 * silu_(z0), a1 * r * g1 * silu_(z1));
        }
#pragma unroll
        for (int i = 0; i < 4; ++i) {
            const int c = i * 128 + F.lane * 2; const size_t o = (size_t)row * 512 + c;
            const f32x2 yh = *(const f32x2*)(YH + o), vx = *(const f32x2*)(VX + o), x0 = *(const f32x2*)(X0 + o);
            const float s0 = INP(22)[c], s1 = INP(22)[c + 1];
            *(unsigned*)(MIX + (size_t)row * MIXW + 512 + c) = pk2(x0[0] * (yh[0] + vx[0] * s0), x0[1] * (yh[1] + vx[1] * s1));
        }
    }
}

template <int LAYER>
DI void p7_ln_route(const Fr& F, const float* xres_lat, const float* xres_ctx, const float* Y, int nrows) {
    const float* MOD = WSP(float, WS_MOD) + (size_t)LAYER * 9 * 6144;
    float* X1 = WSP(float, WS_X1); bf16_t* VB = WSP(bf16_t, WS_VB);
    int* RI = WSP(int, WS_RI); float* RW = WSP(float, WS_RW);
    unsigned* CNT = WSP(unsigned, WS_CTL) + CW_CNT + LAYER * 32;
    const float* lng = INP(6) + (size_t)(LAYER * 2 + 0) * DM; const float* lnb = INP(7) + (size_t)(LAYER * 2 + 0) * DM;
    const float* rw = INP(34) + (size_t)LAYER * DM * NEXP; const float* rb = INP(35) + LAYER * NEXP;
    LAS float* vrow = (LAS float*)F.lds + F.wave * 2048;
    for (int rp = F.gwave; rp < nrows / 2; rp += F.nwaves) {
#pragma unroll
        for (int rr = 0; rr < 2; ++rr) {
            const int row = rp * 2 + rr; const bool isc = row >= TL; const int b = isc ? (row - TL) >> 8 : row >> 11;
            const float* xr = isc ? xres_ctx + (size_t)(row - TL) * DM : xres_lat + (size_t)row * DM;
            const float* md = MOD + (size_t)(isc ? 8 : b) * 6144;
            f32x4 y[4]; float s = 0.f;
#pragma unroll
            for (int i = 0; i < 4; ++i) { const int k = i * 256 + F.lane * 4;
                y[i] = *(const f32x4*)(xr + k) * ALPHA + *(const f32x4*)(md + 2048 + k) * *(const f32x4*)(Y + (size_t)row * DM + k);
                s += (y[i][0] + y[i][1]) + (y[i][2] + y[i][3]); }
            const float mu = wsum(s) * (1.0f / 1024.0f); float q = 0.f;
#pragma unroll
            for (int i = 0; i < 4; ++i) { const f32x4 dd = y[i] - mu; q += (dd[0] * dd[0] + dd[1] * dd[1]) + (dd[2] * dd[2] + dd[3] * dd[3]); }
            const float rstd = rsqrtf(wsum(q) * (1.0f / 1024.0f) + LN_EPS);
#pragma unroll
            for (int i = 0; i < 4; ++i) { const int k = i * 256 + F.lane * 4;
                const f32x4 x1 = (y[i] - mu) * rstd * *(const f32x4*)(lng + k) + *(const f32x4*)(lnb + k);
                *(f32x4*)(X1 + (size_t)row * DM + k) = x1;
                const f32x4 v = x1 * (*(const f32x4*)(md + 4096 + k) + 1.0f) + *(const f32x4*)(md + 3072 + k);
                u32x2 w; w.x = pk2(v[0], v[1]); w.y = pk2(v[2], v[3]);
                *(u32x2*)(VB + (size_t)row * DM + k) = w;
                *(LAS f32x4*)(vrow + rr * 1024 + k) = v; }
        }
        const int hf = F.lane >> 5, e = F.lane & 31; const int row = rp * 2 + hf;
        float lg = rb[e];
        const LAS float* vr = vrow + hf * 1024;
#pragma unroll 8
        for (int k = 0; k < 1024; ++k) lg += vr[k] * rw[k * NEXP + e];
        float val = lg; float sv[4]; int si[4];
#pragma unroll
        for (int kk = 0; kk < 4; ++kk) {
            float bv = val; int bi = e;
#pragma unroll
            for (int off = 16; off >= 1; off >>= 1) { const float ov = __shfl_xor(bv, off); const int oi = __shfl_xor(bi, off); if (ov > bv || (ov == bv && oi < bi)) { bv = ov; bi = oi; } }
            sv[kk] = bv; si[kk] = bi; if (e == bi) val = -3.0e38f;
        }
        const float e1 = __expf(sv[1] - sv[0]), e2 = __expf(sv[2] - sv[0]), e3 = __expf(sv[3] - sv[0]); const float inv = 1.0f / (1.0f + e1 + e2 + e3);
        if (e == 0) {
            *(int4*)(RI + (size_t)row * 4) = make_int4(si[0], si[1], si[2], si[3]);
            *(f32x4*)(RW + (size_t)row * 4) = (f32x4){inv, e1 * inv, e2 * inv, e3 * inv};
            atomicAdd(CNT + si[0], 1u); atomicAdd(CNT + si[1], 1u); atomicAdd(CNT + si[2], 1u); atomicAdd(CNT + si[3], 1u);
        }
    }
}

template <int LAYER>
DI void p8_assign(const Fr& F, int nrows) {
    const unsigned* CNT = WSP(unsigned, WS_CTL) + CW_CNT + LAYER * 32; unsigned* CUR = WSP(unsigned, WS_CTL) + CW_CUR + LAYER * 32; unsigned* NT = WSP(unsigned, WS_CTL) + CW_NT + LAYER;
    LAS int* offs = (LAS int*)F.lds;
    if (F.tid == 0) { int o = 0; for (int e = 0; e < NEXP; ++e) { offs[e] = o; o += (int)((CNT[e] + 255u) & ~255u); } offs[32] = o; }
    __syncthreads();
    int* TILE_E = WSP(int, WS_TILEE); const int ntile = offs[32] >> 8;
    if (F.bid == 0) { for (int tl = F.tid; tl < ntile; tl += NTHR) { int e = 0; while (e < 31 && offs[e + 1] <= tl * 256) ++e; TILE_E[tl] = e; } if (F.tid == 0) *NT = (unsigned)ntile; }
    bf16_t* VBG = WSP(bf16_t, WS_VBG); const bf16_t* VB = WSP(bf16_t, WS_VB);
    for (int e = F.bid; e < NEXP; e += F.G) { const int r0 = offs[e] + (int)CNT[e], r1 = offs[e + 1];
        for (int r = r0 + F.wave; r < r1; r += 8) { u32x4 zz = (u32x4){0u, 0u, 0u, 0u}; *(u32x4*)(VBG + (size_t)r * DM + F.lane * 8) = zz; *(u32x4*)(VBG + (size_t)r * DM + 512 + F.lane * 8) = zz; } }
    const int* RI = WSP(int, WS_RI); int* SP = WSP(int, WS_SP);
    for (int row = F.gwave; row < nrows; row += F.nwaves) {
        const u32x4 v0 = *(const u32x4*)(VB + (size_t)row * DM + F.lane * 8), v1 = *(const u32x4*)(VB + (size_t)row * DM + 512 + F.lane * 8);
#pragma unroll
        for (int k = 0; k < 4; ++k) {
            const int e = RI[(size_t)row * 4 + k]; int pos = 0;
            if (F.lane == 0) pos = offs[e] + (int)atomicAdd(CUR + e, 1u);
            pos = __shfl(pos, 0);
            *(u32x4*)(VBG + (size_t)pos * DM + F.lane * 8) = v0; *(u32x4*)(VBG + (size_t)pos * DM + 512 + F.lane * 8) = v1;
            if (F.lane == 0) SP[(size_t)row * 4 + k] = pos;
        }
    }
}

template <int LAYER>
DI void p11_combine(const Fr& F, int nrows, float* xout) {
    const float* MOD = WSP(float, WS_MOD) + (size_t)LAYER * 9 * 6144;
    const float* X1 = WSP(float, WS_X1); const bf16_t* YS = WSP(bf16_t, WS_YS);
    const int* SP = WSP(int, WS_SP); const float* RW = WSP(float, WS_RW);
    const float* lng = INP(6) + (size_t)(LAYER * 2 + 1) * DM; const float* lnb = INP(7) + (size_t)(LAYER * 2 + 1) * DM;
    const float* MODN = WSP(float, WS_MOD) + (size_t)1 * 9 * 6144; const float* POS = WSP(float, WS_POS); bf16_t* UN = WSP(bf16_t, A1_U);
    for (int row = F.gwave; row < nrows; row += F.nwaves) {
        const bool isc = row >= TL; const int b = isc ? (row - TL) >> 8 : row >> 11;
        const float* md = MOD + (size_t)(isc ? 8 : b) * 6144;
        const int4 sp = *(const int4*)(SP + (size_t)row * 4); const f32x4 rw = *(const f32x4*)(RW + (size_t)row * 4);
        const int spa[4] = {sp.x, sp.y, sp.z, sp.w};
        f32x4 y[4]; float s = 0.f;
#pragma unroll
        for (int i = 0; i < 4; ++i) { const int k = i * 256 + F.lane * 4; f32x4 f = (f32x4){0.f, 0.f, 0.f, 0.f};
#pragma unroll
            for (int j = 0; j < 4; ++j) { const u32x2 w = *(const u32x2*)(YS + (size_t)spa[j] * DM + k);
                f += (f32x4){__uint_as_float(w.x << 16), __uint_as_float(w.x & 0xffff0000u), __uint_as_float(w.y << 16), __uint_as_float(w.y & 0xffff0000u)} * rw[j]; }
            y[i] = *(const f32x4*)(X1 + (size_t)row * DM + k) * ALPHA + *(const f32x4*)(md + 5120 + k) * f;
            s += (y[i][0] + y[i][1]) + (y[i][2] + y[i][3]); }
        const float mu = wsum(s) * (1.0f / 1024.0f); float q = 0.f;
#pragma unroll
        for (int i = 0; i < 4; ++i) { const f32x4 dd = y[i] - mu; q += (dd[0] * dd[0] + dd[1] * dd[1]) + (dd[2] * dd[2] + dd[3] * dd[3]); }
        const float rstd = rsqrtf(wsum(q) * (1.0f / 1024.0f) + LN_EPS);
#pragma unroll
        for (int i = 0; i < 4; ++i) { const int k = i * 256 + F.lane * 4;
            const f32x4 x2 = (y[i] - mu) * rstd * *(const f32x4*)(lng + k) + *(const f32x4*)(lnb + k);
            *(f32x4*)(xout + (size_t)row * DM + k) = x2;
            if (LAYER == 0) {
                const float* mn = MODN + (size_t)(isc ? 8 : b) * 6144;
                f32x4 u = x2 * (*(const f32x4*)(mn + 1024 + k) + 1.0f) + *(const f32x4*)(mn + k);
                if (!isc) u += *(const f32x4*)(POS + (size_t)(row & 2047) * DM + k);
                u32x2 w; w.x = pk2(u[0], u[1]); w.y = pk2(u[2], u[3]);
                *(u32x2*)(UN + (size_t)row * DM + k) = w;
            } }
    }
}

DI void p13_lru_conv(const Fr& F) {
    const float* P1 = WSP(float, A1_P); float* XC = WSP(float, A1_XC); const float* cw = INP(25); const float* cb = INP(26);
    for (int i = F.bid * NTHR + F.tid; i < TT * DM; i += F.G * NTHR) {
        const int row = i >> 10, c = i & 1023; const bool isc = row >= TL; const int t = isc ? ((row - TL) & 255) : (row & 2047); const int L = isc ? CTXL : SEQ;
        float a = cb[c];
#pragma unroll
        for (int j = 0; j < 4; ++j) { const int tt = t - 2 + j; if (tt >= 0 && tt < L) a += cw[j * DM + c] * P1[(size_t)(row - 2 + j) * 2048 + c]; }
        XC[i] = a;
    }
}
DI void p14_lru_gates(const Fr& F) {
    const float* XC = WSP(float, A1_XC); float* LA = WSP(float, A1_LA); float* LB = WSP(float, A1_LB);
    for (int u = F.bid * NTHR + F.tid; u < (TT / 4) * DM; u += F.G * NTHR) {
        const int col = u & 1023, r0 = (u >> 10) * 4, h = col >> 8, j = col & 255;
        float acc[4][4];
#pragma unroll
        for (int r = 0; r < 4; ++r)
#pragma unroll
            for (int g = 0; g < 4; ++g) acc[r][g] = 0.f;
        const float* wa0 = INP(27) + ((size_t)(0 * 4 + h) * 256) * 256 + j; const float* wa1 = INP(27) + ((size_t)(1 * 4 + h) * 256) * 256 + j;
        const float* wx0 = INP(29) + ((size_t)(0 * 4 + h) * 256) * 256 + j; const float* wx1 = INP(29) + ((size_t)(1 * 4 + h) * 256) * 256 + j;
        const float* xr = XC + (size_t)r0 * DM + h * 256;
        for (int i = 0; i < 256; ++i) {
            const float w0 = wa0[(size_t)i * 256], w1 = wa1[(size_t)i * 256], w2 = wx0[(size_t)i * 256], w3 = wx1[(size_t)i * 256];
#pragma unroll
            for (int r = 0; r < 4; ++r) { const float x = xr[(size_t)r * DM + i]; acc[r][0] += x * w0; acc[r][1] += x * w1; acc[r][2] += x * w2; acc[r][3] += x * w3; }
        }
#pragma unroll
        for (int d = 0; d < 2; ++d) {
            const float sp = softplus_(INP(31)[d * DM + col]), ba = INP(28)[d * DM + col], bx = INP(30)[d * DM + col];
#pragma unroll
            for (int r = 0; r < 4; ++r) {
                const float rg = sigm(acc[r][d] + ba), ig = sigm(acc[r][2 + d] + bx);
                const float log_a = -8.0f * rg * sp; const float x = XC[(size_t)(r0 + r) * DM + col];
                LA[((size_t)d * TT + r0 + r) * DM + col] = expf(log_a);
                LB[((size_t)d * TT + r0 + r) * DM + col] = sqrtf(-expm1f(2.0f * log_a)) * (ig * x);
            }
        }
    }
}
DI void p15_lru_scan(const Fr& F) {
    const float* LA = WSP(float, A1_LA); const float* LB = WSP(float, A1_LB); float* HS = WSP(float, A1_HS);
    for (int u = F.bid * NTHR + F.tid; u < NB * 2 * DM; u += F.G * NTHR) {
        const int col = u & 1023, d = (u >> 10) & 1, b = u >> 11;
        float hst = 0.f;
        for (int p = 0; p < CTXL + SEQ; ++p) { const int row = row_of(b, d, p);
            hst = LA[((size_t)d * TT + row) * DM + col] * hst + LB[((size_t)d * TT + row) * DM + col];
            if (p >= CTXL) HS[((size_t)d * TL + row) * DM + col] = hst; }
    }
}
DI void p16_lru_gate(const Fr& F) {
    const float* HS = WSP(float, A1_HS); const float* P1 = WSP(float, A1_P); bf16_t* HG = WSP(bf16_t, A1_HG);
    for (int i = F.bid * NTHR + F.tid; i < TL * DM / 2; i += F.G * NTHR) {
        const int row = i >> 9, c = (i & 511) * 2;
        const f32x2 h0 = *(const f32x2*)(HS + (size_t)row * DM + c), h1 = *(const f32x2*)(HS + ((size_t)TL + row) * DM + c), gt = *(const f32x2*)(P1 + (size_t)row * 2048 + 1024 + c);
        *(unsigned*)(HG + (size_t)row * DM + c) = pk2((h0[0] + h1[0]) * gelu_tanh(gt[0]), (h0[1] + h1[1]) * gelu_tanh(gt[1]));
    }
}
constexpr int NPH = 23;
__global__ void __launch_bounds__(NTHR, 2) mk_fwd(Args args) {
    extern __shared__ __attribute__((aligned(16))) unsigned char lds_raw[];
    Fr F;
    F.a = &args; F.lds = (LAS unsigned char*)lds_raw; F.ws = args.ws;
    F.tid = threadIdx.x; F.lane = F.tid & 63; F.wave = __builtin_amdgcn_readfirstlane(F.tid >> 6); F.G = gridDim.x; F.bid = blockIdx.x;
    F.gwave = F.bid * 8 + F.wave; F.nwaves = F.G * 8;
    volatile LAS unsigned* xbw = (volatile LAS unsigned*)(F.lds + LDS_MAIN);
    if (F.tid < 4) xbw[F.tid] = 0u;
    __syncthreads();
#if MK_ONE_LAUNCH
    XcdBarrier bar = xcd_barrier_post(WSP(unsigned, WS_CTL) + CW_BAR, xbw);
#define GRID_BAR() xcd_barrier(bar)
#else
#define GRID_BAR() do {} while (0)
#endif
    const int lo = args.ph_lo, hi = args.ph_hi;
#ifndef MK_PH_MASK
#define MK_PH_MASK 0xFFFFFFFFu
#endif
#define IN(k) (((MK_PH_MASK >> (k)) & 1u) && lo <= (k) && (k) < hi)
#define SEAM(k) do { if (IN((k) + 1)) { GRID_BAR(); } } while (0)
    LAS unsigned char* glds = F.lds;

    if (IN(0)) { p0_prologue(F); SEAM(0); }
    if (IN(1)) { p1_mod0(F); SEAM(1); }
    if (IN(2)) {
        __syncthreads();
        pg8::Gemm g{WSP(bf16_t, A0_U), WSP(bf16_t, WS_WEVIN), TT, NP0, DM}; pg8::StaticOrder S; S.init(TT, NP0, F.G, F.bid);
        pg8::EpiBf16 E{WSP(bf16_t, A0_P), NP0, nullptr, 0};
        pg8::gemm_phase(glds, g, S, E); SEAM(2);
    }
    if (IN(3)) { p3_prep(F); SEAM(3); }
    if (IN(4)) { __syncthreads(); p4_mix_core(F); SEAM(4); }
    if (IN(5)) { p5_mix(F); SEAM(5); }
    if (IN(6)) {
        __syncthreads();
        pg8::Gemm g{WSP(bf16_t, A0_MIX), WSP(bf16_t, WS_WEVOUT), TT, DM, MIXW}; pg8::StaticOrder S; S.init(TT, DM, F.G, F.bid);
        pg8::EpiF32 E{WSP(float, A0_Y), DM, nullptr};
        pg8::gemm_phase(glds, g, S, E); SEAM(6);
    }
    if (IN(7)) { __syncthreads(); p7_ln_route<0>(F, INP(0), INP(2), WSP(float, A0_Y), TT); SEAM(7); }
    if (IN(8)) { __syncthreads(); p8_assign<0>(F, TT); SEAM(8); }
    if (IN(9)) {
        __syncthreads();
        const int ntm = (int)WSP(unsigned, WS_CTL)[CW_NT + 0];
        pg8::Gemm g{WSP(bf16_t, WS_VBG), WSP(bf16_t, WS_WM1), ntm * 256, 2048, DM}; pg8::MoeOrder S{WSP(int, WS_TILEE), ntm, 8, F.G, F.bid};
        pg8::EpiSwiglu E{WSP(bf16_t, WS_ACT), DM, INP(37), 2048};
        pg8::gemm_phase(glds, g, S, E); SEAM(9);
    }
    if (IN(10)) {
        __syncthreads();
        const int ntm = (int)WSP(unsigned, WS_CTL)[CW_NT + 0];
        pg8::Gemm g{WSP(bf16_t, WS_ACT), WSP(bf16_t, WS_WM2), ntm * 256, DM, DM}; pg8::MoeOrder S{WSP(int, WS_TILEE), ntm, 4, F.G, F.bid};
        pg8::EpiBf16 E{WSP(bf16_t, WS_YS), DM, INP(39), DM};
        pg8::gemm_phase(glds, g, S, E); SEAM(10);
    }
    if (IN(11)) { p11_combine<0>(F, TT, WSP(float, WS_X2)); SEAM(11); }
    if (IN(12)) {
        __syncthreads();
        pg8::Gemm g{WSP(bf16_t, A1_U), WSP(bf16_t, WS_WODIN), TT, 2048, DM}; pg8::StaticOrder S; S.init(TT, 2048, F.G, F.bid);
        pg8::EpiF32 E{WSP(float, A1_P), 2048, INP(24)};
        pg8::gemm_phase(glds, g, S, E); SEAM(12);
    }
    if (IN(13)) { p13_lru_conv(F); SEAM(13); }
    if (IN(14)) { p14_lru_gates(F); SEAM(14); }
    if (IN(15)) { p15_lru_scan(F); SEAM(15); }
    if (IN(16)) { p16_lru_gate(F); SEAM(16); }
    if (IN(17)) {
        __syncthreads();
        pg8::Gemm g{WSP(bf16_t, A1_HG), WSP(bf16_t, WS_WODOUT), TL, DM, DM}; pg8::StaticOrder S; S.init(TL, DM, F.G, F.bid);
        pg8::EpiF32 E{WSP(float, A1_Y), DM, INP(33)};
        pg8::gemm_phase(glds, g, S, E); SEAM(17);
    }
    if (IN(18)) { __syncthreads(); p7_ln_route<1>(F, WSP(float, WS_X2), WSP(float, WS_X2) + (size_t)TL * DM, WSP(float, A1_Y), TL); SEAM(18); }
    if (IN(19)) { __syncthreads(); p8_assign<1>(F, TL); SEAM(19); }
    if (IN(20)) {
        __syncthreads();
        const int ntm = (int)WSP(unsigned, WS_CTL)[CW_NT + 1];
        pg8::Gemm g{WSP(bf16_t, WS_VBG), WSP(bf16_t, WS_WM1) + (size_t)32 * 2048 * DM, ntm * 256, 2048, DM}; pg8::MoeOrder S{WSP(int, WS_TILEE), ntm, 8, F.G, F.bid};
        pg8::EpiSwiglu E{WSP(bf16_t, WS_ACT), DM, INP(37) + (size_t)32 * 2048, 2048};
        pg8::gemm_phase(glds, g, S, E); SEAM(20);
    }
    if (IN(21)) {
        __syncthreads();
        const int ntm = (int)WSP(unsigned, WS_CTL)[CW_NT + 1];
        pg8::Gemm g{WSP(bf16_t, WS_ACT), WSP(bf16_t, WS_WM2) + (size_t)32 * DM * DM, ntm * 256, DM, DM}; pg8::MoeOrder S{WSP(int, WS_TILEE), ntm, 4, F.G, F.bid};
        pg8::EpiBf16 E{WSP(bf16_t, WS_YS), DM, INP(39) + (size_t)32 * DM, DM};
        pg8::gemm_phase(glds, g, S, E); SEAM(21);
    }
    if (IN(22)) { p11_combine<1>(F, TL, args.out); }
#undef IN
#undef SEAM
}

extern "C" void kernel_launch(void* const* d_in, const int* in_sizes, int n_in, void* d_out, int out_size, void* d_ws, size_t ws_size, hipStream_t stream) {
    static int grid = 0;
    if (grid == 0) {
        static const int exp_sizes[40] = {16777216, 8192, 2097152, 1024, 12582912, 12288, 4096, 4096, 3686400, 1048576, 6144, 8, 8, 128, 4608, 1536, 2112, 64, 8192, 128, 65536, 64, 512,
            2097152, 2048, 4096, 1024, 524288, 2048, 524288, 2048, 2048, 1048576, 1024, 65536, 64, 134217728, 131072, 67108864, 65536};
        bool ok_sizes = (n_in == 40);
        for (int i = 0; ok_sizes && i < 40; ++i) if (in_sizes[i] != exp_sizes[i]) { fprintf(stderr, "kernel_launch: input %d has %d elements, expected %d\n", i, in_sizes[i], exp_sizes[i]); ok_sizes = false; }
        if (!ok_sizes || out_size != TL * DM || ws_size < WS_END) { fprintf(stderr, "kernel_launch: unexpected shapes: n_in %d out %d ws %zu (need %zu)\n", n_in, out_size, ws_size, (size_t)WS_END); grid = -1; return; }
        int dev = 0, cus = 0, per_cu = 0;
        if (hipGetDevice(&dev) != hipSuccess || hipDeviceGetAttribute(&cus, hipDeviceAttributeMultiprocessorCount, dev) != hipSuccess) { grid = -1; return; }
        if (hipFuncSetAttribute((const void*)mk_fwd, hipFuncAttributeMaxDynamicSharedMemorySize, LDS_BYTES) != hipSuccess) { fprintf(stderr, "kernel_launch: hipFuncSetAttribute failed\n"); grid = -1; return; }
        if (hipOccupancyMaxActiveBlocksPerMultiprocessor(&per_cu, (const void*)mk_fwd, NTHR, LDS_BYTES) != hipSuccess || per_cu < 1) { fprintf(stderr, "kernel_launch: occupancy query says %d\n", per_cu); }
        (void)hipGetLastError();
        grid = cus;
    }
    if (grid < 0) return;
    (void)hipMemsetAsync((char*)d_ws + WS_CTL, 0, CTL_BYTES, stream);
    Args a{};
    for (int i = 0; i < 40; ++i) a.in[i] = (const float*)d_in[i];
    a.out = (float*)d_out; a.ws = (unsigned char*)d_ws;
#if MK_ONE_LAUNCH
    a.ph_lo = 0; a.ph_hi = NPH;
    hipLaunchKernelGGL(mk_fwd, dim3(grid), dim3(NTHR), LDS_BYTES, stream, a);
#else
#ifndef MK_MAXPH
#define MK_MAXPH NPH
#endif
    for (int p = 0; p < MK_MAXPH; ++p) { a.ph_lo = p; a.ph_hi = p + 1; hipLaunchKernelGGL(mk_fwd, dim3(grid), dim3(NTHR), LDS_BYTES, stream, a); }
#endif
}
```

```cpp
#include <hip/hip_runtime.h>
#include <cstdio>
#include <cstdint>

#ifndef MK_ONE_LAUNCH
#define MK_ONE_LAUNCH 1
#endif

#define LAS __attribute__((address_space(3)))
#define DI __device__ __forceinline__
typedef unsigned short bf16_t;
typedef float f32x4 __attribute__((ext_vector_type(4)));
typedef float f32x2 __attribute__((ext_vector_type(2)));
typedef unsigned u32x4 __attribute__((ext_vector_type(4)));
typedef unsigned u32x2 __attribute__((ext_vector_type(2)));

constexpr int DM = 1024, NB = 8, SEQ = 2048, CTXL = 256;
constexpr int TL = NB * SEQ;
constexpr int TC = NB * CTXL;
constexpr int TT = TL + TC;
constexpr int EVEN_IN = 3600, DN_GATE_COL = 2048, HY_COL = 2064;
constexpr int NP0 = 3584;
constexpr int MIXW = 1024;
constexpr int NEXP = 32, TOPK = 4;
constexpr int MOE_ROWS = 82176;
constexpr float ALPHA = 1.4142135623730951f;
constexpr float LN_EPS = 1e-5f, RMS_EPS = 1e-6f;

constexpr size_t al(size_t x) { return (x + 255) & ~(size_t)255; }
constexpr size_t WS_CTL   = 0;
constexpr size_t WS_MOD   = 65536;
constexpr size_t WS_POS   = WS_MOD + al((size_t)2 * 9 * 6144 * 4);
constexpr size_t WS_HFL   = WS_POS + (size_t)SEQ * DM * 4;
constexpr size_t WS_HBL   = WS_HFL + (size_t)SEQ * 512 * 4;
constexpr size_t WS_HFC   = WS_HBL + (size_t)SEQ * 512 * 4;
constexpr size_t WS_HBC   = WS_HFC + (size_t)CTXL * 512 * 4;
constexpr size_t WS_WEVIN = WS_HBC + (size_t)CTXL * 512 * 4;
constexpr size_t WS_WEVOUT= WS_WEVIN + (size_t)NP0 * DM * 2;
constexpr size_t WS_WODIN = WS_WEVOUT + (size_t)DM * MIXW * 2;
constexpr size_t WS_WODOUT= WS_WODIN + (size_t)2048 * DM * 2;
constexpr size_t WS_WLRU  = WS_WODOUT + (size_t)DM * DM * 2;
constexpr size_t WS_BLRU  = WS_WLRU + (size_t)4096 * 256 * 2;
constexpr size_t WS_RWT   = WS_BLRU + 8192 * 4;
constexpr size_t WS_WGT   = WS_RWT + (size_t)2 * 32 * 1024 * 4;
constexpr size_t WS_HID   = WS_WGT + (size_t)16 * 1024 * 4;
constexpr size_t WS_WM1   = WS_HID + (size_t)(SEQ + CTXL) * 64 * 4;
constexpr size_t WS_WM2   = WS_WM1 + (size_t)64 * 2048 * DM * 2;
constexpr size_t WS_X1    = WS_WM2 + (size_t)64 * DM * DM * 2;
constexpr size_t WS_X2    = WS_X1 + (size_t)TT * DM * 4;
constexpr size_t WS_VB    = WS_X2 + (size_t)TT * DM * 4;
constexpr size_t WS_RI    = WS_VB + (size_t)TT * DM * 2;
constexpr size_t WS_RW    = WS_RI + (size_t)TT * 16;
constexpr size_t WS_SP    = WS_RW + (size_t)TT * 16;
constexpr size_t WS_TILEE = WS_SP + (size_t)TT * 16;
constexpr size_t WS_BC    = WS_TILEE + 4096;
constexpr size_t WS_VBG   = WS_BC + (size_t)2 * 1024 * 32 * 4;
constexpr size_t WS_ACT   = WS_VBG + (size_t)MOE_ROWS * DM * 2;
constexpr size_t WS_YS    = WS_ACT + (size_t)MOE_ROWS * DM * 2;
constexpr size_t WS_ARENA = WS_YS + (size_t)MOE_ROWS * DM * 2;
constexpr size_t A0_U     = WS_ARENA;
constexpr size_t A0_P     = A0_U + (size_t)TT * DM * 2;
constexpr size_t A0_GATES = A0_P + (size_t)TT * NP0 * 2;
constexpr size_t A0_QN    = A0_GATES + (size_t)TT * 64;
constexpr size_t A0_KN    = A0_QN + (size_t)TT * 512 * 4;
constexpr size_t A0_VV    = A0_KN + (size_t)TT * 512 * 4;
constexpr size_t A0_GG    = A0_VV + (size_t)TT * 512 * 4;
constexpr size_t A0_BB    = A0_GG + (size_t)2 * TT * 16;
constexpr size_t A0_OD    = A0_BB + (size_t)2 * TT * 16;
constexpr size_t A0_VX    = A0_OD + (size_t)2 * TT * 512 * 4;
constexpr size_t A0_X0    = A0_VX + (size_t)TT * 512 * 4;
constexpr size_t A0_YH    = A0_X0 + (size_t)TT * 512 * 4;
constexpr size_t A0_MIX   = A0_YH + (size_t)TT * 512 * 4;
constexpr size_t A0_Y     = A0_MIX + (size_t)TT * MIXW * 2;
constexpr size_t A0_QB    = A0_Y + (size_t)TT * DM * 4;
constexpr size_t A0_KB    = A0_QB + (size_t)TT * 512 * 2;
constexpr size_t A0_VB3   = A0_KB + (size_t)TT * 512 * 2;
constexpr int    DN_CU    = NB * 4 * 2 * 36;
constexpr size_t A0_WQ    = A0_VB3 + (size_t)TT * 512 * 2;
constexpr size_t A0_KDT   = A0_WQ + (size_t)DN_CU * 32768;
constexpr size_t A0_ATT   = A0_KDT + (size_t)DN_CU * 16384;
constexpr size_t A0_UU    = A0_ATT + (size_t)DN_CU * 8192;
constexpr size_t A0_GL    = A0_UU + (size_t)DN_CU * 32768;
constexpr size_t A0_VXTL  = A0_GL + al((size_t)DN_CU * 4);
constexpr size_t A0_VXTC  = A0_VXTL + (size_t)512 * TL * 2;
constexpr size_t A0_YHTL  = A0_VXTC + (size_t)512 * TC * 2;
constexpr size_t A0_YHTC  = A0_YHTL + (size_t)512 * TL * 4;
constexpr size_t A0_END   = A0_YHTC + (size_t)512 * TC * 4;
constexpr size_t A1_U     = WS_ARENA;
constexpr size_t A1_P     = A1_U + (size_t)TT * DM * 2;
constexpr size_t A1_XC    = A1_P + (size_t)TT * 2048 * 4;
constexpr size_t A1_XCB   = A1_XC + (size_t)TT * DM * 4;
constexpr size_t A1_RG    = A1_XCB + (size_t)TT * DM * 2;
constexpr size_t A1_HS    = A1_RG + (size_t)TT * 4096 * 2;
constexpr size_t A1_HG    = A1_HS + (size_t)2 * TL * DM * 4;
constexpr size_t A1_Y     = A1_HG + (size_t)TL * DM * 2;
constexpr size_t A1_END   = A1_Y + (size_t)TL * DM * 4;
constexpr size_t WS_END   = (A0_END > A1_END ? A0_END : A1_END);

constexpr int CW_BAR = 0;
constexpr int CW_CNT = 4096;
constexpr int CW_CUR = 4096 + 64;
constexpr int CW_NT  = 4096 + 128;
constexpr int CW_TQ  = 4096 + 192;
constexpr size_t CTL_BYTES = 65536;

DI float bf2f(bf16_t b) { return __uint_as_float(((unsigned)b) << 16); }
typedef __bf16 bf16x2_t __attribute__((ext_vector_type(2)));
DI unsigned pk2(float lo, float hi) { const f32x2 v = {lo, hi}; return __builtin_bit_cast(unsigned, __builtin_convertvector(v, bf16x2_t)); }
DI bf16_t f2bf(float f) { return (bf16_t)(pk2(f, 0.f) & 0xffffu); }
DI unsigned pk4_fp8(float a, float b, float c, float d) { int w = 0; w = __builtin_amdgcn_cvt_pk_fp8_f32(a, b, w, false); w = __builtin_amdgcn_cvt_pk_fp8_f32(c, d, w, true); return (unsigned)w; }
#ifndef MK_FP8_L1
#define MK_FP8_L1 1
#endif
#ifndef MK_FP8_L0
#define MK_FP8_L0 1
#endif
constexpr float W1_F8S = 32.0f, W2_F8S = 64.0f;
DI float sigm(float x) { return __builtin_amdgcn_rcpf(1.0f + __expf(-x)); }
DI float silu_(float x) { return x * sigm(x); }
DI float softplus_(float x) { return fmaxf(x, 0.f) + log1pf(__expf(-fabsf(x))); }
DI float gelu_tanh(float x) { return x * sigm(1.5957691216057308f * (x + 0.044715f * x * x * x)); }
DI float wsum(float v) { v += __shfl_xor(v, 32); v += __shfl_xor(v, 16); v += __shfl_xor(v, 8); v += __shfl_xor(v, 4); v += __shfl_xor(v, 2); v += __shfl_xor(v, 1); return v; }

DI int row_of(int b, int d, int p) {
    if (p < CTXL) return TL + b * CTXL + (d ? (CTXL - 1 - p) : p);
    const int q = p - CTXL; return b * SEQ + (d ? (SEQ - 1 - q) : q);
}
static_assert(WS_END <= (size_t)2147483648ull, "workspace map exceeds 4x the largest tensor");
#define XB_TMO      128
#define XB_XCNT(j)  (256  + 64 * (j))
#define XB_XSUB(j)  (1280 + 64 * (j))
#define XB_XGEN(j)  (2304 + 64 * (j))
#define XB_TOP      3328
#define XB_TOPGEN   3392
#define XCD_BAR_WORDS 3456
#define XB_SPIN_CAP (1u << 18)

__device__ __forceinline__ unsigned xb_ld(unsigned* p)              { return __hip_atomic_load(p, __ATOMIC_RELAXED, __HIP_MEMORY_SCOPE_AGENT); }
__device__ __forceinline__ unsigned xb_add(unsigned* p, unsigned v) { return __hip_atomic_fetch_add(p, v, __ATOMIC_RELAXED, __HIP_MEMORY_SCOPE_AGENT); }
__device__ __forceinline__ unsigned xb_xcc_id() { return (unsigned)__builtin_amdgcn_s_getreg((3 << 11) | 20) & 0xFu; }
#define XB_SPIN(cond, bar) do { unsigned _sp = 0; while (cond) { __builtin_amdgcn_s_sleep(1); \
    if ((++_sp & 255u) == 0u) { if (xb_ld(&(bar)[XB_TMO])) break; if (_sp > XB_SPIN_CAP) { atomicAdd(&(bar)[XB_TMO], 1u); break; } } } } while (0)

struct XcdBarrier {
    unsigned* bar; unsigned x;
    volatile LAS unsigned* st;
};

__device__ __forceinline__ XcdBarrier xcd_barrier_post(unsigned* bar, volatile LAS unsigned* st) {
    XcdBarrier b; b.bar = bar; b.x = xb_xcc_id(); b.st = st;
    if (threadIdx.x == 0) (void)xb_add(&bar[XB_XCNT(b.x)], 1u);
    return b;
}
__device__ __forceinline__ void xcd_barrier_complete(unsigned* bar, unsigned x, unsigned& nloc, unsigned& nx) {
    const unsigned G = gridDim.x * gridDim.y * gridDim.z;
    unsigned sum, cnt, mine, sp = 0u;
    for (;;) {
        sum = 0u; cnt = 0u; mine = 0u;
#pragma unroll
        for (unsigned j = 0; j < 16; ++j) { const unsigned c = xb_ld(&bar[XB_XCNT(j)]); sum += c; cnt += (c > 0u) ? 1u : 0u; mine = (j == x) ? c : mine; }
        if (sum == G) break;
        __builtin_amdgcn_s_sleep(1);
        if ((++sp & 255u) == 0u) { if (xb_ld(&bar[XB_TMO])) break; if (sp > XB_SPIN_CAP) { atomicAdd(&bar[XB_TMO], 1u); break; } }
    }
    nloc = mine > 0u ? mine : 1u; nx = cnt > 0u ? cnt : 1u;
}

__device__ __forceinline__ void xcd_barrier(const XcdBarrier& b) {
    asm volatile("s_waitcnt vmcnt(0)" ::: "memory");
    __syncthreads();
    if (threadIdx.x == 0) {
        unsigned* bar = b.bar;
        __builtin_amdgcn_s_waitcnt(0);
        unsigned nloc = b.st[0], nx = b.st[1];
        if (nloc == 0u) { xcd_barrier_complete(bar, b.x, nloc, nx); b.st[0] = nloc; b.st[1] = nx; }
        const unsigned old = xb_add(&bar[XB_XSUB(b.x)], 1u);
        const unsigned gen = old / nloc;
        if (old + 1u == (gen + 1u) * nloc) {
            __builtin_amdgcn_fence(__ATOMIC_RELEASE, "agent");
            asm volatile("s_waitcnt vmcnt(0)" ::: "memory");
            const unsigned og = xb_add(&bar[XB_TOP], 1u);
            const unsigned tg = og / nx;
            if (og + 1u == (tg + 1u) * nx) xb_add(&bar[XB_TOPGEN], 1u);
            else XB_SPIN(xb_ld(&bar[XB_TOPGEN]) == tg, bar);
            __builtin_amdgcn_fence(__ATOMIC_ACQUIRE, "agent");
            xb_add(&bar[XB_XGEN(b.x)], 1u);
            asm volatile("s_waitcnt vmcnt(0)" ::: "memory");
        } else {
            XB_SPIN(xb_ld(&bar[XB_XGEN(b.x)]) == gen, bar);
            __builtin_amdgcn_fence(__ATOMIC_ACQUIRE, "agent");
            asm volatile("s_waitcnt vmcnt(0)" ::: "memory");
        }
    }
    __syncthreads();
}

namespace pg8 {
typedef short bf16x8 __attribute__((ext_vector_type(8)));
constexpr int BM = 256, BK = 64, HALF = 128, HTB = HALF * BK * 2, STAGE_BYTES = 8 * HTB, NXCD = 8, WGM = 8;

__host__ __device__ __forceinline__ int lds_byte(int r, int c) { const int st = (r >> 4) * 2 + (c >> 5), rr = r & 15, cc = c & 31, ob = rr * 64 + cc * 2; return st * 1024 + (ob ^ (((ob >> 9) & 1) << 5)); }
__host__ __device__ __forceinline__ void stage_rc(int b, int& R, int& C) { const int st = b / 1024, sb = b % 1024, swz = sb ^ (((sb >> 9) & 1) << 5); R = (st >> 1) * 16 + swz / 64; C = (st & 1) * 32 + (swz % 64) / 2; }
__host__ __device__ __forceinline__ int perm32(int rho) { const int n = rho >> 4, i = rho & 15; return 8 * (i >> 2) + 4 * n + (i & 3); }

struct Unit { int pm, pn, e; };
struct Gemm { const bf16_t* A; const bf16_t* Bt; int M, N, K, lda; };

struct StaticOrder {
    int nM, nN, nwg, G, c;
    __device__ void init(int M, int N, int G_, int c_) { nM = M / BM; nN = N / BM; nwg = nM * nN; G = G_; c = c_; }
    __device__ bool next(int i, Unit& u) const {
        const long L = (long)i * G + c; if (L >= nwg) return false;
        int wgid = (int)L; { const int q = nwg / NXCD, r = nwg % NXCD, xcd = wgid % NXCD, off = wgid / NXCD; wgid = (xcd < r ? xcd * (q + 1) : r * (q + 1) + (xcd - r) * q) + off; }
        const int nig = WGM * nN, gid = wgid / nig, fm = gid * WGM, gsz = (nM - fm) < WGM ? (nM - fm) : WGM;
        u.pm = fm + ((wgid % nig) % gsz); u.pn = (wgid % nig) / gsz; u.e = 0; return true;
    }
    __device__ __forceinline__ const char* a_ptr(const Gemm& g, const Unit& u) const { return (const char*)g.A + (size_t)u.pm * BM * g.lda * 2; }
    __device__ __forceinline__ const char* b_ptr(const Gemm& g, const Unit& u) const { return (const char*)g.Bt + (size_t)u.pn * BM * g.K * 2; }
};
struct LruOrder : StaticOrder {
    __device__ __forceinline__ const char* a_ptr(const Gemm& g, const Unit& u) const { return (const char*)g.A + (size_t)u.pm * BM * g.lda * 2 + (size_t)((u.pn >> 1) & 3) * 512; }
};
struct MoeOrder {
    const int* tile_e; int ntm, nN, G, c;
    __device__ bool next(int i, Unit& u) const {
        if ((G & 7) == 0 && ((G >> 3) % nN) == 0) {
            const int x = c & 7, s = c >> 3, mpr = (G >> 3) / nN;
            u.pm = i * (8 * mpr) + x * mpr + s / nN; u.pn = s % nN; if (u.pm >= ntm) return false;
        } else { const long L = (long)i * G + c; if (L >= (long)ntm * nN) return false; u.pm = (int)(L / nN); u.pn = (int)(L % nN); }
        u.e = tile_e[u.pm]; return true;
    }
    __device__ __forceinline__ const char* a_ptr(const Gemm& g, const Unit& u) const { return (const char*)g.A + (size_t)u.pm * BM * g.lda * 2; }
    __device__ __forceinline__ const char* b_ptr(const Gemm& g, const Unit& u) const { return (const char*)g.Bt + ((size_t)u.e * g.N + (size_t)u.pn * BM) * g.K * 2; }
};

__device__ __forceinline__ unsigned cvt_pk_bf16(float lo, float hi) { return pk2(lo, hi); }

struct EpiF32 {
    static constexpr bool PERM = false;
    float* C; int ldc; const float* bias;
    __device__ __forceinline__ void operator()(const f32x4 (&acc)[2][2][4][2], const Unit& u, int wr, int wc, int fr, int fq) const {
        const int row0 = u.pm * BM + wr * 64 + fr, col0 = u.pn * BM + wc * 32 + 4 * fq;
        f32x4 bv[2][2];
#pragma unroll
        for (int bj = 0; bj < 2; ++bj)
#pragma unroll
            for (int n = 0; n < 2; ++n) bv[bj][n] = bias ? *(const f32x4*)(bias + col0 + bj * HALF + n * 16) : (f32x4){0.f, 0.f, 0.f, 0.f};
#pragma unroll
        for (int ai = 0; ai < 2; ++ai)
#pragma unroll
            for (int m = 0; m < 4; ++m) { float* rowp = C + (size_t)(row0 + ai * HALF + m * 16) * ldc + col0;
#pragma unroll
                for (int bj = 0; bj < 2; ++bj)
#pragma unroll
                    for (int n = 0; n < 2; ++n) *(f32x4*)(rowp + bj * HALF + n * 16) = acc[ai][bj][m][n] + bv[bj][n]; }
    }
};
struct EpiBf16 {
    static constexpr bool PERM = true;
    bf16_t* O; int ldc; const float* bias; int bias_estride; float scale = 1.0f;
    __device__ __forceinline__ void operator()(const f32x4 (&acc)[2][2][4][2], const Unit& u, int wr, int wc, int fr, int fq) const {
        const int row0 = u.pm * BM + wr * 64 + fr; const int col0 = u.pn * BM + wc * 32 + 8 * fq;
        f32x4 bv[2][2];
#pragma unroll
        for (int bj = 0; bj < 2; ++bj)
#pragma unroll
            for (int n = 0; n < 2; ++n) bv[bj][n] = bias ? *(const f32x4*)(bias + (size_t)u.e * bias_estride + col0 + bj * HALF + 4 * n) : (f32x4){0.f, 0.f, 0.f, 0.f};
#pragma unroll
        for (int ai = 0; ai < 2; ++ai)
#pragma unroll
            for (int m = 0; m < 4; ++m) { bf16_t* rowp = O + (size_t)(row0 + ai * HALF + m * 16) * ldc + col0;
#pragma unroll
                for (int bj = 0; bj < 2; ++bj) { const f32x4 v0 = acc[ai][bj][m][0] * scale + bv[bj][0], v1 = acc[ai][bj][m][1] * scale + bv[bj][1];
                    u32x4 w; w.x = cvt_pk_bf16(v0[0], v0[1]); w.y = cvt_pk_bf16(v0[2], v0[3]); w.z = cvt_pk_bf16(v1[0], v1[1]); w.w = cvt_pk_bf16(v1[2], v1[3]);
                    *(u32x4*)(rowp + bj * HALF) = w; } }
    }
};
__device__ __forceinline__ float sigm_fast(float x) { return __builtin_amdgcn_rcpf(1.0f + __expf(-x)); }
__device__ __forceinline__ unsigned cvt_pk_bf16_trans(float lo, float hi) { return pk2(lo, hi); }
struct EpiSigmoid {
    static constexpr bool PERM = true;
    bf16_t* O; int ldc; const float* bias;
    __device__ __forceinline__ void operator()(const f32x4 (&acc)[2][2][4][2], const Unit& u, int wr, int wc, int fr, int fq) const {
        const int row0 = u.pm * BM + wr * 64 + fr; const int col0 = u.pn * BM + wc * 32 + 8 * fq;
#pragma unroll
        for (int bj = 0; bj < 2; ++bj) {
            const f32x4 b0 = *(const f32x4*)(bias + col0 + bj * HALF), b1 = *(const f32x4*)(bias + col0 + bj * HALF + 4);
#pragma unroll
            for (int ai = 0; ai < 2; ++ai)
#pragma unroll
                for (int m = 0; m < 4; ++m) { bf16_t* rowp = O + (size_t)(row0 + ai * HALF + m * 16) * ldc + col0 + bj * HALF;
                    const f32x4 v0 = acc[ai][bj][m][0] + b0, v1 = acc[ai][bj][m][1] + b1; u32x4 w;
                    w.x = cvt_pk_bf16_trans(sigm_fast(v0[0]), sigm_fast(v0[1])); w.y = cvt_pk_bf16_trans(sigm_fast(v0[2]), sigm_fast(v0[3]));
                    w.z = cvt_pk_bf16_trans(sigm_fast(v1[0]), sigm_fast(v1[1])); w.w = cvt_pk_bf16_trans(sigm_fast(v1[2]), sigm_fast(v1[3]));
                    *(u32x4*)rowp = w; asm volatile("" ::: "memory"); }
        }
    }
};
struct EpiLruAB {
    static constexpr bool PERM = true;
    unsigned* AB; const float* bias; const float* sp8; const bf16_t* xcb; int rows;
    __device__ __forceinline__ void operator()(const f32x4 (&acc)[2][2][4][2], const Unit& u, int wr, int wc, int fr, int fq) const {
        const int row0 = u.pm * BM + wr * 64 + fr;
#pragma unroll
        for (int bj = 0; bj < 2; ++bj) {
            const int n0 = u.pn * BM + bj * HALF + wc * 32 + 8 * fq; const int d = n0 >> 11, ch = ((n0 >> 9) & 3) * 256 + ((n0 & 511) >> 1);
            const f32x4 b0 = *(const f32x4*)(bias + n0), b1 = *(const f32x4*)(bias + n0 + 4), sp = *(const f32x4*)(sp8 + d * 1024 + ch);
#pragma unroll
            for (int ai = 0; ai < 2; ++ai)
#pragma unroll
                for (int m = 0; m < 4; ++m) { const int row = row0 + ai * HALF + m * 16;
                    const f32x4 v0 = acc[ai][bj][m][0] + b0, v1 = acc[ai][bj][m][1] + b1;
                    const u32x2 xr = *(const u32x2*)(xcb + (size_t)row * 1024 + ch);
                    const float x0 = __uint_as_float(xr.x << 16), x1 = __uint_as_float(xr.x & 0xffff0000u), x2 = __uint_as_float(xr.y << 16), x3 = __uint_as_float(xr.y & 0xffff0000u);
                    float la[4], cc[4]; const float rr_[4] = {v0[0], v0[2], v1[0], v1[2]}, ii_[4] = {v0[1], v0[3], v1[1], v1[3]}, xx_[4] = {x0, x1, x2, x3};
#pragma unroll
                    for (int q = 0; q < 4; ++q) { const float dr = 1.0f + __expf(-rr_[q]), di = 1.0f + __expf(-ii_[q]); const float R = __builtin_amdgcn_rcpf(dr * di);
                        la[q] = sp[q] * (R * di); const float a = __expf(la[q]); cc[q] = __builtin_amdgcn_sqrtf(fmaxf(1.0f - a * a, 0.f)) * ((R * dr) * xx_[q]); }
                    const float la0 = la[0], la1 = la[1], la2 = la[2], la3 = la[3], c0 = cc[0], c1 = cc[1], c2 = cc[2], c3 = cc[3];
                    u32x4 w; w.x = cvt_pk_bf16(la0, c0); w.y = cvt_pk_bf16(la1, c1); w.z = cvt_pk_bf16(la2, c2); w.w = cvt_pk_bf16(la3, c3);
                    *(u32x4*)(AB + ((size_t)d * rows + row) * 1024 + ch) = w; asm volatile("" ::: "memory"); }
        }
    }
};
__device__ __forceinline__ float swiglu_(float g, float l) {
    const float glu = fminf(g, 7.0f), lin = fminf(fmaxf(l, -7.0f), 7.0f);
    return glu * __builtin_amdgcn_rcpf(1.0f + __expf(-1.702f * glu)) * (lin + 1.0f);
}
__device__ __forceinline__ f32x2 swiglu2_(f32x2 g, f32x2 l) {
    const f32x2 glu = __builtin_elementwise_min(g, (f32x2){7.0f, 7.0f});
    const f32x2 lin = __builtin_elementwise_min(__builtin_elementwise_max(l, (f32x2){-7.0f, -7.0f}), (f32x2){7.0f, 7.0f});
    const f32x2 t = glu * (-1.702f * 1.4426950408889634f);
    f32x2 e; e.x = __builtin_amdgcn_exp2f(t.x); e.y = __builtin_amdgcn_exp2f(t.y);
    const f32x2 d = e + 1.0f;
    f32x2 r; r.x = __builtin_amdgcn_rcpf(d.x); r.y = __builtin_amdgcn_rcpf(d.y);
    return glu * r * (lin + 1.0f);
}
struct EpiSwiglu {
    static constexpr bool PERM = true;
    bf16_t* O; int ldo; const float* bias; int bias_estride;
    __device__ __forceinline__ void operator()(const f32x4 (&acc)[2][2][4][2], const Unit& u, int wr, int wc, int fr, int fq) const {
        const int row0 = u.pm * BM + wr * 64 + fr; const int col0 = u.pn * BM + wc * 32 + 8 * fq;
        f32x4 bv[2][2];
#pragma unroll
        for (int bj = 0; bj < 2; ++bj)
#pragma unroll
            for (int n = 0; n < 2; ++n) bv[bj][n] = *(const f32x4*)(bias + (size_t)u.e * bias_estride + col0 + bj * HALF + 4 * n);
#pragma unroll
        for (int ai = 0; ai < 2; ++ai)
#pragma unroll
            for (int m = 0; m < 4; ++m) { bf16_t* rowp = O + (size_t)(row0 + ai * HALF + m * 16) * ldo + (col0 >> 1);
#pragma unroll
                for (int bj = 0; bj < 2; ++bj) { const f32x4 v0 = acc[ai][bj][m][0] + bv[bj][0], v1 = acc[ai][bj][m][1] + bv[bj][1];
                    const f32x2 s0 = swiglu2_((f32x2){v0[0], v0[2]}, (f32x2){v0[1], v0[3]}), s1 = swiglu2_((f32x2){v1[0], v1[2]}, (f32x2){v1[1], v1[3]});
                    u32x2 w; w.x = cvt_pk_bf16(s0.x, s0.y); w.y = cvt_pk_bf16(s1.x, s1.y);
                    *(u32x2*)(rowp + bj * (HALF / 2)) = w; } }
    }
};

typedef int v8i_t __attribute__((ext_vector_type(8)));
typedef int v4i_t __attribute__((ext_vector_type(4)));
struct Frag2 { bf16x8 k[2]; };
template <class Epi, class Sched, bool FP8 = false>
__device__ __forceinline__ void gemm_phase(LAS unsigned char* lds, const Gemm g, const Sched& S, const Epi& E) {
    const int tid = threadIdx.x, wid = __builtin_amdgcn_readfirstlane(tid >> 6), lane = tid & 63, wr = wid >> 2, wc = wid & 3, fr = lane & 15, fq = lane >> 4;
    const int K = g.K, nt = K / BK;
    unsigned voffA[2], voffB[2];
#pragma unroll
    for (int i = 0; i < 2; ++i) { int R, C; stage_rc(tid * 16 + i * 8192, R, C); const int Rb = Epi::PERM ? ((R & ~31) + perm32(R & 31)) : R;
        voffA[i] = (unsigned)(R * g.lda + C) * 2u; voffB[i] = (unsigned)(Rb * K + C) * 2u; }
    const size_t kstep = (size_t)(BK * 2);
    const size_t hstep = (size_t)HALF * K * 2, hstepA = (size_t)HALF * g.lda * 2;
    const unsigned ldsw = (unsigned)wid * 1024u;
    const int aoff = lds_byte(wr * 64 + fr, fq * 8), boff = lds_byte(wc * 32 + fr, fq * 8);
#define PG8_SA(b, h) (((b) * 2 + (h)) * HTB)
#define PG8_SB(b, h) ((4 + (b) * 2 + (h)) * HTB)
#define PG8_STAGE(bufoff, gbase, voff) do { _Pragma("unroll") for (int _i = 0; _i < 2; ++_i) \
        __builtin_amdgcn_global_load_lds((const unsigned*)((const char*)(gbase) + (voff)[_i]), (LAS unsigned*)(lds + (bufoff) + ldsw + _i * 8192), 16, 0, 0); } while (0)
#define PG8_LD2(p) __builtin_shufflevector(*(const LAS v4i_t*)(p), *(const LAS v4i_t*)((p) + 1024), 0, 1, 2, 3, 4, 5, 6, 7)
#define PG8_LDA(dst, b, h) do { _Pragma("unroll") for (int m = 0; m < 4; ++m) { if constexpr (FP8) dst##8[m] = PG8_LD2(lds + PG8_SA(b, h) + aoff + m * 2048); \
        else { _Pragma("unroll") for (int k = 0; k < 2; ++k) dst[m].k[k] = *(const LAS bf16x8*)(lds + PG8_SA(b, h) + aoff + m * 2048 + k * 1024); } } } while (0)
#define PG8_LDB(dst, b, h) do { _Pragma("unroll") for (int n = 0; n < 2; ++n) { if constexpr (FP8) dst##8[n] = PG8_LD2(lds + PG8_SB(b, h) + boff + n * 2048); \
        else { _Pragma("unroll") for (int k = 0; k < 2; ++k) dst[n].k[k] = *(const LAS bf16x8*)(lds + PG8_SB(b, h) + boff + n * 2048 + k * 1024); } } } while (0)
#define PG8_MMA(ai, bj, At, Bt) do { __builtin_amdgcn_s_setprio(1); _Pragma("unroll") for (int m = 0; m < 4; ++m) _Pragma("unroll") for (int n = 0; n < 2; ++n) { \
        if constexpr (FP8) asm volatile("v_mfma_scale_f32_16x16x128_f8f6f4 %0, %1, %2, %0, %3, %3 op_sel_hi:[0,0,0]" : "+v"(acc[ai][bj][m][n]) : "v"(Bt##8[n]), "v"(At##8[m]), "v"(f8scale)); \
        else { _Pragma("unroll") for (int k = 0; k < 2; ++k) acc[ai][bj][m][n] = __builtin_amdgcn_mfma_f32_16x16x32_bf16(Bt[n].k[k], At[m].k[k], acc[ai][bj][m][n], 0, 0, 0); } } \
        __builtin_amdgcn_s_setprio(0); } while (0)
#define PG8_WAIT_V(n) asm volatile("s_waitcnt vmcnt(" #n ")" ::: "memory")
#define PG8_WAIT_L(n) asm volatile("s_waitcnt lgkmcnt(" #n ")" ::: "memory")
#define PG8_BAR __builtin_amdgcn_s_barrier()
#define PG8_SCHED __builtin_amdgcn_sched_barrier(0)
    Unit cur, nxt; int ui = 0;
    if (!S.next(0, cur)) return;
    f32x4 acc[2][2][4][2];
#pragma unroll
    for (int a = 0; a < 2; ++a)
#pragma unroll
        for (int b = 0; b < 2; ++b)
#pragma unroll
            for (int m = 0; m < 4; ++m)
#pragma unroll
                for (int n = 0; n < 2; ++n) acc[a][b][m][n] = (f32x4){0.f, 0.f, 0.f, 0.f};
    Frag2 At[4], B0[2], B1[2]; v8i_t At8[4], B08[2], B18[2];
    int f8scale = 0x7f7f7f7f; asm volatile("" : "+v"(f8scale));
    const char* cA = S.a_ptr(g, cur); const char* cB = S.b_ptr(g, cur);
    PG8_STAGE(PG8_SB(0, 0), cB, voffB); PG8_STAGE(PG8_SA(0, 0), cA, voffA); PG8_STAGE(PG8_SB(0, 1), cB + hstep, voffB); PG8_STAGE(PG8_SA(0, 1), cA + hstepA, voffA);
    if (wr == 1) PG8_BAR;
    PG8_WAIT_V(4); PG8_BAR;
    PG8_STAGE(PG8_SB(1, 0), cB + kstep, voffB); PG8_STAGE(PG8_SA(1, 0), cA + kstep, voffA); PG8_STAGE(PG8_SB(1, 1), cB + hstep + kstep, voffB);
    PG8_WAIT_V(6); PG8_BAR;
    for (;;) {
        const bool has_next = S.next(ui + 1, nxt);
        const char* nA = has_next ? S.a_ptr(g, nxt) : cA; const char* nB = has_next ? S.b_ptr(g, nxt) : cB;
#pragma unroll 1
        for (int t = 0; t < nt; t += 2) {
            const bool last = (t == nt - 2);
            const char* a1 = cA + (size_t)(t + 1) * kstep;
            const char* a2 = last ? nA : cA + (size_t)(t + 2) * kstep; const char* b2 = last ? nB : cB + (size_t)(t + 2) * kstep;
            const char* a3 = a2 + kstep; const char* b3 = b2 + kstep;
            PG8_LDB(B0, 0, 0); PG8_SCHED; PG8_LDA(At, 0, 0); PG8_STAGE(PG8_SA(1, 1), a1 + hstepA, voffA);
            PG8_WAIT_L(8); PG8_BAR; PG8_WAIT_L(0); PG8_MMA(0, 0, At, B0); PG8_BAR; PG8_SCHED;
            PG8_LDB(B1, 0, 1); PG8_STAGE(PG8_SB(0, 0), b2, voffB);
            PG8_BAR; PG8_WAIT_L(0); PG8_MMA(0, 1, At, B1); PG8_BAR;
            PG8_LDA(At, 0, 1); PG8_STAGE(PG8_SA(0, 0), a2, voffA);
            PG8_BAR; PG8_WAIT_L(0); PG8_MMA(1, 0, At, B0); PG8_BAR; PG8_SCHED;
            PG8_STAGE(PG8_SB(0, 1), b2 + hstep, voffB);
            PG8_WAIT_V(6); PG8_BAR; PG8_MMA(1, 1, At, B1); PG8_BAR;
            PG8_LDB(B0, 1, 0); PG8_SCHED; PG8_LDA(At, 1, 0); PG8_STAGE(PG8_SA(0, 1), a2 + hstepA, voffA);
            PG8_WAIT_L(8); PG8_BAR; PG8_WAIT_L(0); PG8_MMA(0, 0, At, B0); PG8_BAR; PG8_SCHED;
            PG8_LDB(B1, 1, 1); PG8_STAGE(PG8_SB(1, 0), b3, voffB);
            PG8_BAR; PG8_WAIT_L(0); PG8_MMA(0, 1, At, B1); PG8_BAR;
            PG8_LDA(At, 1, 1); PG8_STAGE(PG8_SA(1, 0), a3, voffA);
            PG8_BAR; PG8_WAIT_L(0); PG8_MMA(1, 0, At, B0); PG8_BAR; PG8_SCHED;
            PG8_STAGE(PG8_SB(1, 1), b3 + hstep, voffB);
            PG8_WAIT_V(6); PG8_BAR; PG8_MMA(1, 1, At, B1); PG8_BAR;
        }
        if constexpr (FP8) asm volatile("s_nop 15\n\ts_nop 15" ::: "memory");
        E(acc, cur, wr, wc, fr, fq);
        if (!has_next) break;
#pragma unroll
        for (int a = 0; a < 2; ++a)
#pragma unroll
            for (int b = 0; b < 2; ++b)
#pragma unroll
                for (int m = 0; m < 4; ++m)
#pragma unroll
                    for (int n = 0; n < 2; ++n) acc[a][b][m][n] = (f32x4){0.f, 0.f, 0.f, 0.f};
        cur = nxt; cA = nA; cB = nB; ++ui;
    }
    PG8_WAIT_V(0);
    if (wr == 0) PG8_BAR;
    PG8_BAR;
#undef PG8_SA
#undef PG8_SB
#undef PG8_STAGE
#undef PG8_LD2
#undef PG8_LDA
#undef PG8_LDB
#undef PG8_MMA
#undef PG8_WAIT_V
#undef PG8_WAIT_L
#undef PG8_BAR
#undef PG8_SCHED
}
struct EpiSwigluF8 {
    static constexpr bool PERM = true;
    unsigned char* O; int ldo; const float* bias; int bias_estride; float scale;
    __device__ __forceinline__ void operator()(const f32x4 (&acc)[2][2][4][2], const Unit& u, int wr, int wc, int fr, int fq) const {
        const int row0 = u.pm * BM + wr * 64 + fr; const int col0 = u.pn * BM + wc * 32 + 8 * fq;
        f32x4 bv[2][2];
#pragma unroll
        for (int bj = 0; bj < 2; ++bj)
#pragma unroll
            for (int n = 0; n < 2; ++n) bv[bj][n] = *(const f32x4*)(bias + (size_t)u.e * bias_estride + col0 + bj * HALF + 4 * n);
#pragma unroll
        for (int ai = 0; ai < 2; ++ai)
#pragma unroll
            for (int m = 0; m < 4; ++m) { unsigned char* rowp = O + (size_t)(row0 + ai * HALF + m * 16) * ldo + (col0 >> 1);
#pragma unroll
                for (int bj = 0; bj < 2; ++bj) { const f32x4 v0 = acc[ai][bj][m][0] * scale + bv[bj][0], v1 = acc[ai][bj][m][1] * scale + bv[bj][1];
                    const f32x2 s0 = swiglu2_((f32x2){v0[0], v0[2]}, (f32x2){v0[1], v0[3]}), s1 = swiglu2_((f32x2){v1[0], v1[2]}, (f32x2){v1[1], v1[3]});
                    *(unsigned*)(rowp + bj * (HALF / 2)) = pk4_fp8(s0.x, s0.y, s1.x, s1.y); } }
    }
};
}
constexpr int NTHR = 512;
constexpr int LDS_MAIN = 131072;
constexpr int LDS_CTL_OFF = 8 * 64 * 65 * 4;
constexpr int LDS_BYTES = LDS_CTL_OFF + 256;
struct Args { const float* in[40]; float* out; unsigned char* ws; int ph_lo, ph_hi; int flags, pad; };

struct Fr {
    const Args* a; LAS unsigned char* lds; unsigned char* ws; int tid, lane, wave, G, bid; int gwave, nwaves;
};
#define WSP(T, off) ((T*)(F.ws + (off)))
#define INP(i) (F.a->in[i])

typedef float f32x16 __attribute__((ext_vector_type(16)));
typedef short bf16x8v __attribute__((ext_vector_type(8)));
#define MFMA32(a, b, c) __builtin_amdgcn_mfma_f32_32x32x16_bf16((a), (b), (c), 0, 0, 0)
DI int crow(int reg, int h) { return (reg & 3) + 8 * (reg >> 2) + 4 * h; }
DI int afrag_off(int m, int k, int nks) { return ((m >> 5) * nks + (k >> 4)) * 1024 + ((m & 31) + 32 * ((k >> 3) & 1)) * 16 + (k & 7) * 2; }
DI f32x16 zero16() { f32x16 z;
#pragma unroll
    for (int i = 0; i < 16; ++i) z[i] = 0.f; return z; }
DI bf16x8v scale8(u32x4 raw, const float (&s)[8], bool rev) {
    float v[8];
    v[0] = __uint_as_float(raw.x << 16); v[1] = __uint_as_float(raw.x & 0xffff0000u); v[2] = __uint_as_float(raw.y << 16); v[3] = __uint_as_float(raw.y & 0xffff0000u);
    v[4] = __uint_as_float(raw.z << 16); v[5] = __uint_as_float(raw.z & 0xffff0000u); v[6] = __uint_as_float(raw.w << 16); v[7] = __uint_as_float(raw.w & 0xffff0000u);
    u32x4 o;
    if (!rev) { o.x = pk2(v[0] * s[0], v[1] * s[1]); o.y = pk2(v[2] * s[2], v[3] * s[3]); o.z = pk2(v[4] * s[4], v[5] * s[5]); o.w = pk2(v[6] * s[6], v[7] * s[7]); }
    else      { o.x = pk2(v[7] * s[0], v[6] * s[1]); o.y = pk2(v[5] * s[2], v[4] * s[3]); o.z = pk2(v[3] * s[4], v[2] * s[5]); o.w = pk2(v[1] * s[6], v[0] * s[7]); }
    return __builtin_bit_cast(bf16x8v, o);
}

constexpr int DA_QS = 0, DA_KS = 17408, DA_KT = 34816, DA_VT = 53248, DA_AF = 71680, DA_AR = 89088, DA_TF = 106496, DA_TR = 115712, DA_SC = 124928;
constexpr int DA_RS = 272, DA_TS = 144;

DI void dnA_unit(const Fr& F, int unit) {
    const int tc = unit % 36, h = (unit / 36) & 3, b = unit / 144;
    const int row0 = (tc < 4) ? TL + b * CTXL + tc * 64 : b * SEQ + (tc - 4) * 64;
    LAS unsigned char* L = F.lds;
    LAS float* sc = (LAS float*)(L + DA_SC);
    int lane = F.lane, w = F.wave, r = lane & 31, hh = lane >> 5;
#define DN_RELAUNDER() do { int tz_ = threadIdx.x; asm volatile("" : "+v"(tz_)); lane = tz_ & 63; r = lane & 31; hh = lane >> 5; } while (0)
    {
        const bf16_t* P = WSP(bf16_t, A0_P); const float* cw = INP(10);
        const bool isc = tc < 4; const int Lq = isc ? CTXL : SEQ; const int t0 = (isc ? tc * 64 : (tc - 4) * 64) + w * 8, rowb = row0 + w * 8;
        unsigned praw[3][11];
#pragma unroll
        for (int s = 0; s < 3; ++s)
#pragma unroll
            for (int rr = 0; rr < 11; ++rr) { const int tl = t0 + rr - 2; praw[s][rr] = (tl >= 0 && tl < Lq) ? *(const unsigned*)(P + (size_t)(rowb + rr - 2) * NP0 + s * 512 + h * 128 + lane * 2) : 0u; }
#pragma unroll
        for (int s = 0; s < 3; ++s) {
            const int col = s * 512 + h * 128 + lane * 2;
            float w0[4], w1[4];
#pragma unroll
            for (int i = 0; i < 4; ++i) { w0[i] = cw[i * 1536 + col]; w1[i] = cw[i * 1536 + col + 1]; }
            float p0[11], p1[11];
#pragma unroll
            for (int rr = 0; rr < 11; ++rr) { p0[rr] = __uint_as_float(praw[s][rr] << 16); p1[rr] = __uint_as_float(praw[s][rr] & 0xffff0000u); }
#pragma unroll
            for (int j = 0; j < 8; ++j) {
                float a0 = w0[0] * p0[j] + w0[1] * p0[j + 1] + w0[2] * p0[j + 2] + w0[3] * p0[j + 3];
                float a1 = w1[0] * p1[j] + w1[1] * p1[j + 1] + w1[2] * p1[j + 2] + w1[3] * p1[j + 3];
                a0 = silu_(a0); a1 = silu_(a1);
                if (s < 2) { const float ss = wsum(a0 * a0 + a1 * a1); float rn = rsqrtf(ss + RMS_EPS); if (s == 0) rn *= 0.08838834764831845f; a0 *= rn; a1 *= rn; }
                const int i = w * 8 + j; const unsigned pk = pk2(a0, a1);
                if (s == 0) *(LAS unsigned*)(L + DA_QS + i * DA_RS + lane * 4) = pk;
                if (s == 1) { *(LAS unsigned*)(L + DA_KS + i * DA_RS + lane * 4) = pk;
                    *(LAS bf16_t*)(L + DA_KT + (2 * lane) * DA_TS + i * 2) = (bf16_t)(pk & 0xffff); *(LAS bf16_t*)(L + DA_KT + (2 * lane + 1) * DA_TS + i * 2) = (bf16_t)(pk >> 16); }
                if (s == 2) { *(LAS bf16_t*)(L + DA_VT + (2 * lane) * DA_TS + i * 2) = (bf16_t)(pk & 0xffff); *(LAS bf16_t*)(L + DA_VT + (2 * lane + 1) * DA_TS + i * 2) = (bf16_t)(pk >> 16); }
            }
        }
    }
    if (w < 2) {
        const int tok = w ? 63 - lane : lane; const float* gp = WSP(float, A0_GATES) + (size_t)(row0 + tok) * 16 + w * 8;
        float x = -expf(INP(11)[w * 4 + h]) * softplus_(gp[h] + INP(12)[w * 4 + h]);
#pragma unroll
        for (int off = 1; off < 64; off <<= 1) { const float y = __shfl_up(x, off); if (lane >= off) x += y; }
        sc[w * 64 + tok] = x;
        sc[128 + w * 64 + tok] = sigm(gp[4 + h]);
    }
    __syncthreads();
    DN_RELAUNDER();
    {
        const int which = w >> 2, mt = (w >> 1) & 1, nt = w & 1;
        f32x16 acc = zero16();
        const LAS unsigned char* bsrc = L + (which ? DA_QS : DA_KS);
#pragma unroll
        for (int ks = 0; ks < 8; ++ks) {
            const bf16x8v a = *(const LAS bf16x8v*)(L + DA_KS + (mt * 32 + r) * DA_RS + (ks * 16 + 8 * hh) * 2);
            const bf16x8v bb = *(const LAS bf16x8v*)(bsrc + (nt * 32 + r) * DA_RS + (ks * 16 + 8 * hh) * 2);
            acc = MFMA32(a, bb, acc);
        }
        if (which == 0) {
            const int j = nt * 32 + r; const float gfj = sc[j], grj = sc[64 + j];
            LAS float* Af = (LAS float*)(L + DA_AF); LAS float* Ar = (LAS float*)(L + DA_AR);
#pragma unroll
            for (int reg = 0; reg < 16; ++reg) { const int i = mt * 32 + crow(reg, hh); const float kk = acc[reg];
                Af[i * 68 + j] = (j < i) ? sc[128 + i] * kk * __expf(sc[i] - gfj) : 0.f;
                Ar[(63 - i) * 68 + (63 - j)] = (j > i) ? sc[192 + i] * kk * __expf(sc[64 + i] - grj) : 0.f; }
        } else {
            const int i = nt * 32 + r; const float gfi = sc[i], gri = sc[64 + i];
            const size_t cuf = ((size_t)((b * 4 + h) * 2 + 0) * 36 + tc), cur = ((size_t)((b * 4 + h) * 2 + 1) * 36 + ((tc < 4) ? 3 - tc : 4 + 35 - tc));
            unsigned char* attf = WSP(unsigned char, A0_ATT) + cuf * 8192; unsigned char* attr = WSP(unsigned char, A0_ATT) + cur * 8192;
#pragma unroll
            for (int g4 = 0; g4 < 4; ++g4) {
                const int j0 = mt * 32 + 8 * g4 + 4 * hh; float vf[4], vr[4];
#pragma unroll
                for (int e = 0; e < 4; ++e) { const int j = j0 + e; const float a = acc[4 * g4 + e];
                    vf[e] = (j <= i) ? a * __expf(gfi - sc[j]) : 0.f; vr[e] = (j >= i) ? a * __expf(gri - sc[64 + j]) : 0.f; }
                u32x2 wf; wf.x = pk2(vf[0], vf[1]); wf.y = pk2(vf[2], vf[3]);
                *(u32x2*)(attf + afrag_off(i, j0, 4)) = wf;
                u32x2 wr; wr.x = pk2(vr[3], vr[2]); wr.y = pk2(vr[1], vr[0]);
                *(u32x2*)(attr + afrag_off(63 - i, 60 - j0, 4)) = wr;
            }
        }
    }
    __syncthreads();
    DN_RELAUNDER();
    if (w < 2) {
        const LAS float* A = (const LAS float*)(L + (w ? DA_AR : DA_AF)); LAS unsigned char* T = L + (w ? DA_TR : DA_TF);
        float tcol[64];
        f32x4 av[2][16];
#pragma unroll
        for (int i = 0; i < 64; ++i) {
            if (i + 1 < 64) {
#pragma unroll
                for (int j4 = 0; j4 < (i + 1 + 3) / 4; ++j4) av[(i + 1) & 1][j4] = *(const LAS f32x4*)(A + (i + 1) * 68 + j4 * 4);
            }
            float s0 = (i == lane) ? 1.0f : 0.0f, s1 = 0.f, s2 = 0.f, s3 = 0.f;
#pragma unroll
            for (int j4 = 0; j4 < (i + 3) / 4; ++j4) { const f32x4 a4 = av[i & 1][j4];
                if (j4 * 4 + 0 < i) s0 -= a4[0] * tcol[j4 * 4 + 0];
                if (j4 * 4 + 1 < i) s1 -= a4[1] * tcol[j4 * 4 + 1];
                if (j4 * 4 + 2 < i) s2 -= a4[2] * tcol[j4 * 4 + 2];
                if (j4 * 4 + 3 < i) s3 -= a4[3] * tcol[j4 * 4 + 3]; }
            const float s = (s0 + s1) + (s2 + s3);
            tcol[i] = s;
            *(LAS bf16_t*)(T + i * DA_TS + lane * 2) = f2bf(s);
            asm volatile("" ::: "memory");
        }
    } else {
        for (int p = (w * 64 + lane) - 128; p < 4096; p += NTHR - 128) {
            const int d = p >> 11, kind = (p >> 10) & 1, q = p & 1023;
            const size_t cu = ((size_t)((b * 4 + h) * 2 + d) * 36 + (d ? ((tc < 4) ? 3 - tc : 4 + 35 - tc) : tc));
            const LAS float* gc = sc + d * 64;
            if (kind == 0) {
                const int ip = q >> 4, c8 = (q & 15) * 8, i = d ? 63 - ip : ip; const float e = __expf(gc[i]);
                const u32x4 raw = *(const LAS u32x4*)(L + DA_QS + i * DA_RS + c8 * 2); const float s8[8] = {e, e, e, e, e, e, e, e};
                *(bf16x8v*)(WSP(unsigned char, A0_WQ) + cu * 32768 + afrag_off(64 + ip, c8, 8)) = scale8(raw, s8, false);
            } else {
                const int dk = q >> 3, i8 = (q & 7) * 8; const float gl = d ? gc[0] : gc[63]; float s8[8];
#pragma unroll
                for (int e = 0; e < 8; ++e) { const int i = d ? 63 - (i8 + e) : i8 + e; s8[e] = __expf(gl - gc[i]); }
                const u32x4 raw = *(const LAS u32x4*)(L + DA_KT + dk * DA_TS + (d ? 56 - i8 : i8) * 2);
                *(bf16x8v*)(WSP(unsigned char, A0_KDT) + cu * 16384 + afrag_off(dk, i8, 4)) = scale8(raw, s8, d != 0);
            }
        }
    }
    __syncthreads();
#pragma unroll 1
    for (int d = 0; d < 2; ++d) {
        DN_RELAUNDER();
        const size_t cu = ((size_t)((b * 4 + h) * 2 + d) * 36 + (d ? ((tc < 4) ? 3 - tc : 4 + 35 - tc) : tc));
        const LAS unsigned char* T = L + (d ? DA_TR : DA_TF); const LAS float* gc = sc + d * 64; const LAS float* be = sc + 128 + d * 64;
        {
            const int mt = w >> 2, nt = w & 3; f32x16 acc = zero16();
#pragma unroll
            for (int ks = 0; ks < 4; ++ks) {
                const bf16x8v a = *(const LAS bf16x8v*)(T + (mt * 32 + r) * DA_TS + (ks * 16 + 8 * hh) * 2);
                const int jp = ks * 16 + 8 * hh; float s8[8];
#pragma unroll
                for (int e = 0; e < 8; ++e) s8[e] = be[d ? 63 - (jp + e) : jp + e];
                const u32x4 raw = *(const LAS u32x4*)(L + DA_VT + (nt * 32 + r) * DA_TS + (d ? 56 - jp : jp) * 2);
                acc = MFMA32(a, scale8(raw, s8, d != 0), acc);
            }
            float* uu = WSP(float, A0_UU) + cu * 8192 + ((size_t)(mt * 4 + nt) * 64 + lane) * 16;
#pragma unroll
            for (int g4 = 0; g4 < 4; ++g4) *(f32x4*)(uu + 4 * g4) = (f32x4){acc[4 * g4], acc[4 * g4 + 1], acc[4 * g4 + 2], acc[4 * g4 + 3]};
        }
        {
            const int mt = w >> 1, nt = w & 1; f32x16 acc = zero16();
#pragma unroll
            for (int ks = 0; ks < 4; ++ks) {
                const int jp = ks * 16 + 8 * hh; float s8[8];
#pragma unroll
                for (int e = 0; e < 8; ++e) { const int j = d ? 63 - (jp + e) : jp + e; s8[e] = be[j] * __expf(gc[j]); }
                const u32x4 raw = *(const LAS u32x4*)(L + DA_KT + (mt * 32 + r) * DA_TS + (d ? 56 - jp : jp) * 2);
                const bf16x8v bb = *(const LAS bf16x8v*)(T + (nt * 32 + r) * DA_TS + (ks * 16 + 8 * hh) * 2);
                acc = MFMA32(scale8(raw, s8, d != 0), bb, acc);
            }
            unsigned char* wq = WSP(unsigned char, A0_WQ) + cu * 32768; const int ip = nt * 32 + r;
#pragma unroll
            for (int g4 = 0; g4 < 4; ++g4) { const int k0 = mt * 32 + 8 * g4 + 4 * hh; u32x2 o; o.x = pk2(acc[4 * g4], acc[4 * g4 + 1]); o.y = pk2(acc[4 * g4 + 2], acc[4 * g4 + 3]);
                *(u32x2*)(wq + afrag_off(ip, k0, 8)) = o; }
        }
        if (F.tid == 0) WSP(float, A0_GL)[cu] = __expf(d ? gc[0] : gc[63]);
    }
    __syncthreads();
#undef DN_RELAUNDER
}

constexpr int DB_ST = 0, DB_VN = 34816;
DI void dnB_chain(const Fr& F, int unit) {
    const int d = unit & 1, h = (unit >> 1) & 3, b = unit >> 3;
    LAS unsigned char* L = F.lds; const int lane = F.lane, w = F.wave, r = lane & 31, hh = lane >> 5;
    const int mt = w >> 1, ntb = (w & 1) * 2;
    for (int i = F.tid; i < DB_VN / 16; i += NTHR) *(LAS u32x4*)(L + i * 16) = (u32x4){0u, 0u, 0u, 0u};
    f32x16 S0 = zero16(), S1 = zero16();
    const unsigned char* WQ = WSP(unsigned char, A0_WQ) + (size_t)unit * 36 * 32768; const unsigned char* KDT = WSP(unsigned char, A0_KDT) + (size_t)unit * 36 * 16384;
    const unsigned char* ATT = WSP(unsigned char, A0_ATT) + (size_t)unit * 36 * 8192; const float* UU = WSP(float, A0_UU) + (size_t)unit * 36 * 8192; const float* GL = WSP(float, A0_GL) + (size_t)unit * 36;
    float* OD = WSP(float, A0_OD) + (size_t)d * TT * 512;
    __syncthreads();
    bf16x8v wqf[8], kdf[4], atf[4]; f32x4 u0f[4], u1f[4]; float gl;
    {
        const unsigned char* wq = WQ + (size_t)(mt * 8) * 1024 + lane * 16; const unsigned char* kd = KDT + (size_t)(mt * 4) * 1024 + lane * 16;
        const unsigned char* at = ATT + (size_t)((mt & 1) * 4) * 1024 + lane * 16; const float* u0 = UU + ((size_t)((mt & 1) * 4 + ntb) * 64 + lane) * 16;
#pragma unroll
        for (int ks = 0; ks < 8; ++ks) wqf[ks] = *(const bf16x8v*)(wq + ks * 1024);
#pragma unroll
        for (int ks = 0; ks < 4; ++ks) { kdf[ks] = *(const bf16x8v*)(kd + ks * 1024); atf[ks] = *(const bf16x8v*)(at + ks * 1024); u0f[ks] = *(const f32x4*)(u0 + 4 * ks); u1f[ks] = *(const f32x4*)(u0 + 64 * 16 + 4 * ks); }
        gl = GL[0];
    }
#pragma unroll 1
    for (int n = 0; n < 36; ++n) {
        const int nn = (n + 1 < 36) ? n + 1 : n;
        const unsigned char* wq = WQ + (size_t)nn * 32768 + (size_t)(mt * 8) * 1024 + lane * 16;
        const unsigned char* kd = KDT + (size_t)nn * 16384 + (size_t)(mt * 4) * 1024 + lane * 16;
        const unsigned char* at = ATT + (size_t)nn * 8192 + (size_t)((mt & 1) * 4) * 1024 + lane * 16;
        const float* u0 = UU + (size_t)nn * 8192 + ((size_t)((mt & 1) * 4 + ntb) * 64 + lane) * 16;
        f32x16 P0 = zero16(), P1 = zero16();
#pragma unroll
        for (int ks = 0; ks < 8; ++ks) {
            const bf16x8v b0 = *(const LAS bf16x8v*)(L + DB_ST + (ntb * 32 + r) * 272 + (ks * 16 + 8 * hh) * 2);
            const bf16x8v b1 = *(const LAS bf16x8v*)(L + DB_ST + ((ntb + 1) * 32 + r) * 272 + (ks * 16 + 8 * hh) * 2);
            P0 = MFMA32(wqf[ks], b0, P0); P1 = MFMA32(wqf[ks], b1, P1);
        }
#pragma unroll
        for (int ks = 0; ks < 8; ++ks) wqf[ks] = *(const bf16x8v*)(wq + ks * 1024);
        if (w < 4) {
#pragma unroll
            for (int g4 = 0; g4 < 4; ++g4) {
                const f32x4 a0 = u0f[g4], a1 = u1f[g4]; const int i0 = mt * 32 + 8 * g4 + 4 * hh;
                u32x2 o0, o1; o0.x = pk2(a0[0] - P0[4 * g4], a0[1] - P0[4 * g4 + 1]); o0.y = pk2(a0[2] - P0[4 * g4 + 2], a0[3] - P0[4 * g4 + 3]);
                o1.x = pk2(a1[0] - P1[4 * g4], a1[1] - P1[4 * g4 + 1]); o1.y = pk2(a1[2] - P1[4 * g4 + 2], a1[3] - P1[4 * g4 + 3]);
                *(LAS u32x2*)(L + DB_VN + (ntb * 32 + r) * 144 + i0 * 2) = o0; *(LAS u32x2*)(L + DB_VN + ((ntb + 1) * 32 + r) * 144 + i0 * 2) = o1;
            }
#pragma unroll
            for (int g4 = 0; g4 < 4; ++g4) { u0f[g4] = *(const f32x4*)(u0 + 4 * g4); u1f[g4] = *(const f32x4*)(u0 + 64 * 16 + 4 * g4); }
        }
        __syncthreads();
#pragma unroll
        for (int i = 0; i < 16; ++i) { S0[i] *= gl; S1[i] *= gl; }
        gl = GL[nn];
#pragma unroll
        for (int ks = 0; ks < 4; ++ks) {
            const bf16x8v b0 = *(const LAS bf16x8v*)(L + DB_VN + (ntb * 32 + r) * 144 + (ks * 16 + 8 * hh) * 2);
            const bf16x8v b1 = *(const LAS bf16x8v*)(L + DB_VN + ((ntb + 1) * 32 + r) * 144 + (ks * 16 + 8 * hh) * 2);
            S0 = MFMA32(kdf[ks], b0, S0); S1 = MFMA32(kdf[ks], b1, S1);
            if (w >= 4) { P0 = MFMA32(atf[ks], b0, P0); P1 = MFMA32(atf[ks], b1, P1); }
        }
#pragma unroll
        for (int ks = 0; ks < 4; ++ks) { kdf[ks] = *(const bf16x8v*)(kd + ks * 1024); if (w >= 4) atf[ks] = *(const bf16x8v*)(at + ks * 1024); }
        if (w >= 4) {
            const int ip0 = (mt - 2) * 32 + 4 * hh; const long rstep = d ? -512 : 512;
            float* ob = OD + (size_t)row_of(b, d, n * 64 + ip0) * 512 + h * 128 + ntb * 32 + r;
#pragma unroll
            for (int reg = 0; reg < 16; ++reg) { float* o = ob + ((reg & 3) + 8 * (reg >> 2)) * rstep; o[0] = P0[reg]; o[32] = P1[reg]; }
        }
#pragma unroll
        for (int g4 = 0; g4 < 4; ++g4) { const int k0 = mt * 32 + 8 * g4 + 4 * hh;
            u32x2 o0, o1; o0.x = pk2(S0[4 * g4], S0[4 * g4 + 1]); o0.y = pk2(S0[4 * g4 + 2], S0[4 * g4 + 3]); o1.x = pk2(S1[4 * g4], S1[4 * g4 + 1]); o1.y = pk2(S1[4 * g4 + 2], S1[4 * g4 + 3]);
            *(LAS u32x2*)(L + DB_ST + (ntb * 32 + r) * 272 + k0 * 2) = o0; *(LAS u32x2*)(L + DB_ST + ((ntb + 1) * 32 + r) * 272 + k0 * 2) = o1; }
        __syncthreads();
    }
}
#ifndef MK_DN_NAIVE
#define MK_DN_NAIVE 0
#endif
DI void tconv(const Fr& F, const float* src, size_t sbs, int ld, int col0, int K, int N, bf16_t* dst, size_t dbs, int nb, int drs = 0, long u0 = 0, long u1 = -1, int vbid = -1, int vG = 0) {
    if (drs == 0) drs = K;
    LAS float* tile = (LAS float*)F.lds;
    const int tk = K / 64, tn = N / 256, per = tk * tn; const long total = (u1 >= 0) ? u1 : (long)nb * per;
    const int rr = F.tid >> 6, c4 = (F.tid & 63) * 4; const int ustep = (vbid >= 0) ? vG : F.G;
    f32x4 v[8];
    long u = u0 + ((vbid >= 0) ? vbid : F.bid);
    if (u < total) { const int b = (int)(u / per), r = (int)(u % per), kt = r / tn, nt_ = r % tn; const float* sp = src + (size_t)b * sbs + (size_t)(kt * 64) * ld + col0 + nt_ * 256;
#pragma unroll
        for (int h = 0; h < 8; ++h) v[h] = __builtin_nontemporal_load((const f32x4*)(sp + (size_t)(rr + 8 * h) * ld + c4)); }
    for (; u < total; u += ustep) {
        const int b = (int)(u / per), r = (int)(u % per), kt = r / tn, nt_ = r % tn;
#pragma unroll
        for (int h = 0; h < 8; ++h) { LAS float* tp = tile + (rr + 8 * h) * 257 + c4; tp[0] = v[h][0]; tp[1] = v[h][1]; tp[2] = v[h][2]; tp[3] = v[h][3]; }
        __syncthreads();
        const long un = u + ustep;
        if (un < total) { const int b2 = (int)(un / per), r2 = (int)(un % per), kt2 = r2 / tn, nt2 = r2 % tn; const float* sp = src + (size_t)b2 * sbs + (size_t)(kt2 * 64) * ld + col0 + nt2 * 256;
#pragma unroll
            for (int h = 0; h < 8; ++h) v[h] = __builtin_nontemporal_load((const f32x4*)(sp + (size_t)(rr + 8 * h) * ld + c4)); }
        {
#pragma unroll
            for (int q = 0; q < 4; ++q) { const int n = (F.tid >> 3) + 64 * q, k8 = (F.tid & 7) * 8; float x[8];
#pragma unroll
                for (int j = 0; j < 8; ++j) x[j] = tile[(k8 + j) * 257 + n];
                u32x4 w; w.x = pk2(x[0], x[1]); w.y = pk2(x[2], x[3]); w.z = pk2(x[4], x[5]); w.w = pk2(x[6], x[7]);
                *(u32x4*)(dst + (size_t)b * dbs + (size_t)(nt_ * 256 + n) * drs + kt * 64 + k8) = w; } }
        __syncthreads();
    }
}

#ifndef MK_BG_CONV
#define MK_BG_CONV 0
#endif
constexpr int TQ_PER_LAYER = 32 * 768, TQ_TOTAL = 2 * TQ_PER_LAYER;
DI void conv_chunk_wave(const Fr& F, int c, LAS float* tile  ) {
    const int l = c / TQ_PER_LAYER, r = c % TQ_PER_LAYER, e = r / 768, q = r % 768; const int lane = F.lane;
    const bool is2 = q >= 512; const int qq = is2 ? q - 512 : q; const int N = is2 ? DM : 2048; const int nts = N / 64;
    const int kt = qq / nts, nt_ = qq % nts;
    const float* src = (is2 ? INP(38) + ((size_t)l * 32 + e) * DM * DM : INP(36) + ((size_t)l * 32 + e) * DM * 2048) + (size_t)(kt * 64) * N + nt_ * 64;
    bf16_t* dst = (is2 ? WSP(bf16_t, WS_WM2) + ((size_t)l * 32 + e) * DM * DM : WSP(bf16_t, WS_WM1) + ((size_t)l * 32 + e) * 2048 * DM) + (size_t)(nt_ * 64) * DM + kt * 64;
    const int rs = lane >> 4, c4 = (lane & 15) * 4;
    f32x4 v[16];
#pragma unroll
    for (int j = 0; j < 16; ++j) v[j] = __builtin_nontemporal_load((const f32x4*)(src + (size_t)(rs + 4 * j) * N + c4));
#pragma unroll
    for (int j = 0; j < 16; ++j) { LAS float* tp = tile + (rs + 4 * j) * 65 + c4; tp[0] = v[j][0]; tp[1] = v[j][1]; tp[2] = v[j][2]; tp[3] = v[j][3]; }
#pragma unroll
    for (int j = 0; j < 8; ++j) { const int n = (lane >> 3) + 8 * j, k8 = (lane & 7) * 8; float x[8];
#pragma unroll
        for (int i = 0; i < 8; ++i) x[i] = tile[(k8 + i) * 65 + n];
        u32x4 w; w.x = pk2(x[0], x[1]); w.y = pk2(x[2], x[3]); w.z = pk2(x[4], x[5]); w.w = pk2(x[6], x[7]);
        *(u32x4*)(dst + (size_t)n * DM + k8) = w; }
}
DI int conv_claim(const Fr& F) { int c = 0; if (F.lane == 0) c = (int)__hip_atomic_fetch_add(WSP(unsigned, WS_CTL) + CW_TQ, 1u, __ATOMIC_RELAXED, __HIP_MEMORY_SCOPE_AGENT); return __builtin_amdgcn_readfirstlane(c); }
DI void conv_drain(const Fr& F, int upto) {
    LAS float* tile = (LAS float*)F.lds + F.wave * (64 * 65);
    for (;;) { const int c = conv_claim(F); if (c >= TQ_TOTAL) break; conv_chunk_wave(F, c, tile); if (c >= upto) break; }
}
DI void xcd_barrier_work(const XcdBarrier& b, const Fr& F) {
    asm volatile("s_waitcnt vmcnt(0)" ::: "memory");
    if (threadIdx.x == 0) b.st[2] = 0u;
    __syncthreads();
    if (F.wave == 0) {
        if (threadIdx.x == 0) {
            unsigned* bar = b.bar;
            __builtin_amdgcn_s_waitcnt(0);
            unsigned nloc = b.st[0], nx = b.st[1];
            if (nloc == 0u) { xcd_barrier_complete(bar, b.x, nloc, nx); b.st[0] = nloc; b.st[1] = nx; }
            const unsigned old = xb_add(&bar[XB_XSUB(b.x)], 1u);
            const unsigned gen = old / nloc;
            if (old + 1u == (gen + 1u) * nloc) {
                __builtin_amdgcn_fence(__ATOMIC_RELEASE, "agent");
                asm volatile("s_waitcnt vmcnt(0)" ::: "memory");
                const unsigned og = xb_add(&bar[XB_TOP], 1u);
                const unsigned tg = og / nx;
                if (og + 1u == (tg + 1u) * nx) xb_add(&bar[XB_TOPGEN], 1u);
                else XB_SPIN(xb_ld(&bar[XB_TOPGEN]) == tg, bar);
                __builtin_amdgcn_fence(__ATOMIC_ACQUIRE, "agent");
                xb_add(&bar[XB_XGEN(b.x)], 1u);
                asm volatile("s_waitcnt vmcnt(0)" ::: "memory");
            } else {
                XB_SPIN(xb_ld(&bar[XB_XGEN(b.x)]) == gen, bar);
                __builtin_amdgcn_fence(__ATOMIC_ACQUIRE, "agent");
                asm volatile("s_waitcnt vmcnt(0)" ::: "memory");
            }
            b.st[2] = 1u;
        }
    } else {
        LAS float* tile = (LAS float*)F.lds + F.wave * (64 * 65);
        while (b.st[2] == 0u) { const int c = conv_claim(F); if (c >= TQ_TOTAL) break; conv_chunk_wave(F, c, tile); }
    }
    __syncthreads();
}

DI void tconv8(const Fr& F, const float* src, size_t sbs, int ld, int K, int N, unsigned char* dst, size_t dbs, int nb, float scale, long u0, long u1, int vbid, int vG) {
    LAS float* tile = (LAS float*)F.lds;
    const int tk = K / 128, tn = N / 128, per = tk * tn; const long total = (u1 >= 0) ? u1 : (long)nb * per;
    const int rr = F.tid >> 5, c4 = (F.tid & 31) * 4; const int ustep = (vbid >= 0) ? vG : F.G;
    f32x4 v[8];
    long u = u0 + ((vbid >= 0) ? vbid : F.bid);
    if (u < total) { const int b = (int)(u / per), r = (int)(u % per), kt = r / tn, nt_ = r % tn; const float* sp = src + (size_t)b * sbs + (size_t)(kt * 128) * ld + nt_ * 128;
#pragma unroll
        for (int h = 0; h < 8; ++h) v[h] = __builtin_nontemporal_load((const f32x4*)(sp + (size_t)(rr + 16 * h) * ld + c4)); }
    for (; u < total; u += ustep) {
        const int b = (int)(u / per), r = (int)(u % per), kt = r / tn, nt_ = r % tn;
#pragma unroll
        for (int h = 0; h < 8; ++h) { LAS float* tp = tile + (rr + 16 * h) * 129 + c4; tp[0] = v[h][0]; tp[1] = v[h][1]; tp[2] = v[h][2]; tp[3] = v[h][3]; }
        __syncthreads();
        const long un = u + ustep;
        if (un < total) { const int b2 = (int)(un / per), r2 = (int)(un % per), kt2 = r2 / tn, nt2 = r2 % tn; const float* sp = src + (size_t)b2 * sbs + (size_t)(kt2 * 128) * ld + nt2 * 128;
#pragma unroll
            for (int h = 0; h < 8; ++h) v[h] = __builtin_nontemporal_load((const f32x4*)(sp + (size_t)(rr + 16 * h) * ld + c4)); }
#pragma unroll
        for (int q = 0; q < 2; ++q) { const int n = (F.tid >> 3) + 64 * q, k16 = (F.tid & 7) * 16; float x[16];
#pragma unroll
            for (int j = 0; j < 16; ++j) x[j] = tile[(k16 + j) * 129 + n] * scale;
            u32x4 w; w.x = pk4_fp8(x[0], x[1], x[2], x[3]); w.y = pk4_fp8(x[4], x[5], x[6], x[7]); w.z = pk4_fp8(x[8], x[9], x[10], x[11]); w.w = pk4_fp8(x[12], x[13], x[14], x[15]);
            *(u32x4*)(dst + (size_t)b * dbs + (size_t)(nt_ * 128 + n) * K + kt * 128 + k16) = w; }
        __syncthreads();
    }
}
constexpr int L1W1_A = 1344, L1W1_B = 2304, L1W2_A = 1536;
DI void moe_w_l1_part(const Fr& F, int which, long u0, long u1, int vbid, int vG) {
#if MK_FP8_L1
    if (which == 0) tconv8(F, INP(36) + (size_t)32 * DM * 2048, (size_t)DM * 2048, 2048, DM, 2048, WSP(unsigned char, WS_WM1) + (size_t)32 * 2048 * DM * 2, (size_t)2048 * DM, 32, W1_F8S, u0, u1, vbid, vG);
    else tconv8(F, INP(38) + (size_t)32 * DM * DM, (size_t)DM * DM, DM, DM, DM, WSP(unsigned char, WS_WM2) + (size_t)32 * DM * DM * 2, (size_t)DM * DM, 32, W2_F8S, u0, u1, vbid, vG);
#else
    if (which == 0) tconv(F, INP(36) + (size_t)32 * DM * 2048, (size_t)DM * 2048, 2048, 0, DM, 2048, WSP(bf16_t, WS_WM1) + (size_t)32 * 2048 * DM, (size_t)2048 * DM, 32, 0, u0, u1, vbid, vG);
    else tconv(F, INP(38) + (size_t)32 * DM * DM, (size_t)DM * DM, DM, 0, DM, DM, WSP(bf16_t, WS_WM2) + (size_t)32 * DM * DM, (size_t)DM * DM, 32, 0, u0, u1, vbid, vG);
#endif
}
#ifndef MK_P0_MASK
#define MK_P0_MASK 31
#endif
#ifndef MK_P0_TWICE
#define MK_P0_TWICE 0
#endif
DI void p0_prologue(const Fr& F) {
    for (int rep_ = 0; rep_ < ((MK_P0_TWICE & 2) ? 2 : 1); ++rep_) {
    for (int tix = F.bid; tix < 544; tix += F.G) {
        if (tix < 128)      tconv(F, INP(8), 0, EVEN_IN, 0, DM, 2048, WSP(bf16_t, WS_WEVIN), 0, 1, 0, tix, tix + 1, 0, 1);
        else if (tix < 224) tconv(F, INP(8), 0, EVEN_IN, HY_COL, DM, 1536, WSP(bf16_t, WS_WEVIN) + (size_t)2048 * DM, 0, 1, 0, tix - 128, tix - 127, 0, 1);
        else if (tix < 288) tconv(F, INP(9), 0, DM, 0, MIXW, DM, WSP(bf16_t, WS_WEVOUT), 0, 1, 0, tix - 224, tix - 223, 0, 1);
        else if (tix < 416) tconv(F, INP(23), 0, 2048, 0, DM, 2048, WSP(bf16_t, WS_WODIN), 0, 1, 0, tix - 288, tix - 287, 0, 1);
        else if (tix < 480) tconv(F, INP(32), 0, DM, 0, DM, DM, WSP(bf16_t, WS_WODOUT), 0, 1, 0, tix - 416, tix - 415, 0, 1);
        else {
            const int th = (tix - 480) >> 2, kt = (tix - 480) & 3, g = th >> 3, d = (th >> 2) & 1, h = th & 3;
            tconv(F, (g ? INP(29) : INP(27)) + (size_t)(d * 4 + h) * 65536, 0, 256, 0, 256, 256, WSP(bf16_t, WS_WLRU) + ((size_t)(d * 4 + h) * 512 + g) * 256, 0, 1, 512, kt, kt + 1, 0, 1); }
    }
    for (int i = F.bid * NTHR + F.tid; i < 4096; i += F.G * NTHR) { const int g = i & 1, j = (i >> 1) & 255, h = (i >> 9) & 3, d = i >> 11;
        WSP(float, WS_BLRU)[i] = (g ? INP(30) : INP(28))[d * DM + h * 256 + j];
        if (i < 2048) WSP(float, WS_BLRU)[4096 + i] = -8.0f * softplus_(INP(31)[i]); }
    }
    for (int i = F.bid * NTHR + F.tid; i < 2 * DM * NEXP; i += F.G * NTHR) { const int l = i >> 15, k = (i >> 5) & 1023, e = i & 31; WSP(float, WS_RWT)[(size_t)l * 32768 + e * DM + k] = INP(34)[i]; }
    for (int i = F.bid * NTHR + F.tid; i < 16 * DM; i += F.G * NTHR) { const int k = i >> 4, g = i & 15; WSP(float, WS_WGT)[g * DM + k] = INP(8)[(size_t)k * EVEN_IN + DN_GATE_COL + g]; }
#if !MK_BG_CONV
#if MK_FP8_L0
    tconv8(F, INP(36), (size_t)DM * 2048, 2048, DM, 2048, WSP(unsigned char, WS_WM1), (size_t)2048 * DM, 32, W1_F8S, 0, -1, -1, 0);
    tconv8(F, INP(38), (size_t)DM * DM, DM, DM, DM, WSP(unsigned char, WS_WM2), (size_t)DM * DM, 32, W2_F8S, 0, -1, -1, 0);
#else
    tconv(F, INP(36), (size_t)DM * 2048, 2048, 0, DM, 2048, WSP(bf16_t, WS_WM1), (size_t)2048 * DM, 32);
    tconv(F, INP(38), (size_t)DM * DM, DM, 0, DM, DM, WSP(bf16_t, WS_WM2), (size_t)DM * DM, 32);
#endif
    if (F.G == 256) { moe_w_l1_part(F, 0, L1W1_B, 4096, F.bid, F.G); moe_w_l1_part(F, 1, L1W2_A, 2048, F.bid, F.G); } else { moe_w_l1_part(F, 0, 0, 4096, F.bid, F.G); moe_w_l1_part(F, 1, 0, 2048, F.bid, F.G); }
#endif
    for (int rep_ = 0; rep_ < ((MK_P0_TWICE & 4) ? 2 : 1); ++rep_)
    if (MK_P0_MASK & 4) {
        LAS float* sl = (LAS float*)F.lds;
        LAS float* part = sl + 9 * 1024;
        for (int i = F.tid; i < 9 * 1024; i += NTHR) { const int r = i >> 10, k = i & 1023; const float v = (r < 8) ? INP(1)[r * DM + k] : INP(3)[k]; sl[i] = silu_(v); }
        __syncthreads();
        float* MOD = WSP(float, WS_MOD);
        for (int u = F.bid; u < 192; u += F.G) {
            const int l = u / 96, n0 = (u % 96) * 64;
            const float* W = INP(4) + (size_t)l * DM * 6144 + n0 + F.lane;
            float acc[9];
#pragma unroll
            for (int r = 0; r < 9; ++r) acc[r] = 0.f;
#pragma unroll 16
            for (int k = F.wave * 128; k < F.wave * 128 + 128; ++k) { const float w = W[(size_t)k * 6144];
#pragma unroll
                for (int r = 0; r < 9; ++r) acc[r] += sl[r * 1024 + k] * w; }
#pragma unroll
            for (int r = 0; r < 9; ++r) part[(F.wave * 9 + r) * 64 + F.lane] = acc[r];
            __syncthreads();
            for (int i = F.tid; i < 9 * 64; i += NTHR) { const int r = i >> 6, ln = i & 63; float s = INP(5)[(size_t)l * 6144 + n0 + ln];
#pragma unroll
                for (int w = 0; w < 8; ++w) s += part[(w * 9 + r) * 64 + ln];
                MOD[((size_t)l * 9 + r) * 6144 + n0 + ln] = s; }
            __syncthreads();
        }
    }
    if (MK_P0_MASK & 8) {
        float* POS = WSP(float, WS_POS);
        for (int i = F.bid * NTHR + F.tid; i < SEQ * DM; i += F.G * NTHR) {
            const int t = i >> 10, d = i & 1023, q = d >> 8, fi = d & 255;
            const float omega = 1.0f / powf(10000.0f, (float)fi / 256.0f);
            const float p = (q < 2) ? (float)(t >> 6) : (float)(t & 63);
            const float ang = p * omega;
            POS[i] = (q & 1) ? cosf(ang) : sinf(ang);
        }
    }
    for (int rep_ = 0; rep_ < ((MK_P0_TWICE & 1) ? 2 : 1); ++rep_)
    if (MK_P0_MASK & 16) {
        const int f = F.lane; const float fr = INP(21)[f];
        for (int u = F.gwave; u < SEQ + CTXL; u += F.nwaves) {
            const bool isc = u >= SEQ; const int L = isc ? CTXL : SEQ, i = isc ? u - SEQ : u;
            const float t = (float)i / (float)(L - 1), wpos = 6.283185307179586f * (float)i / (float)L;
            float zv = t;
            if (f >= 1 && f < 33) { const float fb = 1e-4f + (float)((f - 1) & 15) * ((15.0f - 1e-4f) / 15.0f); zv = (f < 17) ? cosf(fb * wpos) : -sinf(fb * wpos); }
            float s = INP(17)[f];
#pragma unroll 11
            for (int e = 0; e < 33; ++e) s += __shfl(zv, e) * INP(16)[e * 64 + f];
            float hcur = sinf(fr * s);
#pragma unroll 1
            for (int ly = 0; ly < 2; ++ly) { float s2 = INP(19)[ly * 64 + f];
#pragma unroll 16
                for (int e = 0; e < 64; ++e) s2 += __shfl(hcur, e) * INP(18)[ly * 4096 + e * 64 + f];
                hcur = sinf(fr * s2); }
            WSP(float, WS_HID)[(size_t)u * 64 + f] = hcur;
        }
    }
}
DI void hy_filter_out(const Fr& F) {
    LAS float* wsl = (LAS float*)F.lds;
    const float MIN_DECAY = -3.0701134573253942f, MAX_DECAY = -15.350567286626972f;
    for (int u = F.bid; u < 128; u += F.G) {
        __syncthreads();
        { const int g = F.tid >> 3, j = F.tid & 7; wsl[g * 8 + j] = INP(20)[g * 1024 + u * 8 + j]; }
        __syncthreads();
        const float* HID = WSP(float, WS_HID);
        for (int lg = F.tid; lg < SEQ + CTXL; lg += NTHR) {
            const bool isc = lg >= SEQ; const int L = isc ? CTXL : SEQ, i = isc ? lg - SEQ : lg; const float t = (float)i / (float)(L - 1);
            f32x4 hv[16];
#pragma unroll
            for (int q = 0; q < 16; ++q) hv[q] = *(const f32x4*)(HID + (size_t)lg * 64 + q * 4);
            f32x4 a0 = (f32x4){0.f, 0.f, 0.f, 0.f}, a1 = a0;
#pragma unroll
            for (int q = 0; q < 16; ++q)
#pragma unroll
                for (int e = 0; e < 4; ++e) { const LAS f32x4* wp = (const LAS f32x4*)(wsl + (q * 4 + e) * 8); a0 += wp[0] * hv[q][e]; a1 += wp[1] * hv[q][e]; if (e == 3) asm volatile("" ::: "memory"); }
#pragma unroll
            for (int j = 0; j < 8; ++j) { const int col = u * 8 + j, c = col & 511; const float delta = fabsf(MIN_DECAY + (float)c * ((MAX_DECAY - MIN_DECAY) / 511.0f));
                const float v = (j < 4 ? a0[j & 3] : a1[j & 3]) * expf(-t * delta);
                float* dst = (col < 512) ? (isc ? WSP(float, WS_HFC) : WSP(float, WS_HFL)) : (isc ? WSP(float, WS_HBC) : WSP(float, WS_HBL));
                dst[(size_t)c * L + i] = v; }
        }
    }
    __syncthreads();
}

DI void p1_mod0(const Fr& F) {
    hy_filter_out(F);
    LAS float* wgt = (LAS float*)F.lds;
    { const f32x4* src = WSP(f32x4, WS_WGT);
#pragma unroll
      for (int it = 0; it < 8; ++it) *(LAS f32x4*)(wgt + (F.tid + it * NTHR) * 4) = src[F.tid + it * NTHR]; }
    __syncthreads();
    const float* MOD = WSP(float, WS_MOD); const float* POS = WSP(float, WS_POS);
    bf16_t* U = WSP(bf16_t, A0_U); float* GATES = WSP(float, A0_GATES);
    for (int row = F.gwave; row < TT; row += F.nwaves) {
        const bool isc = row >= TL; const int b = isc ? (row - TL) >> 8 : row >> 11; const int t = isc ? 0 : (row & 2047);
        const float* xin = isc ? INP(2) + (size_t)(row - TL) * DM : INP(0) + (size_t)row * DM;
        const float* md = MOD + (size_t)(isc ? 8 : b) * 6144;
        f32x4 xv[4], pv[4], shv[4], scv[4];
#pragma unroll
        for (int i = 0; i < 4; ++i) { const int k = i * 256 + F.lane * 4; xv[i] = *(const f32x4*)(xin + k); shv[i] = *(const f32x4*)(md + k); scv[i] = *(const f32x4*)(md + 1024 + k);
            pv[i] = isc ? (f32x4){0.f, 0.f, 0.f, 0.f} : *(const f32x4*)(POS + (size_t)t * DM + k); }
        float ga[16];
#pragma unroll
        for (int g = 0; g < 16; ++g) ga[g] = 0.f;
#pragma unroll
        for (int i = 0; i < 4; ++i) {
            const int k = i * 256 + F.lane * 4;
            const f32x4 u = xv[i] * (scv[i] + 1.0f) + shv[i] + pv[i];
            u32x2 w; w.x = pk2(u[0], u[1]); w.y = pk2(u[2], u[3]);
            *(u32x2*)(U + (size_t)row * DM + k) = w;
#pragma unroll
            for (int g = 0; g < 16; ++g) { const f32x4 wv = *(const LAS f32x4*)(wgt + g * 1024 + k); ga[g] += u[0] * wv[0] + u[1] * wv[1] + u[2] * wv[2] + u[3] * wv[3]; }
            asm volatile("" ::: "memory");
        }
#define RS16(N, OFF) { const bool up = (F.lane & (OFF)) != 0; _Pragma("unroll") for (int g = 0; g < (N); ++g) { const float kp = up ? ga[g + (N)] : ga[g], sd = up ? ga[g] : ga[g + (N)]; ga[g] = kp + __shfl_xor(sd, (OFF)); } }
        RS16(8, 32) RS16(4, 16) RS16(2, 8) RS16(1, 4)
#undef RS16
        float tot = ga[0]; tot += __shfl_xor(tot, 2); tot += __shfl_xor(tot, 1);
        if ((F.lane & 3) == 0) GATES[(size_t)row * 16 + (F.lane >> 2)] = tot;
    }
}

#ifndef MK_PREP_TWICE
#define MK_PREP_TWICE 0
#endif
DI void p3_prep(const Fr& F) {
#if !MK_DN_NAIVE
    __syncthreads();
    for (int u = F.bid; u < NB * 4 * 36; u += F.G) dnA_unit(F, u);
#if MK_PREP_TWICE == 1
    for (int u = F.bid; u < NB * 4 * 36; u += F.G) dnA_unit(F, u);
#endif
#endif
    const bf16_t* P = WSP(bf16_t, A0_P); const float* GATES = WSP(float, A0_GATES);
    float* QN = WSP(float, A0_QN); float* KN = WSP(float, A0_KN); float* VV = WSP(float, A0_VV);
    float* GG = WSP(float, A0_GG); float* BB = WSP(float, A0_BB);
    const float* cw = INP(10);
#if MK_DN_NAIVE
    for (int u = F.bid; u < (TT / 64) * 4; u += F.G) {
        const int rt = u >> 2, h = u & 3, row0 = rt * 64 + F.wave * 8; const bool isc = row0 >= TL; const int L = isc ? CTXL : SEQ;
        const int t0 = isc ? ((row0 - TL) & 255) : (row0 & 2047);
#pragma unroll 1
        for (int s = 0; s < 3; ++s) {
            const int col = s * 512 + h * 128 + F.lane * 2;
            float w0[4], w1[4];
#pragma unroll
            for (int i = 0; i < 4; ++i) { w0[i] = cw[i * 1536 + col]; w1[i] = cw[i * 1536 + col + 1]; }
            float p0[11], p1[11];
#pragma unroll
            for (int rr = 0; rr < 11; ++rr) { const int tl = t0 + rr - 2; unsigned pv = 0u; if (tl >= 0 && tl < L) pv = *(const unsigned*)(P + (size_t)(row0 + rr - 2) * NP0 + col);
                p0[rr] = __uint_as_float(pv << 16); p1[rr] = __uint_as_float(pv & 0xffff0000u); }
            bf16_t* dstb = (s == 0 ? WSP(bf16_t, A0_QB) : (s == 1 ? WSP(bf16_t, A0_KB) : WSP(bf16_t, A0_VB3))) + (size_t)row0 * 512 + h * 128 + F.lane * 2;
#pragma unroll
            for (int j = 0; j < 8; ++j) {
                float a0 = w0[0] * p0[j] + w0[1] * p0[j + 1] + w0[2] * p0[j + 2] + w0[3] * p0[j + 3];
                float a1 = w1[0] * p1[j] + w1[1] * p1[j + 1] + w1[2] * p1[j + 2] + w1[3] * p1[j + 3];
                a0 = silu_(a0); a1 = silu_(a1);
                if (s < 2) { const float ss = wsum(a0 * a0 + a1 * a1); float r = rsqrtf(ss + RMS_EPS); if (s == 0) r *= 0.08838834764831845f; a0 *= r; a1 *= r; }
#if MK_DN_NAIVE
                { float* dst = (s == 0 ? QN : (s == 1 ? KN : VV)) + (size_t)(row0 + j) * 512 + h * 128 + F.lane * 2; *(f32x2*)dst = (f32x2){a0, a1}; }
#endif
                *(unsigned*)(dstb + (size_t)j * 512) = pk2(a0, a1);
            }
        }
        if (F.lane < 16) { const int d = F.lane & 1, row = row0 + (F.lane >> 1);
            const float gd = GATES[(size_t)row * 16 + d * 8 + h], gb = GATES[(size_t)row * 16 + d * 8 + 4 + h];
            GG[((size_t)d * TT + row) * 4 + h] = -expf(INP(11)[d * 4 + h]) * softplus_(gd + INP(12)[d * 4 + h]);
            BB[((size_t)d * TT + row) * 4 + h] = sigm(gb); }
    }
#endif
    float* VX = WSP(float, A0_VX); float* X0 = WSP(float, A0_X0);
    const float* hw = INP(14); const float* hb = INP(15);
    LAS bf16_t* tile = (LAS bf16_t*)F.lds;
    __syncthreads();
    const bool bal = (F.G == 256) && !MK_DN_NAIVE; const int hu0 = bal ? (F.bid < 128 ? F.bid : 384 + (F.bid - 128)) : F.bid, hu1 = bal ? (F.bid < 128 ? 384 : 1152) : (TT / 64) * 4, hus = bal ? 128 : F.G;
    for (int u = hu0; u < hu1; u += hus) {
        const int rt = u >> 2, ct = u & 3, row0 = rt * 64; const bool isc = row0 >= TL; const int L = isc ? CTXL : SEQ;
        const int t0 = isc ? ((row0 - TL) & 255) : (row0 & 2047);
        const int cl = F.tid & 63, rg = F.tid >> 6, c = ct * 128 + cl * 2;
        unsigned praw[3][10];
#pragma unroll
        for (int rr = 0; rr < 10; ++rr) { const int tl = t0 + rg * 8 + rr - 1; const bool ok = tl >= 0 && tl < L;
#pragma unroll
            for (int sg = 0; sg < 3; ++sg) praw[sg][rr] = ok ? *(const unsigned*)(P + (size_t)(row0 + rg * 8 + rr - 1) * NP0 + 2048 + sg * 512 + c) : 0u; }
        f32x2 w3[3][3], b3[3];
#pragma unroll
        for (int sg = 0; sg < 3; ++sg) { b3[sg] = *(const f32x2*)(hb + sg * 512 + c);
#pragma unroll
            for (int j = 0; j < 3; ++j) w3[sg][j] = *(const f32x2*)(hw + j * 1536 + sg * 512 + c); }
#pragma unroll
        for (int j = 0; j < 8; ++j) { f32x2 r3[3];
#pragma unroll
            for (int sg = 0; sg < 3; ++sg) { r3[sg] = b3[sg];
#pragma unroll
                for (int q = 0; q < 3; ++q) { const unsigned pw = praw[sg][j + q]; r3[sg] += w3[sg][q] * (f32x2){__uint_as_float(pw << 16), __uint_as_float(pw & 0xffff0000u)}; } }
            const size_t o = (size_t)(row0 + rg * 8 + j) * 512 + c; const f32x2 vx = r3[2] * r3[1];
            *(f32x2*)(X0 + o) = r3[0]; *(f32x2*)(VX + o) = vx;
            const unsigned pk = pk2(vx[0], vx[1]);
            tile[(cl * 2) * 72 + rg * 8 + j] = (bf16_t)(pk & 0xffffu); tile[(cl * 2 + 1) * 72 + rg * 8 + j] = (bf16_t)(pk >> 16); }
        __syncthreads();
        { const int c2 = F.tid >> 2, seg = F.tid & 3; const u32x4 v0 = *(const LAS u32x4*)(tile + c2 * 72 + seg * 16), v1 = *(const LAS u32x4*)(tile + c2 * 72 + seg * 16 + 8);
          bf16_t* dst = isc ? WSP(bf16_t, A0_VXTC) + (size_t)(ct * 128 + c2) * TC + (row0 - TL) : WSP(bf16_t, A0_VXTL) + (size_t)(ct * 128 + c2) * TL + row0;
          *(u32x4*)(dst + seg * 16) = v0; *(u32x4*)(dst + seg * 16 + 8) = v1; }
        __syncthreads();
    }
}

DI void dn_chain(const Fr& F, int unit) {
    const int b = unit >> 3, h = (unit >> 1) & 3, d = unit & 1;
    const float* QN = WSP(float, A0_QN); const float* KN = WSP(float, A0_KN); const float* VV = WSP(float, A0_VV);
    const float* GG = WSP(float, A0_GG) + (size_t)d * TT * 4; const float* BB = WSP(float, A0_BB) + (size_t)d * TT * 4;
    float* OD = WSP(float, A0_OD) + (size_t)d * TT * 512;
    LAS float* qs = (LAS float*)F.lds; LAS float* ks = qs + 128; LAS float* vs = ks + 128; LAS float* red1 = vs + 128; LAS float* red2 = red1 + 512; LAS float* scal = red2 + 512;
    const int dv = F.tid & 127, kb = F.tid >> 7;
    float S[32];
#pragma unroll
    for (int i = 0; i < 32; ++i) S[i] = 0.f;
    for (int p = 0; p < CTXL + SEQ; ++p) {
        const int row = row_of(b, d, p);
        if (F.tid < 128) qs[F.tid] = QN[(size_t)row * 512 + h * 128 + F.tid];
        else if (F.tid < 256) ks[F.tid - 128] = KN[(size_t)row * 512 + h * 128 + F.tid - 128];
        else if (F.tid < 384) vs[F.tid - 256] = VV[(size_t)row * 512 + h * 128 + F.tid - 256];
        else if (F.tid == 384) scal[0] = expf(GG[(size_t)row * 4 + h]);
        else if (F.tid == 385) scal[1] = BB[(size_t)row * 4 + h];
        __syncthreads();
        float part = 0.f;
#pragma unroll
        for (int i = 0; i < 32; ++i) part += ks[kb * 32 + i] * S[i];
        red1[kb * 128 + dv] = part;
        __syncthreads();
        const float kS = red1[dv] + red1[128 + dv] + red1[256 + dv] + red1[384 + dv];
        const float eg = scal[0], beta = scal[1];
        const float delta = beta * (vs[dv] - eg * kS);
        float op = 0.f;
#pragma unroll
        for (int i = 0; i < 32; ++i) { S[i] = eg * S[i] + ks[kb * 32 + i] * delta; op += qs[kb * 32 + i] * S[i]; }
        red2[kb * 128 + dv] = op;
        __syncthreads();
        if (kb == 0) OD[(size_t)row * 512 + h * 128 + dv] = red2[dv] + red2[128 + dv] + red2[256 + dv] + red2[384 + dv];
    }
    __syncthreads();
}
constexpr int HY_RS_LAT = 2 * (2 * SEQ + 64) + 64, HY_RS_CTX = 2 * (2 * CTXL + 64) + 64;
DI void hy_mfma_unit(const Fr& F, int c) {
    typedef short bf16x8h __attribute__((ext_vector_type(8)));
    LAS unsigned char* Lm = F.lds;
    const int lane = F.lane, w = F.wave, m = lane & 15, q = lane >> 4, ml = m & 7, mh = m >> 3, n8 = lane & 7;
#pragma unroll 1
    for (int kind = 0; kind < 2; ++kind) {
        const int L = kind ? CTXL : SEQ, RS = kind ? HY_RS_CTX : HY_RS_LAT;
        const float* HFt = (kind ? WSP(float, WS_HFC) : WSP(float, WS_HFL)) + (size_t)c * L; const float* HBt = (kind ? WSP(float, WS_HBC) : WSP(float, WS_HBL)) + (size_t)c * L;
        LAS unsigned char* Rsh = Lm; LAS unsigned char* Vt = Lm + 8 * HY_RS_LAT;
        __syncthreads();
        for (int x2 = F.tid; x2 < L + 32; x2 += NTHR) {
#pragma unroll
            for (int a = 0; a < 8; ++a) { float v2[2];
#pragma unroll
                for (int e = 0; e < 2; ++e) { const int idx = 2 * x2 + e - a, i = idx - L; v2[e] = (idx <= 0 || idx >= 2 * L) ? 0.f : (i <= 0 ? HFt[-i] : HBt[i]); }
                *(LAS unsigned*)(Rsh + a * RS + x2 * 4) = pk2(v2[0], v2[1]); }
        }
        { const u32x4* src = (const u32x4*)(kind ? WSP(bf16_t, A0_VXTC) + (size_t)c * TC : WSP(bf16_t, A0_VXTL) + (size_t)c * TL);
          for (int i = F.tid; i < L; i += NTHR) *(LAS u32x4*)(Vt + i * 16) = src[i]; }
        __syncthreads();
        float* YT = kind ? WSP(float, A0_YHTC) + (size_t)c * TC : WSP(float, A0_YHTL) + (size_t)c * TL;
        const int ng = L / 128, nks = L / 32;
        for (int g = w; g < ng; g += 8) {
            const int mt0 = g * 8;
            const LAS unsigned char* abase = Rsh + ml * RS + (L - 16 * mt0 + 8 * q - 8 * mh) * 2;
            const LAS unsigned char* bbase = Vt + n8 * (L * 2) + (8 * q) * 2;
            bf16x8h fr[8]; f32x4 acc[8];
#pragma unroll
            for (int i = 0; i < 8; ++i) { acc[i] = (f32x4){0.f, 0.f, 0.f, 0.f}; fr[(8 - i) & 7] = *(const LAS bf16x8h*)(abase + (-i) * 32); }
            for (int ks4 = 0; ks4 < nks; ks4 += 4) {
#pragma unroll
                for (int kk = 0; kk < 4; ++kk) {
                    const int ks = ks4 + kk;
                    const bf16x8h bv = *(const LAS bf16x8h*)(bbase + ks * 64);
#pragma unroll
                    for (int i = 0; i < 8; ++i) acc[i] = __builtin_amdgcn_mfma_f32_16x16x32_bf16(fr[(2 * kk - i) & 7], bv, acc[i], 0, 0, 0);
                    fr[(2 * kk + 1) & 7] = *(const LAS bf16x8h*)(abase + (2 * ks + 1) * 32);
                    fr[(2 * kk + 2) & 7] = *(const LAS bf16x8h*)(abase + (2 * ks + 2) * 32);
                }
            }
            if (m < 8) {
#pragma unroll
                for (int i = 0; i < 8; ++i) *(f32x4*)(YT + (size_t)m * L + 16 * (mt0 + i) + 4 * q) = acc[i];
            }
        }
    }
    __syncthreads();
}
DI void p4a_dn_chunks(const Fr& F) {}
DI void p4_mix_core(const Fr& F) {
#if MK_DN_NAIVE
    for (int u = F.bid; u < 64 + 512; u += F.G) { if (u < 64) dn_chain(F, u); else hy_mfma_unit(F, u - 64); }
#else
    if (F.G >= 128) { if (F.bid < 64) dnB_chain(F, F.bid); else { for (int c = F.bid - 64; c < 512; c += F.G - 64) hy_mfma_unit(F, c);
            if (F.G == 256 && !MK_BG_CONV) moe_w_l1_part(F, 1, 0, L1W2_A, F.bid - 64, F.G - 64); } }
    else for (int u = F.bid; u < 64 + 512; u += F.G) { if (u < 64) dnB_chain(F, u); else hy_mfma_unit(F, u - 64); }
#endif
}

DI void p5_mix(const Fr& F) {
    const float* OD = WSP(float, A0_OD); const bf16_t* P = WSP(bf16_t, A0_P); bf16_t* MIX = WSP(bf16_t, A0_MIX);
    const float* YH = WSP(float, A0_YH); const float* VX = WSP(float, A0_VX); const float* X0 = WSP(float, A0_X0);
    for (int row = F.gwave; row < TT; row += F.nwaves) {
        const int hs = F.lane >> 5, l32 = F.lane & 31; const f32x4 gn = *(const f32x4*)(INP(13) + l32 * 4);
#pragma unroll
        for (int hp = 0; hp < 2; ++hp) {
            const int col = (hp * 2 + hs) * 128 + l32 * 4;
            const f32x4 o = *(const f32x4*)(OD + (size_t)row * 512 + col) + *(const f32x4*)(OD + ((size_t)TT + row) * 512 + col);
            float ss = (o[0] * o[0] + o[1] * o[1]) + (o[2] * o[2] + o[3] * o[3]);
            ss += __shfl_xor(ss, 16); ss += __shfl_xor(ss, 8); ss += __shfl_xor(ss, 4); ss += __shfl_xor(ss, 2); ss += __shfl_xor(ss, 1);
            const float r = rsqrtf(ss * (1.0f / 128.0f) + RMS_EPS);
            const u32x2 zv = *(const u32x2*)(P + (size_t)row * NP0 + 1536 + col);
            const float z0 = __uint_as_float(zv.x << 16), z1 = __uint_as_float(zv.x & 0xffff0000u), z2 = __uint_as_float(zv.y << 16), z3 = __uint_as_float(zv.y & 0xffff0000u);
            u32x2 w; w.x = pk2(o[0] * r * gn[0] * silu_(z0), o[1] * r * gn[1] * silu_(z1)); w.y = pk2(o[2] * r * gn[2] * silu_(z2), o[3] * r * gn[3] * silu_(z3));
            *(u32x2*)(MIX + (size_t)row * MIXW + col) = w;
        }
    }
    LAS float* t2 = (LAS float*)F.lds;
    __syncthreads();
    for (int u = F.bid; u < (TT / 64) * 4; u += F.G) {
        const int rt = u >> 2, ct = u & 3, row0 = rt * 64; const bool isc = row0 >= TL;
        { const int c2 = F.tid >> 2, seg = F.tid & 3;
          const float* src = isc ? WSP(float, A0_YHTC) + (size_t)(ct * 128 + c2) * TC + (row0 - TL) : WSP(float, A0_YHTL) + (size_t)(ct * 128 + c2) * TL + row0;
          LAS float* tp = t2 + c2 * 65 + seg * 16;
#pragma unroll
          for (int q = 0; q < 4; ++q) { const f32x4 a = *(const f32x4*)(src + seg * 16 + q * 4); tp[q * 4] = a[0]; tp[q * 4 + 1] = a[1]; tp[q * 4 + 2] = a[2]; tp[q * 4 + 3] = a[3]; } }
        __syncthreads();
        { const int cl = F.tid & 63, rg = F.tid >> 6, c = ct * 128 + cl * 2; const f32x2 sk = *(const f32x2*)(INP(22) + c);
#pragma unroll
          for (int j = 0; j < 8; ++j) { const int row = row0 + rg * 8 + j; const size_t o = (size_t)row * 512 + c;
              const f32x2 x0 = *(const f32x2*)(X0 + o), vx = *(const f32x2*)(VX + o);
              const f32x2 yh = (f32x2){t2[(cl * 2) * 65 + rg * 8 + j], t2[(cl * 2 + 1) * 65 + rg * 8 + j]};
              const f32x2 r = x0 * (yh + vx * sk);
              *(unsigned*)(MIX + (size_t)row * MIXW + 512 + c) = pk2(r[0], r[1]); } }
        __syncthreads();
    }
}

template <int LAYER>
DI void p7_ln_route(const Fr& F, const float* xres_lat, const float* xres_ctx, const bf16_t* Y, int nrows) {
    const float* MOD = WSP(float, WS_MOD) + (size_t)LAYER * 9 * 6144;
    float* X1 = WSP(float, WS_X1); bf16_t* VB = WSP(bf16_t, WS_VB);
    int* RI = WSP(int, WS_RI); float* RW = WSP(float, WS_RW);
    const float* lng = INP(6) + (size_t)(LAYER * 2 + 0) * DM; const float* lnb = INP(7) + (size_t)(LAYER * 2 + 0) * DM;
    const float* rb = INP(35) + LAYER * NEXP;
    LAS float* rwt = (LAS float*)F.lds;
    { const f32x4* src = WSP(f32x4, WS_RWT) + (size_t)LAYER * 8192;
#pragma unroll
      for (int it = 0; it < 16; ++it) *(LAS f32x4*)(rwt + (F.tid + it * NTHR) * 4) = src[F.tid + it * NTHR]; }
    __syncthreads();
    const int lane = F.lane;
    LAS unsigned* lcnt = (LAS unsigned*)(F.lds + LDS_CTL_OFF + 64);
    if (F.tid < 32) lcnt[F.tid] = 0u;
    __syncthreads();
    const int per = 2 * ((nrows / 2 + F.G - 1) / F.G), rb0 = (F.bid * per < nrows) ? F.bid * per : nrows, rb1 = (rb0 + per < nrows) ? rb0 + per : nrows;
    f32x4 xq[2][4]; u32x2 yq[2][4];
#define LN_LOAD_PAIR(RP) do { _Pragma("unroll") for (int rr_ = 0; rr_ < 2; ++rr_) { const int row_ = (RP) * 2 + rr_; const bool isc_ = row_ >= TL; \
        const float* xr_ = isc_ ? xres_ctx + (size_t)(row_ - TL) * DM : xres_lat + (size_t)row_ * DM; \
        _Pragma("unroll") for (int i_ = 0; i_ < 4; ++i_) { xq[rr_][i_] = *(const f32x4*)(xr_ + i_ * 256 + lane * 4); yq[rr_][i_] = *(const u32x2*)(Y + (size_t)row_ * DM + i_ * 256 + lane * 4); } } } while (0)
    if (rb0 / 2 + F.wave < rb1 / 2) LN_LOAD_PAIR(rb0 / 2 + F.wave);
    for (int rp = rb0 / 2 + F.wave; rp < rb1 / 2; rp += 8) {
        f32x4 va[4], vb[4];
#pragma unroll
        for (int rr = 0; rr < 2; ++rr) {
            const int row = rp * 2 + rr; const bool isc = row >= TL; const int b = isc ? (row - TL) >> 8 : row >> 11;
            const float* md = MOD + (size_t)(isc ? 8 : b) * 6144;
            f32x4 y[4]; float s = 0.f;
#pragma unroll
            for (int i = 0; i < 4; ++i) { const int k = i * 256 + lane * 4;
                const u32x2 yw = yq[rr][i];
                const f32x4 yv = (f32x4){__uint_as_float(yw.x << 16), __uint_as_float(yw.x & 0xffff0000u), __uint_as_float(yw.y << 16), __uint_as_float(yw.y & 0xffff0000u)};
                y[i] = xq[rr][i] * ALPHA + *(const f32x4*)(md + 2048 + k) * yv;
                s += (y[i][0] + y[i][1]) + (y[i][2] + y[i][3]); }
            const float mu = wsum(s) * (1.0f / 1024.0f); float q = 0.f;
#pragma unroll
            for (int i = 0; i < 4; ++i) { const f32x4 dd = y[i] - mu; q += (dd[0] * dd[0] + dd[1] * dd[1]) + (dd[2] * dd[2] + dd[3] * dd[3]); }
            const float rstd = rsqrtf(wsum(q) * (1.0f / 1024.0f) + LN_EPS);
#pragma unroll
            for (int i = 0; i < 4; ++i) { const int k = i * 256 + lane * 4;
                const f32x4 x1 = (y[i] - mu) * rstd * *(const f32x4*)(lng + k) + *(const f32x4*)(lnb + k);
                *(f32x4*)(X1 + (size_t)row * DM + k) = x1;
                const f32x4 v = x1 * (*(const f32x4*)(md + 4096 + k) + 1.0f) + *(const f32x4*)(md + 3072 + k);
                u32x2 w; w.x = pk2(v[0], v[1]); w.y = pk2(v[2], v[3]);
                *(u32x2*)(VB + (size_t)row * DM + k) = w;
                if (rr == 0) va[i] = v; else vb[i] = v; }
        }
        if (rp + 8 < rb1 / 2) LN_LOAD_PAIR(rp + 8);
        float pa[32], pb[32];
#pragma unroll
        for (int e = 0; e < 32; ++e) { f32x2 sa = (f32x2){0.f, 0.f}, sb = sa;
#pragma unroll
            for (int i = 0; i < 4; ++i) { const f32x4 wv = *(const LAS f32x4*)(rwt + e * DM + i * 256 + lane * 4);
                const f32x2 w01 = (f32x2){wv[0], wv[1]}, w23 = (f32x2){wv[2], wv[3]};
                sa += (f32x2){va[i][0], va[i][1]} * w01; sa += (f32x2){va[i][2], va[i][3]} * w23;
                sb += (f32x2){vb[i][0], vb[i][1]} * w01; sb += (f32x2){vb[i][2], vb[i][3]} * w23; }
            pa[e] = sa.x + sa.y; pb[e] = sb.x + sb.y; asm volatile("" ::: "memory"); }
#define RS_STEP(N, OFF) { const bool up = (lane & (OFF)) != 0; \
            _Pragma("unroll") for (int e = 0; e < (N); ++e) { \
                const float ka = up ? pa[e + (N)] : pa[e], sa_ = up ? pa[e] : pa[e + (N)]; const float kb = up ? pb[e + (N)] : pb[e], sb_ = up ? pb[e] : pb[e + (N)]; \
                pa[e] = ka + __shfl_xor(sa_, (OFF)); pb[e] = kb + __shfl_xor(sb_, (OFF)); } }
        RS_STEP(16, 32) RS_STEP(8, 16) RS_STEP(4, 8) RS_STEP(2, 4) RS_STEP(1, 2)
#undef RS_STEP
        const int e = lane >> 1;
        float lga = pa[0] + __shfl_xor(pa[0], 1) + rb[e], lgb = pb[0] + __shfl_xor(pb[0], 1) + rb[e];
#pragma unroll
        for (int rr = 0; rr < 2; ++rr) {
            const int row = rp * 2 + rr; float val = rr ? lgb : lga; float sv[4]; int si[4];
#pragma unroll
            for (int kk = 0; kk < 4; ++kk) {
                float bv = val; int bi = e;
#pragma unroll
                for (int off = 32; off >= 2; off >>= 1) { const float ov = __shfl_xor(bv, off); const int oi = __shfl_xor(bi, off); if (ov > bv || (ov == bv && oi < bi)) { bv = ov; bi = oi; } }
                sv[kk] = bv; si[kk] = bi; if (e == bi) val = -3.0e38f;
            }
            const float e1 = __expf(sv[1] - sv[0]), e2 = __expf(sv[2] - sv[0]), e3 = __expf(sv[3] - sv[0]); const float inv = 1.0f / (1.0f + e1 + e2 + e3);
            if (lane == 0) {
                *(int4*)(RI + (size_t)row * 4) = make_int4(si[0], si[1], si[2], si[3]);
                *(f32x4*)(RW + (size_t)row * 4) = (f32x4){inv, e1 * inv, e2 * inv, e3 * inv};
                atomicAdd((unsigned*)(lcnt + si[0]), 1u); atomicAdd((unsigned*)(lcnt + si[1]), 1u); atomicAdd((unsigned*)(lcnt + si[2]), 1u); atomicAdd((unsigned*)(lcnt + si[3]), 1u);
            }
        }
    }
#undef LN_LOAD_PAIR
    __syncthreads();
    if (F.tid < 32) WSP(unsigned, WS_BC)[((size_t)LAYER * 1024 + F.bid) * 32 + F.tid] = lcnt[F.tid];
}

template <int LAYER>
DI void p8_assign(const Fr& F, int nrows) {
    unsigned* NT = WSP(unsigned, WS_CTL) + CW_NT + LAYER; const unsigned* BC = WSP(unsigned, WS_BC) + (size_t)LAYER * 1024 * 32;
    LAS int* offs = (LAS int*)F.lds;
    LAS unsigned* lcnt = (LAS unsigned*)(offs + 64);
    LAS int* lpos = (LAS int*)(offs + 192);
    { LAS unsigned* pt = (LAS unsigned*)(offs + 1024); const int e = F.tid & 31, sg = F.tid >> 5; unsigned tot = 0, pre = 0;
      for (int bb = sg; bb < F.G; bb += 16) { const unsigned c = BC[bb * 32 + e]; tot += c; pre += (bb < F.bid) ? c : 0u; }
      pt[sg * 32 + e] = tot; pt[512 + sg * 32 + e] = pre;
      __syncthreads();
      if (F.tid < 32) { unsigned t2 = 0, p2 = 0; for (int g = 0; g < 16; ++g) { t2 += pt[g * 32 + F.tid]; p2 += pt[512 + g * 32 + F.tid]; } lcnt[64 + F.tid] = t2; lcnt[32 + F.tid] = p2; lcnt[F.tid] = 0u; } }
    __syncthreads();
    if (F.tid == 0) { int o = 0; for (int e = 0; e < NEXP; ++e) { offs[e] = o; o += (int)((lcnt[64 + e] + 255u) & ~255u); } offs[32] = o; }
    __syncthreads();
    int* TILE_E = WSP(int, WS_TILEE); const int ntile = offs[32] >> 8;
    if (F.bid == 0) { for (int tl = F.tid; tl < ntile; tl += NTHR) { int e = 0; while (e < 31 && offs[e + 1] <= tl * 256) ++e; TILE_E[tl] = e; } if (F.tid == 0) *NT = (unsigned)ntile; }
    bf16_t* VBG = WSP(bf16_t, WS_VBG); const bf16_t* VB = WSP(bf16_t, WS_VB);
    constexpr bool F8 = (LAYER == 1) ? (MK_FP8_L1 != 0) : (MK_FP8_L0 != 0);
    unsigned char* VBG8 = WSP(unsigned char, WS_VBG);
    for (int e = F.bid; e < NEXP; e += F.G) { const int r0 = offs[e] + (int)lcnt[64 + e], r1 = offs[e + 1];
        for (int r = r0 + F.wave; r < r1; r += 8) { u32x4 zz = (u32x4){0u, 0u, 0u, 0u};
            if (F8) *(u32x4*)(VBG8 + (size_t)r * DM + F.lane * 16) = zz;
            else { *(u32x4*)(VBG + (size_t)r * DM + F.lane * 8) = zz; *(u32x4*)(VBG + (size_t)r * DM + 512 + F.lane * 8) = zz; } } }
    const int* RI = WSP(int, WS_RI); int* SP = WSP(int, WS_SP);
    const int per = 2 * ((nrows / 2 + F.G - 1) / F.G), rb0 = (F.bid * per < nrows) ? F.bid * per : nrows, rb1 = (rb0 + per < nrows) ? rb0 + per : nrows; const int nslot = (rb1 > rb0 ? rb1 - rb0 : 0) * 4;
    if (F.tid < nslot) { const int my_e = RI[(size_t)rb0 * 4 + F.tid]; const int my_rank = (int)atomicAdd((unsigned*)(lcnt + my_e), 1u);
        const int pos = offs[my_e] + (int)lcnt[32 + my_e] + my_rank; lpos[F.tid] = pos; SP[(size_t)rb0 * 4 + F.tid] = pos; }
    __syncthreads();
    for (int rl = F.wave; rl < rb1 - rb0; rl += 8) { const int row = rb0 + rl;
        const u32x4 v0 = *(const u32x4*)(VB + (size_t)row * DM + F.lane * 8), v1 = *(const u32x4*)(VB + (size_t)row * DM + 512 + F.lane * 8);
        u32x2 q0 = (u32x2){0u, 0u}, q1 = q0;
        if (F8) { q0.x = pk4_fp8(__uint_as_float(v0.x << 16), __uint_as_float(v0.x & 0xffff0000u), __uint_as_float(v0.y << 16), __uint_as_float(v0.y & 0xffff0000u));
                  q0.y = pk4_fp8(__uint_as_float(v0.z << 16), __uint_as_float(v0.z & 0xffff0000u), __uint_as_float(v0.w << 16), __uint_as_float(v0.w & 0xffff0000u));
                  q1.x = pk4_fp8(__uint_as_float(v1.x << 16), __uint_as_float(v1.x & 0xffff0000u), __uint_as_float(v1.y << 16), __uint_as_float(v1.y & 0xffff0000u));
                  q1.y = pk4_fp8(__uint_as_float(v1.z << 16), __uint_as_float(v1.z & 0xffff0000u), __uint_as_float(v1.w << 16), __uint_as_float(v1.w & 0xffff0000u)); }
#pragma unroll
        for (int k = 0; k < 4; ++k) { const int pos = lpos[rl * 4 + k];
            if (F8) { *(u32x2*)(VBG8 + (size_t)pos * DM + F.lane * 8) = q0; *(u32x2*)(VBG8 + (size_t)pos * DM + 512 + F.lane * 8) = q1; }
            else { *(u32x4*)(VBG + (size_t)pos * DM + F.lane * 8) = v0; *(u32x4*)(VBG + (size_t)pos * DM + 512 + F.lane * 8) = v1; } }
    }
    __syncthreads();
}

template <int LAYER>
DI void p11_combine(const Fr& F, int nrows, float* xout) {
    const float* MOD = WSP(float, WS_MOD) + (size_t)LAYER * 9 * 6144;
    const float* X1 = WSP(float, WS_X1); const bf16_t* YS = WSP(bf16_t, WS_YS);
    const int* SP = WSP(int, WS_SP); const float* RW = WSP(float, WS_RW);
    const float* lng = INP(6) + (size_t)(LAYER * 2 + 1) * DM; const float* lnb = INP(7) + (size_t)(LAYER * 2 + 1) * DM;
    const float* MODN = WSP(float, WS_MOD) + (size_t)1 * 9 * 6144; const float* POS = WSP(float, WS_POS); bf16_t* UN = WSP(bf16_t, A1_U);
    u32x2 ysq[4][4]; f32x4 x1q[4], posq[4]; int4 spn = make_int4(0, 0, 0, 0); f32x4 rwq = (f32x4){0.f, 0.f, 0.f, 0.f}, rwn = rwq;
#define CMB_LOAD_ROW(ROW, SPV) do { const int spa_[4] = {(SPV).x, (SPV).y, (SPV).z, (SPV).w}; \
        _Pragma("unroll") for (int i_ = 0; i_ < 4; ++i_) { const int k_ = i_ * 256 + F.lane * 4; x1q[i_] = *(const f32x4*)(X1 + (size_t)(ROW) * DM + k_); \
            if (LAYER == 0) posq[i_] = ((ROW) >= TL) ? (f32x4){0.f, 0.f, 0.f, 0.f} : *(const f32x4*)(POS + (size_t)((ROW) & 2047) * DM + k_); \
            _Pragma("unroll") for (int j_ = 0; j_ < 4; ++j_) ysq[j_][i_] = *(const u32x2*)(YS + (size_t)spa_[j_] * DM + k_); } } while (0)
    int row = F.gwave;
    if (row < nrows) { const int4 sp0 = *(const int4*)(SP + (size_t)row * 4); rwq = *(const f32x4*)(RW + (size_t)row * 4); CMB_LOAD_ROW(row, sp0);
        if (row + F.nwaves < nrows) { spn = *(const int4*)(SP + (size_t)(row + F.nwaves) * 4); rwn = *(const f32x4*)(RW + (size_t)(row + F.nwaves) * 4); } }
    for (; row < nrows; row += F.nwaves) {
        const bool isc = row >= TL; const int b = isc ? (row - TL) >> 8 : row >> 11;
        const float* md = MOD + (size_t)(isc ? 8 : b) * 6144;
        f32x4 y[4], pcur[4]; float s = 0.f;
#pragma unroll
        for (int i = 0; i < 4; ++i) { const int k = i * 256 + F.lane * 4; f32x4 f = (f32x4){0.f, 0.f, 0.f, 0.f};
#pragma unroll
            for (int j = 0; j < 4; ++j) { const u32x2 w = ysq[j][i];
                f += (f32x4){__uint_as_float(w.x << 16), __uint_as_float(w.x & 0xffff0000u), __uint_as_float(w.y << 16), __uint_as_float(w.y & 0xffff0000u)} * rwq[j]; }
            y[i] = x1q[i] * ALPHA + *(const f32x4*)(md + 5120 + k) * f; if (LAYER == 0) pcur[i] = posq[i];
            s += (y[i][0] + y[i][1]) + (y[i][2] + y[i][3]); }
        { const int rn = row + F.nwaves; if (rn < nrows) { const int4 spv = spn; rwq = rwn; CMB_LOAD_ROW(rn, spv);
              const int rn2 = rn + F.nwaves; if (rn2 < nrows) { spn = *(const int4*)(SP + (size_t)rn2 * 4); rwn = *(const f32x4*)(RW + (size_t)rn2 * 4); } } }
        const float mu = wsum(s) * (1.0f / 1024.0f); float q = 0.f;
#pragma unroll
        for (int i = 0; i < 4; ++i) { const f32x4 dd = y[i] - mu; q += (dd[0] * dd[0] + dd[1] * dd[1]) + (dd[2] * dd[2] + dd[3] * dd[3]); }
        const float rstd = rsqrtf(wsum(q) * (1.0f / 1024.0f) + LN_EPS);
#pragma unroll
        for (int i = 0; i < 4; ++i) { const int k = i * 256 + F.lane * 4;
            const f32x4 x2 = (y[i] - mu) * rstd * *(const f32x4*)(lng + k) + *(const f32x4*)(lnb + k);
            *(f32x4*)(xout + (size_t)row * DM + k) = x2;
            if (LAYER == 0) {
                const float* mn = MODN + (size_t)(isc ? 8 : b) * 6144;
                const f32x4 u = x2 * (*(const f32x4*)(mn + 1024 + k) + 1.0f) + *(const f32x4*)(mn + k) + pcur[i];
                u32x2 w; w.x = pk2(u[0], u[1]); w.y = pk2(u[2], u[3]);
                *(u32x2*)(UN + (size_t)row * DM + k) = w;
            } }
    }
#undef CMB_LOAD_ROW
}

DI void p13_lru_conv(const Fr& F) {
    const bf16_t* P1 = WSP(bf16_t, A1_P); float* XC = WSP(float, A1_XC); bf16_t* XCB = WSP(bf16_t, A1_XCB); const float* cw = INP(25); const float* cb = INP(26);
    for (int u = F.bid; u < (TT / 64) * 4; u += F.G) {
        const int rt = u >> 2, c = (u & 3) * 256 + F.lane * 4, row0 = rt * 64 + F.wave * 8; const bool isc = row0 >= TL; const int L = isc ? CTXL : SEQ;
        const int t0 = isc ? ((row0 - TL) & 255) : (row0 & 2047);
        f32x4 w[4]; const f32x4 bv = *(const f32x4*)(cb + c);
#pragma unroll
        for (int i = 0; i < 4; ++i) w[i] = *(const f32x4*)(cw + i * DM + c);
        f32x4 p[11];
#pragma unroll
        for (int rr = 0; rr < 11; ++rr) { const int tl = t0 + rr - 2; u32x2 pv = (u32x2){0u, 0u}; if (tl >= 0 && tl < L) pv = *(const u32x2*)(P1 + (size_t)(row0 + rr - 2) * 2048 + c);
            p[rr] = (f32x4){__uint_as_float(pv.x << 16), __uint_as_float(pv.x & 0xffff0000u), __uint_as_float(pv.y << 16), __uint_as_float(pv.y & 0xffff0000u)}; }
#pragma unroll
        for (int j = 0; j < 8; ++j) { const f32x4 a = bv + w[0] * p[j] + w[1] * p[j + 1] + w[2] * p[j + 2] + w[3] * p[j + 3];
            *(f32x4*)(XC + (size_t)(row0 + j) * DM + c) = a; u32x2 o; o.x = pk2(a[0], a[1]); o.y = pk2(a[2], a[3]); *(u32x2*)(XCB + (size_t)(row0 + j) * DM + c) = o; }
    }
}
#define LRU_SG(x) (x)
DI void p15_lru_scan(const Fr& F) {
    const unsigned* AB = WSP(unsigned, A1_RG); bf16_t* HS = WSP(bf16_t, A1_HS);
    LAS float* agg = (LAS float*)F.lds;
    for (int u = F.bid; u < NB * 2 * 16; u += F.G) {
        const int cg = u & 15, d = (u >> 4) & 1, b = u >> 5; const int pr = F.lane & 31, j = F.wave * 2 + (F.lane >> 5), col = cg * 64 + pr * 2;
        const unsigned* ab = AB + (size_t)d * TT * DM + col;
        float As0 = 0.f, As1 = 0.f, Bp0 = 0.f, Bp1 = 0.f;
#pragma unroll 16
        for (int s = 0; s < 144; ++s) { const u32x2 v = *(const u32x2*)(ab + (size_t)row_of(b, d, j * 144 + s) * DM);
            const float la0 = __uint_as_float(v.x << 16), bc0 = __uint_as_float(v.x & 0xffff0000u), la1 = __uint_as_float(v.y << 16), bc1 = __uint_as_float(v.y & 0xffff0000u);
            As0 += la0; Bp0 = __expf(la0) * Bp0 + bc0; As1 += la1; Bp1 = __expf(la1) * Bp1 + bc1; }
        *(LAS f32x4*)(agg + (j * 32 + pr) * 4) = (f32x4){__expf(As0), Bp0, __expf(As1), Bp1};
        __syncthreads();
        float h0 = 0.f, h1 = 0.f;
        for (int m = 0; m < j; ++m) { const f32x4 g = *(const LAS f32x4*)(agg + (m * 32 + pr) * 4); h0 = g[0] * h0 + g[1]; h1 = g[2] * h1 + g[3]; }
#pragma unroll 16
        for (int s = 0; s < 144; ++s) { const int p = j * 144 + s; const int row = row_of(b, d, p); const u32x2 v = *(const u32x2*)(ab + (size_t)row * DM);
            const float la0 = __uint_as_float(v.x << 16), bc0 = __uint_as_float(v.x & 0xffff0000u), la1 = __uint_as_float(v.y << 16), bc1 = __uint_as_float(v.y & 0xffff0000u);
            h0 = __expf(la0) * h0 + bc0; h1 = __expf(la1) * h1 + bc1;
            if (p >= CTXL) *(unsigned*)(HS + ((size_t)d * TL + row) * DM + col) = pk2(h0, h1); }
        __syncthreads();
    }
}
DI void p16_lru_gate(const Fr& F) {
    const bf16_t* HS = WSP(bf16_t, A1_HS); const bf16_t* P1 = WSP(bf16_t, A1_P); bf16_t* HG = WSP(bf16_t, A1_HG);
    for (int i = F.bid * NTHR + F.tid; i < TL * DM / 8; i += F.G * NTHR) {
        const int row = i >> 7, c = (i & 127) * 8;
        const u32x4 h0 = *(const u32x4*)(HS + (size_t)row * DM + c), h1 = *(const u32x4*)(HS + ((size_t)TL + row) * DM + c), gt = *(const u32x4*)(P1 + (size_t)row * 2048 + 1024 + c);
        u32x4 o;
#pragma unroll
        for (int q = 0; q < 4; ++q) {
            const float ha = __uint_as_float(h0[q] << 16) + __uint_as_float(h1[q] << 16), hb2 = __uint_as_float(h0[q] & 0xffff0000u) + __uint_as_float(h1[q] & 0xffff0000u);
            o[q] = pk2(ha * gelu_tanh(__uint_as_float(gt[q] << 16)), hb2 * gelu_tanh(__uint_as_float(gt[q] & 0xffff0000u))); }
        *(u32x4*)(HG + (size_t)row * DM + c) = o;
    }
}

#ifndef MK_DIAG
#define MK_DIAG 0
#endif
#ifndef MK_DIAG_SUB
#define MK_DIAG_SUB 0
#endif
constexpr int CW_DIAG = 4096 + 256;
DI void diag_max(const Fr& F, float v) { if (v == v) atomicMax(WSP(unsigned, WS_CTL) + CW_DIAG, __float_as_uint(fabsf(v))); else atomicMax(WSP(unsigned, WS_CTL) + CW_DIAG, 0x7f000000u); }
DI void diag_lru_gates(const Fr& F) {
    const bf16_t* RG = WSP(bf16_t, A1_RG); const float* XC = WSP(float, A1_XC);
    for (int smp = F.bid * NTHR + F.tid; smp < 262144; smp += F.G * NTHR) {
        const unsigned hsh = (unsigned)smp * 2654435761u; const int row = (int)(hsh % (unsigned)TT); const int tcol = (int)((hsh >> 7) % 4096u);
        const int t = tcol >> 10, col = tcol & 1023, h = col >> 8, j = col & 255;
        const float* W = (t < 2 ? INP(27) : INP(29)) + (size_t)((t & 1) * 4 + h) * 65536 + j;
        float acc = (t < 2 ? INP(28) : INP(30))[(t & 1) * DM + col];
        for (int i = 0; i < 256; ++i) acc += XC[(size_t)row * DM + h * 256 + i] * W[(size_t)i * 256];
        const float df = sigm(acc) - LRU_SG(bf2f(RG[(size_t)row * 4096 + tcol]));
#if MK_DIAG_SUB == 0
        diag_max(F, df);
#elif MK_DIAG_SUB == 1
        if (!(fabsf(df) < 0.05f)) atomicAdd(WSP(unsigned, WS_CTL) + CW_DIAG + 1, 1u);
#elif MK_DIAG_SUB == 2
        if (!(fabsf(df) < 0.05f)) atomicMax(WSP(unsigned, WS_CTL) + CW_DIAG + 1, (unsigned)(tcol >> 8) + 1u);
#elif MK_DIAG_SUB == 3
        if (!(fabsf(df) < 0.05f)) atomicMax(WSP(unsigned, WS_CTL) + CW_DIAG + 1, (unsigned)(row >> 8) + 1u);
#elif MK_DIAG_SUB == 4
        if (!(fabsf(df) < 0.05f)) { const int uid = (row >> 8) * 16 + (tcol >> 8); atomicOr(WSP(unsigned, WS_CTL) + CW_DIAG + 8 + (uid >> 5), 1u << (uid & 31)); }
#elif MK_DIAG_SUB == 5
        if (!(fabsf(df) < 0.05f)) { const int uid = row & 255; atomicOr(WSP(unsigned, WS_CTL) + CW_DIAG + 8 + (uid >> 5), 1u << (uid & 31)); }
#elif MK_DIAG_SUB == 6
        if (!(fabsf(df) < 0.05f)) { const int uid = tcol & 255; atomicOr(WSP(unsigned, WS_CTL) + CW_DIAG + 8 + (uid >> 5), 1u << (uid & 31)); }
#endif
    }
}
DI void diag_lru_scan(const Fr& F) {
    const bf16_t* RG = WSP(bf16_t, A1_RG); const float* XC = WSP(float, A1_XC); const float* HS = WSP(float, A1_HS);
    for (int u = F.bid * NTHR + F.tid; u < NB * 2 * DM; u += F.G * NTHR) {
        const int col = u & 1023, d = (u >> 10) & 1, b = u >> 11; const float sp = softplus_(INP(31)[d * DM + col]);
        float hst = 0.f, md = 0.f;
        for (int p = 0; p < CTXL + SEQ; ++p) { const int row = row_of(b, d, p);
            const float r = LRU_SG(bf2f(RG[(size_t)row * 4096 + d * 1024 + col])), ig = LRU_SG(bf2f(RG[(size_t)row * 4096 + (2 + d) * 1024 + col])), x = XC[(size_t)row * DM + col];
            const float la = -8.0f * r * sp, a = expf(la), bc = sqrtf(fmaxf(-expm1f(2.0f * la), 0.f)) * (ig * x);
            hst = a * hst + bc;
            if (p >= CTXL) { const float df = fabsf(hst - HS[((size_t)d * TL + row) * DM + col]); md = (df > md || df != df) ? df : md; } }
        diag_max(F, md);
    }
}
DI void diag_fill(const Fr& F, float* out) {
#if MK_DIAG_SUB == 0
    const float v = 1.0f + 1000.0f * __uint_as_float(WSP(unsigned, WS_CTL)[CW_DIAG]);
#elif MK_DIAG_SUB >= 4
    unsigned cntb = 0; for (int i = 0; i < 40; ++i) cntb += __popc(WSP(unsigned, WS_CTL)[CW_DIAG + 8 + i]);
    const float v = 1.0f + (float)cntb;
#else
    const float v = 1.0f + (float)WSP(unsigned, WS_CTL)[CW_DIAG + 1];
#endif
    for (int i = F.bid * NTHR + F.tid; i < TL * DM; i += F.G * NTHR) out[i] = v;
}
enum { PH_PRO = 0, PH_MOD0, PH_INPROJ0, PH_PREP0, PH_CORE0, PH_MIX0, PH_OUTPROJ0, PH_LN0, PH_ASG0, PH_MOE1_0, PH_MOE2_0, PH_CMB0,
       PH_INPROJ1, PH_CONV1, PH_GATES1, PH_SCAN1, PH_GATE1, PH_OUTPROJ1, PH_LN1, PH_ASG1, PH_MOE1_1, PH_MOE2_1, PH_CMB1, NPH };
__global__ void __launch_bounds__(NTHR, 2) mk_fwd(Args args) {
    extern __shared__ __attribute__((aligned(16))) unsigned char lds_raw[];
    Fr F;
    F.a = &args; F.lds = (LAS unsigned char*)lds_raw; F.ws = args.ws;
    F.tid = threadIdx.x; F.lane = F.tid & 63; F.wave = __builtin_amdgcn_readfirstlane(F.tid >> 6); F.G = gridDim.x; F.bid = blockIdx.x;
    F.gwave = F.bid * 8 + F.wave; F.nwaves = F.G * 8;
    volatile LAS unsigned* xbw = (volatile LAS unsigned*)(F.lds + LDS_CTL_OFF);
    if (F.tid < 4) xbw[F.tid] = 0u;
    __syncthreads();
#if MK_ONE_LAUNCH
    XcdBarrier bar = xcd_barrier_post(WSP(unsigned, WS_CTL) + CW_BAR, xbw);
#if MK_BG_CONV
#define GRID_BAR() xcd_barrier_work(bar, F)
#else
#define GRID_BAR() xcd_barrier(bar)
#endif
#else
#define GRID_BAR() do {} while (0)
#endif
    const int lo = args.ph_lo, hi = args.ph_hi;
#ifndef MK_PH_MASK
#define MK_PH_MASK 0xFFFFFFFFu
#endif
#define IN(k) (((MK_PH_MASK >> (k)) & 1u) && lo <= (k) && (k) < hi)
#define SEAM(k) do { if (IN((k) + 1)) { GRID_BAR(); } } while (0)
    LAS unsigned char* glds = F.lds;

    if (IN(PH_PRO)) { p0_prologue(F); SEAM(PH_PRO); }
    if (IN(PH_MOD0)) { p1_mod0(F); SEAM(PH_MOD0); }
    if (IN(PH_INPROJ0)) {
        __syncthreads();
        pg8::Gemm g{WSP(bf16_t, A0_U), WSP(bf16_t, WS_WEVIN), TT, NP0, DM, DM}; pg8::StaticOrder S; S.init(TT, NP0, F.G, F.bid);
        pg8::EpiBf16 E{WSP(bf16_t, A0_P), NP0, nullptr, 0};
        pg8::gemm_phase(glds, g, S, E); SEAM(PH_INPROJ0);
    }
    if (IN(PH_PREP0)) { p3_prep(F); SEAM(PH_PREP0); }
    if (IN(PH_CORE0)) { __syncthreads(); p4_mix_core(F); SEAM(PH_CORE0); }
    if (IN(PH_MIX0)) { p5_mix(F); SEAM(PH_MIX0); }
    if (IN(PH_OUTPROJ0)) {
        __syncthreads();
        pg8::Gemm g{WSP(bf16_t, A0_MIX), WSP(bf16_t, WS_WEVOUT), TT, DM, MIXW, MIXW}; pg8::StaticOrder S; S.init(TT, DM, F.G, F.bid);
        pg8::EpiBf16 E{WSP(bf16_t, A0_Y), DM, nullptr, 0};
        pg8::gemm_phase(glds, g, S, E);
        if (F.G == 256 && !MK_BG_CONV && F.bid >= 32) moe_w_l1_part(F, 0, 0, L1W1_A, F.bid - 32, 224);
        SEAM(PH_OUTPROJ0);
    }
    if (IN(PH_LN0)) { __syncthreads(); p7_ln_route<0>(F, INP(0), INP(2), WSP(bf16_t, A0_Y), TT); SEAM(PH_LN0); }
    if (IN(PH_ASG0)) { __syncthreads(); p8_assign<0>(F, TT);
#if MK_BG_CONV
        conv_drain(F, TQ_PER_LAYER);
#endif
        SEAM(PH_ASG0); }
    if (IN(PH_MOE1_0)) {
        __syncthreads();
        const int ntm = (int)WSP(unsigned, WS_CTL)[CW_NT + 0];
#if MK_FP8_L0
        pg8::Gemm g{WSP(bf16_t, WS_VBG), WSP(bf16_t, WS_WM1), ntm * 256, 2048, DM / 2, DM / 2}; pg8::MoeOrder S{WSP(int, WS_TILEE), ntm, 8, F.G, F.bid};
        pg8::EpiSwigluF8 E{WSP(unsigned char, WS_ACT), DM, INP(37), 2048, 1.0f / W1_F8S};
        pg8::gemm_phase<pg8::EpiSwigluF8, pg8::MoeOrder, true>(glds, g, S, E); SEAM(PH_MOE1_0);
#else
        pg8::Gemm g{WSP(bf16_t, WS_VBG), WSP(bf16_t, WS_WM1), ntm * 256, 2048, DM, DM}; pg8::MoeOrder S{WSP(int, WS_TILEE), ntm, 8, F.G, F.bid};
        pg8::EpiSwiglu E{WSP(bf16_t, WS_ACT), DM, INP(37), 2048};
        pg8::gemm_phase(glds, g, S, E); SEAM(PH_MOE1_0);
#endif
    }
    if (IN(PH_MOE2_0)) {
        __syncthreads();
        const int ntm = (int)WSP(unsigned, WS_CTL)[CW_NT + 0];
#if MK_FP8_L0
        pg8::Gemm g{WSP(bf16_t, WS_ACT), WSP(bf16_t, WS_WM2), ntm * 256, DM, DM / 2, DM / 2}; pg8::MoeOrder S{WSP(int, WS_TILEE), ntm, 4, F.G, F.bid};
        pg8::EpiBf16 E{WSP(bf16_t, WS_YS), DM, INP(39), DM, 1.0f / W2_F8S};
        pg8::gemm_phase<pg8::EpiBf16, pg8::MoeOrder, true>(glds, g, S, E); SEAM(PH_MOE2_0);
#else
        pg8::Gemm g{WSP(bf16_t, WS_ACT), WSP(bf16_t, WS_WM2), ntm * 256, DM, DM, DM}; pg8::MoeOrder S{WSP(int, WS_TILEE), ntm, 4, F.G, F.bid};
        pg8::EpiBf16 E{WSP(bf16_t, WS_YS), DM, INP(39), DM};
        pg8::gemm_phase(glds, g, S, E); SEAM(PH_MOE2_0);
#endif
    }
    if (IN(PH_CMB0)) { p11_combine<0>(F, TT, WSP(float, WS_X2)); SEAM(PH_CMB0); }
    if (IN(PH_INPROJ1)) {
        __syncthreads();
        pg8::Gemm g{WSP(bf16_t, A1_U), WSP(bf16_t, WS_WODIN), TT, 2048, DM, DM}; pg8::StaticOrder S; S.init(TT, 2048, F.G, F.bid);
        pg8::EpiBf16 E{WSP(bf16_t, A1_P), 2048, INP(24), 0};
        pg8::gemm_phase(glds, g, S, E);
        if (F.G == 256 && !MK_BG_CONV && F.bid >= 64) moe_w_l1_part(F, 0, L1W1_A, L1W1_B, F.bid - 64, 192);
        SEAM(PH_INPROJ1);
    }
    if (IN(PH_CONV1)) { p13_lru_conv(F); SEAM(PH_CONV1); }
    if (IN(PH_GATES1)) {
        __syncthreads();
        pg8::Gemm g{WSP(bf16_t, A1_XCB), WSP(bf16_t, WS_WLRU), TT, 4096, 256, DM}; pg8::LruOrder S; S.init(TT, 4096, F.G, F.bid);
        pg8::EpiLruAB E{WSP(unsigned, A1_RG), WSP(float, WS_BLRU), WSP(float, WS_BLRU) + 4096, WSP(bf16_t, A1_XCB), TT};
        pg8::gemm_phase(glds, g, S, E); SEAM(PH_GATES1);
    }
#if MK_DIAG == 1
    if (IN(PH_SCAN1)) { diag_lru_gates(F); SEAM(PH_SCAN1); }
#else
    if (IN(PH_SCAN1)) { __syncthreads(); p15_lru_scan(F); SEAM(PH_SCAN1); }
#endif
#if MK_DIAG == 2
    if (IN(PH_GATE1)) { diag_lru_scan(F); SEAM(PH_GATE1); }
#else
    if (IN(PH_GATE1)) { p16_lru_gate(F); SEAM(PH_GATE1); }
#endif
    if (IN(PH_OUTPROJ1)) {
        __syncthreads();
        pg8::Gemm g{WSP(bf16_t, A1_HG), WSP(bf16_t, WS_WODOUT), TL, DM, DM, DM}; pg8::StaticOrder S; S.init(TL, DM, F.G, F.bid);
        pg8::EpiBf16 E{WSP(bf16_t, A1_Y), DM, INP(33), 0};
        pg8::gemm_phase(glds, g, S, E); SEAM(PH_OUTPROJ1);
    }
    if (IN(PH_LN1)) { __syncthreads(); p7_ln_route<1>(F, WSP(float, WS_X2), WSP(float, WS_X2) + (size_t)TL * DM, WSP(bf16_t, A1_Y), TL); SEAM(PH_LN1); }
    if (IN(PH_ASG1)) { __syncthreads(); p8_assign<1>(F, TL);
#if MK_BG_CONV
        conv_drain(F, TQ_TOTAL);
#endif
        SEAM(PH_ASG1); }
    if (IN(PH_MOE1_1)) {
        __syncthreads();
        const int ntm = (int)WSP(unsigned, WS_CTL)[CW_NT + 1];
#if MK_FP8_L1
        pg8::Gemm g{WSP(bf16_t, WS_VBG), (const bf16_t*)(WSP(unsigned char, WS_WM1) + (size_t)32 * 2048 * DM * 2), ntm * 256, 2048, DM / 2, DM / 2}; pg8::MoeOrder S{WSP(int, WS_TILEE), ntm, 8, F.G, F.bid};
        pg8::EpiSwigluF8 E{WSP(unsigned char, WS_ACT), DM, INP(37) + (size_t)32 * 2048, 2048, 1.0f / W1_F8S};
        pg8::gemm_phase<pg8::EpiSwigluF8, pg8::MoeOrder, true>(glds, g, S, E); SEAM(PH_MOE1_1);
#else
        pg8::Gemm g{WSP(bf16_t, WS_VBG), WSP(bf16_t, WS_WM1) + (size_t)32 * 2048 * DM, ntm * 256, 2048, DM, DM}; pg8::MoeOrder S{WSP(int, WS_TILEE), ntm, 8, F.G, F.bid};
        pg8::EpiSwiglu E{WSP(bf16_t, WS_ACT), DM, INP(37) + (size_t)32 * 2048, 2048};
        pg8::gemm_phase(glds, g, S, E); SEAM(PH_MOE1_1);
#endif
    }
    if (IN(PH_MOE2_1)) {
        __syncthreads();
        const int ntm = (int)WSP(unsigned, WS_CTL)[CW_NT + 1];
#if MK_FP8_L1
        pg8::Gemm g{WSP(bf16_t, WS_ACT), (const bf16_t*)(WSP(unsigned char, WS_WM2) + (size_t)32 * DM * DM * 2), ntm * 256, DM, DM / 2, DM / 2}; pg8::MoeOrder S{WSP(int, WS_TILEE), ntm, 4, F.G, F.bid};
        pg8::EpiBf16 E{WSP(bf16_t, WS_YS), DM, INP(39) + (size_t)32 * DM, DM, 1.0f / W2_F8S};
        pg8::gemm_phase<pg8::EpiBf16, pg8::MoeOrder, true>(glds, g, S, E); SEAM(PH_MOE2_1);
#else
        pg8::Gemm g{WSP(bf16_t, WS_ACT), WSP(bf16_t, WS_WM2) + (size_t)32 * DM * DM, ntm * 256, DM, DM, DM}; pg8::MoeOrder S{WSP(int, WS_TILEE), ntm, 4, F.G, F.bid};
        pg8::EpiBf16 E{WSP(bf16_t, WS_YS), DM, INP(39) + (size_t)32 * DM, DM};
        pg8::gemm_phase(glds, g, S, E); SEAM(PH_MOE2_1);
#endif
    }
#if MK_DIAG
    if (IN(PH_CMB1)) { diag_fill(F, args.out); }
#else
    if (IN(PH_CMB1)) { p11_combine<1>(F, TL, args.out); }
#endif
#undef IN
#undef SEAM
}

extern "C" void kernel_launch(void* const* d_in, const int* in_sizes, int n_in, void* d_out, int out_size, void* d_ws, size_t ws_size, hipStream_t stream) {
    static int grid = 0;
    if (grid == 0) {
        static const int exp_sizes[40] = {16777216, 8192, 2097152, 1024, 12582912, 12288, 4096, 4096, 3686400, 1048576, 6144, 8, 8, 128, 4608, 1536, 2112, 64, 8192, 128, 65536, 64, 512,
            2097152, 2048, 4096, 1024, 524288, 2048, 524288, 2048, 2048, 1048576, 1024, 65536, 64, 134217728, 131072, 67108864, 65536};
        bool ok_sizes = (n_in == 40);
        for (int i = 0; ok_sizes && i < 40; ++i) if (in_sizes[i] != exp_sizes[i]) { fprintf(stderr, "kernel_launch: input %d has %d elements, expected %d\n", i, in_sizes[i], exp_sizes[i]); ok_sizes = false; }
        if (!ok_sizes || out_size != TL * DM || ws_size < WS_END) { fprintf(stderr, "kernel_launch: unexpected shapes: n_in %d out %d ws %zu (need %zu)\n", n_in, out_size, ws_size, (size_t)WS_END); grid = -1; return; }
        int dev = 0, cus = 0, per_cu = 0;
        if (hipGetDevice(&dev) != hipSuccess || hipDeviceGetAttribute(&cus, hipDeviceAttributeMultiprocessorCount, dev) != hipSuccess) { grid = -1; return; }
        if (hipFuncSetAttribute((const void*)mk_fwd, hipFuncAttributeMaxDynamicSharedMemorySize, LDS_BYTES) != hipSuccess) { fprintf(stderr, "kernel_launch: hipFuncSetAttribute failed\n"); grid = -1; return; }
        if (hipOccupancyMaxActiveBlocksPerMultiprocessor(&per_cu, (const void*)mk_fwd, NTHR, LDS_BYTES) != hipSuccess || per_cu < 1) { fprintf(stderr, "kernel_launch: occupancy query says %d\n", per_cu); }
        (void)hipGetLastError();
        grid = cus;
    }
    if (grid < 0) return;
    (void)hipMemsetAsync((char*)d_ws + WS_CTL, 0, CTL_BYTES, stream);
    Args a{};
    for (int i = 0; i < 40; ++i) a.in[i] = (const float*)d_in[i];
    a.out = (float*)d_out; a.ws = (unsigned char*)d_ws;
#if MK_ONE_LAUNCH
    a.ph_lo = 0; a.ph_hi = NPH;
    hipLaunchKernelGGL(mk_fwd, dim3(grid), dim3(NTHR), LDS_BYTES, stream, a);
#else
#ifndef MK_MAXPH
#define MK_MAXPH NPH
#endif
#ifndef MK_REPEAT
#define MK_REPEAT -1
#endif
    for (int p = 0; p < MK_MAXPH; ++p) { a.ph_lo = p; a.ph_hi = p + 1; hipLaunchKernelGGL(mk_fwd, dim3(grid), dim3(NTHR), LDS_BYTES, stream, a);
        if (p == MK_REPEAT) { a.flags = 1; hipLaunchKernelGGL(mk_fwd, dim3(grid), dim3(NTHR), LDS_BYTES, stream, a); a.flags = 0; } }
#endif
}
```

```cpp
#include <hip/hip_runtime.h>
#include <cstdio>
#include <cstdint>

#ifndef MK_ONE_LAUNCH
#define MK_ONE_LAUNCH 1
#endif

#define LAS __attribute__((address_space(3)))
#define DI __device__ __forceinline__
typedef unsigned short bf16_t;
typedef float f32x4 __attribute__((ext_vector_type(4)));
typedef float f32x2 __attribute__((ext_vector_type(2)));
typedef unsigned u32x4 __attribute__((ext_vector_type(4)));
typedef unsigned u32x2 __attribute__((ext_vector_type(2)));

constexpr int DM = 1024, NB = 8, SEQ = 2048, CTXL = 256;
constexpr int TL = NB * SEQ;
constexpr int TC = NB * CTXL;
constexpr int TT = TL + TC;
constexpr int EVEN_IN = 3600, DN_GATE_COL = 2048, HY_COL = 2064;
constexpr int NP0 = 3584;
constexpr int MIXW = 1024;
constexpr int NEXP = 32, TOPK = 4;
constexpr int MOE_ROWS = 82176;
constexpr float ALPHA = 1.4142135623730951f;
constexpr float LN_EPS = 1e-5f, RMS_EPS = 1e-6f;

constexpr size_t al(size_t x) { return (x + 255) & ~(size_t)255; }
constexpr size_t WS_CTL   = 0;
constexpr size_t WS_MOD   = 65536;
constexpr size_t WS_POS   = WS_MOD + al((size_t)2 * 9 * 6144 * 4);
constexpr size_t WS_HFL   = WS_POS + (size_t)SEQ * DM * 4;
constexpr size_t WS_HBL   = WS_HFL + (size_t)SEQ * 512 * 4;
constexpr size_t WS_HFC   = WS_HBL + (size_t)SEQ * 512 * 4;
constexpr size_t WS_HBC   = WS_HFC + (size_t)CTXL * 512 * 4;
constexpr size_t WS_WEVIN = WS_HBC + (size_t)CTXL * 512 * 4;
constexpr size_t WS_WEVOUT= WS_WEVIN + (size_t)NP0 * DM * 2;
constexpr size_t WS_WODIN = WS_WEVOUT + (size_t)DM * MIXW * 2;
constexpr size_t WS_WODOUT= WS_WODIN + (size_t)2048 * DM * 2;
constexpr size_t WS_WLRU  = WS_WODOUT + (size_t)DM * DM * 2;
constexpr size_t WS_BLRU  = WS_WLRU + (size_t)4096 * 256 * 2;
constexpr size_t WS_RWT   = WS_BLRU + 8192 * 4;
constexpr size_t WS_WGT   = WS_RWT + (size_t)2 * 32 * 1024 * 4;
constexpr size_t WS_HID   = WS_WGT + (size_t)16 * 1024 * 4;
constexpr size_t WS_WM1   = WS_HID + (size_t)(SEQ + CTXL) * 64 * 4;
constexpr size_t WS_WM2   = WS_WM1 + (size_t)64 * 2048 * DM * 2;
constexpr size_t WS_X1    = WS_WM2 + (size_t)64 * DM * DM * 2;
constexpr size_t WS_X2    = WS_X1 + (size_t)TT * DM * 4;
constexpr size_t WS_VB    = WS_X2 + (size_t)TT * DM * 4;
constexpr size_t WS_RI    = WS_VB + (size_t)TT * DM * 2;
constexpr size_t WS_RW    = WS_RI + (size_t)TT * 16;
constexpr size_t WS_SP    = WS_RW + (size_t)TT * 16;
constexpr size_t WS_TILEE = WS_SP + (size_t)TT * 16;
constexpr size_t WS_BC    = WS_TILEE + 4096;
constexpr size_t WS_VBG   = WS_BC + (size_t)2 * 1024 * 32 * 4;
constexpr size_t WS_ACT   = WS_VBG + (size_t)MOE_ROWS * DM * 2;
constexpr size_t WS_YS    = WS_ACT + (size_t)MOE_ROWS * DM * 2;
constexpr size_t WS_ARENA = WS_YS + (size_t)MOE_ROWS * DM * 2;
constexpr size_t A0_U     = WS_ARENA;
constexpr size_t A0_P     = A0_U + (size_t)TT * DM * 2;
constexpr size_t A0_GATES = A0_P + (size_t)TT * NP0 * 2;
constexpr size_t A0_QN    = A0_GATES + (size_t)TT * 64;
constexpr size_t A0_KN    = A0_QN + (size_t)TT * 512 * 4;
constexpr size_t A0_VV    = A0_KN + (size_t)TT * 512 * 4;
constexpr size_t A0_GG    = A0_VV + (size_t)TT * 512 * 4;
constexpr size_t A0_BB    = A0_GG + (size_t)2 * TT * 16;
constexpr size_t A0_OD    = A0_BB + (size_t)2 * TT * 16;
constexpr size_t A0_VX    = A0_OD + (size_t)2 * TT * 512 * 4;
constexpr size_t A0_X0    = A0_VX + (size_t)TT * 512 * 4;
constexpr size_t A0_YH    = A0_X0 + (size_t)TT * 512 * 4;
constexpr size_t A0_MIX   = A0_YH + (size_t)TT * 512 * 4;
constexpr size_t A0_Y     = A0_MIX + (size_t)TT * MIXW * 2;
constexpr size_t A0_QB    = A0_Y + (size_t)TT * DM * 4;
constexpr size_t A0_KB    = A0_QB + (size_t)TT * 512 * 2;
constexpr size_t A0_VB3   = A0_KB + (size_t)TT * 512 * 2;
constexpr int    DN_CU    = NB * 4 * 2 * 36;
constexpr size_t A0_WQ    = A0_VB3 + (size_t)TT * 512 * 2;
constexpr size_t A0_KDT   = A0_WQ + (size_t)DN_CU * 32768;
constexpr size_t A0_ATT   = A0_KDT + (size_t)DN_CU * 16384;
constexpr size_t A0_UU    = A0_ATT + (size_t)DN_CU * 8192;
constexpr size_t A0_GL    = A0_UU + (size_t)DN_CU * 32768;
constexpr size_t A0_VXTL  = A0_GL + al((size_t)DN_CU * 4);
constexpr size_t A0_VXTC  = A0_VXTL + (size_t)512 * TL * 2;
constexpr size_t A0_YHTL  = A0_VXTC + (size_t)512 * TC * 2;
constexpr size_t A0_YHTC  = A0_YHTL + (size_t)512 * TL * 4;
constexpr size_t A0_END   = A0_YHTC + (size_t)512 * TC * 4;
constexpr size_t A1_U     = WS_ARENA;
constexpr size_t A1_P     = A1_U + (size_t)TT * DM * 2;
constexpr size_t A1_XC    = A1_P + (size_t)TT * 2048 * 4;
constexpr size_t A1_XCB   = A1_XC + (size_t)TT * DM * 4;
constexpr size_t A1_RG    = A1_XCB + (size_t)TT * DM * 2;
constexpr size_t A1_HS    = A1_RG + (size_t)TT * 4096 * 2;
constexpr size_t A1_HG    = A1_HS + (size_t)2 * TL * DM * 4;
constexpr size_t A1_Y     = A1_HG + (size_t)TL * DM * 2;
constexpr size_t A1_END   = A1_Y + (size_t)TL * DM * 4;
constexpr size_t WS_END   = (A0_END > A1_END ? A0_END : A1_END);

constexpr int CW_BAR = 0;
constexpr int CW_CNT = 4096;
constexpr int CW_CUR = 4096 + 64;
constexpr int CW_NT  = 4096 + 128;
constexpr int CW_TQ  = 4096 + 192;
constexpr size_t CTL_BYTES = 65536;

DI float bf2f(bf16_t b) { return __uint_as_float(((unsigned)b) << 16); }
typedef __bf16 bf16x2_t __attribute__((ext_vector_type(2)));
DI unsigned pk2(float lo, float hi) { const f32x2 v = {lo, hi}; return __builtin_bit_cast(unsigned, __builtin_convertvector(v, bf16x2_t)); }
DI bf16_t f2bf(float f) { return (bf16_t)(pk2(f, 0.f) & 0xffffu); }
DI unsigned pk4_fp8(float a, float b, float c, float d) { int w = 0; w = __builtin_amdgcn_cvt_pk_fp8_f32(a, b, w, false); w = __builtin_amdgcn_cvt_pk_fp8_f32(c, d, w, true); return (unsigned)w; }
#ifndef MK_FP8_L1
#define MK_FP8_L1 1
#endif
#ifndef MK_FP8_L0
#define MK_FP8_L0 1
#endif
#ifndef MK_FP8_YS
#define MK_FP8_YS 1
#endif
constexpr float W1_F8S = 32.0f, W2_F8S = 64.0f, YS_F8S = 16.0f;
DI float sigm(float x) { return __builtin_amdgcn_rcpf(1.0f + __expf(-x)); }
DI float silu_(float x) { return x * sigm(x); }
DI float softplus_(float x) { return fmaxf(x, 0.f) + log1pf(__expf(-fabsf(x))); }
DI float gelu_tanh(float x) { return x * sigm(1.5957691216057308f * (x + 0.044715f * x * x * x)); }
DI float wsum(float v) { v += __shfl_xor(v, 32); v += __shfl_xor(v, 16); v += __shfl_xor(v, 8); v += __shfl_xor(v, 4); v += __shfl_xor(v, 2); v += __shfl_xor(v, 1); return v; }

DI int row_of(int b, int d, int p) {
    if (p < CTXL) return TL + b * CTXL + (d ? (CTXL - 1 - p) : p);
    const int q = p - CTXL; return b * SEQ + (d ? (SEQ - 1 - q) : q);
}
static_assert(WS_END <= (size_t)2147483648ull, "workspace map exceeds 4x the largest tensor");
#define XB_TMO      128
#define XB_XCNT(j)  (256  + 64 * (j))
#define XB_XSUB(j)  (1280 + 64 * (j))
#define XB_XGEN(j)  (2304 + 64 * (j))
#define XB_TOP      3328
#define XB_TOPGEN   3392
#define XCD_BAR_WORDS 3456
#define XB_SPIN_CAP (1u << 18)

__device__ __forceinline__ unsigned xb_ld(unsigned* p)              { return __hip_atomic_load(p, __ATOMIC_RELAXED, __HIP_MEMORY_SCOPE_AGENT); }
__device__ __forceinline__ unsigned xb_add(unsigned* p, unsigned v) { return __hip_atomic_fetch_add(p, v, __ATOMIC_RELAXED, __HIP_MEMORY_SCOPE_AGENT); }
__device__ __forceinline__ unsigned xb_xcc_id() { return (unsigned)__builtin_amdgcn_s_getreg((3 << 11) | 20) & 0xFu; }
#define XB_SPIN(cond, bar) do { unsigned _sp = 0; while (cond) { __builtin_amdgcn_s_sleep(1); \
    if ((++_sp & 255u) == 0u) { if (xb_ld(&(bar)[XB_TMO])) break; if (_sp > XB_SPIN_CAP) { atomicAdd(&(bar)[XB_TMO], 1u); break; } } } } while (0)

struct XcdBarrier {
    unsigned* bar; unsigned x;
    volatile LAS unsigned* st;
};

__device__ __forceinline__ XcdBarrier xcd_barrier_post(unsigned* bar, volatile LAS unsigned* st) {
    XcdBarrier b; b.bar = bar; b.x = xb_xcc_id(); b.st = st;
    if (threadIdx.x == 0) (void)xb_add(&bar[XB_XCNT(b.x)], 1u);
    return b;
}
__device__ __forceinline__ void xcd_barrier_complete(unsigned* bar, unsigned x, unsigned& nloc, unsigned& nx) {
    const unsigned G = gridDim.x * gridDim.y * gridDim.z;
    unsigned sum, cnt, mine, sp = 0u;
    for (;;) {
        sum = 0u; cnt = 0u; mine = 0u;
#pragma unroll
        for (unsigned j = 0; j < 16; ++j) { const unsigned c = xb_ld(&bar[XB_XCNT(j)]); sum += c; cnt += (c > 0u) ? 1u : 0u; mine = (j == x) ? c : mine; }
        if (sum == G) break;
        __builtin_amdgcn_s_sleep(1);
        if ((++sp & 255u) == 0u) { if (xb_ld(&bar[XB_TMO])) break; if (sp > XB_SPIN_CAP) { atomicAdd(&bar[XB_TMO], 1u); break; } }
    }
    nloc = mine > 0u ? mine : 1u; nx = cnt > 0u ? cnt : 1u;
}

__device__ __forceinline__ void xcd_barrier(const XcdBarrier& b) {
    asm volatile("s_waitcnt vmcnt(0)" ::: "memory");
    __syncthreads();
    if (threadIdx.x == 0) {
        unsigned* bar = b.bar;
        __builtin_amdgcn_s_waitcnt(0);
        unsigned nloc = b.st[0], nx = b.st[1];
        if (nloc == 0u) { xcd_barrier_complete(bar, b.x, nloc, nx); b.st[0] = nloc; b.st[1] = nx; }
        const unsigned old = xb_add(&bar[XB_XSUB(b.x)], 1u);
        const unsigned gen = old / nloc;
        if (old + 1u == (gen + 1u) * nloc) {
            __builtin_amdgcn_fence(__ATOMIC_RELEASE, "agent");
            asm volatile("s_waitcnt vmcnt(0)" ::: "memory");
            const unsigned og = xb_add(&bar[XB_TOP], 1u);
            const unsigned tg = og / nx;
            if (og + 1u == (tg + 1u) * nx) xb_add(&bar[XB_TOPGEN], 1u);
            else XB_SPIN(xb_ld(&bar[XB_TOPGEN]) == tg, bar);
            __builtin_amdgcn_fence(__ATOMIC_ACQUIRE, "agent");
            xb_add(&bar[XB_XGEN(b.x)], 1u);
            asm volatile("s_waitcnt vmcnt(0)" ::: "memory");
        } else {
            XB_SPIN(xb_ld(&bar[XB_XGEN(b.x)]) == gen, bar);
            __builtin_amdgcn_fence(__ATOMIC_ACQUIRE, "agent");
            asm volatile("s_waitcnt vmcnt(0)" ::: "memory");
        }
    }
    __syncthreads();
}

namespace pg8 {
typedef short bf16x8 __attribute__((ext_vector_type(8)));
constexpr int BM = 256, BK = 64, HALF = 128, HTB = HALF * BK * 2, STAGE_BYTES = 8 * HTB, NXCD = 8, WGM = 8;

__host__ __device__ __forceinline__ int lds_byte(int r, int c) { const int st = (r >> 4) * 2 + (c >> 5), rr = r & 15, cc = c & 31, ob = rr * 64 + cc * 2; return st * 1024 + (ob ^ (((ob >> 9) & 1) << 5)); }
__host__ __device__ __forceinline__ void stage_rc(int b, int& R, int& C) { const int st = b / 1024, sb = b % 1024, swz = sb ^ (((sb >> 9) & 1) << 5); R = (st >> 1) * 16 + swz / 64; C = (st & 1) * 32 + (swz % 64) / 2; }
__host__ __device__ __forceinline__ int perm32(int rho) { const int n = rho >> 4, i = rho & 15; return 8 * (i >> 2) + 4 * n + (i & 3); }

struct Unit { int pm, pn, e; };
struct Gemm { const bf16_t* A; const bf16_t* Bt; int M, N, K, lda; };

struct StaticOrder {
    int nM, nN, nwg, G, c;
    __device__ void init(int M, int N, int G_, int c_) { nM = M / BM; nN = N / BM; nwg = nM * nN; G = G_; c = c_; }
    __device__ bool next(int i, Unit& u) const {
        const long L = (long)i * G + c; if (L >= nwg) return false;
        int wgid = (int)L; { const int q = nwg / NXCD, r = nwg % NXCD, xcd = wgid % NXCD, off = wgid / NXCD; wgid = (xcd < r ? xcd * (q + 1) : r * (q + 1) + (xcd - r) * q) + off; }
        const int nig = WGM * nN, gid = wgid / nig, fm = gid * WGM, gsz = (nM - fm) < WGM ? (nM - fm) : WGM;
        u.pm = fm + ((wgid % nig) % gsz); u.pn = (wgid % nig) / gsz; u.e = 0; return true;
    }
    __device__ __forceinline__ const char* a_ptr(const Gemm& g, const Unit& u) const { return (const char*)g.A + (size_t)u.pm * BM * g.lda * 2; }
    __device__ __forceinline__ const char* b_ptr(const Gemm& g, const Unit& u) const { return (const char*)g.Bt + (size_t)u.pn * BM * g.K * 2; }
};
struct LruOrder : StaticOrder {
    __device__ __forceinline__ const char* a_ptr(const Gemm& g, const Unit& u) const { return (const char*)g.A + (size_t)u.pm * BM * g.lda * 2 + (size_t)((u.pn >> 1) & 3) * 512; }
};
struct MoeOrder {
    const int* tile_e; int ntm, nN, G, c;
    __device__ bool next(int i, Unit& u) const {
        if ((G & 7) == 0 && ((G >> 3) % nN) == 0) {
            const int x = c & 7, s = c >> 3, mpr = (G >> 3) / nN;
            u.pm = i * (8 * mpr) + x * mpr + s / nN; u.pn = s % nN; if (u.pm >= ntm) return false;
        } else { const long L = (long)i * G + c; if (L >= (long)ntm * nN) return false; u.pm = (int)(L / nN); u.pn = (int)(L % nN); }
        u.e = tile_e[u.pm]; return true;
    }
    __device__ __forceinline__ const char* a_ptr(const Gemm& g, const Unit& u) const { return (const char*)g.A + (size_t)u.pm * BM * g.lda * 2; }
    __device__ __forceinline__ const char* b_ptr(const Gemm& g, const Unit& u) const { return (const char*)g.Bt + ((size_t)u.e * g.N + (size_t)u.pn * BM) * g.K * 2; }
};

__device__ __forceinline__ unsigned cvt_pk_bf16(float lo, float hi) { return pk2(lo, hi); }

struct EpiF32 {
    static constexpr bool PERM = false;
    float* C; int ldc; const float* bias;
    __device__ __forceinline__ void operator()(const f32x4 (&acc)[2][2][4][2], const Unit& u, int wr, int wc, int fr, int fq) const {
        const int row0 = u.pm * BM + wr * 64 + fr, col0 = u.pn * BM + wc * 32 + 4 * fq;
        f32x4 bv[2][2];
#pragma unroll
        for (int bj = 0; bj < 2; ++bj)
#pragma unroll
            for (int n = 0; n < 2; ++n) bv[bj][n] = bias ? *(const f32x4*)(bias + col0 + bj * HALF + n * 16) : (f32x4){0.f, 0.f, 0.f, 0.f};
#pragma unroll
        for (int ai = 0; ai < 2; ++ai)
#pragma unroll
            for (int m = 0; m < 4; ++m) { float* rowp = C + (size_t)(row0 + ai * HALF + m * 16) * ldc + col0;
#pragma unroll
                for (int bj = 0; bj < 2; ++bj)
#pragma unroll
                    for (int n = 0; n < 2; ++n) *(f32x4*)(rowp + bj * HALF + n * 16) = acc[ai][bj][m][n] + bv[bj][n]; }
    }
};
struct EpiBf16 {
    static constexpr bool PERM = true;
    bf16_t* O; int ldc; const float* bias; int bias_estride; float scale = 1.0f;
    __device__ __forceinline__ void operator()(const f32x4 (&acc)[2][2][4][2], const Unit& u, int wr, int wc, int fr, int fq) const {
        const int row0 = u.pm * BM + wr * 64 + fr; const int col0 = u.pn * BM + wc * 32 + 8 * fq;
        f32x4 bv[2][2];
#pragma unroll
        for (int bj = 0; bj < 2; ++bj)
#pragma unroll
            for (int n = 0; n < 2; ++n) bv[bj][n] = bias ? *(const f32x4*)(bias + (size_t)u.e * bias_estride + col0 + bj * HALF + 4 * n) : (f32x4){0.f, 0.f, 0.f, 0.f};
#pragma unroll
        for (int ai = 0; ai < 2; ++ai)
#pragma unroll
            for (int m = 0; m < 4; ++m) { bf16_t* rowp = O + (size_t)(row0 + ai * HALF + m * 16) * ldc + col0;
#pragma unroll
                for (int bj = 0; bj < 2; ++bj) { const f32x4 v0 = acc[ai][bj][m][0] * scale + bv[bj][0], v1 = acc[ai][bj][m][1] * scale + bv[bj][1];
                    u32x4 w; w.x = cvt_pk_bf16(v0[0], v0[1]); w.y = cvt_pk_bf16(v0[2], v0[3]); w.z = cvt_pk_bf16(v1[0], v1[1]); w.w = cvt_pk_bf16(v1[2], v1[3]);
                    *(u32x4*)(rowp + bj * HALF) = w; } }
    }
};
__device__ __forceinline__ float sigm_fast(float x) { return __builtin_amdgcn_rcpf(1.0f + __expf(-x)); }
__device__ __forceinline__ unsigned cvt_pk_bf16_trans(float lo, float hi) { return pk2(lo, hi); }
struct EpiSigmoid {
    static constexpr bool PERM = true;
    bf16_t* O; int ldc; const float* bias;
    __device__ __forceinline__ void operator()(const f32x4 (&acc)[2][2][4][2], const Unit& u, int wr, int wc, int fr, int fq) const {
        const int row0 = u.pm * BM + wr * 64 + fr; const int col0 = u.pn * BM + wc * 32 + 8 * fq;
#pragma unroll
        for (int bj = 0; bj < 2; ++bj) {
            const f32x4 b0 = *(const f32x4*)(bias + col0 + bj * HALF), b1 = *(const f32x4*)(bias + col0 + bj * HALF + 4);
#pragma unroll
            for (int ai = 0; ai < 2; ++ai)
#pragma unroll
                for (int m = 0; m < 4; ++m) { bf16_t* rowp = O + (size_t)(row0 + ai * HALF + m * 16) * ldc + col0 + bj * HALF;
                    const f32x4 v0 = acc[ai][bj][m][0] + b0, v1 = acc[ai][bj][m][1] + b1; u32x4 w;
                    w.x = cvt_pk_bf16_trans(sigm_fast(v0[0]), sigm_fast(v0[1])); w.y = cvt_pk_bf16_trans(sigm_fast(v0[2]), sigm_fast(v0[3]));
                    w.z = cvt_pk_bf16_trans(sigm_fast(v1[0]), sigm_fast(v1[1])); w.w = cvt_pk_bf16_trans(sigm_fast(v1[2]), sigm_fast(v1[3]));
                    *(u32x4*)rowp = w; asm volatile("" ::: "memory"); }
        }
    }
};
struct EpiLruAB {
    static constexpr bool PERM = true;
    unsigned* AB; const float* bias; const float* sp8; const bf16_t* xcb; int rows;
    __device__ __forceinline__ void operator()(const f32x4 (&acc)[2][2][4][2], const Unit& u, int wr, int wc, int fr, int fq) const {
        const int row0 = u.pm * BM + wr * 64 + fr;
#pragma unroll
        for (int bj = 0; bj < 2; ++bj) {
            const int n0 = u.pn * BM + bj * HALF + wc * 32 + 8 * fq; const int d = n0 >> 11, ch = ((n0 >> 9) & 3) * 256 + ((n0 & 511) >> 1);
            const f32x4 b0 = *(const f32x4*)(bias + n0), b1 = *(const f32x4*)(bias + n0 + 4), sp = *(const f32x4*)(sp8 + d * 1024 + ch);
#pragma unroll
            for (int ai = 0; ai < 2; ++ai)
#pragma unroll
                for (int m = 0; m < 4; ++m) { const int row = row0 + ai * HALF + m * 16;
                    const f32x4 v0 = acc[ai][bj][m][0] + b0, v1 = acc[ai][bj][m][1] + b1;
                    const u32x2 xr = *(const u32x2*)(xcb + (size_t)row * 1024 + ch);
                    const float x0 = __uint_as_float(xr.x << 16), x1 = __uint_as_float(xr.x & 0xffff0000u), x2 = __uint_as_float(xr.y << 16), x3 = __uint_as_float(xr.y & 0xffff0000u);
                    float la[4], cc[4]; const float rr_[4] = {v0[0], v0[2], v1[0], v1[2]}, ii_[4] = {v0[1], v0[3], v1[1], v1[3]}, xx_[4] = {x0, x1, x2, x3};
#pragma unroll
                    for (int q = 0; q < 4; ++q) { const float dr = 1.0f + __expf(-rr_[q]), di = 1.0f + __expf(-ii_[q]); const float R = __builtin_amdgcn_rcpf(dr * di);
                        la[q] = sp[q] * (R * di); const float a = __expf(la[q]); cc[q] = __builtin_amdgcn_sqrtf(fmaxf(1.0f - a * a, 0.f)) * ((R * dr) * xx_[q]); }
                    const float la0 = la[0], la1 = la[1], la2 = la[2], la3 = la[3], c0 = cc[0], c1 = cc[1], c2 = cc[2], c3 = cc[3];
                    u32x4 w; w.x = cvt_pk_bf16(la0, c0); w.y = cvt_pk_bf16(la1, c1); w.z = cvt_pk_bf16(la2, c2); w.w = cvt_pk_bf16(la3, c3);
                    *(u32x4*)(AB + ((size_t)d * rows + row) * 1024 + ch) = w; asm volatile("" ::: "memory"); }
        }
    }
};
__device__ __forceinline__ float swiglu_(float g, float l) {
    const float glu = fminf(g, 7.0f), lin = fminf(fmaxf(l, -7.0f), 7.0f);
    return glu * __builtin_amdgcn_rcpf(1.0f + __expf(-1.702f * glu)) * (lin + 1.0f);
}
__device__ __forceinline__ f32x2 swiglu2_(f32x2 g, f32x2 l) {
    const f32x2 glu = __builtin_elementwise_min(g, (f32x2){7.0f, 7.0f});
    const f32x2 lin = __builtin_elementwise_min(__builtin_elementwise_max(l, (f32x2){-7.0f, -7.0f}), (f32x2){7.0f, 7.0f});
    const f32x2 t = glu * (-1.702f * 1.4426950408889634f);
    f32x2 e; e.x = __builtin_amdgcn_exp2f(t.x); e.y = __builtin_amdgcn_exp2f(t.y);
    const f32x2 d = e + 1.0f;
    f32x2 r; r.x = __builtin_amdgcn_rcpf(d.x); r.y = __builtin_amdgcn_rcpf(d.y);
    return glu * r * (lin + 1.0f);
}
struct EpiSwiglu {
    static constexpr bool PERM = true;
    bf16_t* O; int ldo; const float* bias; int bias_estride;
    __device__ __forceinline__ void operator()(const f32x4 (&acc)[2][2][4][2], const Unit& u, int wr, int wc, int fr, int fq) const {
        const int row0 = u.pm * BM + wr * 64 + fr; const int col0 = u.pn * BM + wc * 32 + 8 * fq;
        f32x4 bv[2][2];
#pragma unroll
        for (int bj = 0; bj < 2; ++bj)
#pragma unroll
            for (int n = 0; n < 2; ++n) bv[bj][n] = *(const f32x4*)(bias + (size_t)u.e * bias_estride + col0 + bj * HALF + 4 * n);
#pragma unroll
        for (int ai = 0; ai < 2; ++ai)
#pragma unroll
            for (int m = 0; m < 4; ++m) { bf16_t* rowp = O + (size_t)(row0 + ai * HALF + m * 16) * ldo + (col0 >> 1);
#pragma unroll
                for (int bj = 0; bj < 2; ++bj) { const f32x4 v0 = acc[ai][bj][m][0] + bv[bj][0], v1 = acc[ai][bj][m][1] + bv[bj][1];
                    const f32x2 s0 = swiglu2_((f32x2){v0[0], v0[2]}, (f32x2){v0[1], v0[3]}), s1 = swiglu2_((f32x2){v1[0], v1[2]}, (f32x2){v1[1], v1[3]});
                    u32x2 w; w.x = cvt_pk_bf16(s0.x, s0.y); w.y = cvt_pk_bf16(s1.x, s1.y);
                    *(u32x2*)(rowp + bj * (HALF / 2)) = w; } }
    }
};

typedef int v8i_t __attribute__((ext_vector_type(8)));
typedef int v4i_t __attribute__((ext_vector_type(4)));
struct Frag2 { bf16x8 k[2]; };
template <class Epi, class Sched, bool FP8 = false>
__device__ __forceinline__ void gemm_phase(LAS unsigned char* lds, const Gemm g, const Sched& S, const Epi& E) {
    const int tid = threadIdx.x, wid = __builtin_amdgcn_readfirstlane(tid >> 6), lane = tid & 63, wr = wid >> 2, wc = wid & 3, fr = lane & 15, fq = lane >> 4;
    const int K = g.K, nt = K / BK;
    unsigned voffA[2], voffB[2];
#pragma unroll
    for (int i = 0; i < 2; ++i) { int R, C; stage_rc(tid * 16 + i * 8192, R, C); const int Rb = Epi::PERM ? ((R & ~31) + perm32(R & 31)) : R;
        voffA[i] = (unsigned)(R * g.lda + C) * 2u; voffB[i] = (unsigned)(Rb * K + C) * 2u; }
    const size_t kstep = (size_t)(BK * 2);
    const size_t hstep = (size_t)HALF * K * 2, hstepA = (size_t)HALF * g.lda * 2;
    const unsigned ldsw = (unsigned)wid * 1024u;
    const int aoff = lds_byte(wr * 64 + fr, fq * 8), boff = lds_byte(wc * 32 + fr, fq * 8);
#define PG8_SA(b, h) (((b) * 2 + (h)) * HTB)
#define PG8_SB(b, h) ((4 + (b) * 2 + (h)) * HTB)
#define PG8_STAGE(bufoff, gbase, voff) do { _Pragma("unroll") for (int _i = 0; _i < 2; ++_i) \
        __builtin_amdgcn_global_load_lds((const unsigned*)((const char*)(gbase) + (voff)[_i]), (LAS unsigned*)(lds + (bufoff) + ldsw + _i * 8192), 16, 0, 0); } while (0)
#define PG8_LD2(p) __builtin_shufflevector(*(const LAS v4i_t*)(p), *(const LAS v4i_t*)((p) + 1024), 0, 1, 2, 3, 4, 5, 6, 7)
#define PG8_LDA(dst, b, h) do { _Pragma("unroll") for (int m = 0; m < 4; ++m) { if constexpr (FP8) dst##8[m] = PG8_LD2(lds + PG8_SA(b, h) + aoff + m * 2048); \
        else { _Pragma("unroll") for (int k = 0; k < 2; ++k) dst[m].k[k] = *(const LAS bf16x8*)(lds + PG8_SA(b, h) + aoff + m * 2048 + k * 1024); } } } while (0)
#define PG8_LDB(dst, b, h) do { _Pragma("unroll") for (int n = 0; n < 2; ++n) { if constexpr (FP8) dst##8[n] = PG8_LD2(lds + PG8_SB(b, h) + boff + n * 2048); \
        else { _Pragma("unroll") for (int k = 0; k < 2; ++k) dst[n].k[k] = *(const LAS bf16x8*)(lds + PG8_SB(b, h) + boff + n * 2048 + k * 1024); } } } while (0)
#define PG8_MMA(ai, bj, At, Bt) do { __builtin_amdgcn_s_setprio(1); _Pragma("unroll") for (int m = 0; m < 4; ++m) _Pragma("unroll") for (int n = 0; n < 2; ++n) { \
        if constexpr (FP8) asm volatile("v_mfma_scale_f32_16x16x128_f8f6f4 %0, %1, %2, %0, %3, %3 op_sel_hi:[0,0,0]" : "+v"(acc[ai][bj][m][n]) : "v"(Bt##8[n]), "v"(At##8[m]), "v"(f8scale)); \
        else { _Pragma("unroll") for (int k = 0; k < 2; ++k) acc[ai][bj][m][n] = __builtin_amdgcn_mfma_f32_16x16x32_bf16(Bt[n].k[k], At[m].k[k], acc[ai][bj][m][n], 0, 0, 0); } } \
        __builtin_amdgcn_s_setprio(0); } while (0)
#define PG8_WAIT_V(n) asm volatile("s_waitcnt vmcnt(" #n ")" ::: "memory")
#define PG8_WAIT_L(n) asm volatile("s_waitcnt lgkmcnt(" #n ")" ::: "memory")
#define PG8_BAR __builtin_amdgcn_s_barrier()
#define PG8_SCHED __builtin_amdgcn_sched_barrier(0)
    Unit cur, nxt; int ui = 0;
    if (!S.next(0, cur)) return;
    f32x4 acc[2][2][4][2];
#pragma unroll
    for (int a = 0; a < 2; ++a)
#pragma unroll
        for (int b = 0; b < 2; ++b)
#pragma unroll
            for (int m = 0; m < 4; ++m)
#pragma unroll
                for (int n = 0; n < 2; ++n) acc[a][b][m][n] = (f32x4){0.f, 0.f, 0.f, 0.f};
    Frag2 At[4], B0[2], B1[2]; v8i_t At8[4], B08[2], B18[2];
    int f8scale = 0x7f7f7f7f; asm volatile("" : "+v"(f8scale));
    const char* cA = S.a_ptr(g, cur); const char* cB = S.b_ptr(g, cur);
    PG8_STAGE(PG8_SB(0, 0), cB, voffB); PG8_STAGE(PG8_SA(0, 0), cA, voffA); PG8_STAGE(PG8_SB(0, 1), cB + hstep, voffB); PG8_STAGE(PG8_SA(0, 1), cA + hstepA, voffA);
    if (wr == 1) PG8_BAR;
    PG8_WAIT_V(4); PG8_BAR;
    PG8_STAGE(PG8_SB(1, 0), cB + kstep, voffB); PG8_STAGE(PG8_SA(1, 0), cA + kstep, voffA); PG8_STAGE(PG8_SB(1, 1), cB + hstep + kstep, voffB);
    PG8_WAIT_V(6); PG8_BAR;
    for (;;) {
        const bool has_next = S.next(ui + 1, nxt);
        const char* nA = has_next ? S.a_ptr(g, nxt) : cA; const char* nB = has_next ? S.b_ptr(g, nxt) : cB;
#pragma unroll 1
        for (int t = 0; t < nt; t += 2) {
            const bool last = (t == nt - 2);
            const char* a1 = cA + (size_t)(t + 1) * kstep;
            const char* a2 = last ? nA : cA + (size_t)(t + 2) * kstep; const char* b2 = last ? nB : cB + (size_t)(t + 2) * kstep;
            const char* a3 = a2 + kstep; const char* b3 = b2 + kstep;
            PG8_LDB(B0, 0, 0); PG8_SCHED; PG8_LDA(At, 0, 0); PG8_STAGE(PG8_SA(1, 1), a1 + hstepA, voffA);
            PG8_WAIT_L(8); PG8_BAR; PG8_WAIT_L(0); PG8_MMA(0, 0, At, B0); PG8_BAR; PG8_SCHED;
            PG8_LDB(B1, 0, 1); PG8_STAGE(PG8_SB(0, 0), b2, voffB);
            PG8_BAR; PG8_WAIT_L(0); PG8_MMA(0, 1, At, B1); PG8_BAR;
            PG8_LDA(At, 0, 1); PG8_STAGE(PG8_SA(0, 0), a2, voffA);
            PG8_BAR; PG8_WAIT_L(0); PG8_MMA(1, 0, At, B0); PG8_BAR; PG8_SCHED;
            PG8_STAGE(PG8_SB(0, 1), b2 + hstep, voffB);
            PG8_WAIT_V(6); PG8_BAR; PG8_MMA(1, 1, At, B1); PG8_BAR;
            PG8_LDB(B0, 1, 0); PG8_SCHED; PG8_LDA(At, 1, 0); PG8_STAGE(PG8_SA(0, 1), a2 + hstepA, voffA);
            PG8_WAIT_L(8); PG8_BAR; PG8_WAIT_L(0); PG8_MMA(0, 0, At, B0); PG8_BAR; PG8_SCHED;
            PG8_LDB(B1, 1, 1); PG8_STAGE(PG8_SB(1, 0), b3, voffB);
            PG8_BAR; PG8_WAIT_L(0); PG8_MMA(0, 1, At, B1); PG8_BAR;
            PG8_LDA(At, 1, 1); PG8_STAGE(PG8_SA(1, 0), a3, voffA);
            PG8_BAR; PG8_WAIT_L(0); PG8_MMA(1, 0, At, B0); PG8_BAR; PG8_SCHED;
            PG8_STAGE(PG8_SB(1, 1), b3 + hstep, voffB);
            PG8_WAIT_V(6); PG8_BAR; PG8_MMA(1, 1, At, B1); PG8_BAR;
        }
        if constexpr (FP8) asm volatile("s_nop 15\n\ts_nop 15" ::: "memory");
        E(acc, cur, wr, wc, fr, fq);
        if (!has_next) break;
#pragma unroll
        for (int a = 0; a < 2; ++a)
#pragma unroll
            for (int b = 0; b < 2; ++b)
#pragma unroll
                for (int m = 0; m < 4; ++m)
#pragma unroll
                    for (int n = 0; n < 2; ++n) acc[a][b][m][n] = (f32x4){0.f, 0.f, 0.f, 0.f};
        cur = nxt; cA = nA; cB = nB; ++ui;
    }
    PG8_WAIT_V(0);
    if (wr == 0) PG8_BAR;
    PG8_BAR;
#undef PG8_SA
#undef PG8_SB
#undef PG8_STAGE
#undef PG8_LD2
#undef PG8_LDA
#undef PG8_LDB
#undef PG8_MMA
#undef PG8_WAIT_V
#undef PG8_WAIT_L
#undef PG8_BAR
#undef PG8_SCHED
}
struct EpiF8 {
    static constexpr bool PERM = true;
    unsigned char* O; int ldc; const float* bias; int bias_estride; float scale, oscale;
    __device__ __forceinline__ void operator()(const f32x4 (&acc)[2][2][4][2], const Unit& u, int wr, int wc, int fr, int fq) const {
        const int row0 = u.pm * BM + wr * 64 + fr; const int col0 = u.pn * BM + wc * 32 + 8 * fq;
        f32x4 bv[2][2];
#pragma unroll
        for (int bj = 0; bj < 2; ++bj)
#pragma unroll
            for (int n = 0; n < 2; ++n) bv[bj][n] = *(const f32x4*)(bias + (size_t)u.e * bias_estride + col0 + bj * HALF + 4 * n) * oscale;
        const float sc = scale * oscale;
#pragma unroll
        for (int ai = 0; ai < 2; ++ai)
#pragma unroll
            for (int m = 0; m < 4; ++m) { unsigned char* rowp = O + (size_t)(row0 + ai * HALF + m * 16) * ldc + col0;
#pragma unroll
                for (int bj = 0; bj < 2; ++bj) { const f32x4 v0 = acc[ai][bj][m][0] * sc + bv[bj][0], v1 = acc[ai][bj][m][1] * sc + bv[bj][1];
                    u32x2 w; w.x = pk4_fp8(v0[0], v0[1], v0[2], v0[3]); w.y = pk4_fp8(v1[0], v1[1], v1[2], v1[3]);
                    *(u32x2*)(rowp + bj * HALF) = w; } }
    }
};
struct EpiSwigluF8 {
    static constexpr bool PERM = true;
    unsigned char* O; int ldo; const float* bias; int bias_estride; float scale;
    __device__ __forceinline__ void operator()(const f32x4 (&acc)[2][2][4][2], const Unit& u, int wr, int wc, int fr, int fq) const {
        const int row0 = u.pm * BM + wr * 64 + fr; const int col0 = u.pn * BM + wc * 32 + 8 * fq;
        f32x4 bv[2][2];
#pragma unroll
        for (int bj = 0; bj < 2; ++bj)
#pragma unroll
            for (int n = 0; n < 2; ++n) bv[bj][n] = *(const f32x4*)(bias + (size_t)u.e * bias_estride + col0 + bj * HALF + 4 * n);
#pragma unroll
        for (int ai = 0; ai < 2; ++ai)
#pragma unroll
            for (int m = 0; m < 4; ++m) { unsigned char* rowp = O + (size_t)(row0 + ai * HALF + m * 16) * ldo + (col0 >> 1);
#pragma unroll
                for (int bj = 0; bj < 2; ++bj) { const f32x4 v0 = acc[ai][bj][m][0] * scale + bv[bj][0], v1 = acc[ai][bj][m][1] * scale + bv[bj][1];
                    const f32x2 s0 = swiglu2_((f32x2){v0[0], v0[2]}, (f32x2){v0[1], v0[3]}), s1 = swiglu2_((f32x2){v1[0], v1[2]}, (f32x2){v1[1], v1[3]});
                    *(unsigned*)(rowp + bj * (HALF / 2)) = pk4_fp8(s0.x, s0.y, s1.x, s1.y); } }
    }
};
}
constexpr int NTHR = 512;
constexpr int LDS_MAIN = 131072;
constexpr int LDS_CTL_OFF = 8 * 64 * 65 * 4;
constexpr int LDS_BYTES = LDS_CTL_OFF + 256;
struct Args { const float* in[40]; float* out; unsigned char* ws; int ph_lo, ph_hi; int flags, pad; };

struct Fr {
    const Args* a; LAS unsigned char* lds; unsigned char* ws; int tid, lane, wave, G, bid; int gwave, nwaves;
};
#define WSP(T, off) ((T*)(F.ws + (off)))
#define INP(i) (F.a->in[i])

typedef float f32x16 __attribute__((ext_vector_type(16)));
typedef short bf16x8v __attribute__((ext_vector_type(8)));
#define MFMA32(a, b, c) __builtin_amdgcn_mfma_f32_32x32x16_bf16((a), (b), (c), 0, 0, 0)
DI int crow(int reg, int h) { return (reg & 3) + 8 * (reg >> 2) + 4 * h; }
DI int afrag_off(int m, int k, int nks) { return ((m >> 5) * nks + (k >> 4)) * 1024 + ((m & 31) + 32 * ((k >> 3) & 1)) * 16 + (k & 7) * 2; }
DI f32x16 zero16() { f32x16 z;
#pragma unroll
    for (int i = 0; i < 16; ++i) z[i] = 0.f; return z; }
DI bf16x8v scale8(u32x4 raw, const float (&s)[8], bool rev) {
    float v[8];
    v[0] = __uint_as_float(raw.x << 16); v[1] = __uint_as_float(raw.x & 0xffff0000u); v[2] = __uint_as_float(raw.y << 16); v[3] = __uint_as_float(raw.y & 0xffff0000u);
    v[4] = __uint_as_float(raw.z << 16); v[5] = __uint_as_float(raw.z & 0xffff0000u); v[6] = __uint_as_float(raw.w << 16); v[7] = __uint_as_float(raw.w & 0xffff0000u);
    u32x4 o;
    if (!rev) { o.x = pk2(v[0] * s[0], v[1] * s[1]); o.y = pk2(v[2] * s[2], v[3] * s[3]); o.z = pk2(v[4] * s[4], v[5] * s[5]); o.w = pk2(v[6] * s[6], v[7] * s[7]); }
    else      { o.x = pk2(v[7] * s[0], v[6] * s[1]); o.y = pk2(v[5] * s[2], v[4] * s[3]); o.z = pk2(v[3] * s[4], v[2] * s[5]); o.w = pk2(v[1] * s[6], v[0] * s[7]); }
    return __builtin_bit_cast(bf16x8v, o);
}

constexpr int DA_QS = 0, DA_KS = 17408, DA_KT = 34816, DA_VT = 53248, DA_AF = 71680, DA_AR = 89088, DA_TF = 106496, DA_TR = 115712, DA_SC = 124928;
constexpr int DA_RS = 272, DA_TS = 144;

DI void dnA_unit(const Fr& F, int unit) {
    const int tc = unit % 36, h = (unit / 36) & 3, b = unit / 144;
    const int row0 = (tc < 4) ? TL + b * CTXL + tc * 64 : b * SEQ + (tc - 4) * 64;
    LAS unsigned char* L = F.lds;
    LAS float* sc = (LAS float*)(L + DA_SC);
    int lane = F.lane, w = F.wave, r = lane & 31, hh = lane >> 5;
#define DN_RELAUNDER() do { int tz_ = threadIdx.x; asm volatile("" : "+v"(tz_)); lane = tz_ & 63; r = lane & 31; hh = lane >> 5; } while (0)
    {
        const bf16_t* P = WSP(bf16_t, A0_P); const float* cw = INP(10);
        const bool isc = tc < 4; const int Lq = isc ? CTXL : SEQ; const int t0 = (isc ? tc * 64 : (tc - 4) * 64) + w * 8, rowb = row0 + w * 8;
        unsigned praw[3][11];
#pragma unroll
        for (int s = 0; s < 3; ++s)
#pragma unroll
            for (int rr = 0; rr < 11; ++rr) { const int tl = t0 + rr - 2; praw[s][rr] = (tl >= 0 && tl < Lq) ? *(const unsigned*)(P + (size_t)(rowb + rr - 2) * NP0 + s * 512 + h * 128 + lane * 2) : 0u; }
#pragma unroll
        for (int s = 0; s < 3; ++s) {
            const int col = s * 512 + h * 128 + lane * 2;
            float w0[4], w1[4];
#pragma unroll
            for (int i = 0; i < 4; ++i) { w0[i] = cw[i * 1536 + col]; w1[i] = cw[i * 1536 + col + 1]; }
            float p0[11], p1[11];
#pragma unroll
            for (int rr = 0; rr < 11; ++rr) { p0[rr] = __uint_as_float(praw[s][rr] << 16); p1[rr] = __uint_as_float(praw[s][rr] & 0xffff0000u); }
#pragma unroll
            for (int j = 0; j < 8; ++j) {
                float a0 = w0[0] * p0[j] + w0[1] * p0[j + 1] + w0[2] * p0[j + 2] + w0[3] * p0[j + 3];
                float a1 = w1[0] * p1[j] + w1[1] * p1[j + 1] + w1[2] * p1[j + 2] + w1[3] * p1[j + 3];
                a0 = silu_(a0); a1 = silu_(a1);
                if (s < 2) { const float ss = wsum(a0 * a0 + a1 * a1); float rn = rsqrtf(ss + RMS_EPS); if (s == 0) rn *= 0.08838834764831845f; a0 *= rn; a1 *= rn; }
                const int i = w * 8 + j; const unsigned pk = pk2(a0, a1);
                if (s == 0) *(LAS unsigned*)(L + DA_QS + i * DA_RS + lane * 4) = pk;
                if (s == 1) { *(LAS unsigned*)(L + DA_KS + i * DA_RS + lane * 4) = pk;
                    *(LAS bf16_t*)(L + DA_KT + (2 * lane) * DA_TS + i * 2) = (bf16_t)(pk & 0xffff); *(LAS bf16_t*)(L + DA_KT + (2 * lane + 1) * DA_TS + i * 2) = (bf16_t)(pk >> 16); }
                if (s == 2) { *(LAS bf16_t*)(L + DA_VT + (2 * lane) * DA_TS + i * 2) = (bf16_t)(pk & 0xffff); *(LAS bf16_t*)(L + DA_VT + (2 * lane + 1) * DA_TS + i * 2) = (bf16_t)(pk >> 16); }
            }
        }
    }
    if (w < 2) {
        const int tok = w ? 63 - lane : lane; const float* gp = WSP(float, A0_GATES) + (size_t)(row0 + tok) * 16 + w * 8;
        float x = -expf(INP(11)[w * 4 + h]) * softplus_(gp[h] + INP(12)[w * 4 + h]);
#pragma unroll
        for (int off = 1; off < 64; off <<= 1) { const float y = __shfl_up(x, off); if (lane >= off) x += y; }
        sc[w * 64 + tok] = x;
        sc[128 + w * 64 + tok] = sigm(gp[4 + h]);
    }
    __syncthreads();
    DN_RELAUNDER();
    {
        const int which = w >> 2, mt = (w >> 1) & 1, nt = w & 1;
        f32x16 acc = zero16();
        const LAS unsigned char* bsrc = L + (which ? DA_QS : DA_KS);
#pragma unroll
        for (int ks = 0; ks < 8; ++ks) {
            const bf16x8v a = *(const LAS bf16x8v*)(L + DA_KS + (mt * 32 + r) * DA_RS + (ks * 16 + 8 * hh) * 2);
            const bf16x8v bb = *(const LAS bf16x8v*)(bsrc + (nt * 32 + r) * DA_RS + (ks * 16 + 8 * hh) * 2);
            acc = MFMA32(a, bb, acc);
        }
        if (which == 0) {
            const int j = nt * 32 + r; const float gfj = sc[j], grj = sc[64 + j];
            LAS float* Af = (LAS float*)(L + DA_AF); LAS float* Ar = (LAS float*)(L + DA_AR);
#pragma unroll
            for (int reg = 0; reg < 16; ++reg) { const int i = mt * 32 + crow(reg, hh); const float kk = acc[reg];
                Af[i * 68 + j] = (j < i) ? sc[128 + i] * kk * __expf(sc[i] - gfj) : 0.f;
                Ar[(63 - i) * 68 + (63 - j)] = (j > i) ? sc[192 + i] * kk * __expf(sc[64 + i] - grj) : 0.f; }
        } else {
            const int i = nt * 32 + r; const float gfi = sc[i], gri = sc[64 + i];
            const size_t cuf = ((size_t)((b * 4 + h) * 2 + 0) * 36 + tc), cur = ((size_t)((b * 4 + h) * 2 + 1) * 36 + ((tc < 4) ? 3 - tc : 4 + 35 - tc));
            unsigned char* attf = WSP(unsigned char, A0_ATT) + cuf * 8192; unsigned char* attr = WSP(unsigned char, A0_ATT) + cur * 8192;
#pragma unroll
            for (int g4 = 0; g4 < 4; ++g4) {
                const int j0 = mt * 32 + 8 * g4 + 4 * hh; float vf[4], vr[4];
#pragma unroll
                for (int e = 0; e < 4; ++e) { const int j = j0 + e; const float a = acc[4 * g4 + e];
                    vf[e] = (j <= i) ? a * __expf(gfi - sc[j]) : 0.f; vr[e] = (j >= i) ? a * __expf(gri - sc[64 + j]) : 0.f; }
                u32x2 wf; wf.x = pk2(vf[0], vf[1]); wf.y = pk2(vf[2], vf[3]);
                *(u32x2*)(attf + afrag_off(i, j0, 4)) = wf;
                u32x2 wr; wr.x = pk2(vr[3], vr[2]); wr.y = pk2(vr[1], vr[0]);
                *(u32x2*)(attr + afrag_off(63 - i, 60 - j0, 4)) = wr;
            }
        }
    }
    __syncthreads();
    DN_RELAUNDER();
    if (w < 2) {
        const LAS float* A = (const LAS float*)(L + (w ? DA_AR : DA_AF)); LAS unsigned char* T = L + (w ? DA_TR : DA_TF);
        float tcol[64];
        f32x4 av[2][16];
#pragma unroll
        for (int i = 0; i < 64; ++i) {
            if (i + 1 < 64) {
#pragma unroll
                for (int j4 = 0; j4 < (i + 1 + 3) / 4; ++j4) av[(i + 1) & 1][j4] = *(const LAS f32x4*)(A + (i + 1) * 68 + j4 * 4);
            }
            float s0 = (i == lane) ? 1.0f : 0.0f, s1 = 0.f, s2 = 0.f, s3 = 0.f;
#pragma unroll
            for (int j4 = 0; j4 < (i + 3) / 4; ++j4) { const f32x4 a4 = av[i & 1][j4];
                if (j4 * 4 + 0 < i) s0 -= a4[0] * tcol[j4 * 4 + 0];
                if (j4 * 4 + 1 < i) s1 -= a4[1] * tcol[j4 * 4 + 1];
                if (j4 * 4 + 2 < i) s2 -= a4[2] * tcol[j4 * 4 + 2];
                if (j4 * 4 + 3 < i) s3 -= a4[3] * tcol[j4 * 4 + 3]; }
            const float s = (s0 + s1) + (s2 + s3);
            tcol[i] = s;
            *(LAS bf16_t*)(T + i * DA_TS + lane * 2) = f2bf(s);
            asm volatile("" ::: "memory");
        }
    } else {
        for (int p = (w * 64 + lane) - 128; p < 4096; p += NTHR - 128) {
            const int d = p >> 11, kind = (p >> 10) & 1, q = p & 1023;
            const size_t cu = ((size_t)((b * 4 + h) * 2 + d) * 36 + (d ? ((tc < 4) ? 3 - tc : 4 + 35 - tc) : tc));
            const LAS float* gc = sc + d * 64;
            if (kind == 0) {
                const int ip = q >> 4, c8 = (q & 15) * 8, i = d ? 63 - ip : ip; const float e = __expf(gc[i]);
                const u32x4 raw = *(const LAS u32x4*)(L + DA_QS + i * DA_RS + c8 * 2); const float s8[8] = {e, e, e, e, e, e, e, e};
                *(bf16x8v*)(WSP(unsigned char, A0_WQ) + cu * 32768 + afrag_off(64 + ip, c8, 8)) = scale8(raw, s8, false);
            } else {
                const int dk = q >> 3, i8 = (q & 7) * 8; const float gl = d ? gc[0] : gc[63]; float s8[8];
#pragma unroll
                for (int e = 0; e < 8; ++e) { const int i = d ? 63 - (i8 + e) : i8 + e; s8[e] = __expf(gl - gc[i]); }
                const u32x4 raw = *(const LAS u32x4*)(L + DA_KT + dk * DA_TS + (d ? 56 - i8 : i8) * 2);
                *(bf16x8v*)(WSP(unsigned char, A0_KDT) + cu * 16384 + afrag_off(dk, i8, 4)) = scale8(raw, s8, d != 0);
            }
        }
    }
    __syncthreads();
#pragma unroll 1
    for (int d = 0; d < 2; ++d) {
        DN_RELAUNDER();
        const size_t cu = ((size_t)((b * 4 + h) * 2 + d) * 36 + (d ? ((tc < 4) ? 3 - tc : 4 + 35 - tc) : tc));
        const LAS unsigned char* T = L + (d ? DA_TR : DA_TF); const LAS float* gc = sc + d * 64; const LAS float* be = sc + 128 + d * 64;
        {
            const int mt = w >> 2, nt = w & 3; f32x16 acc = zero16();
#pragma unroll
            for (int ks = 0; ks < 4; ++ks) {
                const bf16x8v a = *(const LAS bf16x8v*)(T + (mt * 32 + r) * DA_TS + (ks * 16 + 8 * hh) * 2);
                const int jp = ks * 16 + 8 * hh; float s8[8];
#pragma unroll
                for (int e = 0; e < 8; ++e) s8[e] = be[d ? 63 - (jp + e) : jp + e];
                const u32x4 raw = *(const LAS u32x4*)(L + DA_VT + (nt * 32 + r) * DA_TS + (d ? 56 - jp : jp) * 2);
                acc = MFMA32(a, scale8(raw, s8, d != 0), acc);
            }
            float* uu = WSP(float, A0_UU) + cu * 8192 + ((size_t)(mt * 4 + nt) * 64 + lane) * 16;
#pragma unroll
            for (int g4 = 0; g4 < 4; ++g4) *(f32x4*)(uu + 4 * g4) = (f32x4){acc[4 * g4], acc[4 * g4 + 1], acc[4 * g4 + 2], acc[4 * g4 + 3]};
        }
        {
            const int mt = w >> 1, nt = w & 1; f32x16 acc = zero16();
#pragma unroll
            for (int ks = 0; ks < 4; ++ks) {
                const int jp = ks * 16 + 8 * hh; float s8[8];
#pragma unroll
                for (int e = 0; e < 8; ++e) { const int j = d ? 63 - (jp + e) : jp + e; s8[e] = be[j] * __expf(gc[j]); }
                const u32x4 raw = *(const LAS u32x4*)(L + DA_KT + (mt * 32 + r) * DA_TS + (d ? 56 - jp : jp) * 2);
                const bf16x8v bb = *(const LAS bf16x8v*)(T + (nt * 32 + r) * DA_TS + (ks * 16 + 8 * hh) * 2);
                acc = MFMA32(scale8(raw, s8, d != 0), bb, acc);
            }
            unsigned char* wq = WSP(unsigned char, A0_WQ) + cu * 32768; const int ip = nt * 32 + r;
#pragma unroll
            for (int g4 = 0; g4 < 4; ++g4) { const int k0 = mt * 32 + 8 * g4 + 4 * hh; u32x2 o; o.x = pk2(acc[4 * g4], acc[4 * g4 + 1]); o.y = pk2(acc[4 * g4 + 2], acc[4 * g4 + 3]);
                *(u32x2*)(wq + afrag_off(ip, k0, 8)) = o; }
        }
        if (F.tid == 0) WSP(float, A0_GL)[cu] = __expf(d ? gc[0] : gc[63]);
    }
    __syncthreads();
#undef DN_RELAUNDER
}

constexpr int DB_ST = 0, DB_VN = 34816;
DI void dnB_chain(const Fr& F, int unit) {
    const int d = unit & 1, h = (unit >> 1) & 3, b = unit >> 3;
    LAS unsigned char* L = F.lds; const int lane = F.lane, w = F.wave, r = lane & 31, hh = lane >> 5;
    const int mt = w >> 1, ntb = (w & 1) * 2;
    for (int i = F.tid; i < DB_VN / 16; i += NTHR) *(LAS u32x4*)(L + i * 16) = (u32x4){0u, 0u, 0u, 0u};
    f32x16 S0 = zero16(), S1 = zero16();
    const unsigned char* WQ = WSP(unsigned char, A0_WQ) + (size_t)unit * 36 * 32768; const unsigned char* KDT = WSP(unsigned char, A0_KDT) + (size_t)unit * 36 * 16384;
    const unsigned char* ATT = WSP(unsigned char, A0_ATT) + (size_t)unit * 36 * 8192; const float* UU = WSP(float, A0_UU) + (size_t)unit * 36 * 8192; const float* GL = WSP(float, A0_GL) + (size_t)unit * 36;
    float* OD = WSP(float, A0_OD) + (size_t)d * TT * 512;
    __syncthreads();
    bf16x8v wqf[8], kdf[4], atf[4]; f32x4 u0f[4], u1f[4]; float gl;
    {
        const unsigned char* wq = WQ + (size_t)(mt * 8) * 1024 + lane * 16; const unsigned char* kd = KDT + (size_t)(mt * 4) * 1024 + lane * 16;
        const unsigned char* at = ATT + (size_t)((mt & 1) * 4) * 1024 + lane * 16; const float* u0 = UU + ((size_t)((mt & 1) * 4 + ntb) * 64 + lane) * 16;
#pragma unroll
        for (int ks = 0; ks < 8; ++ks) wqf[ks] = *(const bf16x8v*)(wq + ks * 1024);
#pragma unroll
        for (int ks = 0; ks < 4; ++ks) { kdf[ks] = *(const bf16x8v*)(kd + ks * 1024); atf[ks] = *(const bf16x8v*)(at + ks * 1024); u0f[ks] = *(const f32x4*)(u0 + 4 * ks); u1f[ks] = *(const f32x4*)(u0 + 64 * 16 + 4 * ks); }
        gl = GL[0];
    }
#pragma unroll 1
    for (int n = 0; n < 36; ++n) {
        const int nn = (n + 1 < 36) ? n + 1 : n;
        const unsigned char* wq = WQ + (size_t)nn * 32768 + (size_t)(mt * 8) * 1024 + lane * 16;
        const unsigned char* kd = KDT + (size_t)nn * 16384 + (size_t)(mt * 4) * 1024 + lane * 16;
        const unsigned char* at = ATT + (size_t)nn * 8192 + (size_t)((mt & 1) * 4) * 1024 + lane * 16;
        const float* u0 = UU + (size_t)nn * 8192 + ((size_t)((mt & 1) * 4 + ntb) * 64 + lane) * 16;
        f32x16 P0 = zero16(), P1 = zero16();
#pragma unroll
        for (int ks = 0; ks < 8; ++ks) {
            const bf16x8v b0 = *(const LAS bf16x8v*)(L + DB_ST + (ntb * 32 + r) * 272 + (ks * 16 + 8 * hh) * 2);
            const bf16x8v b1 = *(const LAS bf16x8v*)(L + DB_ST + ((ntb + 1) * 32 + r) * 272 + (ks * 16 + 8 * hh) * 2);
            P0 = MFMA32(wqf[ks], b0, P0); P1 = MFMA32(wqf[ks], b1, P1);
        }
#pragma unroll
        for (int ks = 0; ks < 8; ++ks) wqf[ks] = *(const bf16x8v*)(wq + ks * 1024);
        if (w < 4) {
#pragma unroll
            for (int g4 = 0; g4 < 4; ++g4) {
                const f32x4 a0 = u0f[g4], a1 = u1f[g4]; const int i0 = mt * 32 + 8 * g4 + 4 * hh;
                u32x2 o0, o1; o0.x = pk2(a0[0] - P0[4 * g4], a0[1] - P0[4 * g4 + 1]); o0.y = pk2(a0[2] - P0[4 * g4 + 2], a0[3] - P0[4 * g4 + 3]);
                o1.x = pk2(a1[0] - P1[4 * g4], a1[1] - P1[4 * g4 + 1]); o1.y = pk2(a1[2] - P1[4 * g4 + 2], a1[3] - P1[4 * g4 + 3]);
                *(LAS u32x2*)(L + DB_VN + (ntb * 32 + r) * 144 + i0 * 2) = o0; *(LAS u32x2*)(L + DB_VN + ((ntb + 1) * 32 + r) * 144 + i0 * 2) = o1;
            }
#pragma unroll
            for (int g4 = 0; g4 < 4; ++g4) { u0f[g4] = *(const f32x4*)(u0 + 4 * g4); u1f[g4] = *(const f32x4*)(u0 + 64 * 16 + 4 * g4); }
        }
        __syncthreads();
#pragma unroll
        for (int i = 0; i < 16; ++i) { S0[i] *= gl; S1[i] *= gl; }
        gl = GL[nn];
#pragma unroll
        for (int ks = 0; ks < 4; ++ks) {
            const bf16x8v b0 = *(const LAS bf16x8v*)(L + DB_VN + (ntb * 32 + r) * 144 + (ks * 16 + 8 * hh) * 2);
            const bf16x8v b1 = *(const LAS bf16x8v*)(L + DB_VN + ((ntb + 1) * 32 + r) * 144 + (ks * 16 + 8 * hh) * 2);
            S0 = MFMA32(kdf[ks], b0, S0); S1 = MFMA32(kdf[ks], b1, S1);
            if (w >= 4) { P0 = MFMA32(atf[ks], b0, P0); P1 = MFMA32(atf[ks], b1, P1); }
        }
#pragma unroll
        for (int ks = 0; ks < 4; ++ks) { kdf[ks] = *(const bf16x8v*)(kd + ks * 1024); if (w >= 4) atf[ks] = *(const bf16x8v*)(at + ks * 1024); }
        if (w >= 4) {
            const int ip0 = (mt - 2) * 32 + 4 * hh; const long rstep = d ? -512 : 512;
            float* ob = OD + (size_t)row_of(b, d, n * 64 + ip0) * 512 + h * 128 + ntb * 32 + r;
#pragma unroll
            for (int reg = 0; reg < 16; ++reg) { float* o = ob + ((reg & 3) + 8 * (reg >> 2)) * rstep; o[0] = P0[reg]; o[32] = P1[reg]; }
        }
#pragma unroll
        for (int g4 = 0; g4 < 4; ++g4) { const int k0 = mt * 32 + 8 * g4 + 4 * hh;
            u32x2 o0, o1; o0.x = pk2(S0[4 * g4], S0[4 * g4 + 1]); o0.y = pk2(S0[4 * g4 + 2], S0[4 * g4 + 3]); o1.x = pk2(S1[4 * g4], S1[4 * g4 + 1]); o1.y = pk2(S1[4 * g4 + 2], S1[4 * g4 + 3]);
            *(LAS u32x2*)(L + DB_ST + (ntb * 32 + r) * 272 + k0 * 2) = o0; *(LAS u32x2*)(L + DB_ST + ((ntb + 1) * 32 + r) * 272 + k0 * 2) = o1; }
        __syncthreads();
    }
}
#ifndef MK_DN_NAIVE
#define MK_DN_NAIVE 0
#endif
DI void tconv(const Fr& F, const float* src, size_t sbs, int ld, int col0, int K, int N, bf16_t* dst, size_t dbs, int nb, int drs = 0, long u0 = 0, long u1 = -1, int vbid = -1, int vG = 0) {
    if (drs == 0) drs = K;
    LAS float* tile = (LAS float*)F.lds;
    const int tk = K / 64, tn = N / 256, per = tk * tn; const long total = (u1 >= 0) ? u1 : (long)nb * per;
    const int rr = F.tid >> 6, c4 = (F.tid & 63) * 4; const int ustep = (vbid >= 0) ? vG : F.G;
    f32x4 v[8];
    long u = u0 + ((vbid >= 0) ? vbid : F.bid);
    if (u < total) { const int b = (int)(u / per), r = (int)(u % per), kt = r / tn, nt_ = r % tn; const float* sp = src + (size_t)b * sbs + (size_t)(kt * 64) * ld + col0 + nt_ * 256;
#pragma unroll
        for (int h = 0; h < 8; ++h) v[h] = __builtin_nontemporal_load((const f32x4*)(sp + (size_t)(rr + 8 * h) * ld + c4)); }
    for (; u < total; u += ustep) {
        const int b = (int)(u / per), r = (int)(u % per), kt = r / tn, nt_ = r % tn;
#pragma unroll
        for (int h = 0; h < 8; ++h) { LAS float* tp = tile + (rr + 8 * h) * 257 + c4; tp[0] = v[h][0]; tp[1] = v[h][1]; tp[2] = v[h][2]; tp[3] = v[h][3]; }
        __syncthreads();
        const long un = u + ustep;
        if (un < total) { const int b2 = (int)(un / per), r2 = (int)(un % per), kt2 = r2 / tn, nt2 = r2 % tn; const float* sp = src + (size_t)b2 * sbs + (size_t)(kt2 * 64) * ld + col0 + nt2 * 256;
#pragma unroll
            for (int h = 0; h < 8; ++h) v[h] = __builtin_nontemporal_load((const f32x4*)(sp + (size_t)(rr + 8 * h) * ld + c4)); }
        {
#pragma unroll
            for (int q = 0; q < 4; ++q) { const int n = (F.tid >> 3) + 64 * q, k8 = (F.tid & 7) * 8; float x[8];
#pragma unroll
                for (int j = 0; j < 8; ++j) x[j] = tile[(k8 + j) * 257 + n];
                u32x4 w; w.x = pk2(x[0], x[1]); w.y = pk2(x[2], x[3]); w.z = pk2(x[4], x[5]); w.w = pk2(x[6], x[7]);
                *(u32x4*)(dst + (size_t)b * dbs + (size_t)(nt_ * 256 + n) * drs + kt * 64 + k8) = w; } }
        __syncthreads();
    }
}

#ifndef MK_BG_CONV
#define MK_BG_CONV 0
#endif
constexpr int TQ_PER_LAYER = 32 * 768, TQ_TOTAL = 2 * TQ_PER_LAYER;
DI void conv_chunk_wave(const Fr& F, int c, LAS float* tile  ) {
    const int l = c / TQ_PER_LAYER, r = c % TQ_PER_LAYER, e = r / 768, q = r % 768; const int lane = F.lane;
    const bool is2 = q >= 512; const int qq = is2 ? q - 512 : q; const int N = is2 ? DM : 2048; const int nts = N / 64;
    const int kt = qq / nts, nt_ = qq % nts;
    const float* src = (is2 ? INP(38) + ((size_t)l * 32 + e) * DM * DM : INP(36) + ((size_t)l * 32 + e) * DM * 2048) + (size_t)(kt * 64) * N + nt_ * 64;
    bf16_t* dst = (is2 ? WSP(bf16_t, WS_WM2) + ((size_t)l * 32 + e) * DM * DM : WSP(bf16_t, WS_WM1) + ((size_t)l * 32 + e) * 2048 * DM) + (size_t)(nt_ * 64) * DM + kt * 64;
    const int rs = lane >> 4, c4 = (lane & 15) * 4;
    f32x4 v[16];
#pragma unroll
    for (int j = 0; j < 16; ++j) v[j] = __builtin_nontemporal_load((const f32x4*)(src + (size_t)(rs + 4 * j) * N + c4));
#pragma unroll
    for (int j = 0; j < 16; ++j) { LAS float* tp = tile + (rs + 4 * j) * 65 + c4; tp[0] = v[j][0]; tp[1] = v[j][1]; tp[2] = v[j][2]; tp[3] = v[j][3]; }
#pragma unroll
    for (int j = 0; j < 8; ++j) { const int n = (lane >> 3) + 8 * j, k8 = (lane & 7) * 8; float x[8];
#pragma unroll
        for (int i = 0; i < 8; ++i) x[i] = tile[(k8 + i) * 65 + n];
        u32x4 w; w.x = pk2(x[0], x[1]); w.y = pk2(x[2], x[3]); w.z = pk2(x[4], x[5]); w.w = pk2(x[6], x[7]);
        *(u32x4*)(dst + (size_t)n * DM + k8) = w; }
}
DI int conv_claim(const Fr& F) { int c = 0; if (F.lane == 0) c = (int)__hip_atomic_fetch_add(WSP(unsigned, WS_CTL) + CW_TQ, 1u, __ATOMIC_RELAXED, __HIP_MEMORY_SCOPE_AGENT); return __builtin_amdgcn_readfirstlane(c); }
DI void conv_drain(const Fr& F, int upto) {
    LAS float* tile = (LAS float*)F.lds + F.wave * (64 * 65);
    for (;;) { const int c = conv_claim(F); if (c >= TQ_TOTAL) break; conv_chunk_wave(F, c, tile); if (c >= upto) break; }
}
DI void xcd_barrier_work(const XcdBarrier& b, const Fr& F) {
    asm volatile("s_waitcnt vmcnt(0)" ::: "memory");
    if (threadIdx.x == 0) b.st[2] = 0u;
    __syncthreads();
    if (F.wave == 0) {
        if (threadIdx.x == 0) {
            unsigned* bar = b.bar;
            __builtin_amdgcn_s_waitcnt(0);
            unsigned nloc = b.st[0], nx = b.st[1];
            if (nloc == 0u) { xcd_barrier_complete(bar, b.x, nloc, nx); b.st[0] = nloc; b.st[1] = nx; }
            const unsigned old = xb_add(&bar[XB_XSUB(b.x)], 1u);
            const unsigned gen = old / nloc;
            if (old + 1u == (gen + 1u) * nloc) {
                __builtin_amdgcn_fence(__ATOMIC_RELEASE, "agent");
                asm volatile("s_waitcnt vmcnt(0)" ::: "memory");
                const unsigned og = xb_add(&bar[XB_TOP], 1u);
                const unsigned tg = og / nx;
                if (og + 1u == (tg + 1u) * nx) xb_add(&bar[XB_TOPGEN], 1u);
                else XB_SPIN(xb_ld(&bar[XB_TOPGEN]) == tg, bar);
                __builtin_amdgcn_fence(__ATOMIC_ACQUIRE, "agent");
                xb_add(&bar[XB_XGEN(b.x)], 1u);
                asm volatile("s_waitcnt vmcnt(0)" ::: "memory");
            } else {
                XB_SPIN(xb_ld(&bar[XB_XGEN(b.x)]) == gen, bar);
                __builtin_amdgcn_fence(__ATOMIC_ACQUIRE, "agent");
                asm volatile("s_waitcnt vmcnt(0)" ::: "memory");
            }
            b.st[2] = 1u;
        }
    } else {
        LAS float* tile = (LAS float*)F.lds + F.wave * (64 * 65);
        while (b.st[2] == 0u) { const int c = conv_claim(F); if (c >= TQ_TOTAL) break; conv_chunk_wave(F, c, tile); }
    }
    __syncthreads();
}

DI void tconv8(const Fr& F, const float* src, size_t sbs, int ld, int K, int N, unsigned char* dst, size_t dbs, int nb, float scale, long u0, long u1, int vbid, int vG) {
    LAS float* tile = (LAS float*)F.lds;
    const int tk = K / 128, tn = N / 128, per = tk * tn; const long total = (u1 >= 0) ? u1 : (long)nb * per;
    const int rr = F.tid >> 5, c4 = (F.tid & 31) * 4; const int ustep = (vbid >= 0) ? vG : F.G;
    f32x4 v[8];
    long u = u0 + ((vbid >= 0) ? vbid : F.bid);
    if (u < total) { const int b = (int)(u / per), r = (int)(u % per), kt = r / tn, nt_ = r % tn; const float* sp = src + (size_t)b * sbs + (size_t)(kt * 128) * ld + nt_ * 128;
#pragma unroll
        for (int h = 0; h < 8; ++h) v[h] = __builtin_nontemporal_load((const f32x4*)(sp + (size_t)(rr + 16 * h) * ld + c4)); }
    for (; u < total; u += ustep) {
        const int b = (int)(u / per), r = (int)(u % per), kt = r / tn, nt_ = r % tn;
#pragma unroll
        for (int h = 0; h < 8; ++h) { LAS float* tp = tile + (rr + 16 * h) * 129 + c4; tp[0] = v[h][0]; tp[1] = v[h][1]; tp[2] = v[h][2]; tp[3] = v[h][3]; }
        __syncthreads();
        const long un = u + ustep;
        if (un < total) { const int b2 = (int)(un / per), r2 = (int)(un % per), kt2 = r2 / tn, nt2 = r2 % tn; const float* sp = src + (size_t)b2 * sbs + (size_t)(kt2 * 128) * ld + nt2 * 128;
#pragma unroll
            for (int h = 0; h < 8; ++h) v[h] = __builtin_nontemporal_load((const f32x4*)(sp + (size_t)(rr + 16 * h) * ld + c4)); }
#pragma unroll
        for (int q = 0; q < 2; ++q) { const int n = (F.tid >> 3) + 64 * q, k16 = (F.tid & 7) * 16; float x[16];
#pragma unroll
            for (int j = 0; j < 16; ++j) x[j] = tile[(k16 + j) * 129 + n] * scale;
            u32x4 w; w.x = pk4_fp8(x[0], x[1], x[2], x[3]); w.y = pk4_fp8(x[4], x[5], x[6], x[7]); w.z = pk4_fp8(x[8], x[9], x[10], x[11]); w.w = pk4_fp8(x[12], x[13], x[14], x[15]);
            *(u32x4*)(dst + (size_t)b * dbs + (size_t)(nt_ * 128 + n) * K + kt * 128 + k16) = w; }
        __syncthreads();
    }
}
constexpr int L1W1_A = 1344, L1W1_B = 2304, L1W2_A = 1536;
DI void moe_w_l1_part(const Fr& F, int which, long u0, long u1, int vbid, int vG) {
#if MK_FP8_L1
    if (which == 0) tconv8(F, INP(36) + (size_t)32 * DM * 2048, (size_t)DM * 2048, 2048, DM, 2048, WSP(unsigned char, WS_WM1) + (size_t)32 * 2048 * DM * 2, (size_t)2048 * DM, 32, W1_F8S, u0, u1, vbid, vG);
    else tconv8(F, INP(38) + (size_t)32 * DM * DM, (size_t)DM * DM, DM, DM, DM, WSP(unsigned char, WS_WM2) + (size_t)32 * DM * DM * 2, (size_t)DM * DM, 32, W2_F8S, u0, u1, vbid, vG);
#else
    if (which == 0) tconv(F, INP(36) + (size_t)32 * DM * 2048, (size_t)DM * 2048, 2048, 0, DM, 2048, WSP(bf16_t, WS_WM1) + (size_t)32 * 2048 * DM, (size_t)2048 * DM, 32, 0, u0, u1, vbid, vG);
    else tconv(F, INP(38) + (size_t)32 * DM * DM, (size_t)DM * DM, DM, 0, DM, DM, WSP(bf16_t, WS_WM2) + (size_t)32 * DM * DM, (size_t)DM * DM, 32, 0, u0, u1, vbid, vG);
#endif
}
#ifndef MK_P0_MASK
#define MK_P0_MASK 31
#endif
#ifndef MK_P0_TWICE
#define MK_P0_TWICE 0
#endif
DI void p0_prologue(const Fr& F) {
    for (int rep_ = 0; rep_ < ((MK_P0_TWICE & 2) ? 2 : 1); ++rep_) {
    for (int tix = F.bid; tix < 544; tix += F.G) {
        if (tix < 128)      tconv(F, INP(8), 0, EVEN_IN, 0, DM, 2048, WSP(bf16_t, WS_WEVIN), 0, 1, 0, tix, tix + 1, 0, 1);
        else if (tix < 224) tconv(F, INP(8), 0, EVEN_IN, HY_COL, DM, 1536, WSP(bf16_t, WS_WEVIN) + (size_t)2048 * DM, 0, 1, 0, tix - 128, tix - 127, 0, 1);
        else if (tix < 288) tconv(F, INP(9), 0, DM, 0, MIXW, DM, WSP(bf16_t, WS_WEVOUT), 0, 1, 0, tix - 224, tix - 223, 0, 1);
        else if (tix < 416) tconv(F, INP(23), 0, 2048, 0, DM, 2048, WSP(bf16_t, WS_WODIN), 0, 1, 0, tix - 288, tix - 287, 0, 1);
        else if (tix < 480) tconv(F, INP(32), 0, DM, 0, DM, DM, WSP(bf16_t, WS_WODOUT), 0, 1, 0, tix - 416, tix - 415, 0, 1);
        else {
            const int th = (tix - 480) >> 2, kt = (tix - 480) & 3, g = th >> 3, d = (th >> 2) & 1, h = th & 3;
            tconv(F, (g ? INP(29) : INP(27)) + (size_t)(d * 4 + h) * 65536, 0, 256, 0, 256, 256, WSP(bf16_t, WS_WLRU) + ((size_t)(d * 4 + h) * 512 + g) * 256, 0, 1, 512, kt, kt + 1, 0, 1); }
    }
    for (int i = F.bid * NTHR + F.tid; i < 4096; i += F.G * NTHR) { const int g = i & 1, j = (i >> 1) & 255, h = (i >> 9) & 3, d = i >> 11;
        WSP(float, WS_BLRU)[i] = (g ? INP(30) : INP(28))[d * DM + h * 256 + j];
        if (i < 2048) WSP(float, WS_BLRU)[4096 + i] = -8.0f * softplus_(INP(31)[i]); }
    }
    for (int i = F.bid * NTHR + F.tid; i < 2 * DM * NEXP; i += F.G * NTHR) { const int l = i >> 15, k = (i >> 5) & 1023, e = i & 31; WSP(float, WS_RWT)[(size_t)l * 32768 + e * DM + k] = INP(34)[i]; }
    for (int i = F.bid * NTHR + F.tid; i < 16 * DM; i += F.G * NTHR) { const int k = i >> 4, g = i & 15; WSP(float, WS_WGT)[g * DM + k] = INP(8)[(size_t)k * EVEN_IN + DN_GATE_COL + g]; }
#if !MK_BG_CONV
#if MK_FP8_L0
    tconv8(F, INP(36), (size_t)DM * 2048, 2048, DM, 2048, WSP(unsigned char, WS_WM1), (size_t)2048 * DM, 32, W1_F8S, 0, -1, -1, 0);
    tconv8(F, INP(38), (size_t)DM * DM, DM, DM, DM, WSP(unsigned char, WS_WM2), (size_t)DM * DM, 32, W2_F8S, 0, -1, -1, 0);
#else
    tconv(F, INP(36), (size_t)DM * 2048, 2048, 0, DM, 2048, WSP(bf16_t, WS_WM1), (size_t)2048 * DM, 32);
    tconv(F, INP(38), (size_t)DM * DM, DM, 0, DM, DM, WSP(bf16_t, WS_WM2), (size_t)DM * DM, 32);
#endif
    if (F.G == 256) { moe_w_l1_part(F, 0, L1W1_B, 4096, F.bid, F.G); moe_w_l1_part(F, 1, L1W2_A, 2048, F.bid, F.G); } else { moe_w_l1_part(F, 0, 0, 4096, F.bid, F.G); moe_w_l1_part(F, 1, 0, 2048, F.bid, F.G); }
#endif
    for (int rep_ = 0; rep_ < ((MK_P0_TWICE & 4) ? 2 : 1); ++rep_)
    if (MK_P0_MASK & 4) {
        LAS float* sl = (LAS float*)F.lds;
        LAS float* part = sl + 9 * 1024;
        for (int i = F.tid; i < 9 * 1024; i += NTHR) { const int r = i >> 10, k = i & 1023; const float v = (r < 8) ? INP(1)[r * DM + k] : INP(3)[k]; sl[i] = silu_(v); }
        __syncthreads();
        float* MOD = WSP(float, WS_MOD);
        for (int u = F.bid; u < 192; u += F.G) {
            const int l = u / 96, n0 = (u % 96) * 64;
            const float* W = INP(4) + (size_t)l * DM * 6144 + n0 + F.lane;
            float acc[9];
#pragma unroll
            for (int r = 0; r < 9; ++r) acc[r] = 0.f;
#pragma unroll 16
            for (int k = F.wave * 128; k < F.wave * 128 + 128; ++k) { const float w = W[(size_t)k * 6144];
#pragma unroll
                for (int r = 0; r < 9; ++r) acc[r] += sl[r * 1024 + k] * w; }
#pragma unroll
            for (int r = 0; r < 9; ++r) part[(F.wave * 9 + r) * 64 + F.lane] = acc[r];
            __syncthreads();
            for (int i = F.tid; i < 9 * 64; i += NTHR) { const int r = i >> 6, ln = i & 63; float s = INP(5)[(size_t)l * 6144 + n0 + ln];
#pragma unroll
                for (int w = 0; w < 8; ++w) s += part[(w * 9 + r) * 64 + ln];
                MOD[((size_t)l * 9 + r) * 6144 + n0 + ln] = s; }
            __syncthreads();
        }
    }
    if (MK_P0_MASK & 8) {
        float* POS = WSP(float, WS_POS);
        for (int i = F.bid * NTHR + F.tid; i < SEQ * DM; i += F.G * NTHR) {
            const int t = i >> 10, d = i & 1023, q = d >> 8, fi = d & 255;
            const float omega = 1.0f / powf(10000.0f, (float)fi / 256.0f);
            const float p = (q < 2) ? (float)(t >> 6) : (float)(t & 63);
            const float ang = p * omega;
            POS[i] = (q & 1) ? cosf(ang) : sinf(ang);
        }
    }
    for (int rep_ = 0; rep_ < ((MK_P0_TWICE & 1) ? 2 : 1); ++rep_)
    if (MK_P0_MASK & 16) {
        const int f = F.lane; const float fr = INP(21)[f];
        for (int u = F.gwave; u < SEQ + CTXL; u += F.nwaves) {
            const bool isc = u >= SEQ; const int L = isc ? CTXL : SEQ, i = isc ? u - SEQ : u;
            const float t = (float)i / (float)(L - 1), wpos = 6.283185307179586f * (float)i / (float)L;
            float zv = t;
            if (f >= 1 && f < 33) { const float fb = 1e-4f + (float)((f - 1) & 15) * ((15.0f - 1e-4f) / 15.0f); zv = (f < 17) ? cosf(fb * wpos) : -sinf(fb * wpos); }
            float s = INP(17)[f];
#pragma unroll 11
            for (int e = 0; e < 33; ++e) s += __shfl(zv, e) * INP(16)[e * 64 + f];
            float hcur = sinf(fr * s);
#pragma unroll 1
            for (int ly = 0; ly < 2; ++ly) { float s2 = INP(19)[ly * 64 + f];
#pragma unroll 16
                for (int e = 0; e < 64; ++e) s2 += __shfl(hcur, e) * INP(18)[ly * 4096 + e * 64 + f];
                hcur = sinf(fr * s2); }
            WSP(float, WS_HID)[(size_t)u * 64 + f] = hcur;
        }
    }
}
DI void hy_filter_out(const Fr& F) {
    LAS float* wsl = (LAS float*)F.lds;
    const float MIN_DECAY = -3.0701134573253942f, MAX_DECAY = -15.350567286626972f;
    for (int u = F.bid; u < 128; u += F.G) {
        __syncthreads();
        { const int g = F.tid >> 3, j = F.tid & 7; wsl[g * 8 + j] = INP(20)[g * 1024 + u * 8 + j]; }
        __syncthreads();
        const float* HID = WSP(float, WS_HID);
        for (int lg = F.tid; lg < SEQ + CTXL; lg += NTHR) {
            const bool isc = lg >= SEQ; const int L = isc ? CTXL : SEQ, i = isc ? lg - SEQ : lg; const float t = (float)i / (float)(L - 1);
            f32x4 hv[16];
#pragma unroll
            for (int q = 0; q < 16; ++q) hv[q] = *(const f32x4*)(HID + (size_t)lg * 64 + q * 4);
            f32x4 a0 = (f32x4){0.f, 0.f, 0.f, 0.f}, a1 = a0;
#pragma unroll
            for (int q = 0; q < 16; ++q)
#pragma unroll
                for (int e = 0; e < 4; ++e) { const LAS f32x4* wp = (const LAS f32x4*)(wsl + (q * 4 + e) * 8); a0 += wp[0] * hv[q][e]; a1 += wp[1] * hv[q][e]; if (e == 3) asm volatile("" ::: "memory"); }
#pragma unroll
            for (int j = 0; j < 8; ++j) { const int col = u * 8 + j, c = col & 511; const float delta = fabsf(MIN_DECAY + (float)c * ((MAX_DECAY - MIN_DECAY) / 511.0f));
                const float v = (j < 4 ? a0[j & 3] : a1[j & 3]) * expf(-t * delta);
                float* dst = (col < 512) ? (isc ? WSP(float, WS_HFC) : WSP(float, WS_HFL)) : (isc ? WSP(float, WS_HBC) : WSP(float, WS_HBL));
                dst[(size_t)c * L + i] = v; }
        }
    }
    __syncthreads();
}

DI void p1_mod0(const Fr& F) {
    hy_filter_out(F);
    LAS float* wgt = (LAS float*)F.lds;
    { const f32x4* src = WSP(f32x4, WS_WGT);
#pragma unroll
      for (int it = 0; it < 8; ++it) *(LAS f32x4*)(wgt + (F.tid + it * NTHR) * 4) = src[F.tid + it * NTHR]; }
    __syncthreads();
    const float* MOD = WSP(float, WS_MOD); const float* POS = WSP(float, WS_POS);
    bf16_t* U = WSP(bf16_t, A0_U); float* GATES = WSP(float, A0_GATES);
    for (int row = F.gwave; row < TT; row += F.nwaves) {
        const bool isc = row >= TL; const int b = isc ? (row - TL) >> 8 : row >> 11; const int t = isc ? 0 : (row & 2047);
        const float* xin = isc ? INP(2) + (size_t)(row - TL) * DM : INP(0) + (size_t)row * DM;
        const float* md = MOD + (size_t)(isc ? 8 : b) * 6144;
        f32x4 xv[4], pv[4], shv[4], scv[4];
#pragma unroll
        for (int i = 0; i < 4; ++i) { const int k = i * 256 + F.lane * 4; xv[i] = *(const f32x4*)(xin + k); shv[i] = *(const f32x4*)(md + k); scv[i] = *(const f32x4*)(md + 1024 + k);
            pv[i] = isc ? (f32x4){0.f, 0.f, 0.f, 0.f} : *(const f32x4*)(POS + (size_t)t * DM + k); }
        float ga[16];
#pragma unroll
        for (int g = 0; g < 16; ++g) ga[g] = 0.f;
#pragma unroll
        for (int i = 0; i < 4; ++i) {
            const int k = i * 256 + F.lane * 4;
            const f32x4 u = xv[i] * (scv[i] + 1.0f) + shv[i] + pv[i];
            u32x2 w; w.x = pk2(u[0], u[1]); w.y = pk2(u[2], u[3]);
            *(u32x2*)(U + (size_t)row * DM + k) = w;
#pragma unroll
            for (int g = 0; g < 16; ++g) { const f32x4 wv = *(const LAS f32x4*)(wgt + g * 1024 + k); ga[g] += u[0] * wv[0] + u[1] * wv[1] + u[2] * wv[2] + u[3] * wv[3]; }
            asm volatile("" ::: "memory");
        }
#define RS16(N, OFF) { const bool up = (F.lane & (OFF)) != 0; _Pragma("unroll") for (int g = 0; g < (N); ++g) { const float kp = up ? ga[g + (N)] : ga[g], sd = up ? ga[g] : ga[g + (N)]; ga[g] = kp + __shfl_xor(sd, (OFF)); } }
        RS16(8, 32) RS16(4, 16) RS16(2, 8) RS16(1, 4)
#undef RS16
        float tot = ga[0]; tot += __shfl_xor(tot, 2); tot += __shfl_xor(tot, 1);
        if ((F.lane & 3) == 0) GATES[(size_t)row * 16 + (F.lane >> 2)] = tot;
    }
}

#ifndef MK_PREP_TWICE
#define MK_PREP_TWICE 0
#endif
DI void p3_prep(const Fr& F) {
#if !MK_DN_NAIVE
    __syncthreads();
    for (int u = F.bid; u < NB * 4 * 36; u += F.G) dnA_unit(F, u);
#if MK_PREP_TWICE == 1
    for (int u = F.bid; u < NB * 4 * 36; u += F.G) dnA_unit(F, u);
#endif
#endif
    const bf16_t* P = WSP(bf16_t, A0_P); const float* GATES = WSP(float, A0_GATES);
    float* QN = WSP(float, A0_QN); float* KN = WSP(float, A0_KN); float* VV = WSP(float, A0_VV);
    float* GG = WSP(float, A0_GG); float* BB = WSP(float, A0_BB);
    const float* cw = INP(10);
#if MK_DN_NAIVE
    for (int u = F.bid; u < (TT / 64) * 4; u += F.G) {
        const int rt = u >> 2, h = u & 3, row0 = rt * 64 + F.wave * 8; const bool isc = row0 >= TL; const int L = isc ? CTXL : SEQ;
        const int t0 = isc ? ((row0 - TL) & 255) : (row0 & 2047);
#pragma unroll 1
        for (int s = 0; s < 3; ++s) {
            const int col = s * 512 + h * 128 + F.lane * 2;
            float w0[4], w1[4];
#pragma unroll
            for (int i = 0; i < 4; ++i) { w0[i] = cw[i * 1536 + col]; w1[i] = cw[i * 1536 + col + 1]; }
            float p0[11], p1[11];
#pragma unroll
            for (int rr = 0; rr < 11; ++rr) { const int tl = t0 + rr - 2; unsigned pv = 0u; if (tl >= 0 && tl < L) pv = *(const unsigned*)(P + (size_t)(row0 + rr - 2) * NP0 + col);
                p0[rr] = __uint_as_float(pv << 16); p1[rr] = __uint_as_float(pv & 0xffff0000u); }
            bf16_t* dstb = (s == 0 ? WSP(bf16_t, A0_QB) : (s == 1 ? WSP(bf16_t, A0_KB) : WSP(bf16_t, A0_VB3))) + (size_t)row0 * 512 + h * 128 + F.lane * 2;
#pragma unroll
            for (int j = 0; j < 8; ++j) {
                float a0 = w0[0] * p0[j] + w0[1] * p0[j + 1] + w0[2] * p0[j + 2] + w0[3] * p0[j + 3];
                float a1 = w1[0] * p1[j] + w1[1] * p1[j + 1] + w1[2] * p1[j + 2] + w1[3] * p1[j + 3];
                a0 = silu_(a0); a1 = silu_(a1);
                if (s < 2) { const float ss = wsum(a0 * a0 + a1 * a1); float r = rsqrtf(ss + RMS_EPS); if (s == 0) r *= 0.08838834764831845f; a0 *= r; a1 *= r; }
#if MK_DN_NAIVE
                { float* dst = (s == 0 ? QN : (s == 1 ? KN : VV)) + (size_t)(row0 + j) * 512 + h * 128 + F.lane * 2; *(f32x2*)dst = (f32x2){a0, a1}; }
#endif
                *(unsigned*)(dstb + (size_t)j * 512) = pk2(a0, a1);
            }
        }
        if (F.lane < 16) { const int d = F.lane & 1, row = row0 + (F.lane >> 1);
            const float gd = GATES[(size_t)row * 16 + d * 8 + h], gb = GATES[(size_t)row * 16 + d * 8 + 4 + h];
            GG[((size_t)d * TT + row) * 4 + h] = -expf(INP(11)[d * 4 + h]) * softplus_(gd + INP(12)[d * 4 + h]);
            BB[((size_t)d * TT + row) * 4 + h] = sigm(gb); }
    }
#endif
    float* VX = WSP(float, A0_VX); float* X0 = WSP(float, A0_X0);
    const float* hw = INP(14); const float* hb = INP(15);
    LAS bf16_t* tile = (LAS bf16_t*)F.lds;
    __syncthreads();
    const bool bal = (F.G == 256) && !MK_DN_NAIVE; const int hu0 = bal ? (F.bid < 128 ? F.bid : 384 + (F.bid - 128)) : F.bid, hu1 = bal ? (F.bid < 128 ? 384 : 1152) : (TT / 64) * 4, hus = bal ? 128 : F.G;
    for (int u = hu0; u < hu1; u += hus) {
        const int rt = u >> 2, ct = u & 3, row0 = rt * 64; const bool isc = row0 >= TL; const int L = isc ? CTXL : SEQ;
        const int t0 = isc ? ((row0 - TL) & 255) : (row0 & 2047);
        const int cl = F.tid & 63, rg = F.tid >> 6, c = ct * 128 + cl * 2;
        unsigned praw[3][10];
#pragma unroll
        for (int rr = 0; rr < 10; ++rr) { const int tl = t0 + rg * 8 + rr - 1; const bool ok = tl >= 0 && tl < L;
#pragma unroll
            for (int sg = 0; sg < 3; ++sg) praw[sg][rr] = ok ? *(const unsigned*)(P + (size_t)(row0 + rg * 8 + rr - 1) * NP0 + 2048 + sg * 512 + c) : 0u; }
        f32x2 w3[3][3], b3[3];
#pragma unroll
        for (int sg = 0; sg < 3; ++sg) { b3[sg] = *(const f32x2*)(hb + sg * 512 + c);
#pragma unroll
            for (int j = 0; j < 3; ++j) w3[sg][j] = *(const f32x2*)(hw + j * 1536 + sg * 512 + c); }
#pragma unroll
        for (int j = 0; j < 8; ++j) { f32x2 r3[3];
#pragma unroll
            for (int sg = 0; sg < 3; ++sg) { r3[sg] = b3[sg];
#pragma unroll
                for (int q = 0; q < 3; ++q) { const unsigned pw = praw[sg][j + q]; r3[sg] += w3[sg][q] * (f32x2){__uint_as_float(pw << 16), __uint_as_float(pw & 0xffff0000u)}; } }
            const size_t o = (size_t)(row0 + rg * 8 + j) * 512 + c; const f32x2 vx = r3[2] * r3[1];
            *(f32x2*)(X0 + o) = r3[0]; *(f32x2*)(VX + o) = vx;
            const unsigned pk = pk2(vx[0], vx[1]);
            tile[(cl * 2) * 72 + rg * 8 + j] = (bf16_t)(pk & 0xffffu); tile[(cl * 2 + 1) * 72 + rg * 8 + j] = (bf16_t)(pk >> 16); }
        __syncthreads();
        { const int c2 = F.tid >> 2, seg = F.tid & 3; const u32x4 v0 = *(const LAS u32x4*)(tile + c2 * 72 + seg * 16), v1 = *(const LAS u32x4*)(tile + c2 * 72 + seg * 16 + 8);
          bf16_t* dst = isc ? WSP(bf16_t, A0_VXTC) + (size_t)(ct * 128 + c2) * TC + (row0 - TL) : WSP(bf16_t, A0_VXTL) + (size_t)(ct * 128 + c2) * TL + row0;
          *(u32x4*)(dst + seg * 16) = v0; *(u32x4*)(dst + seg * 16 + 8) = v1; }
        __syncthreads();
    }
}

DI void dn_chain(const Fr& F, int unit) {
    const int b = unit >> 3, h = (unit >> 1) & 3, d = unit & 1;
    const float* QN = WSP(float, A0_QN); const float* KN = WSP(float, A0_KN); const float* VV = WSP(float, A0_VV);
    const float* GG = WSP(float, A0_GG) + (size_t)d * TT * 4; const float* BB = WSP(float, A0_BB) + (size_t)d * TT * 4;
    float* OD = WSP(float, A0_OD) + (size_t)d * TT * 512;
    LAS float* qs = (LAS float*)F.lds; LAS float* ks = qs + 128; LAS float* vs = ks + 128; LAS float* red1 = vs + 128; LAS float* red2 = red1 + 512; LAS float* scal = red2 + 512;
    const int dv = F.tid & 127, kb = F.tid >> 7;
    float S[32];
#pragma unroll
    for (int i = 0; i < 32; ++i) S[i] = 0.f;
    for (int p = 0; p < CTXL + SEQ; ++p) {
        const int row = row_of(b, d, p);
        if (F.tid < 128) qs[F.tid] = QN[(size_t)row * 512 + h * 128 + F.tid];
        else if (F.tid < 256) ks[F.tid - 128] = KN[(size_t)row * 512 + h * 128 + F.tid - 128];
        else if (F.tid < 384) vs[F.tid - 256] = VV[(size_t)row * 512 + h * 128 + F.tid - 256];
        else if (F.tid == 384) scal[0] = expf(GG[(size_t)row * 4 + h]);
        else if (F.tid == 385) scal[1] = BB[(size_t)row * 4 + h];
        __syncthreads();
        float part = 0.f;
#pragma unroll
        for (int i = 0; i < 32; ++i) part += ks[kb * 32 + i] * S[i];
        red1[kb * 128 + dv] = part;
        __syncthreads();
        const float kS = red1[dv] + red1[128 + dv] + red1[256 + dv] + red1[384 + dv];
        const float eg = scal[0], beta = scal[1];
        const float delta = beta * (vs[dv] - eg * kS);
        float op = 0.f;
#pragma unroll
        for (int i = 0; i < 32; ++i) { S[i] = eg * S[i] + ks[kb * 32 + i] * delta; op += qs[kb * 32 + i] * S[i]; }
        red2[kb * 128 + dv] = op;
        __syncthreads();
        if (kb == 0) OD[(size_t)row * 512 + h * 128 + dv] = red2[dv] + red2[128 + dv] + red2[256 + dv] + red2[384 + dv];
    }
    __syncthreads();
}
constexpr int HY_RS_LAT = 2 * (2 * SEQ + 64) + 64, HY_RS_CTX = 2 * (2 * CTXL + 64) + 64;
DI void hy_mfma_unit(const Fr& F, int c) {
    typedef short bf16x8h __attribute__((ext_vector_type(8)));
    LAS unsigned char* Lm = F.lds;
    const int lane = F.lane, w = F.wave, m = lane & 15, q = lane >> 4, ml = m & 7, mh = m >> 3, n8 = lane & 7;
#pragma unroll 1
    for (int kind = 0; kind < 2; ++kind) {
        const int L = kind ? CTXL : SEQ, RS = kind ? HY_RS_CTX : HY_RS_LAT;
        const float* HFt = (kind ? WSP(float, WS_HFC) : WSP(float, WS_HFL)) + (size_t)c * L; const float* HBt = (kind ? WSP(float, WS_HBC) : WSP(float, WS_HBL)) + (size_t)c * L;
        LAS unsigned char* Rsh = Lm; LAS unsigned char* Vt = Lm + 8 * HY_RS_LAT;
        __syncthreads();
        for (int x2 = F.tid; x2 < L + 32; x2 += NTHR) {
#pragma unroll
            for (int a = 0; a < 8; ++a) { float v2[2];
#pragma unroll
                for (int e = 0; e < 2; ++e) { const int idx = 2 * x2 + e - a, i = idx - L; v2[e] = (idx <= 0 || idx >= 2 * L) ? 0.f : (i <= 0 ? HFt[-i] : HBt[i]); }
                *(LAS unsigned*)(Rsh + a * RS + x2 * 4) = pk2(v2[0], v2[1]); }
        }
        { const u32x4* src = (const u32x4*)(kind ? WSP(bf16_t, A0_VXTC) + (size_t)c * TC : WSP(bf16_t, A0_VXTL) + (size_t)c * TL);
          for (int i = F.tid; i < L; i += NTHR) *(LAS u32x4*)(Vt + i * 16) = src[i]; }
        __syncthreads();
        float* YT = kind ? WSP(float, A0_YHTC) + (size_t)c * TC : WSP(float, A0_YHTL) + (size_t)c * TL;
        const int ng = L / 128, nks = L / 32;
        for (int g = w; g < ng; g += 8) {
            const int mt0 = g * 8;
            const LAS unsigned char* abase = Rsh + ml * RS + (L - 16 * mt0 + 8 * q - 8 * mh) * 2;
            const LAS unsigned char* bbase = Vt + n8 * (L * 2) + (8 * q) * 2;
            bf16x8h fr[8]; f32x4 acc[8];
#pragma unroll
            for (int i = 0; i < 8; ++i) { acc[i] = (f32x4){0.f, 0.f, 0.f, 0.f}; fr[(8 - i) & 7] = *(const LAS bf16x8h*)(abase + (-i) * 32); }
            for (int ks4 = 0; ks4 < nks; ks4 += 4) {
#pragma unroll
                for (int kk = 0; kk < 4; ++kk) {
                    const int ks = ks4 + kk;
                    const bf16x8h bv = *(const LAS bf16x8h*)(bbase + ks * 64);
#pragma unroll
                    for (int i = 0; i < 8; ++i) acc[i] = __builtin_amdgcn_mfma_f32_16x16x32_bf16(fr[(2 * kk - i) & 7], bv, acc[i], 0, 0, 0);
                    fr[(2 * kk + 1) & 7] = *(const LAS bf16x8h*)(abase + (2 * ks + 1) * 32);
                    fr[(2 * kk + 2) & 7] = *(const LAS bf16x8h*)(abase + (2 * ks + 2) * 32);
                }
            }
            if (m < 8) {
#pragma unroll
                for (int i = 0; i < 8; ++i) *(f32x4*)(YT + (size_t)m * L + 16 * (mt0 + i) + 4 * q) = acc[i];
            }
        }
    }
    __syncthreads();
}
DI void p4a_dn_chunks(const Fr& F) {}
DI void p4_mix_core(const Fr& F) {
#if MK_DN_NAIVE
    for (int u = F.bid; u < 64 + 512; u += F.G) { if (u < 64) dn_chain(F, u); else hy_mfma_unit(F, u - 64); }
#else
    if (F.G >= 128) { if (F.bid < 64) dnB_chain(F, F.bid); else { for (int c = F.bid - 64; c < 512; c += F.G - 64) hy_mfma_unit(F, c);
            if (F.G == 256 && !MK_BG_CONV) moe_w_l1_part(F, 1, 0, L1W2_A, F.bid - 64, F.G - 64); } }
    else for (int u = F.bid; u < 64 + 512; u += F.G) { if (u < 64) dnB_chain(F, u); else hy_mfma_unit(F, u - 64); }
#endif
}

DI void p5_mix(const Fr& F) {
    const float* OD = WSP(float, A0_OD); const bf16_t* P = WSP(bf16_t, A0_P); bf16_t* MIX = WSP(bf16_t, A0_MIX);
    const float* YH = WSP(float, A0_YH); const float* VX = WSP(float, A0_VX); const float* X0 = WSP(float, A0_X0);
    for (int row = F.gwave; row < TT; row += F.nwaves) {
        const int hs = F.lane >> 5, l32 = F.lane & 31; const f32x4 gn = *(const f32x4*)(INP(13) + l32 * 4);
#pragma unroll
        for (int hp = 0; hp < 2; ++hp) {
            const int col = (hp * 2 + hs) * 128 + l32 * 4;
            const f32x4 o = *(const f32x4*)(OD + (size_t)row * 512 + col) + *(const f32x4*)(OD + ((size_t)TT + row) * 512 + col);
            float ss = (o[0] * o[0] + o[1] * o[1]) + (o[2] * o[2] + o[3] * o[3]);
            ss += __shfl_xor(ss, 16); ss += __shfl_xor(ss, 8); ss += __shfl_xor(ss, 4); ss += __shfl_xor(ss, 2); ss += __shfl_xor(ss, 1);
            const float r = rsqrtf(ss * (1.0f / 128.0f) + RMS_EPS);
            const u32x2 zv = *(const u32x2*)(P + (size_t)row * NP0 + 1536 + col);
            const float z0 = __uint_as_float(zv.x << 16), z1 = __uint_as_float(zv.x & 0xffff0000u), z2 = __uint_as_float(zv.y << 16), z3 = __uint_as_float(zv.y & 0xffff0000u);
            u32x2 w; w.x = pk2(o[0] * r * gn[0] * silu_(z0), o[1] * r * gn[1] * silu_(z1)); w.y = pk2(o[2] * r * gn[2] * silu_(z2), o[3] * r * gn[3] * silu_(z3));
            *(u32x2*)(MIX + (size_t)row * MIXW + col) = w;
        }
    }
    LAS float* t2 = (LAS float*)F.lds;
    __syncthreads();
    for (int u = F.bid; u < (TT / 64) * 4; u += F.G) {
        const int rt = u >> 2, ct = u & 3, row0 = rt * 64; const bool isc = row0 >= TL;
        { const int c2 = F.tid >> 2, seg = F.tid & 3;
          const float* src = isc ? WSP(float, A0_YHTC) + (size_t)(ct * 128 + c2) * TC + (row0 - TL) : WSP(float, A0_YHTL) + (size_t)(ct * 128 + c2) * TL + row0;
          LAS float* tp = t2 + c2 * 65 + seg * 16;
#pragma unroll
          for (int q = 0; q < 4; ++q) { const f32x4 a = *(const f32x4*)(src + seg * 16 + q * 4); tp[q * 4] = a[0]; tp[q * 4 + 1] = a[1]; tp[q * 4 + 2] = a[2]; tp[q * 4 + 3] = a[3]; } }
        __syncthreads();
        { const int cl = F.tid & 63, rg = F.tid >> 6, c = ct * 128 + cl * 2; const f32x2 sk = *(const f32x2*)(INP(22) + c);
#pragma unroll
          for (int j = 0; j < 8; ++j) { const int row = row0 + rg * 8 + j; const size_t o = (size_t)row * 512 + c;
              const f32x2 x0 = *(const f32x2*)(X0 + o), vx = *(const f32x2*)(VX + o);
              const f32x2 yh = (f32x2){t2[(cl * 2) * 65 + rg * 8 + j], t2[(cl * 2 + 1) * 65 + rg * 8 + j]};
              const f32x2 r = x0 * (yh + vx * sk);
              *(unsigned*)(MIX + (size_t)row * MIXW + 512 + c) = pk2(r[0], r[1]); } }
        __syncthreads();
    }
}

template <int LAYER>
DI void p7_ln_route(const Fr& F, const float* xres_lat, const float* xres_ctx, const bf16_t* Y, int nrows) {
    const float* MOD = WSP(float, WS_MOD) + (size_t)LAYER * 9 * 6144;
    float* X1 = WSP(float, WS_X1); bf16_t* VB = WSP(bf16_t, WS_VB);
    int* RI = WSP(int, WS_RI); float* RW = WSP(float, WS_RW);
    const float* lng = INP(6) + (size_t)(LAYER * 2 + 0) * DM; const float* lnb = INP(7) + (size_t)(LAYER * 2 + 0) * DM;
    const float* rb = INP(35) + LAYER * NEXP;
    LAS float* rwt = (LAS float*)F.lds;
    { const f32x4* src = WSP(f32x4, WS_RWT) + (size_t)LAYER * 8192;
#pragma unroll
      for (int it = 0; it < 16; ++it) *(LAS f32x4*)(rwt + (F.tid + it * NTHR) * 4) = src[F.tid + it * NTHR]; }
    __syncthreads();
    const int lane = F.lane;
    LAS unsigned* lcnt = (LAS unsigned*)(F.lds + LDS_CTL_OFF + 64);
    if (F.tid < 32) lcnt[F.tid] = 0u;
    __syncthreads();
    const int per = 2 * ((nrows / 2 + F.G - 1) / F.G), rb0 = (F.bid * per < nrows) ? F.bid * per : nrows, rb1 = (rb0 + per < nrows) ? rb0 + per : nrows;
    f32x4 xq[2][4]; u32x2 yq[2][4];
#define LN_LOAD_PAIR(RP) do { _Pragma("unroll") for (int rr_ = 0; rr_ < 2; ++rr_) { const int row_ = (RP) * 2 + rr_; const bool isc_ = row_ >= TL; \
        const float* xr_ = isc_ ? xres_ctx + (size_t)(row_ - TL) * DM : xres_lat + (size_t)row_ * DM; \
        _Pragma("unroll") for (int i_ = 0; i_ < 4; ++i_) { xq[rr_][i_] = *(const f32x4*)(xr_ + i_ * 256 + lane * 4); yq[rr_][i_] = *(const u32x2*)(Y + (size_t)row_ * DM + i_ * 256 + lane * 4); } } } while (0)
    if (rb0 / 2 + F.wave < rb1 / 2) LN_LOAD_PAIR(rb0 / 2 + F.wave);
    for (int rp = rb0 / 2 + F.wave; rp < rb1 / 2; rp += 8) {
        f32x4 va[4], vb[4];
#pragma unroll
        for (int rr = 0; rr < 2; ++rr) {
            const int row = rp * 2 + rr; const bool isc = row >= TL; const int b = isc ? (row - TL) >> 8 : row >> 11;
            const float* md = MOD + (size_t)(isc ? 8 : b) * 6144;
            f32x4 y[4]; float s = 0.f;
#pragma unroll
            for (int i = 0; i < 4; ++i) { const int k = i * 256 + lane * 4;
                const u32x2 yw = yq[rr][i];
                const f32x4 yv = (f32x4){__uint_as_float(yw.x << 16), __uint_as_float(yw.x & 0xffff0000u), __uint_as_float(yw.y << 16), __uint_as_float(yw.y & 0xffff0000u)};
                y[i] = xq[rr][i] * ALPHA + *(const f32x4*)(md + 2048 + k) * yv;
                s += (y[i][0] + y[i][1]) + (y[i][2] + y[i][3]); }
            const float mu = wsum(s) * (1.0f / 1024.0f); float q = 0.f;
#pragma unroll
            for (int i = 0; i < 4; ++i) { const f32x4 dd = y[i] - mu; q += (dd[0] * dd[0] + dd[1] * dd[1]) + (dd[2] * dd[2] + dd[3] * dd[3]); }
            const float rstd = rsqrtf(wsum(q) * (1.0f / 1024.0f) + LN_EPS);
#pragma unroll
            for (int i = 0; i < 4; ++i) { const int k = i * 256 + lane * 4;
                const f32x4 x1 = (y[i] - mu) * rstd * *(const f32x4*)(lng + k) + *(const f32x4*)(lnb + k);
                *(f32x4*)(X1 + (size_t)row * DM + k) = x1;
                const f32x4 v = x1 * (*(const f32x4*)(md + 4096 + k) + 1.0f) + *(const f32x4*)(md + 3072 + k);
                u32x2 w; w.x = pk2(v[0], v[1]); w.y = pk2(v[2], v[3]);
                *(u32x2*)(VB + (size_t)row * DM + k) = w;
                if (rr == 0) va[i] = v; else vb[i] = v; }
        }
        if (rp + 8 < rb1 / 2) LN_LOAD_PAIR(rp + 8);
        float pa[32], pb[32];
#pragma unroll
        for (int e = 0; e < 32; ++e) { f32x2 sa = (f32x2){0.f, 0.f}, sb = sa;
#pragma unroll
            for (int i = 0; i < 4; ++i) { const f32x4 wv = *(const LAS f32x4*)(rwt + e * DM + i * 256 + lane * 4);
                const f32x2 w01 = (f32x2){wv[0], wv[1]}, w23 = (f32x2){wv[2], wv[3]};
                sa += (f32x2){va[i][0], va[i][1]} * w01; sa += (f32x2){va[i][2], va[i][3]} * w23;
                sb += (f32x2){vb[i][0], vb[i][1]} * w01; sb += (f32x2){vb[i][2], vb[i][3]} * w23; }
            pa[e] = sa.x + sa.y; pb[e] = sb.x + sb.y; asm volatile("" ::: "memory"); }
#define RS_STEP(N, OFF) { const bool up = (lane & (OFF)) != 0; \
            _Pragma("unroll") for (int e = 0; e < (N); ++e) { \
                const float ka = up ? pa[e + (N)] : pa[e], sa_ = up ? pa[e] : pa[e + (N)]; const float kb = up ? pb[e + (N)] : pb[e], sb_ = up ? pb[e] : pb[e + (N)]; \
                pa[e] = ka + __shfl_xor(sa_, (OFF)); pb[e] = kb + __shfl_xor(sb_, (OFF)); } }
        RS_STEP(16, 32) RS_STEP(8, 16) RS_STEP(4, 8) RS_STEP(2, 4) RS_STEP(1, 2)
#undef RS_STEP
        const int e = lane >> 1;
        float lga = pa[0] + __shfl_xor(pa[0], 1) + rb[e], lgb = pb[0] + __shfl_xor(pb[0], 1) + rb[e];
#pragma unroll
        for (int rr = 0; rr < 2; ++rr) {
            const int row = rp * 2 + rr; float val = rr ? lgb : lga; float sv[4]; int si[4];
#pragma unroll
            for (int kk = 0; kk < 4; ++kk) {
                float bv = val; int bi = e;
#pragma unroll
                for (int off = 32; off >= 2; off >>= 1) { const float ov = __shfl_xor(bv, off); const int oi = __shfl_xor(bi, off); if (ov > bv || (ov == bv && oi < bi)) { bv = ov; bi = oi; } }
                sv[kk] = bv; si[kk] = bi; if (e == bi) val = -3.0e38f;
            }
            const float e1 = __expf(sv[1] - sv[0]), e2 = __expf(sv[2] - sv[0]), e3 = __expf(sv[3] - sv[0]); const float inv = 1.0f / (1.0f + e1 + e2 + e3);
            if (lane == 0) {
                *(int4*)(RI + (size_t)row * 4) = make_int4(si[0], si[1], si[2], si[3]);
                *(f32x4*)(RW + (size_t)row * 4) = (f32x4){inv, e1 * inv, e2 * inv, e3 * inv};
                atomicAdd((unsigned*)(lcnt + si[0]), 1u); atomicAdd((unsigned*)(lcnt + si[1]), 1u); atomicAdd((unsigned*)(lcnt + si[2]), 1u); atomicAdd((unsigned*)(lcnt + si[3]), 1u);
            }
        }
    }
#undef LN_LOAD_PAIR
    __syncthreads();
    if (F.tid < 32) WSP(unsigned, WS_BC)[((size_t)LAYER * 1024 + F.bid) * 32 + F.tid] = lcnt[F.tid];
}

template <int LAYER>
DI void p8_assign(const Fr& F, int nrows) {
    unsigned* NT = WSP(unsigned, WS_CTL) + CW_NT + LAYER; const unsigned* BC = WSP(unsigned, WS_BC) + (size_t)LAYER * 1024 * 32;
    LAS int* offs = (LAS int*)F.lds;
    LAS unsigned* lcnt = (LAS unsigned*)(offs + 64);
    LAS int* lpos = (LAS int*)(offs + 192);
    { LAS unsigned* pt = (LAS unsigned*)(offs + 1024); const int e = F.tid & 31, sg = F.tid >> 5; unsigned tot = 0, pre = 0;
      for (int bb = sg; bb < F.G; bb += 16) { const unsigned c = BC[bb * 32 + e]; tot += c; pre += (bb < F.bid) ? c : 0u; }
      pt[sg * 32 + e] = tot; pt[512 + sg * 32 + e] = pre;
      __syncthreads();
      if (F.tid < 32) { unsigned t2 = 0, p2 = 0; for (int g = 0; g < 16; ++g) { t2 += pt[g * 32 + F.tid]; p2 += pt[512 + g * 32 + F.tid]; } lcnt[64 + F.tid] = t2; lcnt[32 + F.tid] = p2; lcnt[F.tid] = 0u; } }
    __syncthreads();
    if (F.tid == 0) { int o = 0; for (int e = 0; e < NEXP; ++e) { offs[e] = o; o += (int)((lcnt[64 + e] + 255u) & ~255u); } offs[32] = o; }
    __syncthreads();
    int* TILE_E = WSP(int, WS_TILEE); const int ntile = offs[32] >> 8;
    if (F.bid == 0) { for (int tl = F.tid; tl < ntile; tl += NTHR) { int e = 0; while (e < 31 && offs[e + 1] <= tl * 256) ++e; TILE_E[tl] = e; } if (F.tid == 0) *NT = (unsigned)ntile; }
    bf16_t* VBG = WSP(bf16_t, WS_VBG); const bf16_t* VB = WSP(bf16_t, WS_VB);
    constexpr bool F8 = (LAYER == 1) ? (MK_FP8_L1 != 0) : (MK_FP8_L0 != 0);
    unsigned char* VBG8 = WSP(unsigned char, WS_VBG);
    for (int e = F.bid; e < NEXP; e += F.G) { const int r0 = offs[e] + (int)lcnt[64 + e], r1 = offs[e + 1];
        for (int r = r0 + F.wave; r < r1; r += 8) { u32x4 zz = (u32x4){0u, 0u, 0u, 0u};
            if (F8) *(u32x4*)(VBG8 + (size_t)r * DM + F.lane * 16) = zz;
            else { *(u32x4*)(VBG + (size_t)r * DM + F.lane * 8) = zz; *(u32x4*)(VBG + (size_t)r * DM + 512 + F.lane * 8) = zz; } } }
    const int* RI = WSP(int, WS_RI); int* SP = WSP(int, WS_SP);
    const int per = 2 * ((nrows / 2 + F.G - 1) / F.G), rb0 = (F.bid * per < nrows) ? F.bid * per : nrows, rb1 = (rb0 + per < nrows) ? rb0 + per : nrows; const int nslot = (rb1 > rb0 ? rb1 - rb0 : 0) * 4;
    if (F.tid < nslot) { const int my_e = RI[(size_t)rb0 * 4 + F.tid]; const int my_rank = (int)atomicAdd((unsigned*)(lcnt + my_e), 1u);
        const int pos = offs[my_e] + (int)lcnt[32 + my_e] + my_rank; lpos[F.tid] = pos; SP[(size_t)rb0 * 4 + F.tid] = pos; }
    __syncthreads();
    for (int rl = F.wave; rl < rb1 - rb0; rl += 8) { const int row = rb0 + rl;
        const u32x4 v0 = *(const u32x4*)(VB + (size_t)row * DM + F.lane * 8), v1 = *(const u32x4*)(VB + (size_t)row * DM + 512 + F.lane * 8);
        u32x2 q0 = (u32x2){0u, 0u}, q1 = q0;
        if (F8) { q0.x = pk4_fp8(__uint_as_float(v0.x << 16), __uint_as_float(v0.x & 0xffff0000u), __uint_as_float(v0.y << 16), __uint_as_float(v0.y & 0xffff0000u));
                  q0.y = pk4_fp8(__uint_as_float(v0.z << 16), __uint_as_float(v0.z & 0xffff0000u), __uint_as_float(v0.w << 16), __uint_as_float(v0.w & 0xffff0000u));
                  q1.x = pk4_fp8(__uint_as_float(v1.x << 16), __uint_as_float(v1.x & 0xffff0000u), __uint_as_float(v1.y << 16), __uint_as_float(v1.y & 0xffff0000u));
                  q1.y = pk4_fp8(__uint_as_float(v1.z << 16), __uint_as_float(v1.z & 0xffff0000u), __uint_as_float(v1.w << 16), __uint_as_float(v1.w & 0xffff0000u)); }
#pragma unroll
        for (int k = 0; k < 4; ++k) { const int pos = lpos[rl * 4 + k];
            if (F8) { *(u32x2*)(VBG8 + (size_t)pos * DM + F.lane * 8) = q0; *(u32x2*)(VBG8 + (size_t)pos * DM + 512 + F.lane * 8) = q1; }
            else { *(u32x4*)(VBG + (size_t)pos * DM + F.lane * 8) = v0; *(u32x4*)(VBG + (size_t)pos * DM + 512 + F.lane * 8) = v1; } }
    }
    __syncthreads();
}

template <int LAYER>
DI void p11_combine(const Fr& F, int nrows, float* xout) {
    const float* MOD = WSP(float, WS_MOD) + (size_t)LAYER * 9 * 6144;
    const float* X1 = WSP(float, WS_X1); const bf16_t* YS = WSP(bf16_t, WS_YS);
    const int* SP = WSP(int, WS_SP); const float* RW = WSP(float, WS_RW);
    const float* lng = INP(6) + (size_t)(LAYER * 2 + 1) * DM; const float* lnb = INP(7) + (size_t)(LAYER * 2 + 1) * DM;
    const float* MODN = WSP(float, WS_MOD) + (size_t)1 * 9 * 6144; const float* POS = WSP(float, WS_POS); bf16_t* UN = WSP(bf16_t, A1_U);
    constexpr bool YF8 = MK_FP8_YS && ((LAYER == 0) ? (MK_FP8_L0 != 0) : (MK_FP8_L1 != 0));
    u32x2 ysq[4][4]; f32x4 x1q[4], posq[4]; int4 spn = make_int4(0, 0, 0, 0); f32x4 rwq = (f32x4){0.f, 0.f, 0.f, 0.f}, rwn = rwq;
#define CMB_LOAD_ROW(ROW, SPV) do { const int spa_[4] = {(SPV).x, (SPV).y, (SPV).z, (SPV).w}; \
        _Pragma("unroll") for (int i_ = 0; i_ < 4; ++i_) { const int k_ = i_ * 256 + F.lane * 4; x1q[i_] = *(const f32x4*)(X1 + (size_t)(ROW) * DM + k_); \
            if (LAYER == 0) posq[i_] = ((ROW) >= TL) ? (f32x4){0.f, 0.f, 0.f, 0.f} : *(const f32x4*)(POS + (size_t)((ROW) & 2047) * DM + k_); \
            _Pragma("unroll") for (int j_ = 0; j_ < 4; ++j_) { if (YF8) ysq[j_][i_].x = *(const unsigned*)((const unsigned char*)YS + (size_t)spa_[j_] * DM + k_); else ysq[j_][i_] = *(const u32x2*)(YS + (size_t)spa_[j_] * DM + k_); } } } while (0)
    int row = F.gwave;
    if (row < nrows) { const int4 sp0 = *(const int4*)(SP + (size_t)row * 4); rwq = *(const f32x4*)(RW + (size_t)row * 4); CMB_LOAD_ROW(row, sp0);
        if (row + F.nwaves < nrows) { spn = *(const int4*)(SP + (size_t)(row + F.nwaves) * 4); rwn = *(const f32x4*)(RW + (size_t)(row + F.nwaves) * 4); } }
    for (; row < nrows; row += F.nwaves) {
        const bool isc = row >= TL; const int b = isc ? (row - TL) >> 8 : row >> 11;
        const float* md = MOD + (size_t)(isc ? 8 : b) * 6144;
        f32x4 y[4], pcur[4]; float s = 0.f;
#pragma unroll
        for (int i = 0; i < 4; ++i) { const int k = i * 256 + F.lane * 4; f32x4 f = (f32x4){0.f, 0.f, 0.f, 0.f};
#pragma unroll
            for (int j = 0; j < 4; ++j) { const u32x2 w = ysq[j][i];
                if (YF8) { const f32x2 lo = __builtin_amdgcn_cvt_pk_f32_fp8((int)w.x, false), hi = __builtin_amdgcn_cvt_pk_f32_fp8((int)w.x, true); f += (f32x4){lo.x, lo.y, hi.x, hi.y} * (rwq[j] * (1.0f / YS_F8S)); }
                else f += (f32x4){__uint_as_float(w.x << 16), __uint_as_float(w.x & 0xffff0000u), __uint_as_float(w.y << 16), __uint_as_float(w.y & 0xffff0000u)} * rwq[j]; }
            y[i] = x1q[i] * ALPHA + *(const f32x4*)(md + 5120 + k) * f; if (LAYER == 0) pcur[i] = posq[i];
            s += (y[i][0] + y[i][1]) + (y[i][2] + y[i][3]); }
        { const int rn = row + F.nwaves; if (rn < nrows) { const int4 spv = spn; rwq = rwn; CMB_LOAD_ROW(rn, spv);
              const int rn2 = rn + F.nwaves; if (rn2 < nrows) { spn = *(const int4*)(SP + (size_t)rn2 * 4); rwn = *(const f32x4*)(RW + (size_t)rn2 * 4); } } }
        const float mu = wsum(s) * (1.0f / 1024.0f); float q = 0.f;
#pragma unroll
        for (int i = 0; i < 4; ++i) { const f32x4 dd = y[i] - mu; q += (dd[0] * dd[0] + dd[1] * dd[1]) + (dd[2] * dd[2] + dd[3] * dd[3]); }
        const float rstd = rsqrtf(wsum(q) * (1.0f / 1024.0f) + LN_EPS);
#pragma unroll
        for (int i = 0; i < 4; ++i) { const int k = i * 256 + F.lane * 4;
            const f32x4 x2 = (y[i] - mu) * rstd * *(const f32x4*)(lng + k) + *(const f32x4*)(lnb + k);
            *(f32x4*)(xout + (size_t)row * DM + k) = x2;
            if (LAYER == 0) {
                const float* mn = MODN + (size_t)(isc ? 8 : b) * 6144;
                const f32x4 u = x2 * (*(const f32x4*)(mn + 1024 + k) + 1.0f) + *(const f32x4*)(mn + k) + pcur[i];
                u32x2 w; w.x = pk2(u[0], u[1]); w.y = pk2(u[2], u[3]);
                *(u32x2*)(UN + (size_t)row * DM + k) = w;
            } }
    }
#undef CMB_LOAD_ROW
}

DI void p13_lru_conv(const Fr& F) {
    const bf16_t* P1 = WSP(bf16_t, A1_P); float* XC = WSP(float, A1_XC); bf16_t* XCB = WSP(bf16_t, A1_XCB); const float* cw = INP(25); const float* cb = INP(26);
    for (int u = F.bid; u < (TT / 64) * 4; u += F.G) {
        const int rt = u >> 2, c = (u & 3) * 256 + F.lane * 4, row0 = rt * 64 + F.wave * 8; const bool isc = row0 >= TL; const int L = isc ? CTXL : SEQ;
        const int t0 = isc ? ((row0 - TL) & 255) : (row0 & 2047);
        f32x4 w[4]; const f32x4 bv = *(const f32x4*)(cb + c);
#pragma unroll
        for (int i = 0; i < 4; ++i) w[i] = *(const f32x4*)(cw + i * DM + c);
        f32x4 p[11];
#pragma unroll
        for (int rr = 0; rr < 11; ++rr) { const int tl = t0 + rr - 2; u32x2 pv = (u32x2){0u, 0u}; if (tl >= 0 && tl < L) pv = *(const u32x2*)(P1 + (size_t)(row0 + rr - 2) * 2048 + c);
            p[rr] = (f32x4){__uint_as_float(pv.x << 16), __uint_as_float(pv.x & 0xffff0000u), __uint_as_float(pv.y << 16), __uint_as_float(pv.y & 0xffff0000u)}; }
#pragma unroll
        for (int j = 0; j < 8; ++j) { const f32x4 a = bv + w[0] * p[j] + w[1] * p[j + 1] + w[2] * p[j + 2] + w[3] * p[j + 3];
            *(f32x4*)(XC + (size_t)(row0 + j) * DM + c) = a; u32x2 o; o.x = pk2(a[0], a[1]); o.y = pk2(a[2], a[3]); *(u32x2*)(XCB + (size_t)(row0 + j) * DM + c) = o; }
    }
}
#define LRU_SG(x) (x)
DI void p15_lru_scan(const Fr& F) {
    const unsigned* AB = WSP(unsigned, A1_RG); bf16_t* HS = WSP(bf16_t, A1_HS);
    LAS float* agg = (LAS float*)F.lds;
    for (int u = F.bid; u < NB * 2 * 16; u += F.G) {
        const int cg = u & 15, d = (u >> 4) & 1, b = u >> 5; const int pr = F.lane & 31, j = F.wave * 2 + (F.lane >> 5), col = cg * 64 + pr * 2;
        const unsigned* ab = AB + (size_t)d * TT * DM + col;
        float As0 = 0.f, As1 = 0.f, Bp0 = 0.f, Bp1 = 0.f;
#pragma unroll 16
        for (int s = 0; s < 144; ++s) { const u32x2 v = *(const u32x2*)(ab + (size_t)row_of(b, d, j * 144 + s) * DM);
            const float la0 = __uint_as_float(v.x << 16), bc0 = __uint_as_float(v.x & 0xffff0000u), la1 = __uint_as_float(v.y << 16), bc1 = __uint_as_float(v.y & 0xffff0000u);
            As0 += la0; Bp0 = __expf(la0) * Bp0 + bc0; As1 += la1; Bp1 = __expf(la1) * Bp1 + bc1; }
        *(LAS f32x4*)(agg + (j * 32 + pr) * 4) = (f32x4){__expf(As0), Bp0, __expf(As1), Bp1};
        __syncthreads();
        float h0 = 0.f, h1 = 0.f;
        for (int m = 0; m < j; ++m) { const f32x4 g = *(const LAS f32x4*)(agg + (m * 32 + pr) * 4); h0 = g[0] * h0 + g[1]; h1 = g[2] * h1 + g[3]; }
#pragma unroll 16
        for (int s = 0; s < 144; ++s) { const int p = j * 144 + s; const int row = row_of(b, d, p); const u32x2 v = *(const u32x2*)(ab + (size_t)row * DM);
            const float la0 = __uint_as_float(v.x << 16), bc0 = __uint_as_float(v.x & 0xffff0000u), la1 = __uint_as_float(v.y << 16), bc1 = __uint_as_float(v.y & 0xffff0000u);
            h0 = __expf(la0) * h0 + bc0; h1 = __expf(la1) * h1 + bc1;
            if (p >= CTXL) *(unsigned*)(HS + ((size_t)d * TL + row) * DM + col) = pk2(h0, h1); }
        __syncthreads();
    }
}
DI void p16_lru_gate(const Fr& F) {
    const bf16_t* HS = WSP(bf16_t, A1_HS); const bf16_t* P1 = WSP(bf16_t, A1_P); bf16_t* HG = WSP(bf16_t, A1_HG);
    for (int i = F.bid * NTHR + F.tid; i < TL * DM / 8; i += F.G * NTHR) {
        const int row = i >> 7, c = (i & 127) * 8;
        const u32x4 h0 = *(const u32x4*)(HS + (size_t)row * DM + c), h1 = *(const u32x4*)(HS + ((size_t)TL + row) * DM + c), gt = *(const u32x4*)(P1 + (size_t)row * 2048 + 1024 + c);
        u32x4 o;
#pragma unroll
        for (int q = 0; q < 4; ++q) {
            const float ha = __uint_as_float(h0[q] << 16) + __uint_as_float(h1[q] << 16), hb2 = __uint_as_float(h0[q] & 0xffff0000u) + __uint_as_float(h1[q] & 0xffff0000u);
            o[q] = pk2(ha * gelu_tanh(__uint_as_float(gt[q] << 16)), hb2 * gelu_tanh(__uint_as_float(gt[q] & 0xffff0000u))); }
        *(u32x4*)(HG + (size_t)row * DM + c) = o;
    }
}

#ifndef MK_DIAG
#define MK_DIAG 0
#endif
#ifndef MK_DIAG_SUB
#define MK_DIAG_SUB 0
#endif
constexpr int CW_DIAG = 4096 + 256;
DI void diag_max(const Fr& F, float v) { if (v == v) atomicMax(WSP(unsigned, WS_CTL) + CW_DIAG, __float_as_uint(fabsf(v))); else atomicMax(WSP(unsigned, WS_CTL) + CW_DIAG, 0x7f000000u); }
DI void diag_lru_gates(const Fr& F) {
    const bf16_t* RG = WSP(bf16_t, A1_RG); const float* XC = WSP(float, A1_XC);
    for (int smp = F.bid * NTHR + F.tid; smp < 262144; smp += F.G * NTHR) {
        const unsigned hsh = (unsigned)smp * 2654435761u; const int row = (int)(hsh % (unsigned)TT); const int tcol = (int)((hsh >> 7) % 4096u);
        const int t = tcol >> 10, col = tcol & 1023, h = col >> 8, j = col & 255;
        const float* W = (t < 2 ? INP(27) : INP(29)) + (size_t)((t & 1) * 4 + h) * 65536 + j;
        float acc = (t < 2 ? INP(28) : INP(30))[(t & 1) * DM + col];
        for (int i = 0; i < 256; ++i) acc += XC[(size_t)row * DM + h * 256 + i] * W[(size_t)i * 256];
        const float df = sigm(acc) - LRU_SG(bf2f(RG[(size_t)row * 4096 + tcol]));
#if MK_DIAG_SUB == 0
        diag_max(F, df);
#elif MK_DIAG_SUB == 1
        if (!(fabsf(df) < 0.05f)) atomicAdd(WSP(unsigned, WS_CTL) + CW_DIAG + 1, 1u);
#elif MK_DIAG_SUB == 2
        if (!(fabsf(df) < 0.05f)) atomicMax(WSP(unsigned, WS_CTL) + CW_DIAG + 1, (unsigned)(tcol >> 8) + 1u);
#elif MK_DIAG_SUB == 3
        if (!(fabsf(df) < 0.05f)) atomicMax(WSP(unsigned, WS_CTL) + CW_DIAG + 1, (unsigned)(row >> 8) + 1u);
#elif MK_DIAG_SUB == 4
        if (!(fabsf(df) < 0.05f)) { const int uid = (row >> 8) * 16 + (tcol >> 8); atomicOr(WSP(unsigned, WS_CTL) + CW_DIAG + 8 + (uid >> 5), 1u << (uid & 31)); }
#elif MK_DIAG_SUB == 5
        if (!(fabsf(df) < 0.05f)) { const int uid = row & 255; atomicOr(WSP(unsigned, WS_CTL) + CW_DIAG + 8 + (uid >> 5), 1u << (uid & 31)); }
#elif MK_DIAG_SUB == 6
        if (!(fabsf(df) < 0.05f)) { const int uid = tcol & 255; atomicOr(WSP(unsigned, WS_CTL) + CW_DIAG + 8 + (uid >> 5), 1u << (uid & 31)); }
#endif
    }
}
DI void diag_lru_scan(const Fr& F) {
    const bf16_t* RG = WSP(bf16_t, A1_RG); const float* XC = WSP(float, A1_XC); const float* HS = WSP(float, A1_HS);
    for (int u = F.bid * NTHR + F.tid; u < NB * 2 * DM; u += F.G * NTHR) {
        const int col = u & 1023, d = (u >> 10) & 1, b = u >> 11; const float sp = softplus_(INP(31)[d * DM + col]);
        float hst = 0.f, md = 0.f;
        for (int p = 0; p < CTXL + SEQ; ++p) { const int row = row_of(b, d, p);
            const float r = LRU_SG(bf2f(RG[(size_t)row * 4096 + d * 1024 + col])), ig = LRU_SG(bf2f(RG[(size_t)row * 4096 + (2 + d) * 1024 + col])), x = XC[(size_t)row * DM + col];
            const float la = -8.0f * r * sp, a = expf(la), bc = sqrtf(fmaxf(-expm1f(2.0f * la), 0.f)) * (ig * x);
            hst = a * hst + bc;
            if (p >= CTXL) { const float df = fabsf(hst - HS[((size_t)d * TL + row) * DM + col]); md = (df > md || df != df) ? df : md; } }
        diag_max(F, md);
    }
}
DI void diag_fill(const Fr& F, float* out) {
#if MK_DIAG_SUB == 0
    const float v = 1.0f + 1000.0f * __uint_as_float(WSP(unsigned, WS_CTL)[CW_DIAG]);
#elif MK_DIAG_SUB >= 4
    unsigned cntb = 0; for (int i = 0; i < 40; ++i) cntb += __popc(WSP(unsigned, WS_CTL)[CW_DIAG + 8 + i]);
    const float v = 1.0f + (float)cntb;
#else
    const float v = 1.0f + (float)WSP(unsigned, WS_CTL)[CW_DIAG + 1];
#endif
    for (int i = F.bid * NTHR + F.tid; i < TL * DM; i += F.G * NTHR) out[i] = v;
}
enum { PH_PRO = 0, PH_MOD0, PH_INPROJ0, PH_PREP0, PH_CORE0, PH_MIX0, PH_OUTPROJ0, PH_LN0, PH_ASG0, PH_MOE1_0, PH_MOE2_0, PH_CMB0,
       PH_INPROJ1, PH_CONV1, PH_GATES1, PH_SCAN1, PH_GATE1, PH_OUTPROJ1, PH_LN1, PH_ASG1, PH_MOE1_1, PH_MOE2_1, PH_CMB1, NPH };
__global__ void __launch_bounds__(NTHR, 2) mk_fwd(Args args) {
    extern __shared__ __attribute__((aligned(16))) unsigned char lds_raw[];
    Fr F;
    F.a = &args; F.lds = (LAS unsigned char*)lds_raw; F.ws = args.ws;
    F.tid = threadIdx.x; F.lane = F.tid & 63; F.wave = __builtin_amdgcn_readfirstlane(F.tid >> 6); F.G = gridDim.x; F.bid = blockIdx.x;
    F.gwave = F.bid * 8 + F.wave; F.nwaves = F.G * 8;
    volatile LAS unsigned* xbw = (volatile LAS unsigned*)(F.lds + LDS_CTL_OFF);
    if (F.tid < 4) xbw[F.tid] = 0u;
    __syncthreads();
#if MK_ONE_LAUNCH
    XcdBarrier bar = xcd_barrier_post(WSP(unsigned, WS_CTL) + CW_BAR, xbw);
#if MK_BG_CONV
#define GRID_BAR() xcd_barrier_work(bar, F)
#else
#define GRID_BAR() xcd_barrier(bar)
#endif
#else
#define GRID_BAR() do {} while (0)
#endif
    const int lo = args.ph_lo, hi = args.ph_hi;
#ifndef MK_PH_MASK
#define MK_PH_MASK 0xFFFFFFFFu
#endif
#define IN(k) (((MK_PH_MASK >> (k)) & 1u) && lo <= (k) && (k) < hi)
#define SEAM(k) do { if (IN((k) + 1)) { GRID_BAR(); } } while (0)
    LAS unsigned char* glds = F.lds;

    if (IN(PH_PRO)) { p0_prologue(F); SEAM(PH_PRO); }
    if (IN(PH_MOD0)) { p1_mod0(F); SEAM(PH_MOD0); }
    if (IN(PH_INPROJ0)) {
        __syncthreads();
        pg8::Gemm g{WSP(bf16_t, A0_U), WSP(bf16_t, WS_WEVIN), TT, NP0, DM, DM}; pg8::StaticOrder S; S.init(TT, NP0, F.G, F.bid);
        pg8::EpiBf16 E{WSP(bf16_t, A0_P), NP0, nullptr, 0};
        pg8::gemm_phase(glds, g, S, E); SEAM(PH_INPROJ0);
    }
    if (IN(PH_PREP0)) { p3_prep(F); SEAM(PH_PREP0); }
    if (IN(PH_CORE0)) { __syncthreads(); p4_mix_core(F); SEAM(PH_CORE0); }
    if (IN(PH_MIX0)) { p5_mix(F); SEAM(PH_MIX0); }
    if (IN(PH_OUTPROJ0)) {
        __syncthreads();
        pg8::Gemm g{WSP(bf16_t, A0_MIX), WSP(bf16_t, WS_WEVOUT), TT, DM, MIXW, MIXW}; pg8::StaticOrder S; S.init(TT, DM, F.G, F.bid);
        pg8::EpiBf16 E{WSP(bf16_t, A0_Y), DM, nullptr, 0};
        pg8::gemm_phase(glds, g, S, E);
        if (F.G == 256 && !MK_BG_CONV && F.bid >= 32) moe_w_l1_part(F, 0, 0, L1W1_A, F.bid - 32, 224);
        SEAM(PH_OUTPROJ0);
    }
    if (IN(PH_LN0)) { __syncthreads(); p7_ln_route<0>(F, INP(0), INP(2), WSP(bf16_t, A0_Y), TT); SEAM(PH_LN0); }
    if (IN(PH_ASG0)) { __syncthreads(); p8_assign<0>(F, TT);
#if MK_BG_CONV
        conv_drain(F, TQ_PER_LAYER);
#endif
        SEAM(PH_ASG0); }
    if (IN(PH_MOE1_0)) {
        __syncthreads();
        const int ntm = (int)WSP(unsigned, WS_CTL)[CW_NT + 0];
#if MK_FP8_L0
        pg8::Gemm g{WSP(bf16_t, WS_VBG), WSP(bf16_t, WS_WM1), ntm * 256, 2048, DM / 2, DM / 2}; pg8::MoeOrder S{WSP(int, WS_TILEE), ntm, 8, F.G, F.bid};
        pg8::EpiSwigluF8 E{WSP(unsigned char, WS_ACT), DM, INP(37), 2048, 1.0f / W1_F8S};
        pg8::gemm_phase<pg8::EpiSwigluF8, pg8::MoeOrder, true>(glds, g, S, E); SEAM(PH_MOE1_0);
#else
        pg8::Gemm g{WSP(bf16_t, WS_VBG), WSP(bf16_t, WS_WM1), ntm * 256, 2048, DM, DM}; pg8::MoeOrder S{WSP(int, WS_TILEE), ntm, 8, F.G, F.bid};
        pg8::EpiSwiglu E{WSP(bf16_t, WS_ACT), DM, INP(37), 2048};
        pg8::gemm_phase(glds, g, S, E); SEAM(PH_MOE1_0);
#endif
    }
    if (IN(PH_MOE2_0)) {
        __syncthreads();
        const int ntm = (int)WSP(unsigned, WS_CTL)[CW_NT + 0];
#if MK_FP8_L0
        pg8::Gemm g{WSP(bf16_t, WS_ACT), WSP(bf16_t, WS_WM2), ntm * 256, DM, DM / 2, DM / 2}; pg8::MoeOrder S{WSP(int, WS_TILEE), ntm, 4, F.G, F.bid};
#if MK_FP8_YS
        pg8::EpiF8 E{WSP(unsigned char, WS_YS), DM, INP(39), DM, 1.0f / W2_F8S, YS_F8S};
        pg8::gemm_phase<pg8::EpiF8, pg8::MoeOrder, true>(glds, g, S, E); SEAM(PH_MOE2_0);
#else
        pg8::EpiBf16 E{WSP(bf16_t, WS_YS), DM, INP(39), DM, 1.0f / W2_F8S};
        pg8::gemm_phase<pg8::EpiBf16, pg8::MoeOrder, true>(glds, g, S, E); SEAM(PH_MOE2_0);
#endif
#else
        pg8::Gemm g{WSP(bf16_t, WS_ACT), WSP(bf16_t, WS_WM2), ntm * 256, DM, DM, DM}; pg8::MoeOrder S{WSP(int, WS_TILEE), ntm, 4, F.G, F.bid};
        pg8::EpiBf16 E{WSP(bf16_t, WS_YS), DM, INP(39), DM};
        pg8::gemm_phase(glds, g, S, E); SEAM(PH_MOE2_0);
#endif
    }
    if (IN(PH_CMB0)) { p11_combine<0>(F, TT, WSP(float, WS_X2)); SEAM(PH_CMB0); }
    if (IN(PH_INPROJ1)) {
        __syncthreads();
        pg8::Gemm g{WSP(bf16_t, A1_U), WSP(bf16_t, WS_WODIN), TT, 2048, DM, DM}; pg8::StaticOrder S; S.init(TT, 2048, F.G, F.bid);
        pg8::EpiBf16 E{WSP(bf16_t, A1_P), 2048, INP(24), 0};
        pg8::gemm_phase(glds, g, S, E);
        if (F.G == 256 && !MK_BG_CONV && F.bid >= 64) moe_w_l1_part(F, 0, L1W1_A, L1W1_B, F.bid - 64, 192);
        SEAM(PH_INPROJ1);
    }
    if (IN(PH_CONV1)) { p13_lru_conv(F); SEAM(PH_CONV1); }
    if (IN(PH_GATES1)) {
        __syncthreads();
        pg8::Gemm g{WSP(bf16_t, A1_XCB), WSP(bf16_t, WS_WLRU), TT, 4096, 256, DM}; pg8::LruOrder S; S.init(TT, 4096, F.G, F.bid);
        pg8::EpiLruAB E{WSP(unsigned, A1_RG), WSP(float, WS_BLRU), WSP(float, WS_BLRU) + 4096, WSP(bf16_t, A1_XCB), TT};
        pg8::gemm_phase(glds, g, S, E); SEAM(PH_GATES1);
    }
#if MK_DIAG == 1
    if (IN(PH_SCAN1)) { diag_lru_gates(F); SEAM(PH_SCAN1); }
#else
    if (IN(PH_SCAN1)) { __syncthreads(); p15_lru_scan(F); SEAM(PH_SCAN1); }
#endif
#if MK_DIAG == 2
    if (IN(PH_GATE1)) { diag_lru_scan(F); SEAM(PH_GATE1); }
#else
    if (IN(PH_GATE1)) { p16_lru_gate(F); SEAM(PH_GATE1); }
#endif
    if (IN(PH_OUTPROJ1)) {
        __syncthreads();
        pg8::Gemm g{WSP(bf16_t, A1_HG), WSP(bf16_t, WS_WODOUT), TL, DM, DM, DM}; pg8::StaticOrder S; S.init(TL, DM, F.G, F.bid);
        pg8::EpiBf16 E{WSP(bf16_t, A1_Y), DM, INP(33), 0};
        pg8::gemm_phase(glds, g, S, E); SEAM(PH_OUTPROJ1);
    }
    if (IN(PH_LN1)) { __syncthreads(); p7_ln_route<1>(F, WSP(float, WS_X2), WSP(float, WS_X2) + (size_t)TL * DM, WSP(bf16_t, A1_Y), TL); SEAM(PH_LN1); }
    if (IN(PH_ASG1)) { __syncthreads(); p8_assign<1>(F, TL);
#if MK_BG_CONV
        conv_drain(F, TQ_TOTAL);
#endif
        SEAM(PH_ASG1); }
    if (IN(PH_MOE1_1)) {
        __syncthreads();
        const int ntm = (int)WSP(unsigned, WS_CTL)[CW_NT + 1];
#if MK_FP8_L1
        pg8::Gemm g{WSP(bf16_t, WS_VBG), (const bf16_t*)(WSP(unsigned char, WS_WM1) + (size_t)32 * 2048 * DM * 2), ntm * 256, 2048, DM / 2, DM / 2}; pg8::MoeOrder S{WSP(int, WS_TILEE), ntm, 8, F.G, F.bid};
        pg8::EpiSwigluF8 E{WSP(unsigned char, WS_ACT), DM, INP(37) + (size_t)32 * 2048, 2048, 1.0f / W1_F8S};
        pg8::gemm_phase<pg8::EpiSwigluF8, pg8::MoeOrder, true>(glds, g, S, E); SEAM(PH_MOE1_1);
#else
        pg8::Gemm g{WSP(bf16_t, WS_VBG), WSP(bf16_t, WS_WM1) + (size_t)32 * 2048 * DM, ntm * 256, 2048, DM, DM}; pg8::MoeOrder S{WSP(int, WS_TILEE), ntm, 8, F.G, F.bid};
        pg8::EpiSwiglu E{WSP(bf16_t, WS_ACT), DM, INP(37) + (size_t)32 * 2048, 2048};
        pg8::gemm_phase(glds, g, S, E); SEAM(PH_MOE1_1);
#endif
    }
    if (IN(PH_MOE2_1)) {
        __syncthreads();
        const int ntm = (int)WSP(unsigned, WS_CTL)[CW_NT + 1];
#if MK_FP8_L1
        pg8::Gemm g{WSP(bf16_t, WS_ACT), (const bf16_t*)(WSP(unsigned char, WS_WM2) + (size_t)32 * DM * DM * 2), ntm * 256, DM, DM / 2, DM / 2}; pg8::MoeOrder S{WSP(int, WS_TILEE), ntm, 4, F.G, F.bid};
#if MK_FP8_YS
        pg8::EpiF8 E{WSP(unsigned char, WS_YS), DM, INP(39) + (size_t)32 * DM, DM, 1.0f / W2_F8S, YS_F8S};
        pg8::gemm_phase<pg8::EpiF8, pg8::MoeOrder, true>(glds, g, S, E); SEAM(PH_MOE2_1);
#else
        pg8::EpiBf16 E{WSP(bf16_t, WS_YS), DM, INP(39) + (size_t)32 * DM, DM, 1.0f / W2_F8S};
        pg8::gemm_phase<pg8::EpiBf16, pg8::MoeOrder, true>(glds, g, S, E); SEAM(PH_MOE2_1);
#endif
#else
        pg8::Gemm g{WSP(bf16_t, WS_ACT), WSP(bf16_t, WS_WM2) + (size_t)32 * DM * DM, ntm * 256, DM, DM, DM}; pg8::MoeOrder S{WSP(int, WS_TILEE), ntm, 4, F.G, F.bid};
        pg8::EpiBf16 E{WSP(bf16_t, WS_YS), DM, INP(39) + (size_t)32 * DM, DM};
        pg8::gemm_phase(glds, g, S, E); SEAM(PH_MOE2_1);
#endif
    }
#if MK_DIAG
    if (IN(PH_CMB1)) { diag_fill(F, args.out); }
#else
    if (IN(PH_CMB1)) { p11_combine<1>(F, TL, args.out); }
#endif
#undef IN
#undef SEAM
}

extern "C" void kernel_launch(void* const* d_in, const int* in_sizes, int n_in, void* d_out, int out_size, void* d_ws, size_t ws_size, hipStream_t stream) {
    static int grid = 0;
    if (grid == 0) {
        static const int exp_sizes[40] = {16777216, 8192, 2097152, 1024, 12582912, 12288, 4096, 4096, 3686400, 1048576, 6144, 8, 8, 128, 4608, 1536, 2112, 64, 8192, 128, 65536, 64, 512,
            2097152, 2048, 4096, 1024, 524288, 2048, 524288, 2048, 2048, 1048576, 1024, 65536, 64, 134217728, 131072, 67108864, 65536};
        bool ok_sizes = (n_in == 40);
        for (int i = 0; ok_sizes && i < 40; ++i) if (in_sizes[i] != exp_sizes[i]) { fprintf(stderr, "kernel_launch: input %d has %d elements, expected %d\n", i, in_sizes[i], exp_sizes[i]); ok_sizes = false; }
        if (!ok_sizes || out_size != TL * DM || ws_size < WS_END) { fprintf(stderr, "kernel_launch: unexpected shapes: n_in %d out %d ws %zu (need %zu)\n", n_in, out_size, ws_size, (size_t)WS_END); grid = -1; return; }
        int dev = 0, cus = 0, per_cu = 0;
        if (hipGetDevice(&dev) != hipSuccess || hipDeviceGetAttribute(&cus, hipDeviceAttributeMultiprocessorCount, dev) != hipSuccess) { grid = -1; return; }
        if (hipFuncSetAttribute((const void*)mk_fwd, hipFuncAttributeMaxDynamicSharedMemorySize, LDS_BYTES) != hipSuccess) { fprintf(stderr, "kernel_launch: hipFuncSetAttribute failed\n"); grid = -1; return; }
        if (hipOccupancyMaxActiveBlocksPerMultiprocessor(&per_cu, (const void*)mk_fwd, NTHR, LDS_BYTES) != hipSuccess || per_cu < 1) { fprintf(stderr, "kernel_launch: occupancy query says %d\n", per_cu); }
        (void)hipGetLastError();
        grid = cus;
    }
    if (grid < 0) return;
    (void)hipMemsetAsync((char*)d_ws + WS_CTL, 0, CTL_BYTES, stream);
    Args a{};
    for (int i = 0; i < 40; ++i) a.in[i] = (const float*)d_in[i];
    a.out = (float*)d_out; a.ws = (unsigned char*)d_ws;
#if MK_ONE_LAUNCH
    a.ph_lo = 0; a.ph_hi = NPH;
    hipLaunchKernelGGL(mk_fwd, dim3(grid), dim3(NTHR), LDS_BYTES, stream, a);
#else
#ifndef MK_MAXPH
#define MK_MAXPH NPH
#endif
#ifndef MK_REPEAT
#define MK_REPEAT -1
#endif
    for (int p = 0; p < MK_MAXPH; ++p) { a.ph_lo = p; a.ph_hi = p + 1; hipLaunchKernelGGL(mk_fwd, dim3(grid), dim3(NTHR), LDS_BYTES, stream, a);
        if (p == MK_REPEAT) { a.flags = 1; hipLaunchKernelGGL(mk_fwd, dim3(grid), dim3(NTHR), LDS_BYTES, stream, a); a.flags = 0; } }
#endif
}
```

```cpp
#include <hip/hip_runtime.h>
#include <cstdio>
#include <cstdint>

#ifndef MK_ONE_LAUNCH
#define MK_ONE_LAUNCH 1
#endif

#define LAS __attribute__((address_space(3)))
#define DI __device__ __forceinline__
typedef unsigned short bf16_t;
typedef float f32x4 __attribute__((ext_vector_type(4)));
typedef float f32x2 __attribute__((ext_vector_type(2)));
typedef unsigned u32x4 __attribute__((ext_vector_type(4)));
typedef unsigned u32x2 __attribute__((ext_vector_type(2)));

constexpr int DM = 1024, NB = 8, SEQ = 2048, CTXL = 256;
constexpr int TL = NB * SEQ;
constexpr int TC = NB * CTXL;
constexpr int TT = TL + TC;
constexpr int EVEN_IN = 3600, DN_GATE_COL = 2048, HY_COL = 2064;
constexpr int NP0 = 3584;
constexpr int MIXW = 1024;
constexpr int NEXP = 32, TOPK = 4;
constexpr int MOE_ROWS = 82176;
constexpr float ALPHA = 1.4142135623730951f;
constexpr float LN_EPS = 1e-5f, RMS_EPS = 1e-6f;

constexpr size_t al(size_t x) { return (x + 255) & ~(size_t)255; }
constexpr size_t WS_CTL   = 0;
constexpr size_t WS_MOD   = 65536;
constexpr size_t WS_POS   = WS_MOD + al((size_t)2 * 9 * 6144 * 4);
constexpr size_t WS_HFL   = WS_POS + (size_t)SEQ * DM * 4;
constexpr size_t WS_HBL   = WS_HFL + (size_t)SEQ * 512 * 4;
constexpr size_t WS_HFC   = WS_HBL + (size_t)SEQ * 512 * 4;
constexpr size_t WS_HBC   = WS_HFC + (size_t)CTXL * 512 * 4;
constexpr size_t WS_WEVIN = WS_HBC + (size_t)CTXL * 512 * 4;
constexpr size_t WS_WEVOUT= WS_WEVIN + (size_t)NP0 * DM * 2;
constexpr size_t WS_WODIN = WS_WEVOUT + (size_t)DM * MIXW * 2;
constexpr size_t WS_WODOUT= WS_WODIN + (size_t)2048 * DM * 2;
constexpr size_t WS_WLRU  = WS_WODOUT + (size_t)DM * DM * 2;
constexpr size_t WS_BLRU  = WS_WLRU + (size_t)4096 * 256 * 2;
constexpr size_t WS_RWT   = WS_BLRU + 8192 * 4;
constexpr size_t WS_WGT   = WS_RWT + (size_t)2 * 32 * 1024 * 4;
constexpr size_t WS_HID   = WS_WGT + (size_t)16 * 1024 * 4;
constexpr size_t WS_WM1   = WS_HID + (size_t)(SEQ + CTXL) * 64 * 4;
constexpr size_t WS_WM2   = WS_WM1 + (size_t)64 * 2048 * DM * 2;
constexpr size_t WS_X1    = WS_WM2 + (size_t)64 * DM * DM * 2;
constexpr size_t WS_X2    = WS_X1 + (size_t)TT * DM * 4;
constexpr size_t WS_VB    = WS_X2 + (size_t)TT * DM * 4;
constexpr size_t WS_RI    = WS_VB + (size_t)TT * DM * 2;
constexpr size_t WS_RW    = WS_RI + (size_t)TT * 16;
constexpr size_t WS_SP    = WS_RW + (size_t)TT * 16;
constexpr size_t WS_TILEE = WS_SP + (size_t)TT * 16;
constexpr size_t WS_BC    = WS_TILEE + 4096;
constexpr size_t WS_VBG   = WS_BC + (size_t)2 * 1024 * 32 * 4;
constexpr size_t WS_ACT   = WS_VBG + (size_t)MOE_ROWS * DM * 2;
constexpr size_t WS_YS    = WS_ACT + (size_t)MOE_ROWS * DM * 2;
constexpr size_t WS_ARENA = WS_YS + (size_t)MOE_ROWS * DM * 2;
constexpr size_t A0_U     = WS_ARENA;
constexpr size_t A0_P     = A0_U + (size_t)TT * DM * 2;
constexpr size_t A0_GATES = A0_P + (size_t)TT * NP0 * 2;
constexpr size_t A0_QN    = A0_GATES + (size_t)TT * 64;
constexpr size_t A0_KN    = A0_QN + (size_t)TT * 512 * 4;
constexpr size_t A0_VV    = A0_KN + (size_t)TT * 512 * 4;
constexpr size_t A0_GG    = A0_VV + (size_t)TT * 512 * 4;
constexpr size_t A0_BB    = A0_GG + (size_t)2 * TT * 16;
constexpr size_t A0_OD    = A0_BB + (size_t)2 * TT * 16;
constexpr size_t A0_VX    = A0_OD + (size_t)2 * TT * 512 * 4;
constexpr size_t A0_X0    = A0_VX + (size_t)TT * 512 * 4;
constexpr size_t A0_YH    = A0_X0 + (size_t)TT * 512 * 4;
constexpr size_t A0_MIX   = A0_YH + (size_t)TT * 512 * 4;
constexpr size_t A0_Y     = A0_MIX + (size_t)TT * MIXW * 2;
constexpr size_t A0_QB    = A0_Y + (size_t)TT * DM * 4;
constexpr size_t A0_KB    = A0_QB + (size_t)TT * 512 * 2;
constexpr size_t A0_VB3   = A0_KB + (size_t)TT * 512 * 2;
constexpr int    DN_CU    = NB * 4 * 2 * 36;
constexpr size_t A0_WQ    = A0_VB3 + (size_t)TT * 512 * 2;
constexpr size_t A0_KDT   = A0_WQ + (size_t)DN_CU * 32768;
constexpr size_t A0_ATT   = A0_KDT + (size_t)DN_CU * 16384;
constexpr size_t A0_UU    = A0_ATT + (size_t)DN_CU * 8192;
constexpr size_t A0_GL    = A0_UU + (size_t)DN_CU * 32768;
constexpr size_t A0_VXTL  = A0_GL + al((size_t)DN_CU * 4);
constexpr size_t A0_VXTC  = A0_VXTL + (size_t)512 * TL * 2;
constexpr size_t A0_YHTL  = A0_VXTC + (size_t)512 * TC * 2;
constexpr size_t A0_YHTC  = A0_YHTL + (size_t)512 * TL * 4;
constexpr size_t A0_END   = A0_YHTC + (size_t)512 * TC * 4;
constexpr size_t A1_U     = WS_ARENA;
constexpr size_t A1_P     = A1_U + (size_t)TT * DM * 2;
constexpr size_t A1_XC    = A1_P + (size_t)TT * 2048 * 4;
constexpr size_t A1_XCB   = A1_XC + (size_t)TT * DM * 4;
constexpr size_t A1_RG    = A1_XCB + (size_t)TT * DM * 2;
constexpr size_t A1_HS    = A1_RG + (size_t)TT * 4096 * 2;
constexpr size_t A1_HG    = A1_HS + (size_t)2 * TL * DM * 4;
constexpr size_t A1_Y     = A1_HG + (size_t)TL * DM * 2;
constexpr size_t A1_END   = A1_Y + (size_t)TL * DM * 4;
constexpr size_t WS_END   = (A0_END > A1_END ? A0_END : A1_END);

constexpr int CW_BAR = 0;
constexpr int CW_CNT = 4096;
constexpr int CW_CUR = 4096 + 64;
constexpr int CW_NT  = 4096 + 128;
constexpr int CW_TQ  = 4096 + 192;
constexpr size_t CTL_BYTES = 65536;

DI float bf2f(bf16_t b) { return __uint_as_float(((unsigned)b) << 16); }
typedef __bf16 bf16x2_t __attribute__((ext_vector_type(2)));
DI unsigned pk2(float lo, float hi) { const f32x2 v = {lo, hi}; return __builtin_bit_cast(unsigned, __builtin_convertvector(v, bf16x2_t)); }
DI bf16_t f2bf(float f) { return (bf16_t)(pk2(f, 0.f) & 0xffffu); }
DI unsigned pk4_fp8(float a, float b, float c, float d) { int w = 0; w = __builtin_amdgcn_cvt_pk_fp8_f32(a, b, w, false); w = __builtin_amdgcn_cvt_pk_fp8_f32(c, d, w, true); return (unsigned)w; }
#ifndef MK_FP8_L1
#define MK_FP8_L1 1
#endif
#ifndef MK_FP8_L0
#define MK_FP8_L0 1
#endif
#ifndef MK_FP8_YS
#define MK_FP8_YS 1
#endif
constexpr float W1_F8S = 32.0f, W2_F8S = 64.0f, YS_F8S = 16.0f;
DI float sigm(float x) { return __builtin_amdgcn_rcpf(1.0f + __expf(-x)); }
DI float silu_(float x) { return x * sigm(x); }
DI float softplus_(float x) { return fmaxf(x, 0.f) + log1pf(__expf(-fabsf(x))); }
DI float gelu_tanh(float x) { return x * sigm(1.5957691216057308f * (x + 0.044715f * x * x * x)); }
DI float wsum(float v) { v += __shfl_xor(v, 32); v += __shfl_xor(v, 16); v += __shfl_xor(v, 8); v += __shfl_xor(v, 4); v += __shfl_xor(v, 2); v += __shfl_xor(v, 1); return v; }

DI int row_of(int b, int d, int p) {
    if (p < CTXL) return TL + b * CTXL + (d ? (CTXL - 1 - p) : p);
    const int q = p - CTXL; return b * SEQ + (d ? (SEQ - 1 - q) : q);
}
static_assert(WS_END <= (size_t)2147483648ull, "workspace map exceeds 4x the largest tensor");
#define XB_TMO      128
#define XB_XCNT(j)  (256  + 64 * (j))
#define XB_XSUB(j)  (1280 + 64 * (j))
#define XB_XGEN(j)  (2304 + 64 * (j))
#define XB_TOP      3328
#define XB_TOPGEN   3392
#define XCD_BAR_WORDS 3456
#define XB_SPIN_CAP (1u << 18)

__device__ __forceinline__ unsigned xb_ld(unsigned* p)              { return __hip_atomic_load(p, __ATOMIC_RELAXED, __HIP_MEMORY_SCOPE_AGENT); }
__device__ __forceinline__ unsigned xb_add(unsigned* p, unsigned v) { return __hip_atomic_fetch_add(p, v, __ATOMIC_RELAXED, __HIP_MEMORY_SCOPE_AGENT); }
__device__ __forceinline__ unsigned xb_xcc_id() { return (unsigned)__builtin_amdgcn_s_getreg((3 << 11) | 20) & 0xFu; }
#define XB_SPIN(cond, bar) do { unsigned _sp = 0; while (cond) { __builtin_amdgcn_s_sleep(1); \
    if ((++_sp & 255u) == 0u) { if (xb_ld(&(bar)[XB_TMO])) break; if (_sp > XB_SPIN_CAP) { atomicAdd(&(bar)[XB_TMO], 1u); break; } } } } while (0)

struct XcdBarrier {
    unsigned* bar; unsigned x;
    volatile LAS unsigned* st;
};

__device__ __forceinline__ XcdBarrier xcd_barrier_post(unsigned* bar, volatile LAS unsigned* st) {
    XcdBarrier b; b.bar = bar; b.x = xb_xcc_id(); b.st = st;
    if (threadIdx.x == 0) (void)xb_add(&bar[XB_XCNT(b.x)], 1u);
    return b;
}
__device__ __forceinline__ void xcd_barrier_complete(unsigned* bar, unsigned x, unsigned& nloc, unsigned& nx) {
    const unsigned G = gridDim.x * gridDim.y * gridDim.z;
    unsigned sum, cnt, mine, sp = 0u;
    for (;;) {
        sum = 0u; cnt = 0u; mine = 0u;
#pragma unroll
        for (unsigned j = 0; j < 16; ++j) { const unsigned c = xb_ld(&bar[XB_XCNT(j)]); sum += c; cnt += (c > 0u) ? 1u : 0u; mine = (j == x) ? c : mine; }
        if (sum == G) break;
        __builtin_amdgcn_s_sleep(1);
        if ((++sp & 255u) == 0u) { if (xb_ld(&bar[XB_TMO])) break; if (sp > XB_SPIN_CAP) { atomicAdd(&bar[XB_TMO], 1u); break; } }
    }
    nloc = mine > 0u ? mine : 1u; nx = cnt > 0u ? cnt : 1u;
}

__device__ __forceinline__ void xcd_barrier(const XcdBarrier& b) {
    asm volatile("s_waitcnt vmcnt(0)" ::: "memory");
    __syncthreads();
    if (threadIdx.x == 0) {
        unsigned* bar = b.bar;
        __builtin_amdgcn_s_waitcnt(0);
        unsigned nloc = b.st[0], nx = b.st[1];
        if (nloc == 0u) { xcd_barrier_complete(bar, b.x, nloc, nx); b.st[0] = nloc; b.st[1] = nx; }
        const unsigned old = xb_add(&bar[XB_XSUB(b.x)], 1u);
        const unsigned gen = old / nloc;
        if (old + 1u == (gen + 1u) * nloc) {
            __builtin_amdgcn_fence(__ATOMIC_RELEASE, "agent");
            asm volatile("s_waitcnt vmcnt(0)" ::: "memory");
            const unsigned og = xb_add(&bar[XB_TOP], 1u);
            const unsigned tg = og / nx;
            if (og + 1u == (tg + 1u) * nx) xb_add(&bar[XB_TOPGEN], 1u);
            else XB_SPIN(xb_ld(&bar[XB_TOPGEN]) == tg, bar);
            __builtin_amdgcn_fence(__ATOMIC_ACQUIRE, "agent");
            xb_add(&bar[XB_XGEN(b.x)], 1u);
            asm volatile("s_waitcnt vmcnt(0)" ::: "memory");
        } else {
            XB_SPIN(xb_ld(&bar[XB_XGEN(b.x)]) == gen, bar);
            __builtin_amdgcn_fence(__ATOMIC_ACQUIRE, "agent");
            asm volatile("s_waitcnt vmcnt(0)" ::: "memory");
        }
    }
    __syncthreads();
}

namespace pg8 {
typedef short bf16x8 __attribute__((ext_vector_type(8)));
constexpr int BM = 256, BK = 64, HALF = 128, HTB = HALF * BK * 2, STAGE_BYTES = 8 * HTB, NXCD = 8, WGM = 8;

__host__ __device__ __forceinline__ int lds_byte(int r, int c) { const int st = (r >> 4) * 2 + (c >> 5), rr = r & 15, cc = c & 31, ob = rr * 64 + cc * 2; return st * 1024 + (ob ^ (((ob >> 9) & 1) << 5)); }
__host__ __device__ __forceinline__ void stage_rc(int b, int& R, int& C) { const int st = b / 1024, sb = b % 1024, swz = sb ^ (((sb >> 9) & 1) << 5); R = (st >> 1) * 16 + swz / 64; C = (st & 1) * 32 + (swz % 64) / 2; }
__host__ __device__ __forceinline__ int perm32(int rho) { const int n = rho >> 4, i = rho & 15; return 8 * (i >> 2) + 4 * n + (i & 3); }

struct Unit { int pm, pn, e; };
struct Gemm { const bf16_t* A; const bf16_t* Bt; int M, N, K, lda; };

struct StaticOrder {
    int nM, nN, nwg, G, c;
    __device__ void init(int M, int N, int G_, int c_) { nM = M / BM; nN = N / BM; nwg = nM * nN; G = G_; c = c_; }
    __device__ bool next(int i, Unit& u) const {
        const long L = (long)i * G + c; if (L >= nwg) return false;
        int wgid = (int)L; { const int q = nwg / NXCD, r = nwg % NXCD, xcd = wgid % NXCD, off = wgid / NXCD; wgid = (xcd < r ? xcd * (q + 1) : r * (q + 1) + (xcd - r) * q) + off; }
        const int nig = WGM * nN, gid = wgid / nig, fm = gid * WGM, gsz = (nM - fm) < WGM ? (nM - fm) : WGM;
        u.pm = fm + ((wgid % nig) % gsz); u.pn = (wgid % nig) / gsz; u.e = 0; return true;
    }
    __device__ __forceinline__ const char* a_ptr(const Gemm& g, const Unit& u) const { return (const char*)g.A + (size_t)u.pm * BM * g.lda * 2; }
    __device__ __forceinline__ const char* b_ptr(const Gemm& g, const Unit& u) const { return (const char*)g.Bt + (size_t)u.pn * BM * g.K * 2; }
};
struct LruOrder : StaticOrder {
    __device__ __forceinline__ const char* a_ptr(const Gemm& g, const Unit& u) const { return (const char*)g.A + (size_t)u.pm * BM * g.lda * 2 + (size_t)((u.pn >> 1) & 3) * 512; }
};
struct MoeOrder {
    const int* tile_e; int ntm, nN, G, c;
    __device__ bool next(int i, Unit& u) const {
        if ((G & 7) == 0 && ((G >> 3) % nN) == 0) {
            const int x = c & 7, s = c >> 3, mpr = (G >> 3) / nN;
            u.pm = i * (8 * mpr) + x * mpr + s / nN; u.pn = s % nN; if (u.pm >= ntm) return false;
        } else { const long L = (long)i * G + c; if (L >= (long)ntm * nN) return false; u.pm = (int)(L / nN); u.pn = (int)(L % nN); }
        u.e = tile_e[u.pm]; return true;
    }
    __device__ __forceinline__ const char* a_ptr(const Gemm& g, const Unit& u) const { return (const char*)g.A + (size_t)u.pm * BM * g.lda * 2; }
    __device__ __forceinline__ const char* b_ptr(const Gemm& g, const Unit& u) const { return (const char*)g.Bt + ((size_t)u.e * g.N + (size_t)u.pn * BM) * g.K * 2; }
};

__device__ __forceinline__ unsigned cvt_pk_bf16(float lo, float hi) { return pk2(lo, hi); }

struct EpiF32 {
    static constexpr bool PERM = false;
    float* C; int ldc; const float* bias;
    __device__ __forceinline__ void operator()(const f32x4 (&acc)[2][2][4][2], const Unit& u, int wr, int wc, int fr, int fq) const {
        const int row0 = u.pm * BM + wr * 64 + fr, col0 = u.pn * BM + wc * 32 + 4 * fq;
        f32x4 bv[2][2];
#pragma unroll
        for (int bj = 0; bj < 2; ++bj)
#pragma unroll
            for (int n = 0; n < 2; ++n) bv[bj][n] = bias ? *(const f32x4*)(bias + col0 + bj * HALF + n * 16) : (f32x4){0.f, 0.f, 0.f, 0.f};
#pragma unroll
        for (int ai = 0; ai < 2; ++ai)
#pragma unroll
            for (int m = 0; m < 4; ++m) { float* rowp = C + (size_t)(row0 + ai * HALF + m * 16) * ldc + col0;
#pragma unroll
                for (int bj = 0; bj < 2; ++bj)
#pragma unroll
                    for (int n = 0; n < 2; ++n) *(f32x4*)(rowp + bj * HALF + n * 16) = acc[ai][bj][m][n] + bv[bj][n]; }
    }
};
struct EpiBf16 {
    static constexpr bool PERM = true;
    bf16_t* O; int ldc; const float* bias; int bias_estride; float scale = 1.0f;
    __device__ __forceinline__ void operator()(const f32x4 (&acc)[2][2][4][2], const Unit& u, int wr, int wc, int fr, int fq) const {
        const int row0 = u.pm * BM + wr * 64 + fr; const int col0 = u.pn * BM + wc * 32 + 8 * fq;
        f32x4 bv[2][2];
#pragma unroll
        for (int bj = 0; bj < 2; ++bj)
#pragma unroll
            for (int n = 0; n < 2; ++n) bv[bj][n] = bias ? *(const f32x4*)(bias + (size_t)u.e * bias_estride + col0 + bj * HALF + 4 * n) : (f32x4){0.f, 0.f, 0.f, 0.f};
#pragma unroll
        for (int ai = 0; ai < 2; ++ai)
#pragma unroll
            for (int m = 0; m < 4; ++m) { bf16_t* rowp = O + (size_t)(row0 + ai * HALF + m * 16) * ldc + col0;
#pragma unroll
                for (int bj = 0; bj < 2; ++bj) { const f32x4 v0 = acc[ai][bj][m][0] * scale + bv[bj][0], v1 = acc[ai][bj][m][1] * scale + bv[bj][1];
                    u32x4 w; w.x = cvt_pk_bf16(v0[0], v0[1]); w.y = cvt_pk_bf16(v0[2], v0[3]); w.z = cvt_pk_bf16(v1[0], v1[1]); w.w = cvt_pk_bf16(v1[2], v1[3]);
                    *(u32x4*)(rowp + bj * HALF) = w; } }
    }
};
__device__ __forceinline__ float sigm_fast(float x) { return __builtin_amdgcn_rcpf(1.0f + __expf(-x)); }
__device__ __forceinline__ unsigned cvt_pk_bf16_trans(float lo, float hi) { return pk2(lo, hi); }
struct EpiSigmoid {
    static constexpr bool PERM = true;
    bf16_t* O; int ldc; const float* bias;
    __device__ __forceinline__ void operator()(const f32x4 (&acc)[2][2][4][2], const Unit& u, int wr, int wc, int fr, int fq) const {
        const int row0 = u.pm * BM + wr * 64 + fr; const int col0 = u.pn * BM + wc * 32 + 8 * fq;
#pragma unroll
        for (int bj = 0; bj < 2; ++bj) {
            const f32x4 b0 = *(const f32x4*)(bias + col0 + bj * HALF), b1 = *(const f32x4*)(bias + col0 + bj * HALF + 4);
#pragma unroll
            for (int ai = 0; ai < 2; ++ai)
#pragma unroll
                for (int m = 0; m < 4; ++m) { bf16_t* rowp = O + (size_t)(row0 + ai * HALF + m * 16) * ldc + col0 + bj * HALF;
                    const f32x4 v0 = acc[ai][bj][m][0] + b0, v1 = acc[ai][bj][m][1] + b1; u32x4 w;
                    w.x = cvt_pk_bf16_trans(sigm_fast(v0[0]), sigm_fast(v0[1])); w.y = cvt_pk_bf16_trans(sigm_fast(v0[2]), sigm_fast(v0[3]));
                    w.z = cvt_pk_bf16_trans(sigm_fast(v1[0]), sigm_fast(v1[1])); w.w = cvt_pk_bf16_trans(sigm_fast(v1[2]), sigm_fast(v1[3]));
                    *(u32x4*)rowp = w; asm volatile("" ::: "memory"); }
        }
    }
};
struct EpiLruAB {
    static constexpr bool PERM = true;
    unsigned* AB; const float* bias; const float* sp8; const bf16_t* xcb; int rows;
    __device__ __forceinline__ void operator()(const f32x4 (&acc)[2][2][4][2], const Unit& u, int wr, int wc, int fr, int fq) const {
        const int row0 = u.pm * BM + wr * 64 + fr;
#pragma unroll
        for (int bj = 0; bj < 2; ++bj) {
            const int n0 = u.pn * BM + bj * HALF + wc * 32 + 8 * fq; const int d = n0 >> 11, ch = ((n0 >> 9) & 3) * 256 + ((n0 & 511) >> 1);
            const f32x4 b0 = *(const f32x4*)(bias + n0), b1 = *(const f32x4*)(bias + n0 + 4), sp = *(const f32x4*)(sp8 + d * 1024 + ch);
#pragma unroll
            for (int ai = 0; ai < 2; ++ai)
#pragma unroll
                for (int m = 0; m < 4; ++m) { const int row = row0 + ai * HALF + m * 16;
                    const f32x4 v0 = acc[ai][bj][m][0] + b0, v1 = acc[ai][bj][m][1] + b1;
                    const u32x2 xr = *(const u32x2*)(xcb + (size_t)row * 1024 + ch);
                    const float x0 = __uint_as_float(xr.x << 16), x1 = __uint_as_float(xr.x & 0xffff0000u), x2 = __uint_as_float(xr.y << 16), x3 = __uint_as_float(xr.y & 0xffff0000u);
                    float la[4], cc[4]; const float rr_[4] = {v0[0], v0[2], v1[0], v1[2]}, ii_[4] = {v0[1], v0[3], v1[1], v1[3]}, xx_[4] = {x0, x1, x2, x3};
#pragma unroll
                    for (int q = 0; q < 4; ++q) { const float dr = 1.0f + __expf(-rr_[q]), di = 1.0f + __expf(-ii_[q]); const float R = __builtin_amdgcn_rcpf(dr * di);
                        la[q] = sp[q] * (R * di); const float a = __expf(la[q]); cc[q] = __builtin_amdgcn_sqrtf(fmaxf(1.0f - a * a, 0.f)) * ((R * dr) * xx_[q]); }
                    const float la0 = la[0], la1 = la[1], la2 = la[2], la3 = la[3], c0 = cc[0], c1 = cc[1], c2 = cc[2], c3 = cc[3];
                    u32x4 w; w.x = cvt_pk_bf16(la0, c0); w.y = cvt_pk_bf16(la1, c1); w.z = cvt_pk_bf16(la2, c2); w.w = cvt_pk_bf16(la3, c3);
                    *(u32x4*)(AB + ((size_t)d * rows + row) * 1024 + ch) = w; asm volatile("" ::: "memory"); }
        }
    }
};
__device__ __forceinline__ float swiglu_(float g, float l) {
    const float glu = fminf(g, 7.0f), lin = fminf(fmaxf(l, -7.0f), 7.0f);
    return glu * __builtin_amdgcn_rcpf(1.0f + __expf(-1.702f * glu)) * (lin + 1.0f);
}
__device__ __forceinline__ f32x2 swiglu2_(f32x2 g, f32x2 l) {
    const f32x2 glu = __builtin_elementwise_min(g, (f32x2){7.0f, 7.0f});
    const f32x2 lin = __builtin_elementwise_min(__builtin_elementwise_max(l, (f32x2){-7.0f, -7.0f}), (f32x2){7.0f, 7.0f});
    const f32x2 t = glu * (-1.702f * 1.4426950408889634f);
    f32x2 e; e.x = __builtin_amdgcn_exp2f(t.x); e.y = __builtin_amdgcn_exp2f(t.y);
    const f32x2 d = e + 1.0f;
    f32x2 r; r.x = __builtin_amdgcn_rcpf(d.x); r.y = __builtin_amdgcn_rcpf(d.y);
    return glu * r * (lin + 1.0f);
}
struct EpiSwiglu {
    static constexpr bool PERM = true;
    bf16_t* O; int ldo; const float* bias; int bias_estride;
    __device__ __forceinline__ void operator()(const f32x4 (&acc)[2][2][4][2], const Unit& u, int wr, int wc, int fr, int fq) const {
        const int row0 = u.pm * BM + wr * 64 + fr; const int col0 = u.pn * BM + wc * 32 + 8 * fq;
        f32x4 bv[2][2];
#pragma unroll
        for (int bj = 0; bj < 2; ++bj)
#pragma unroll
            for (int n = 0; n < 2; ++n) bv[bj][n] = *(const f32x4*)(bias + (size_t)u.e * bias_estride + col0 + bj * HALF + 4 * n);
#pragma unroll
        for (int ai = 0; ai < 2; ++ai)
#pragma unroll
            for (int m = 0; m < 4; ++m) { bf16_t* rowp = O + (size_t)(row0 + ai * HALF + m * 16) * ldo + (col0 >> 1);
#pragma unroll
                for (int bj = 0; bj < 2; ++bj) { const f32x4 v0 = acc[ai][bj][m][0] + bv[bj][0], v1 = acc[ai][bj][m][1] + bv[bj][1];
                    const f32x2 s0 = swiglu2_((f32x2){v0[0], v0[2]}, (f32x2){v0[1], v0[3]}), s1 = swiglu2_((f32x2){v1[0], v1[2]}, (f32x2){v1[1], v1[3]});
                    u32x2 w; w.x = cvt_pk_bf16(s0.x, s0.y); w.y = cvt_pk_bf16(s1.x, s1.y);
                    *(u32x2*)(rowp + bj * (HALF / 2)) = w; } }
    }
};

typedef int v8i_t __attribute__((ext_vector_type(8)));
typedef int v4i_t __attribute__((ext_vector_type(4)));
struct Frag2 { bf16x8 k[2]; };
template <class Epi, class Sched, bool FP8 = false>
__device__ __forceinline__ void gemm_phase(LAS unsigned char* lds, const Gemm g, const Sched& S, const Epi& E) {
    const int tid = threadIdx.x, wid = __builtin_amdgcn_readfirstlane(tid >> 6), lane = tid & 63, wr = wid >> 2, wc = wid & 3, fr = lane & 15, fq = lane >> 4;
    const int K = g.K, nt = K / BK;
    unsigned voffA[2], voffB[2];
#pragma unroll
    for (int i = 0; i < 2; ++i) { int R, C; stage_rc(tid * 16 + i * 8192, R, C); const int Rb = Epi::PERM ? ((R & ~31) + perm32(R & 31)) : R;
        voffA[i] = (unsigned)(R * g.lda + C) * 2u; voffB[i] = (unsigned)(Rb * K + C) * 2u; }
    const size_t kstep = (size_t)(BK * 2);
    const size_t hstep = (size_t)HALF * K * 2, hstepA = (size_t)HALF * g.lda * 2;
    const unsigned ldsw = (unsigned)wid * 1024u;
    const int aoff = lds_byte(wr * 64 + fr, fq * 8), boff = lds_byte(wc * 32 + fr, fq * 8);
#define PG8_SA(b, h) (((b) * 2 + (h)) * HTB)
#define PG8_SB(b, h) ((4 + (b) * 2 + (h)) * HTB)
#define PG8_STAGE(bufoff, gbase, voff) do { _Pragma("unroll") for (int _i = 0; _i < 2; ++_i) \
        __builtin_amdgcn_global_load_lds((const unsigned*)((const char*)(gbase) + (voff)[_i]), (LAS unsigned*)(lds + (bufoff) + ldsw + _i * 8192), 16, 0, 0); } while (0)
#define PG8_LD2(p) __builtin_shufflevector(*(const LAS v4i_t*)(p), *(const LAS v4i_t*)((p) + 1024), 0, 1, 2, 3, 4, 5, 6, 7)
#define PG8_LDA(dst, b, h) do { _Pragma("unroll") for (int m = 0; m < 4; ++m) { if constexpr (FP8) dst##8[m] = PG8_LD2(lds + PG8_SA(b, h) + aoff + m * 2048); \
        else { _Pragma("unroll") for (int k = 0; k < 2; ++k) dst[m].k[k] = *(const LAS bf16x8*)(lds + PG8_SA(b, h) + aoff + m * 2048 + k * 1024); } } } while (0)
#define PG8_LDB(dst, b, h) do { _Pragma("unroll") for (int n = 0; n < 2; ++n) { if constexpr (FP8) dst##8[n] = PG8_LD2(lds + PG8_SB(b, h) + boff + n * 2048); \
        else { _Pragma("unroll") for (int k = 0; k < 2; ++k) dst[n].k[k] = *(const LAS bf16x8*)(lds + PG8_SB(b, h) + boff + n * 2048 + k * 1024); } } } while (0)
#define PG8_MMA(ai, bj, At, Bt) do { __builtin_amdgcn_s_setprio(1); _Pragma("unroll") for (int m = 0; m < 4; ++m) _Pragma("unroll") for (int n = 0; n < 2; ++n) { \
        if constexpr (FP8) asm volatile("v_mfma_scale_f32_16x16x128_f8f6f4 %0, %1, %2, %0, %3, %3 op_sel_hi:[0,0,0]" : "+v"(acc[ai][bj][m][n]) : "v"(Bt##8[n]), "v"(At##8[m]), "v"(f8scale)); \
        else { _Pragma("unroll") for (int k = 0; k < 2; ++k) acc[ai][bj][m][n] = __builtin_amdgcn_mfma_f32_16x16x32_bf16(Bt[n].k[k], At[m].k[k], acc[ai][bj][m][n], 0, 0, 0); } } \
        __builtin_amdgcn_s_setprio(0); } while (0)
#define PG8_WAIT_V(n) asm volatile("s_waitcnt vmcnt(" #n ")" ::: "memory")
#define PG8_WAIT_L(n) asm volatile("s_waitcnt lgkmcnt(" #n ")" ::: "memory")
#define PG8_BAR __builtin_amdgcn_s_barrier()
#define PG8_SCHED __builtin_amdgcn_sched_barrier(0)
    Unit cur, nxt; int ui = 0;
    if (!S.next(0, cur)) return;
    f32x4 acc[2][2][4][2];
#pragma unroll
    for (int a = 0; a < 2; ++a)
#pragma unroll
        for (int b = 0; b < 2; ++b)
#pragma unroll
            for (int m = 0; m < 4; ++m)
#pragma unroll
                for (int n = 0; n < 2; ++n) acc[a][b][m][n] = (f32x4){0.f, 0.f, 0.f, 0.f};
    Frag2 At[4], B0[2], B1[2]; v8i_t At8[4], B08[2], B18[2];
    int f8scale = 0x7f7f7f7f; asm volatile("" : "+v"(f8scale));
    const char* cA = S.a_ptr(g, cur); const char* cB = S.b_ptr(g, cur);
    PG8_STAGE(PG8_SB(0, 0), cB, voffB); PG8_STAGE(PG8_SA(0, 0), cA, voffA); PG8_STAGE(PG8_SB(0, 1), cB + hstep, voffB); PG8_STAGE(PG8_SA(0, 1), cA + hstepA, voffA);
    if (wr == 1) PG8_BAR;
    PG8_WAIT_V(4); PG8_BAR;
    PG8_STAGE(PG8_SB(1, 0), cB + kstep, voffB); PG8_STAGE(PG8_SA(1, 0), cA + kstep, voffA); PG8_STAGE(PG8_SB(1, 1), cB + hstep + kstep, voffB);
    PG8_WAIT_V(6); PG8_BAR;
    for (;;) {
        const bool has_next = S.next(ui + 1, nxt);
        const char* nA = has_next ? S.a_ptr(g, nxt) : cA; const char* nB = has_next ? S.b_ptr(g, nxt) : cB;
#pragma unroll 1
        for (int t = 0; t < nt; t += 2) {
            const bool last = (t == nt - 2);
            const char* a1 = cA + (size_t)(t + 1) * kstep;
            const char* a2 = last ? nA : cA + (size_t)(t + 2) * kstep; const char* b2 = last ? nB : cB + (size_t)(t + 2) * kstep;
            const char* a3 = a2 + kstep; const char* b3 = b2 + kstep;
            PG8_LDB(B0, 0, 0); PG8_SCHED; PG8_LDA(At, 0, 0); PG8_STAGE(PG8_SA(1, 1), a1 + hstepA, voffA);
            PG8_WAIT_L(8); PG8_BAR; PG8_WAIT_L(0); PG8_MMA(0, 0, At, B0); PG8_BAR; PG8_SCHED;
            PG8_LDB(B1, 0, 1); PG8_STAGE(PG8_SB(0, 0), b2, voffB);
            PG8_BAR; PG8_WAIT_L(0); PG8_MMA(0, 1, At, B1); PG8_BAR;
            PG8_LDA(At, 0, 1); PG8_STAGE(PG8_SA(0, 0), a2, voffA);
            PG8_BAR; PG8_WAIT_L(0); PG8_MMA(1, 0, At, B0); PG8_BAR; PG8_SCHED;
            PG8_STAGE(PG8_SB(0, 1), b2 + hstep, voffB);
            PG8_WAIT_V(6); PG8_BAR; PG8_MMA(1, 1, At, B1); PG8_BAR;
            PG8_LDB(B0, 1, 0); PG8_SCHED; PG8_LDA(At, 1, 0); PG8_STAGE(PG8_SA(0, 1), a2 + hstepA, voffA);
            PG8_WAIT_L(8); PG8_BAR; PG8_WAIT_L(0); PG8_MMA(0, 0, At, B0); PG8_BAR; PG8_SCHED;
            PG8_LDB(B1, 1, 1); PG8_STAGE(PG8_SB(1, 0), b3, voffB);
            PG8_BAR; PG8_WAIT_L(0); PG8_MMA(0, 1, At, B1); PG8_BAR;
            PG8_LDA(At, 1, 1); PG8_STAGE(PG8_SA(1, 0), a3, voffA);
            PG8_BAR; PG8_WAIT_L(0); PG8_MMA(1, 0, At, B0); PG8_BAR; PG8_SCHED;
            PG8_STAGE(PG8_SB(1, 1), b3 + hstep, voffB);
            PG8_WAIT_V(6); PG8_BAR; PG8_MMA(1, 1, At, B1); PG8_BAR;
        }
        if constexpr (FP8) asm volatile("s_nop 15\n\ts_nop 15" ::: "memory");
        E(acc, cur, wr, wc, fr, fq);
        if (!has_next) break;
#pragma unroll
        for (int a = 0; a < 2; ++a)
#pragma unroll
            for (int b = 0; b < 2; ++b)
#pragma unroll
                for (int m = 0; m < 4; ++m)
#pragma unroll
                    for (int n = 0; n < 2; ++n) acc[a][b][m][n] = (f32x4){0.f, 0.f, 0.f, 0.f};
        cur = nxt; cA = nA; cB = nB; ++ui;
    }
    PG8_WAIT_V(0);
    if (wr == 0) PG8_BAR;
    PG8_BAR;
#undef PG8_SA
#undef PG8_SB
#undef PG8_STAGE
#undef PG8_LD2
#undef PG8_LDA
#undef PG8_LDB
#undef PG8_MMA
#undef PG8_WAIT_V
#undef PG8_WAIT_L
#undef PG8_BAR
#undef PG8_SCHED
}
struct EpiF8 {
    static constexpr bool PERM = true;
    unsigned char* O; int ldc; const float* bias; int bias_estride; float scale, oscale;
    __device__ __forceinline__ void operator()(const f32x4 (&acc)[2][2][4][2], const Unit& u, int wr, int wc, int fr, int fq) const {
        const int row0 = u.pm * BM + wr * 64 + fr; const int col0 = u.pn * BM + wc * 32 + 8 * fq;
        f32x4 bv[2][2];
#pragma unroll
        for (int bj = 0; bj < 2; ++bj)
#pragma unroll
            for (int n = 0; n < 2; ++n) bv[bj][n] = *(const f32x4*)(bias + (size_t)u.e * bias_estride + col0 + bj * HALF + 4 * n) * oscale;
        const float sc = scale * oscale;
#pragma unroll
        for (int ai = 0; ai < 2; ++ai)
#pragma unroll
            for (int m = 0; m < 4; ++m) { unsigned char* rowp = O + (size_t)(row0 + ai * HALF + m * 16) * ldc + col0;
#pragma unroll
                for (int bj = 0; bj < 2; ++bj) { const f32x4 v0 = acc[ai][bj][m][0] * sc + bv[bj][0], v1 = acc[ai][bj][m][1] * sc + bv[bj][1];
                    u32x2 w; w.x = pk4_fp8(v0[0], v0[1], v0[2], v0[3]); w.y = pk4_fp8(v1[0], v1[1], v1[2], v1[3]);
                    *(u32x2*)(rowp + bj * HALF) = w; } }
    }
};
struct EpiSwigluF8 {
    static constexpr bool PERM = true;
    unsigned char* O; int ldo; const float* bias; int bias_estride; float scale;
    __device__ __forceinline__ void operator()(const f32x4 (&acc)[2][2][4][2], const Unit& u, int wr, int wc, int fr, int fq) const {
        const int row0 = u.pm * BM + wr * 64 + fr; const int col0 = u.pn * BM + wc * 32 + 8 * fq;
        f32x4 bv[2][2];
#pragma unroll
        for (int bj = 0; bj < 2; ++bj)
#pragma unroll
            for (int n = 0; n < 2; ++n) bv[bj][n] = *(const f32x4*)(bias + (size_t)u.e * bias_estride + col0 + bj * HALF + 4 * n);
#pragma unroll
        for (int ai = 0; ai < 2; ++ai)
#pragma unroll
            for (int m = 0; m < 4; ++m) { unsigned char* rowp = O + (size_t)(row0 + ai * HALF + m * 16) * ldo + (col0 >> 1);
#pragma unroll
                for (int bj = 0; bj < 2; ++bj) { const f32x4 v0 = acc[ai][bj][m][0] * scale + bv[bj][0], v1 = acc[ai][bj][m][1] * scale + bv[bj][1];
                    const f32x2 s0 = swiglu2_((f32x2){v0[0], v0[2]}, (f32x2){v0[1], v0[3]}), s1 = swiglu2_((f32x2){v1[0], v1[2]}, (f32x2){v1[1], v1[3]});
                    *(unsigned*)(rowp + bj * (HALF / 2)) = pk4_fp8(s0.x, s0.y, s1.x, s1.y); } }
    }
};
}
constexpr int NTHR = 512;
constexpr int LDS_MAIN = 131072;
constexpr int LDS_CTL_OFF = 8 * 64 * 65 * 4;
constexpr int LDS_BYTES = LDS_CTL_OFF + 256;
struct Args { const float* in[40]; float* out; unsigned char* ws; int ph_lo, ph_hi; int flags, pad; };

struct Fr {
    const Args* a; LAS unsigned char* lds; unsigned char* ws; int tid, lane, wave, G, bid; int gwave, nwaves;
};
#define WSP(T, off) ((T*)(F.ws + (off)))
#define INP(i) (F.a->in[i])

typedef float f32x16 __attribute__((ext_vector_type(16)));
typedef short bf16x8v __attribute__((ext_vector_type(8)));
#define MFMA32(a, b, c) __builtin_amdgcn_mfma_f32_32x32x16_bf16((a), (b), (c), 0, 0, 0)
DI int crow(int reg, int h) { return (reg & 3) + 8 * (reg >> 2) + 4 * h; }
DI int afrag_off(int m, int k, int nks) { return ((m >> 5) * nks + (k >> 4)) * 1024 + ((m & 31) + 32 * ((k >> 3) & 1)) * 16 + (k & 7) * 2; }
DI f32x16 zero16() { f32x16 z;
#pragma unroll
    for (int i = 0; i < 16; ++i) z[i] = 0.f; return z; }
DI bf16x8v scale8(u32x4 raw, const float (&s)[8], bool rev) {
    float v[8];
    v[0] = __uint_as_float(raw.x << 16); v[1] = __uint_as_float(raw.x & 0xffff0000u); v[2] = __uint_as_float(raw.y << 16); v[3] = __uint_as_float(raw.y & 0xffff0000u);
    v[4] = __uint_as_float(raw.z << 16); v[5] = __uint_as_float(raw.z & 0xffff0000u); v[6] = __uint_as_float(raw.w << 16); v[7] = __uint_as_float(raw.w & 0xffff0000u);
    u32x4 o;
    if (!rev) { o.x = pk2(v[0] * s[0], v[1] * s[1]); o.y = pk2(v[2] * s[2], v[3] * s[3]); o.z = pk2(v[4] * s[4], v[5] * s[5]); o.w = pk2(v[6] * s[6], v[7] * s[7]); }
    else      { o.x = pk2(v[7] * s[0], v[6] * s[1]); o.y = pk2(v[5] * s[2], v[4] * s[3]); o.z = pk2(v[3] * s[4], v[2] * s[5]); o.w = pk2(v[1] * s[6], v[0] * s[7]); }
    return __builtin_bit_cast(bf16x8v, o);
}

constexpr int DA_QS = 0, DA_KS = 17408, DA_KT = 34816, DA_VT = 53248, DA_AF = 71680, DA_AR = 89088, DA_TF = 106496, DA_TR = 115712, DA_SC = 124928;
constexpr int DA_RS = 272, DA_TS = 144;

DI void dnA_unit(const Fr& F, int unit) {
    const int tc = unit % 36, h = (unit / 36) & 3, b = unit / 144;
    const int row0 = (tc < 4) ? TL + b * CTXL + tc * 64 : b * SEQ + (tc - 4) * 64;
    LAS unsigned char* L = F.lds;
    LAS float* sc = (LAS float*)(L + DA_SC);
    int lane = F.lane, w = F.wave, r = lane & 31, hh = lane >> 5;
#define DN_RELAUNDER() do { int tz_ = threadIdx.x; asm volatile("" : "+v"(tz_)); lane = tz_ & 63; r = lane & 31; hh = lane >> 5; } while (0)
    {
        const bf16_t* P = WSP(bf16_t, A0_P); const float* cw = INP(10);
        const bool isc = tc < 4; const int Lq = isc ? CTXL : SEQ; const int t0 = (isc ? tc * 64 : (tc - 4) * 64) + w * 8, rowb = row0 + w * 8;
        unsigned praw[3][11];
#pragma unroll
        for (int s = 0; s < 3; ++s)
#pragma unroll
            for (int rr = 0; rr < 11; ++rr) { const int tl = t0 + rr - 2; praw[s][rr] = (tl >= 0 && tl < Lq) ? *(const unsigned*)(P + (size_t)(rowb + rr - 2) * NP0 + s * 512 + h * 128 + lane * 2) : 0u; }
#pragma unroll
        for (int s = 0; s < 3; ++s) {
            const int col = s * 512 + h * 128 + lane * 2;
            float w0[4], w1[4];
#pragma unroll
            for (int i = 0; i < 4; ++i) { w0[i] = cw[i * 1536 + col]; w1[i] = cw[i * 1536 + col + 1]; }
            float p0[11], p1[11];
#pragma unroll
            for (int rr = 0; rr < 11; ++rr) { p0[rr] = __uint_as_float(praw[s][rr] << 16); p1[rr] = __uint_as_float(praw[s][rr] & 0xffff0000u); }
#pragma unroll
            for (int j = 0; j < 8; ++j) {
                float a0 = w0[0] * p0[j] + w0[1] * p0[j + 1] + w0[2] * p0[j + 2] + w0[3] * p0[j + 3];
                float a1 = w1[0] * p1[j] + w1[1] * p1[j + 1] + w1[2] * p1[j + 2] + w1[3] * p1[j + 3];
                a0 = silu_(a0); a1 = silu_(a1);
                if (s < 2) { const float ss = wsum(a0 * a0 + a1 * a1); float rn = rsqrtf(ss + RMS_EPS); if (s == 0) rn *= 0.08838834764831845f; a0 *= rn; a1 *= rn; }
                const int i = w * 8 + j; const unsigned pk = pk2(a0, a1);
                if (s == 0) *(LAS unsigned*)(L + DA_QS + i * DA_RS + lane * 4) = pk;
                if (s == 1) { *(LAS unsigned*)(L + DA_KS + i * DA_RS + lane * 4) = pk;
                    *(LAS bf16_t*)(L + DA_KT + (2 * lane) * DA_TS + i * 2) = (bf16_t)(pk & 0xffff); *(LAS bf16_t*)(L + DA_KT + (2 * lane + 1) * DA_TS + i * 2) = (bf16_t)(pk >> 16); }
                if (s == 2) { *(LAS bf16_t*)(L + DA_VT + (2 * lane) * DA_TS + i * 2) = (bf16_t)(pk & 0xffff); *(LAS bf16_t*)(L + DA_VT + (2 * lane + 1) * DA_TS + i * 2) = (bf16_t)(pk >> 16); }
            }
        }
    }
    if (w < 2) {
        const int tok = w ? 63 - lane : lane; const float* gp = WSP(float, A0_GATES) + (size_t)(row0 + tok) * 16 + w * 8;
        float x = -expf(INP(11)[w * 4 + h]) * softplus_(gp[h] + INP(12)[w * 4 + h]);
#pragma unroll
        for (int off = 1; off < 64; off <<= 1) { const float y = __shfl_up(x, off); if (lane >= off) x += y; }
        sc[w * 64 + tok] = x;
        sc[128 + w * 64 + tok] = sigm(gp[4 + h]);
    }
    __syncthreads();
    DN_RELAUNDER();
    {
        const int which = w >> 2, mt = (w >> 1) & 1, nt = w & 1;
        f32x16 acc = zero16();
        const LAS unsigned char* bsrc = L + (which ? DA_QS : DA_KS);
#pragma unroll
        for (int ks = 0; ks < 8; ++ks) {
            const bf16x8v a = *(const LAS bf16x8v*)(L + DA_KS + (mt * 32 + r) * DA_RS + (ks * 16 + 8 * hh) * 2);
            const bf16x8v bb = *(const LAS bf16x8v*)(bsrc + (nt * 32 + r) * DA_RS + (ks * 16 + 8 * hh) * 2);
            acc = MFMA32(a, bb, acc);
        }
        if (which == 0) {
            const int j = nt * 32 + r; const float gfj = sc[j], grj = sc[64 + j];
            LAS float* Af = (LAS float*)(L + DA_AF); LAS float* Ar = (LAS float*)(L + DA_AR);
#pragma unroll
            for (int reg = 0; reg < 16; ++reg) { const int i = mt * 32 + crow(reg, hh); const float kk = acc[reg];
                Af[i * 68 + j] = (j < i) ? sc[128 + i] * kk * __expf(sc[i] - gfj) : 0.f;
                Ar[(63 - i) * 68 + (63 - j)] = (j > i) ? sc[192 + i] * kk * __expf(sc[64 + i] - grj) : 0.f; }
        } else {
            const int i = nt * 32 + r; const float gfi = sc[i], gri = sc[64 + i];
            const size_t cuf = ((size_t)((b * 4 + h) * 2 + 0) * 36 + tc), cur = ((size_t)((b * 4 + h) * 2 + 1) * 36 + ((tc < 4) ? 3 - tc : 4 + 35 - tc));
            unsigned char* attf = WSP(unsigned char, A0_ATT) + cuf * 8192; unsigned char* attr = WSP(unsigned char, A0_ATT) + cur * 8192;
#pragma unroll
            for (int g4 = 0; g4 < 4; ++g4) {
                const int j0 = mt * 32 + 8 * g4 + 4 * hh; float vf[4], vr[4];
#pragma unroll
                for (int e = 0; e < 4; ++e) { const int j = j0 + e; const float a = acc[4 * g4 + e];
                    vf[e] = (j <= i) ? a * __expf(gfi - sc[j]) : 0.f; vr[e] = (j >= i) ? a * __expf(gri - sc[64 + j]) : 0.f; }
                u32x2 wf; wf.x = pk2(vf[0], vf[1]); wf.y = pk2(vf[2], vf[3]);
                *(u32x2*)(attf + afrag_off(i, j0, 4)) = wf;
                u32x2 wr; wr.x = pk2(vr[3], vr[2]); wr.y = pk2(vr[1], vr[0]);
                *(u32x2*)(attr + afrag_off(63 - i, 60 - j0, 4)) = wr;
            }
        }
    }
    __syncthreads();
    DN_RELAUNDER();
    if (w < 2) {
        const LAS float* A = (const LAS float*)(L + (w ? DA_AR : DA_AF)); LAS unsigned char* T = L + (w ? DA_TR : DA_TF);
        float tcol[64];
        f32x4 av[2][16];
#pragma unroll
        for (int i = 0; i < 64; ++i) {
            if (i + 1 < 64) {
#pragma unroll
                for (int j4 = 0; j4 < (i + 1 + 3) / 4; ++j4) av[(i + 1) & 1][j4] = *(const LAS f32x4*)(A + (i + 1) * 68 + j4 * 4);
            }
            float s0 = (i == lane) ? 1.0f : 0.0f, s1 = 0.f, s2 = 0.f, s3 = 0.f;
#pragma unroll
            for (int j4 = 0; j4 < (i + 3) / 4; ++j4) { const f32x4 a4 = av[i & 1][j4];
                if (j4 * 4 + 0 < i) s0 -= a4[0] * tcol[j4 * 4 + 0];
                if (j4 * 4 + 1 < i) s1 -= a4[1] * tcol[j4 * 4 + 1];
                if (j4 * 4 + 2 < i) s2 -= a4[2] * tcol[j4 * 4 + 2];
                if (j4 * 4 + 3 < i) s3 -= a4[3] * tcol[j4 * 4 + 3]; }
            const float s = (s0 + s1) + (s2 + s3);
            tcol[i] = s;
            *(LAS bf16_t*)(T + i * DA_TS + lane * 2) = f2bf(s);
            asm volatile("" ::: "memory");
        }
    } else {
        for (int p = (w * 64 + lane) - 128; p < 4096; p += NTHR - 128) {
            const int d = p >> 11, kind = (p >> 10) & 1, q = p & 1023;
            const size_t cu = ((size_t)((b * 4 + h) * 2 + d) * 36 + (d ? ((tc < 4) ? 3 - tc : 4 + 35 - tc) : tc));
            const LAS float* gc = sc + d * 64;
            if (kind == 0) {
                const int ip = q >> 4, c8 = (q & 15) * 8, i = d ? 63 - ip : ip; const float e = __expf(gc[i]);
                const u32x4 raw = *(const LAS u32x4*)(L + DA_QS + i * DA_RS + c8 * 2); const float s8[8] = {e, e, e, e, e, e, e, e};
                *(bf16x8v*)(WSP(unsigned char, A0_WQ) + cu * 32768 + afrag_off(64 + ip, c8, 8)) = scale8(raw, s8, false);
            } else {
                const int dk = q >> 3, i8 = (q & 7) * 8; const float gl = d ? gc[0] : gc[63]; float s8[8];
#pragma unroll
                for (int e = 0; e < 8; ++e) { const int i = d ? 63 - (i8 + e) : i8 + e; s8[e] = __expf(gl - gc[i]); }
                const u32x4 raw = *(const LAS u32x4*)(L + DA_KT + dk * DA_TS + (d ? 56 - i8 : i8) * 2);
                *(bf16x8v*)(WSP(unsigned char, A0_KDT) + cu * 16384 + afrag_off(dk, i8, 4)) = scale8(raw, s8, d != 0);
            }
        }
    }
    __syncthreads();
#pragma unroll 1
    for (int d = 0; d < 2; ++d) {
        DN_RELAUNDER();
        const size_t cu = ((size_t)((b * 4 + h) * 2 + d) * 36 + (d ? ((tc < 4) ? 3 - tc : 4 + 35 - tc) : tc));
        const LAS unsigned char* T = L + (d ? DA_TR : DA_TF); const LAS float* gc = sc + d * 64; const LAS float* be = sc + 128 + d * 64;
        {
            const int mt = w >> 2, nt = w & 3; f32x16 acc = zero16();
#pragma unroll
            for (int ks = 0; ks < 4; ++ks) {
                const bf16x8v a = *(const LAS bf16x8v*)(T + (mt * 32 + r) * DA_TS + (ks * 16 + 8 * hh) * 2);
                const int jp = ks * 16 + 8 * hh; float s8[8];
#pragma unroll
                for (int e = 0; e < 8; ++e) s8[e] = be[d ? 63 - (jp + e) : jp + e];
                const u32x4 raw = *(const LAS u32x4*)(L + DA_VT + (nt * 32 + r) * DA_TS + (d ? 56 - jp : jp) * 2);
                acc = MFMA32(a, scale8(raw, s8, d != 0), acc);
            }
            float* uu = WSP(float, A0_UU) + cu * 8192 + ((size_t)(mt * 4 + nt) * 64 + lane) * 16;
#pragma unroll
            for (int g4 = 0; g4 < 4; ++g4) *(f32x4*)(uu + 4 * g4) = (f32x4){acc[4 * g4], acc[4 * g4 + 1], acc[4 * g4 + 2], acc[4 * g4 + 3]};
        }
        {
            const int mt = w >> 1, nt = w & 1; f32x16 acc = zero16();
#pragma unroll
            for (int ks = 0; ks < 4; ++ks) {
                const int jp = ks * 16 + 8 * hh; float s8[8];
#pragma unroll
                for (int e = 0; e < 8; ++e) { const int j = d ? 63 - (jp + e) : jp + e; s8[e] = be[j] * __expf(gc[j]); }
                const u32x4 raw = *(const LAS u32x4*)(L + DA_KT + (mt * 32 + r) * DA_TS + (d ? 56 - jp : jp) * 2);
                const bf16x8v bb = *(const LAS bf16x8v*)(T + (nt * 32 + r) * DA_TS + (ks * 16 + 8 * hh) * 2);
                acc = MFMA32(scale8(raw, s8, d != 0), bb, acc);
            }
            unsigned char* wq = WSP(unsigned char, A0_WQ) + cu * 32768; const int ip = nt * 32 + r;
#pragma unroll
            for (int g4 = 0; g4 < 4; ++g4) { const int k0 = mt * 32 + 8 * g4 + 4 * hh; u32x2 o; o.x = pk2(acc[4 * g4], acc[4 * g4 + 1]); o.y = pk2(acc[4 * g4 + 2], acc[4 * g4 + 3]);
                *(u32x2*)(wq + afrag_off(ip, k0, 8)) = o; }
        }
        if (F.tid == 0) WSP(float, A0_GL)[cu] = __expf(d ? gc[0] : gc[63]);
    }
    __syncthreads();
#undef DN_RELAUNDER
}

constexpr int DB_ST = 0, DB_VN = 34816;
DI void dnB_chain(const Fr& F, int unit) {
    const int d = unit & 1, h = (unit >> 1) & 3, b = unit >> 3;
    LAS unsigned char* L = F.lds; const int lane = F.lane, w = F.wave, r = lane & 31, hh = lane >> 5;
    const int mt = w >> 1, ntb = (w & 1) * 2;
    for (int i = F.tid; i < DB_VN / 16; i += NTHR) *(LAS u32x4*)(L + i * 16) = (u32x4){0u, 0u, 0u, 0u};
    f32x16 S0 = zero16(), S1 = zero16();
    const unsigned char* WQ = WSP(unsigned char, A0_WQ) + (size_t)unit * 36 * 32768; const unsigned char* KDT = WSP(unsigned char, A0_KDT) + (size_t)unit * 36 * 16384;
    const unsigned char* ATT = WSP(unsigned char, A0_ATT) + (size_t)unit * 36 * 8192; const float* UU = WSP(float, A0_UU) + (size_t)unit * 36 * 8192; const float* GL = WSP(float, A0_GL) + (size_t)unit * 36;
    float* OD = WSP(float, A0_OD) + (size_t)d * TT * 512;
    __syncthreads();
    bf16x8v wqf[8], kdf[4], atf[4]; f32x4 u0f[4], u1f[4]; float gl;
    {
        const unsigned char* wq = WQ + (size_t)(mt * 8) * 1024 + lane * 16; const unsigned char* kd = KDT + (size_t)(mt * 4) * 1024 + lane * 16;
        const unsigned char* at = ATT + (size_t)((mt & 1) * 4) * 1024 + lane * 16; const float* u0 = UU + ((size_t)((mt & 1) * 4 + ntb) * 64 + lane) * 16;
#pragma unroll
        for (int ks = 0; ks < 8; ++ks) wqf[ks] = *(const bf16x8v*)(wq + ks * 1024);
#pragma unroll
        for (int ks = 0; ks < 4; ++ks) { kdf[ks] = *(const bf16x8v*)(kd + ks * 1024); atf[ks] = *(const bf16x8v*)(at + ks * 1024); u0f[ks] = *(const f32x4*)(u0 + 4 * ks); u1f[ks] = *(const f32x4*)(u0 + 64 * 16 + 4 * ks); }
        gl = GL[0];
    }
#pragma unroll 1
    for (int n = 0; n < 36; ++n) {
        const int nn = (n + 1 < 36) ? n + 1 : n;
        const unsigned char* wq = WQ + (size_t)nn * 32768 + (size_t)(mt * 8) * 1024 + lane * 16;
        const unsigned char* kd = KDT + (size_t)nn * 16384 + (size_t)(mt * 4) * 1024 + lane * 16;
        const unsigned char* at = ATT + (size_t)nn * 8192 + (size_t)((mt & 1) * 4) * 1024 + lane * 16;
        const float* u0 = UU + (size_t)nn * 8192 + ((size_t)((mt & 1) * 4 + ntb) * 64 + lane) * 16;
        f32x16 P0 = zero16(), P1 = zero16();
#pragma unroll
        for (int ks = 0; ks < 8; ++ks) {
            const bf16x8v b0 = *(const LAS bf16x8v*)(L + DB_ST + (ntb * 32 + r) * 272 + (ks * 16 + 8 * hh) * 2);
            const bf16x8v b1 = *(const LAS bf16x8v*)(L + DB_ST + ((ntb + 1) * 32 + r) * 272 + (ks * 16 + 8 * hh) * 2);
            P0 = MFMA32(wqf[ks], b0, P0); P1 = MFMA32(wqf[ks], b1, P1);
        }
#pragma unroll
        for (int ks = 0; ks < 8; ++ks) wqf[ks] = *(const bf16x8v*)(wq + ks * 1024);
        if (w < 4) {
#pragma unroll
            for (int g4 = 0; g4 < 4; ++g4) {
                const f32x4 a0 = u0f[g4], a1 = u1f[g4]; const int i0 = mt * 32 + 8 * g4 + 4 * hh;
                u32x2 o0, o1; o0.x = pk2(a0[0] - P0[4 * g4], a0[1] - P0[4 * g4 + 1]); o0.y = pk2(a0[2] - P0[4 * g4 + 2], a0[3] - P0[4 * g4 + 3]);
                o1.x = pk2(a1[0] - P1[4 * g4], a1[1] - P1[4 * g4 + 1]); o1.y = pk2(a1[2] - P1[4 * g4 + 2], a1[3] - P1[4 * g4 + 3]);
                *(LAS u32x2*)(L + DB_VN + (ntb * 32 + r) * 144 + i0 * 2) = o0; *(LAS u32x2*)(L + DB_VN + ((ntb + 1) * 32 + r) * 144 + i0 * 2) = o1;
            }
#pragma unroll
            for (int g4 = 0; g4 < 4; ++g4) { u0f[g4] = *(const f32x4*)(u0 + 4 * g4); u1f[g4] = *(const f32x4*)(u0 + 64 * 16 + 4 * g4); }
        }
        __syncthreads();
#pragma unroll
        for (int i = 0; i < 16; ++i) { S0[i] *= gl; S1[i] *= gl; }
        gl = GL[nn];
#pragma unroll
        for (int ks = 0; ks < 4; ++ks) {
            const bf16x8v b0 = *(const LAS bf16x8v*)(L + DB_VN + (ntb * 32 + r) * 144 + (ks * 16 + 8 * hh) * 2);
            const bf16x8v b1 = *(const LAS bf16x8v*)(L + DB_VN + ((ntb + 1) * 32 + r) * 144 + (ks * 16 + 8 * hh) * 2);
            S0 = MFMA32(kdf[ks], b0, S0); S1 = MFMA32(kdf[ks], b1, S1);
            if (w >= 4) { P0 = MFMA32(atf[ks], b0, P0); P1 = MFMA32(atf[ks], b1, P1); }
        }
#pragma unroll
        for (int ks = 0; ks < 4; ++ks) { kdf[ks] = *(const bf16x8v*)(kd + ks * 1024); if (w >= 4) atf[ks] = *(const bf16x8v*)(at + ks * 1024); }
        if (w >= 4) {
            const int ip0 = (mt - 2) * 32 + 4 * hh; const long rstep = d ? -512 : 512;
            float* ob = OD + (size_t)row_of(b, d, n * 64 + ip0) * 512 + h * 128 + ntb * 32 + r;
#pragma unroll
            for (int reg = 0; reg < 16; ++reg) { float* o = ob + ((reg & 3) + 8 * (reg >> 2)) * rstep; o[0] = P0[reg]; o[32] = P1[reg]; }
        }
#pragma unroll
        for (int g4 = 0; g4 < 4; ++g4) { const int k0 = mt * 32 + 8 * g4 + 4 * hh;
            u32x2 o0, o1; o0.x = pk2(S0[4 * g4], S0[4 * g4 + 1]); o0.y = pk2(S0[4 * g4 + 2], S0[4 * g4 + 3]); o1.x = pk2(S1[4 * g4], S1[4 * g4 + 1]); o1.y = pk2(S1[4 * g4 + 2], S1[4 * g4 + 3]);
            *(LAS u32x2*)(L + DB_ST + (ntb * 32 + r) * 272 + k0 * 2) = o0; *(LAS u32x2*)(L + DB_ST + ((ntb + 1) * 32 + r) * 272 + k0 * 2) = o1; }
        __syncthreads();
    }
}
#ifndef MK_DN_NAIVE
#define MK_DN_NAIVE 0
#endif
DI void tconv(const Fr& F, const float* src, size_t sbs, int ld, int col0, int K, int N, bf16_t* dst, size_t dbs, int nb, int drs = 0, long u0 = 0, long u1 = -1, int vbid = -1, int vG = 0) {
    if (drs == 0) drs = K;
    LAS float* tile = (LAS float*)F.lds;
    const int tk = K / 64, tn = N / 256, per = tk * tn; const long total = (u1 >= 0) ? u1 : (long)nb * per;
    const int rr = F.tid >> 6, c4 = (F.tid & 63) * 4; const int ustep = (vbid >= 0) ? vG : F.G;
    f32x4 v[8];
    long u = u0 + ((vbid >= 0) ? vbid : F.bid);
    if (u < total) { const int b = (int)(u / per), r = (int)(u % per), kt = r / tn, nt_ = r % tn; const float* sp = src + (size_t)b * sbs + (size_t)(kt * 64) * ld + col0 + nt_ * 256;
#pragma unroll
        for (int h = 0; h < 8; ++h) v[h] = __builtin_nontemporal_load((const f32x4*)(sp + (size_t)(rr + 8 * h) * ld + c4)); }
    for (; u < total; u += ustep) {
        const int b = (int)(u / per), r = (int)(u % per), kt = r / tn, nt_ = r % tn;
#pragma unroll
        for (int h = 0; h < 8; ++h) { LAS float* tp = tile + (rr + 8 * h) * 257 + c4; tp[0] = v[h][0]; tp[1] = v[h][1]; tp[2] = v[h][2]; tp[3] = v[h][3]; }
        __syncthreads();
        const long un = u + ustep;
        if (un < total) { const int b2 = (int)(un / per), r2 = (int)(un % per), kt2 = r2 / tn, nt2 = r2 % tn; const float* sp = src + (size_t)b2 * sbs + (size_t)(kt2 * 64) * ld + col0 + nt2 * 256;
#pragma unroll
            for (int h = 0; h < 8; ++h) v[h] = __builtin_nontemporal_load((const f32x4*)(sp + (size_t)(rr + 8 * h) * ld + c4)); }
        {
#pragma unroll
            for (int q = 0; q < 4; ++q) { const int n = (F.tid >> 3) + 64 * q, k8 = (F.tid & 7) * 8; float x[8];
#pragma unroll
                for (int j = 0; j < 8; ++j) x[j] = tile[(k8 + j) * 257 + n];
                u32x4 w; w.x = pk2(x[0], x[1]); w.y = pk2(x[2], x[3]); w.z = pk2(x[4], x[5]); w.w = pk2(x[6], x[7]);
                *(u32x4*)(dst + (size_t)b * dbs + (size_t)(nt_ * 256 + n) * drs + kt * 64 + k8) = w; } }
        __syncthreads();
    }
}

#ifndef MK_BG_CONV
#define MK_BG_CONV 0
#endif
constexpr int TQ_PER_LAYER = 32 * 768, TQ_TOTAL = 2 * TQ_PER_LAYER;
DI void conv_chunk_wave(const Fr& F, int c, LAS float* tile  ) {
    const int l = c / TQ_PER_LAYER, r = c % TQ_PER_LAYER, e = r / 768, q = r % 768; const int lane = F.lane;
    const bool is2 = q >= 512; const int qq = is2 ? q - 512 : q; const int N = is2 ? DM : 2048; const int nts = N / 64;
    const int kt = qq / nts, nt_ = qq % nts;
    const float* src = (is2 ? INP(38) + ((size_t)l * 32 + e) * DM * DM : INP(36) + ((size_t)l * 32 + e) * DM * 2048) + (size_t)(kt * 64) * N + nt_ * 64;
    bf16_t* dst = (is2 ? WSP(bf16_t, WS_WM2) + ((size_t)l * 32 + e) * DM * DM : WSP(bf16_t, WS_WM1) + ((size_t)l * 32 + e) * 2048 * DM) + (size_t)(nt_ * 64) * DM + kt * 64;
    const int rs = lane >> 4, c4 = (lane & 15) * 4;
    f32x4 v[16];
#pragma unroll
    for (int j = 0; j < 16; ++j) v[j] = __builtin_nontemporal_load((const f32x4*)(src + (size_t)(rs + 4 * j) * N + c4));
#pragma unroll
    for (int j = 0; j < 16; ++j) { LAS float* tp = tile + (rs + 4 * j) * 65 + c4; tp[0] = v[j][0]; tp[1] = v[j][1]; tp[2] = v[j][2]; tp[3] = v[j][3]; }
#pragma unroll
    for (int j = 0; j < 8; ++j) { const int n = (lane >> 3) + 8 * j, k8 = (lane & 7) * 8; float x[8];
#pragma unroll
        for (int i = 0; i < 8; ++i) x[i] = tile[(k8 + i) * 65 + n];
        u32x4 w; w.x = pk2(x[0], x[1]); w.y = pk2(x[2], x[3]); w.z = pk2(x[4], x[5]); w.w = pk2(x[6], x[7]);
        *(u32x4*)(dst + (size_t)n * DM + k8) = w; }
}
DI int conv_claim(const Fr& F) { int c = 0; if (F.lane == 0) c = (int)__hip_atomic_fetch_add(WSP(unsigned, WS_CTL) + CW_TQ, 1u, __ATOMIC_RELAXED, __HIP_MEMORY_SCOPE_AGENT); return __builtin_amdgcn_readfirstlane(c); }
DI void conv_drain(const Fr& F, int upto) {
    LAS float* tile = (LAS float*)F.lds + F.wave * (64 * 65);
    for (;;) { const int c = conv_claim(F); if (c >= TQ_TOTAL) break; conv_chunk_wave(F, c, tile); if (c >= upto) break; }
}
DI void xcd_barrier_work(const XcdBarrier& b, const Fr& F) {
    asm volatile("s_waitcnt vmcnt(0)" ::: "memory");
    if (threadIdx.x == 0) b.st[2] = 0u;
    __syncthreads();
    if (F.wave == 0) {
        if (threadIdx.x == 0) {
            unsigned* bar = b.bar;
            __builtin_amdgcn_s_waitcnt(0);
            unsigned nloc = b.st[0], nx = b.st[1];
            if (nloc == 0u) { xcd_barrier_complete(bar, b.x, nloc, nx); b.st[0] = nloc; b.st[1] = nx; }
            const unsigned old = xb_add(&bar[XB_XSUB(b.x)], 1u);
            const unsigned gen = old / nloc;
            if (old + 1u == (gen + 1u) * nloc) {
                __builtin_amdgcn_fence(__ATOMIC_RELEASE, "agent");
                asm volatile("s_waitcnt vmcnt(0)" ::: "memory");
                const unsigned og = xb_add(&bar[XB_TOP], 1u);
                const unsigned tg = og / nx;
                if (og + 1u == (tg + 1u) * nx) xb_add(&bar[XB_TOPGEN], 1u);
                else XB_SPIN(xb_ld(&bar[XB_TOPGEN]) == tg, bar);
                __builtin_amdgcn_fence(__ATOMIC_ACQUIRE, "agent");
                xb_add(&bar[XB_XGEN(b.x)], 1u);
                asm volatile("s_waitcnt vmcnt(0)" ::: "memory");
            } else {
                XB_SPIN(xb_ld(&bar[XB_XGEN(b.x)]) == gen, bar);
                __builtin_amdgcn_fence(__ATOMIC_ACQUIRE, "agent");
                asm volatile("s_waitcnt vmcnt(0)" ::: "memory");
            }
            b.st[2] = 1u;
        }
    } else {
        LAS float* tile = (LAS float*)F.lds + F.wave * (64 * 65);
        while (b.st[2] == 0u) { const int c = conv_claim(F); if (c >= TQ_TOTAL) break; conv_chunk_wave(F, c, tile); }
    }
    __syncthreads();
}

DI void tconv8(const Fr& F, const float* src, size_t sbs, int ld, int K, int N, unsigned char* dst, size_t dbs, int nb, float scale, long u0, long u1, int vbid, int vG) {
    LAS float* tile = (LAS float*)F.lds;
    const int tk = K / 128, tn = N / 128, per = tk * tn; const long total = (u1 >= 0) ? u1 : (long)nb * per;
    const int rr = F.tid >> 5, c4 = (F.tid & 31) * 4; const int ustep = (vbid >= 0) ? vG : F.G;
    f32x4 v[8];
    long u = u0 + ((vbid >= 0) ? vbid : F.bid);
    if (u < total) { const int b = (int)(u / per), r = (int)(u % per), kt = r / tn, nt_ = r % tn; const float* sp = src + (size_t)b * sbs + (size_t)(kt * 128) * ld + nt_ * 128;
#pragma unroll
        for (int h = 0; h < 8; ++h) v[h] = __builtin_nontemporal_load((const f32x4*)(sp + (size_t)(rr + 16 * h) * ld + c4)); }
    for (; u < total; u += ustep) {
        const int b = (int)(u / per), r = (int)(u % per), kt = r / tn, nt_ = r % tn;
#pragma unroll
        for (int h = 0; h < 8; ++h) { LAS float* tp = tile + (rr + 16 * h) * 129 + c4; tp[0] = v[h][0]; tp[1] = v[h][1]; tp[2] = v[h][2]; tp[3] = v[h][3]; }
        __syncthreads();
        const long un = u + ustep;
        if (un < total) { const int b2 = (int)(un / per), r2 = (int)(un % per), kt2 = r2 / tn, nt2 = r2 % tn; const float* sp = src + (size_t)b2 * sbs + (size_t)(kt2 * 128) * ld + nt2 * 128;
#pragma unroll
            for (int h = 0; h < 8; ++h) v[h] = __builtin_nontemporal_load((const f32x4*)(sp + (size_t)(rr + 16 * h) * ld + c4)); }
#pragma unroll
        for (int q = 0; q < 2; ++q) { const int n = (F.tid >> 3) + 64 * q, k16 = (F.tid & 7) * 16; float x[16];
#pragma unroll
            for (int j = 0; j < 16; ++j) x[j] = tile[(k16 + j) * 129 + n] * scale;
            u32x4 w; w.x = pk4_fp8(x[0], x[1], x[2], x[3]); w.y = pk4_fp8(x[4], x[5], x[6], x[7]); w.z = pk4_fp8(x[8], x[9], x[10], x[11]); w.w = pk4_fp8(x[12], x[13], x[14], x[15]);
            *(u32x4*)(dst + (size_t)b * dbs + (size_t)(nt_ * 128 + n) * K + kt * 128 + k16) = w; }
        __syncthreads();
    }
}
constexpr int L1W1_A = 1344, L1W1_B = 2304, L1W2_A = 1536;
DI void moe_w_l1_part(const Fr& F, int which, long u0, long u1, int vbid, int vG) {
#if MK_FP8_L1
    if (which == 0) tconv8(F, INP(36) + (size_t)32 * DM * 2048, (size_t)DM * 2048, 2048, DM, 2048, WSP(unsigned char, WS_WM1) + (size_t)32 * 2048 * DM * 2, (size_t)2048 * DM, 32, W1_F8S, u0, u1, vbid, vG);
    else tconv8(F, INP(38) + (size_t)32 * DM * DM, (size_t)DM * DM, DM, DM, DM, WSP(unsigned char, WS_WM2) + (size_t)32 * DM * DM * 2, (size_t)DM * DM, 32, W2_F8S, u0, u1, vbid, vG);
#else
    if (which == 0) tconv(F, INP(36) + (size_t)32 * DM * 2048, (size_t)DM * 2048, 2048, 0, DM, 2048, WSP(bf16_t, WS_WM1) + (size_t)32 * 2048 * DM, (size_t)2048 * DM, 32, 0, u0, u1, vbid, vG);
    else tconv(F, INP(38) + (size_t)32 * DM * DM, (size_t)DM * DM, DM, 0, DM, DM, WSP(bf16_t, WS_WM2) + (size_t)32 * DM * DM, (size_t)DM * DM, 32, 0, u0, u1, vbid, vG);
#endif
}
#ifndef MK_P0_MASK
#define MK_P0_MASK 31
#endif
#ifndef MK_P0_TWICE
#define MK_P0_TWICE 0
#endif
DI void p0_prologue(const Fr& F) {
    for (int rep_ = 0; rep_ < ((MK_P0_TWICE & 2) ? 2 : 1); ++rep_) {
    for (int tix = F.bid; tix < 544; tix += F.G) {
        if (tix < 128)      tconv(F, INP(8), 0, EVEN_IN, 0, DM, 2048, WSP(bf16_t, WS_WEVIN), 0, 1, 0, tix, tix + 1, 0, 1);
        else if (tix < 224) tconv(F, INP(8), 0, EVEN_IN, HY_COL, DM, 1536, WSP(bf16_t, WS_WEVIN) + (size_t)2048 * DM, 0, 1, 0, tix - 128, tix - 127, 0, 1);
        else if (tix < 288) tconv(F, INP(9), 0, DM, 0, MIXW, DM, WSP(bf16_t, WS_WEVOUT), 0, 1, 0, tix - 224, tix - 223, 0, 1);
        else if (tix < 416) tconv(F, INP(23), 0, 2048, 0, DM, 2048, WSP(bf16_t, WS_WODIN), 0, 1, 0, tix - 288, tix - 287, 0, 1);
        else if (tix < 480) tconv(F, INP(32), 0, DM, 0, DM, DM, WSP(bf16_t, WS_WODOUT), 0, 1, 0, tix - 416, tix - 415, 0, 1);
        else {
            const int th = (tix - 480) >> 2, kt = (tix - 480) & 3, g = th >> 3, d = (th >> 2) & 1, h = th & 3;
            tconv(F, (g ? INP(29) : INP(27)) + (size_t)(d * 4 + h) * 65536, 0, 256, 0, 256, 256, WSP(bf16_t, WS_WLRU) + ((size_t)(d * 4 + h) * 512 + g) * 256, 0, 1, 512, kt, kt + 1, 0, 1); }
    }
    for (int i = F.bid * NTHR + F.tid; i < 4096; i += F.G * NTHR) { const int g = i & 1, j = (i >> 1) & 255, h = (i >> 9) & 3, d = i >> 11;
        WSP(float, WS_BLRU)[i] = (g ? INP(30) : INP(28))[d * DM + h * 256 + j];
        if (i < 2048) WSP(float, WS_BLRU)[4096 + i] = -8.0f * softplus_(INP(31)[i]); }
    }
    for (int i = F.bid * NTHR + F.tid; i < 2 * DM * NEXP; i += F.G * NTHR) { const int l = i >> 15, k = (i >> 5) & 1023, e = i & 31; WSP(float, WS_RWT)[(size_t)l * 32768 + e * DM + k] = INP(34)[i]; }
    for (int i = F.bid * NTHR + F.tid; i < 16 * DM; i += F.G * NTHR) { const int k = i >> 4, g = i & 15; WSP(float, WS_WGT)[g * DM + k] = INP(8)[(size_t)k * EVEN_IN + DN_GATE_COL + g]; }
#if !MK_BG_CONV
#if MK_FP8_L0
    tconv8(F, INP(36), (size_t)DM * 2048, 2048, DM, 2048, WSP(unsigned char, WS_WM1), (size_t)2048 * DM, 32, W1_F8S, 0, -1, -1, 0);
    tconv8(F, INP(38), (size_t)DM * DM, DM, DM, DM, WSP(unsigned char, WS_WM2), (size_t)DM * DM, 32, W2_F8S, 0, -1, -1, 0);
#else
    tconv(F, INP(36), (size_t)DM * 2048, 2048, 0, DM, 2048, WSP(bf16_t, WS_WM1), (size_t)2048 * DM, 32);
    tconv(F, INP(38), (size_t)DM * DM, DM, 0, DM, DM, WSP(bf16_t, WS_WM2), (size_t)DM * DM, 32);
#endif
    if (F.G == 256) { moe_w_l1_part(F, 0, L1W1_B, 4096, F.bid, F.G); moe_w_l1_part(F, 1, L1W2_A, 2048, F.bid, F.G); } else { moe_w_l1_part(F, 0, 0, 4096, F.bid, F.G); moe_w_l1_part(F, 1, 0, 2048, F.bid, F.G); }
#endif
    for (int rep_ = 0; rep_ < ((MK_P0_TWICE & 4) ? 2 : 1); ++rep_)
    if (MK_P0_MASK & 4) {
        LAS float* sl = (LAS float*)F.lds;
        LAS float* part = sl + 9 * 1024;
        for (int i = F.tid; i < 9 * 1024; i += NTHR) { const int r = i >> 10, k = i & 1023; const float v = (r < 8) ? INP(1)[r * DM + k] : INP(3)[k]; sl[i] = silu_(v); }
        __syncthreads();
        float* MOD = WSP(float, WS_MOD);
        for (int u = F.bid; u < 192; u += F.G) {
            const int l = u / 96, n0 = (u % 96) * 64;
            const float* W = INP(4) + (size_t)l * DM * 6144 + n0 + F.lane;
            float acc[9];
#pragma unroll
            for (int r = 0; r < 9; ++r) acc[r] = 0.f;
#pragma unroll 16
            for (int k = F.wave * 128; k < F.wave * 128 + 128; ++k) { const float w = W[(size_t)k * 6144];
#pragma unroll
                for (int r = 0; r < 9; ++r) acc[r] += sl[r * 1024 + k] * w; }
#pragma unroll
            for (int r = 0; r < 9; ++r) part[(F.wave * 9 + r) * 64 + F.lane] = acc[r];
            __syncthreads();
            for (int i = F.tid; i < 9 * 64; i += NTHR) { const int r = i >> 6, ln = i & 63; float s = INP(5)[(size_t)l * 6144 + n0 + ln];
#pragma unroll
                for (int w = 0; w < 8; ++w) s += part[(w * 9 + r) * 64 + ln];
                MOD[((size_t)l * 9 + r) * 6144 + n0 + ln] = s; }
            __syncthreads();
        }
    }
    if (MK_P0_MASK & 8) {
        float* POS = WSP(float, WS_POS);
        for (int i = F.bid * NTHR + F.tid; i < SEQ * DM; i += F.G * NTHR) {
            const int t = i >> 10, d = i & 1023, q = d >> 8, fi = d & 255;
            const float omega = 1.0f / powf(10000.0f, (float)fi / 256.0f);
            const float p = (q < 2) ? (float)(t >> 6) : (float)(t & 63);
            const float ang = p * omega;
            POS[i] = (q & 1) ? cosf(ang) : sinf(ang);
        }
    }
    for (int rep_ = 0; rep_ < ((MK_P0_TWICE & 1) ? 2 : 1); ++rep_)
    if (MK_P0_MASK & 16) {
        const int f = F.lane; const float fr = INP(21)[f];
        for (int u = F.gwave; u < SEQ + CTXL; u += F.nwaves) {
            const bool isc = u >= SEQ; const int L = isc ? CTXL : SEQ, i = isc ? u - SEQ : u;
            const float t = (float)i / (float)(L - 1), wpos = 6.283185307179586f * (float)i / (float)L;
            float zv = t;
            if (f >= 1 && f < 33) { const float fb = 1e-4f + (float)((f - 1) & 15) * ((15.0f - 1e-4f) / 15.0f); zv = (f < 17) ? cosf(fb * wpos) : -sinf(fb * wpos); }
            float s = INP(17)[f];
#pragma unroll 11
            for (int e = 0; e < 33; ++e) s += __shfl(zv, e) * INP(16)[e * 64 + f];
            float hcur = sinf(fr * s);
#pragma unroll 1
            for (int ly = 0; ly < 2; ++ly) { float s2 = INP(19)[ly * 64 + f];
#pragma unroll 16
                for (int e = 0; e < 64; ++e) s2 += __shfl(hcur, e) * INP(18)[ly * 4096 + e * 64 + f];
                hcur = sinf(fr * s2); }
            WSP(float, WS_HID)[(size_t)u * 64 + f] = hcur;
        }
    }
}
DI void hy_filter_out(const Fr& F) {
    LAS float* wsl = (LAS float*)F.lds;
    const float MIN_DECAY = -3.0701134573253942f, MAX_DECAY = -15.350567286626972f;
    for (int u = F.bid; u < 128; u += F.G) {
        __syncthreads();
        { const int g = F.tid >> 3, j = F.tid & 7; wsl[g * 8 + j] = INP(20)[g * 1024 + u * 8 + j]; }
        __syncthreads();
        const float* HID = WSP(float, WS_HID);
        for (int lg = F.tid; lg < SEQ + CTXL; lg += NTHR) {
            const bool isc = lg >= SEQ; const int L = isc ? CTXL : SEQ, i = isc ? lg - SEQ : lg; const float t = (float)i / (float)(L - 1);
            f32x4 hv[16];
#pragma unroll
            for (int q = 0; q < 16; ++q) hv[q] = *(const f32x4*)(HID + (size_t)lg * 64 + q * 4);
            f32x4 a0 = (f32x4){0.f, 0.f, 0.f, 0.f}, a1 = a0;
#pragma unroll
            for (int q = 0; q < 16; ++q)
#pragma unroll
                for (int e = 0; e < 4; ++e) { const LAS f32x4* wp = (const LAS f32x4*)(wsl + (q * 4 + e) * 8); a0 += wp[0] * hv[q][e]; a1 += wp[1] * hv[q][e]; if (e == 3) asm volatile("" ::: "memory"); }
#pragma unroll
            for (int j = 0; j < 8; ++j) { const int col = u * 8 + j, c = col & 511; const float delta = fabsf(MIN_DECAY + (float)c * ((MAX_DECAY - MIN_DECAY) / 511.0f));
                const float v = (j < 4 ? a0[j & 3] : a1[j & 3]) * expf(-t * delta);
                float* dst = (col < 512) ? (isc ? WSP(float, WS_HFC) : WSP(float, WS_HFL)) : (isc ? WSP(float, WS_HBC) : WSP(float, WS_HBL));
                dst[(size_t)c * L + i] = v; }
        }
    }
    __syncthreads();
}

DI void p1_mod0(const Fr& F) {
    hy_filter_out(F);
    LAS float* wgt = (LAS float*)F.lds;
    { const f32x4* src = WSP(f32x4, WS_WGT);
#pragma unroll
      for (int it = 0; it < 8; ++it) *(LAS f32x4*)(wgt + (F.tid + it * NTHR) * 4) = src[F.tid + it * NTHR]; }
    __syncthreads();
    const float* MOD = WSP(float, WS_MOD); const float* POS = WSP(float, WS_POS);
    bf16_t* U = WSP(bf16_t, A0_U); float* GATES = WSP(float, A0_GATES);
    for (int row = F.gwave; row < TT; row += F.nwaves) {
        const bool isc = row >= TL; const int b = isc ? (row - TL) >> 8 : row >> 11; const int t = isc ? 0 : (row & 2047);
        const float* xin = isc ? INP(2) + (size_t)(row - TL) * DM : INP(0) + (size_t)row * DM;
        const float* md = MOD + (size_t)(isc ? 8 : b) * 6144;
        f32x4 xv[4], pv[4], shv[4], scv[4];
#pragma unroll
        for (int i = 0; i < 4; ++i) { const int k = i * 256 + F.lane * 4; xv[i] = *(const f32x4*)(xin + k); shv[i] = *(const f32x4*)(md + k); scv[i] = *(const f32x4*)(md + 1024 + k);
            pv[i] = isc ? (f32x4){0.f, 0.f, 0.f, 0.f} : *(const f32x4*)(POS + (size_t)t * DM + k); }
        float ga[16];
#pragma unroll
        for (int g = 0; g < 16; ++g) ga[g] = 0.f;
#pragma unroll
        for (int i = 0; i < 4; ++i) {
            const int k = i * 256 + F.lane * 4;
            const f32x4 u = xv[i] * (scv[i] + 1.0f) + shv[i] + pv[i];
            u32x2 w; w.x = pk2(u[0], u[1]); w.y = pk2(u[2], u[3]);
            *(u32x2*)(U + (size_t)row * DM + k) = w;
#pragma unroll
            for (int g = 0; g < 16; ++g) { const f32x4 wv = *(const LAS f32x4*)(wgt + g * 1024 + k); ga[g] += u[0] * wv[0] + u[1] * wv[1] + u[2] * wv[2] + u[3] * wv[3]; }
            asm volatile("" ::: "memory");
        }
#define RS16(N, OFF) { const bool up = (F.lane & (OFF)) != 0; _Pragma("unroll") for (int g = 0; g < (N); ++g) { const float kp = up ? ga[g + (N)] : ga[g], sd = up ? ga[g] : ga[g + (N)]; ga[g] = kp + __shfl_xor(sd, (OFF)); } }
        RS16(8, 32) RS16(4, 16) RS16(2, 8) RS16(1, 4)
#undef RS16
        float tot = ga[0]; tot += __shfl_xor(tot, 2); tot += __shfl_xor(tot, 1);
        if ((F.lane & 3) == 0) GATES[(size_t)row * 16 + (F.lane >> 2)] = tot;
    }
}

#ifndef MK_PREP_TWICE
#define MK_PREP_TWICE 0
#endif
DI void p3_prep(const Fr& F) {
#if !MK_DN_NAIVE
    __syncthreads();
    for (int u = F.bid; u < NB * 4 * 36; u += F.G) dnA_unit(F, u);
#if MK_PREP_TWICE == 1
    for (int u = F.bid; u < NB * 4 * 36; u += F.G) dnA_unit(F, u);
#endif
#endif
    const bf16_t* P = WSP(bf16_t, A0_P); const float* GATES = WSP(float, A0_GATES);
    float* QN = WSP(float, A0_QN); float* KN = WSP(float, A0_KN); float* VV = WSP(float, A0_VV);
    float* GG = WSP(float, A0_GG); float* BB = WSP(float, A0_BB);
    const float* cw = INP(10);
#if MK_DN_NAIVE
    for (int u = F.bid; u < (TT / 64) * 4; u += F.G) {
        const int rt = u >> 2, h = u & 3, row0 = rt * 64 + F.wave * 8; const bool isc = row0 >= TL; const int L = isc ? CTXL : SEQ;
        const int t0 = isc ? ((row0 - TL) & 255) : (row0 & 2047);
#pragma unroll 1
        for (int s = 0; s < 3; ++s) {
            const int col = s * 512 + h * 128 + F.lane * 2;
            float w0[4], w1[4];
#pragma unroll
            for (int i = 0; i < 4; ++i) { w0[i] = cw[i * 1536 + col]; w1[i] = cw[i * 1536 + col + 1]; }
            float p0[11], p1[11];
#pragma unroll
            for (int rr = 0; rr < 11; ++rr) { const int tl = t0 + rr - 2; unsigned pv = 0u; if (tl >= 0 && tl < L) pv = *(const unsigned*)(P + (size_t)(row0 + rr - 2) * NP0 + col);
                p0[rr] = __uint_as_float(pv << 16); p1[rr] = __uint_as_float(pv & 0xffff0000u); }
            bf16_t* dstb = (s == 0 ? WSP(bf16_t, A0_QB) : (s == 1 ? WSP(bf16_t, A0_KB) : WSP(bf16_t, A0_VB3))) + (size_t)row0 * 512 + h * 128 + F.lane * 2;
#pragma unroll
            for (int j = 0; j < 8; ++j) {
                float a0 = w0[0] * p0[j] + w0[1] * p0[j + 1] + w0[2] * p0[j + 2] + w0[3] * p0[j + 3];
                float a1 = w1[0] * p1[j] + w1[1] * p1[j + 1] + w1[2] * p1[j + 2] + w1[3] * p1[j + 3];
                a0 = silu_(a0); a1 = silu_(a1);
                if (s < 2) { const float ss = wsum(a0 * a0 + a1 * a1); float r = rsqrtf(ss + RMS_EPS); if (s == 0) r *= 0.08838834764831845f; a0 *= r; a1 *= r; }
#if MK_DN_NAIVE
                { float* dst = (s == 0 ? QN : (s == 1 ? KN : VV)) + (size_t)(row0 + j) * 512 + h * 128 + F.lane * 2; *(f32x2*)dst = (f32x2){a0, a1}; }
#endif
                *(unsigned*)(dstb + (size_t)j * 512) = pk2(a0, a1);
            }
        }
        if (F.lane < 16) { const int d = F.lane & 1, row = row0 + (F.lane >> 1);
            const float gd = GATES[(size_t)row * 16 + d * 8 + h], gb = GATES[(size_t)row * 16 + d * 8 + 4 + h];
            GG[((size_t)d * TT + row) * 4 + h] = -expf(INP(11)[d * 4 + h]) * softplus_(gd + INP(12)[d * 4 + h]);
            BB[((size_t)d * TT + row) * 4 + h] = sigm(gb); }
    }
#endif
    float* VX = WSP(float, A0_VX); float* X0 = WSP(float, A0_X0);
    const float* hw = INP(14); const float* hb = INP(15);
    LAS bf16_t* tile = (LAS bf16_t*)F.lds;
    __syncthreads();
    const bool bal = (F.G == 256) && !MK_DN_NAIVE; const int hu0 = bal ? (F.bid < 128 ? F.bid : 384 + (F.bid - 128)) : F.bid, hu1 = bal ? (F.bid < 128 ? 384 : 1152) : (TT / 64) * 4, hus = bal ? 128 : F.G;
    for (int u = hu0; u < hu1; u += hus) {
        const int rt = u >> 2, ct = u & 3, row0 = rt * 64; const bool isc = row0 >= TL; const int L = isc ? CTXL : SEQ;
        const int t0 = isc ? ((row0 - TL) & 255) : (row0 & 2047);
        const int cl = F.tid & 63, rg = F.tid >> 6, c = ct * 128 + cl * 2;
        unsigned praw[3][10];
#pragma unroll
        for (int rr = 0; rr < 10; ++rr) { const int tl = t0 + rg * 8 + rr - 1; const bool ok = tl >= 0 && tl < L;
#pragma unroll
            for (int sg = 0; sg < 3; ++sg) praw[sg][rr] = ok ? *(const unsigned*)(P + (size_t)(row0 + rg * 8 + rr - 1) * NP0 + 2048 + sg * 512 + c) : 0u; }
        f32x2 w3[3][3], b3[3];
#pragma unroll
        for (int sg = 0; sg < 3; ++sg) { b3[sg] = *(const f32x2*)(hb + sg * 512 + c);
#pragma unroll
            for (int j = 0; j < 3; ++j) w3[sg][j] = *(const f32x2*)(hw + j * 1536 + sg * 512 + c); }
#pragma unroll
        for (int j = 0; j < 8; ++j) { f32x2 r3[3];
#pragma unroll
            for (int sg = 0; sg < 3; ++sg) { r3[sg] = b3[sg];
#pragma unroll
                for (int q = 0; q < 3; ++q) { const unsigned pw = praw[sg][j + q]; r3[sg] += w3[sg][q] * (f32x2){__uint_as_float(pw << 16), __uint_as_float(pw & 0xffff0000u)}; } }
            const size_t o = (size_t)(row0 + rg * 8 + j) * 512 + c; const f32x2 vx = r3[2] * r3[1];
            *(f32x2*)(X0 + o) = r3[0]; *(f32x2*)(VX + o) = vx;
            const unsigned pk = pk2(vx[0], vx[1]);
            tile[(cl * 2) * 72 + rg * 8 + j] = (bf16_t)(pk & 0xffffu); tile[(cl * 2 + 1) * 72 + rg * 8 + j] = (bf16_t)(pk >> 16); }
        __syncthreads();
        { const int c2 = F.tid >> 2, seg = F.tid & 3; const u32x4 v0 = *(const LAS u32x4*)(tile + c2 * 72 + seg * 16), v1 = *(const LAS u32x4*)(tile + c2 * 72 + seg * 16 + 8);
          bf16_t* dst = isc ? WSP(bf16_t, A0_VXTC) + (size_t)(ct * 128 + c2) * TC + (row0 - TL) : WSP(bf16_t, A0_VXTL) + (size_t)(ct * 128 + c2) * TL + row0;
          *(u32x4*)(dst + seg * 16) = v0; *(u32x4*)(dst + seg * 16 + 8) = v1; }
        __syncthreads();
    }
}

DI void dn_chain(const Fr& F, int unit) {
    const int b = unit >> 3, h = (unit >> 1) & 3, d = unit & 1;
    const float* QN = WSP(float, A0_QN); const float* KN = WSP(float, A0_KN); const float* VV = WSP(float, A0_VV);
    const float* GG = WSP(float, A0_GG) + (size_t)d * TT * 4; const float* BB = WSP(float, A0_BB) + (size_t)d * TT * 4;
    float* OD = WSP(float, A0_OD) + (size_t)d * TT * 512;
    LAS float* qs = (LAS float*)F.lds; LAS float* ks = qs + 128; LAS float* vs = ks + 128; LAS float* red1 = vs + 128; LAS float* red2 = red1 + 512; LAS float* scal = red2 + 512;
    const int dv = F.tid & 127, kb = F.tid >> 7;
    float S[32];
#pragma unroll
    for (int i = 0; i < 32; ++i) S[i] = 0.f;
    for (int p = 0; p < CTXL + SEQ; ++p) {
        const int row = row_of(b, d, p);
        if (F.tid < 128) qs[F.tid] = QN[(size_t)row * 512 + h * 128 + F.tid];
        else if (F.tid < 256) ks[F.tid - 128] = KN[(size_t)row * 512 + h * 128 + F.tid - 128];
        else if (F.tid < 384) vs[F.tid - 256] = VV[(size_t)row * 512 + h * 128 + F.tid - 256];
        else if (F.tid == 384) scal[0] = expf(GG[(size_t)row * 4 + h]);
        else if (F.tid == 385) scal[1] = BB[(size_t)row * 4 + h];
        __syncthreads();
        float part = 0.f;
#pragma unroll
        for (int i = 0; i < 32; ++i) part += ks[kb * 32 + i] * S[i];
        red1[kb * 128 + dv] = part;
        __syncthreads();
        const float kS = red1[dv] + red1[128 + dv] + red1[256 + dv] + red1[384 + dv];
        const float eg = scal[0], beta = scal[1];
        const float delta = beta * (vs[dv] - eg * kS);
        float op = 0.f;
#pragma unroll
        for (int i = 0; i < 32; ++i) { S[i] = eg * S[i] + ks[kb * 32 + i] * delta; op += qs[kb * 32 + i] * S[i]; }
        red2[kb * 128 + dv] = op;
        __syncthreads();
        if (kb == 0) OD[(size_t)row * 512 + h * 128 + dv] = red2[dv] + red2[128 + dv] + red2[256 + dv] + red2[384 + dv];
    }
    __syncthreads();
}
constexpr int HY_RS_LAT = 2 * (2 * SEQ + 64) + 64, HY_RS_CTX = 2 * (2 * CTXL + 64) + 64;
DI void hy_mfma_unit(const Fr& F, int c) {
    typedef short bf16x8h __attribute__((ext_vector_type(8)));
    LAS unsigned char* Lm = F.lds;
    const int lane = F.lane, w = F.wave, m = lane & 15, q = lane >> 4, ml = m & 7, mh = m >> 3, n8 = lane & 7;
#pragma unroll 1
    for (int kind = 0; kind < 2; ++kind) {
        const int L = kind ? CTXL : SEQ, RS = kind ? HY_RS_CTX : HY_RS_LAT;
        const float* HFt = (kind ? WSP(float, WS_HFC) : WSP(float, WS_HFL)) + (size_t)c * L; const float* HBt = (kind ? WSP(float, WS_HBC) : WSP(float, WS_HBL)) + (size_t)c * L;
        LAS unsigned char* Rsh = Lm; LAS unsigned char* Vt = Lm + 8 * HY_RS_LAT;
        __syncthreads();
        for (int x2 = F.tid; x2 < L + 32; x2 += NTHR) {
#pragma unroll
            for (int a = 0; a < 8; ++a) { float v2[2];
#pragma unroll
                for (int e = 0; e < 2; ++e) { const int idx = 2 * x2 + e - a, i = idx - L; v2[e] = (idx <= 0 || idx >= 2 * L) ? 0.f : (i <= 0 ? HFt[-i] : HBt[i]); }
                *(LAS unsigned*)(Rsh + a * RS + x2 * 4) = pk2(v2[0], v2[1]); }
        }
        { const u32x4* src = (const u32x4*)(kind ? WSP(bf16_t, A0_VXTC) + (size_t)c * TC : WSP(bf16_t, A0_VXTL) + (size_t)c * TL);
          for (int i = F.tid; i < L; i += NTHR) *(LAS u32x4*)(Vt + i * 16) = src[i]; }
        __syncthreads();
        float* YT = kind ? WSP(float, A0_YHTC) + (size_t)c * TC : WSP(float, A0_YHTL) + (size_t)c * TL;
        const int ng = L / 128, nks = L / 32;
        for (int g = w; g < ng; g += 8) {
            const int mt0 = g * 8;
            const LAS unsigned char* abase = Rsh + ml * RS + (L - 16 * mt0 + 8 * q - 8 * mh) * 2;
            const LAS unsigned char* bbase = Vt + n8 * (L * 2) + (8 * q) * 2;
            bf16x8h fr[8]; f32x4 acc[8];
#pragma unroll
            for (int i = 0; i < 8; ++i) { acc[i] = (f32x4){0.f, 0.f, 0.f, 0.f}; fr[(8 - i) & 7] = *(const LAS bf16x8h*)(abase + (-i) * 32); }
            for (int ks4 = 0; ks4 < nks; ks4 += 4) {
#pragma unroll
                for (int kk = 0; kk < 4; ++kk) {
                    const int ks = ks4 + kk;
                    const bf16x8h bv = *(const LAS bf16x8h*)(bbase + ks * 64);
#pragma unroll
                    for (int i = 0; i < 8; ++i) acc[i] = __builtin_amdgcn_mfma_f32_16x16x32_bf16(fr[(2 * kk - i) & 7], bv, acc[i], 0, 0, 0);
                    fr[(2 * kk + 1) & 7] = *(const LAS bf16x8h*)(abase + (2 * ks + 1) * 32);
                    fr[(2 * kk + 2) & 7] = *(const LAS bf16x8h*)(abase + (2 * ks + 2) * 32);
                }
            }
            if (m < 8) {
#pragma unroll
                for (int i = 0; i < 8; ++i) *(f32x4*)(YT + (size_t)m * L + 16 * (mt0 + i) + 4 * q) = acc[i];
            }
        }
    }
    __syncthreads();
}
DI void p4a_dn_chunks(const Fr& F) {}
DI void p4_mix_core(const Fr& F) {
#if MK_DN_NAIVE
    for (int u = F.bid; u < 64 + 512; u += F.G) { if (u < 64) dn_chain(F, u); else hy_mfma_unit(F, u - 64); }
#else
    if (F.G >= 128) { if (F.bid < 64) dnB_chain(F, F.bid); else { for (int c = F.bid - 64; c < 512; c += F.G - 64) hy_mfma_unit(F, c);
            if (F.G == 256 && !MK_BG_CONV) moe_w_l1_part(F, 1, 0, L1W2_A, F.bid - 64, F.G - 64); } }
    else for (int u = F.bid; u < 64 + 512; u += F.G) { if (u < 64) dnB_chain(F, u); else hy_mfma_unit(F, u - 64); }
#endif
}

DI void p5_mix(const Fr& F) {
    const float* OD = WSP(float, A0_OD); const bf16_t* P = WSP(bf16_t, A0_P); bf16_t* MIX = WSP(bf16_t, A0_MIX);
    const float* YH = WSP(float, A0_YH); const float* VX = WSP(float, A0_VX); const float* X0 = WSP(float, A0_X0);
    for (int row = F.gwave; row < TT; row += F.nwaves) {
        const int hs = F.lane >> 5, l32 = F.lane & 31; const f32x4 gn = *(const f32x4*)(INP(13) + l32 * 4);
#pragma unroll
        for (int hp = 0; hp < 2; ++hp) {
            const int col = (hp * 2 + hs) * 128 + l32 * 4;
            const f32x4 o = *(const f32x4*)(OD + (size_t)row * 512 + col) + *(const f32x4*)(OD + ((size_t)TT + row) * 512 + col);
            float ss = (o[0] * o[0] + o[1] * o[1]) + (o[2] * o[2] + o[3] * o[3]);
            ss += __shfl_xor(ss, 16); ss += __shfl_xor(ss, 8); ss += __shfl_xor(ss, 4); ss += __shfl_xor(ss, 2); ss += __shfl_xor(ss, 1);
            const float r = rsqrtf(ss * (1.0f / 128.0f) + RMS_EPS);
            const u32x2 zv = *(const u32x2*)(P + (size_t)row * NP0 + 1536 + col);
            const float z0 = __uint_as_float(zv.x << 16), z1 = __uint_as_float(zv.x & 0xffff0000u), z2 = __uint_as_float(zv.y << 16), z3 = __uint_as_float(zv.y & 0xffff0000u);
            u32x2 w; w.x = pk2(o[0] * r * gn[0] * silu_(z0), o[1] * r * gn[1] * silu_(z1)); w.y = pk2(o[2] * r * gn[2] * silu_(z2), o[3] * r * gn[3] * silu_(z3));
            *(u32x2*)(MIX + (size_t)row * MIXW + col) = w;
        }
    }
    LAS float* t2 = (LAS float*)F.lds;
    __syncthreads();
    for (int u = F.bid; u < (TT / 64) * 4; u += F.G) {
        const int rt = u >> 2, ct = u & 3, row0 = rt * 64; const bool isc = row0 >= TL;
        { const int c2 = F.tid >> 2, seg = F.tid & 3;
          const float* src = isc ? WSP(float, A0_YHTC) + (size_t)(ct * 128 + c2) * TC + (row0 - TL) : WSP(float, A0_YHTL) + (size_t)(ct * 128 + c2) * TL + row0;
          LAS float* tp = t2 + c2 * 65 + seg * 16;
#pragma unroll
          for (int q = 0; q < 4; ++q) { const f32x4 a = *(const f32x4*)(src + seg * 16 + q * 4); tp[q * 4] = a[0]; tp[q * 4 + 1] = a[1]; tp[q * 4 + 2] = a[2]; tp[q * 4 + 3] = a[3]; } }
        __syncthreads();
        { const int cl = F.tid & 63, rg = F.tid >> 6, c = ct * 128 + cl * 2; const f32x2 sk = *(const f32x2*)(INP(22) + c);
#pragma unroll
          for (int j = 0; j < 8; ++j) { const int row = row0 + rg * 8 + j; const size_t o = (size_t)row * 512 + c;
              const f32x2 x0 = *(const f32x2*)(X0 + o), vx = *(const f32x2*)(VX + o);
              const f32x2 yh = (f32x2){t2[(cl * 2) * 65 + rg * 8 + j], t2[(cl * 2 + 1) * 65 + rg * 8 + j]};
              const f32x2 r = x0 * (yh + vx * sk);
              *(unsigned*)(MIX + (size_t)row * MIXW + 512 + c) = pk2(r[0], r[1]); } }
        __syncthreads();
    }
}

template <int LAYER>
DI void p7_ln_route(const Fr& F, const float* xres_lat, const float* xres_ctx, const bf16_t* Y, int nrows) {
    const float* MOD = WSP(float, WS_MOD) + (size_t)LAYER * 9 * 6144;
    float* X1 = WSP(float, WS_X1); bf16_t* VB = WSP(bf16_t, WS_VB);
    int* RI = WSP(int, WS_RI); float* RW = WSP(float, WS_RW);
    const float* lng = INP(6) + (size_t)(LAYER * 2 + 0) * DM; const float* lnb = INP(7) + (size_t)(LAYER * 2 + 0) * DM;
    const float* rb = INP(35) + LAYER * NEXP;
    LAS float* rwt = (LAS float*)F.lds;
    { const f32x4* src = WSP(f32x4, WS_RWT) + (size_t)LAYER * 8192;
#pragma unroll
      for (int it = 0; it < 16; ++it) *(LAS f32x4*)(rwt + (F.tid + it * NTHR) * 4) = src[F.tid + it * NTHR]; }
    __syncthreads();
    const int lane = F.lane;
    LAS unsigned* lcnt = (LAS unsigned*)(F.lds + LDS_CTL_OFF + 64);
    if (F.tid < 32) lcnt[F.tid] = 0u;
    __syncthreads();
    const int per = 2 * ((nrows / 2 + F.G - 1) / F.G), rb0 = (F.bid * per < nrows) ? F.bid * per : nrows, rb1 = (rb0 + per < nrows) ? rb0 + per : nrows;
    f32x4 xq[2][4]; u32x2 yq[2][4];
#define LN_LOAD_PAIR(RP) do { _Pragma("unroll") for (int rr_ = 0; rr_ < 2; ++rr_) { const int row_ = (RP) * 2 + rr_; const bool isc_ = row_ >= TL; \
        const float* xr_ = isc_ ? xres_ctx + (size_t)(row_ - TL) * DM : xres_lat + (size_t)row_ * DM; \
        _Pragma("unroll") for (int i_ = 0; i_ < 4; ++i_) { xq[rr_][i_] = *(const f32x4*)(xr_ + i_ * 256 + lane * 4); yq[rr_][i_] = *(const u32x2*)(Y + (size_t)row_ * DM + i_ * 256 + lane * 4); } } } while (0)
    if (rb0 / 2 + F.wave < rb1 / 2) LN_LOAD_PAIR(rb0 / 2 + F.wave);
    for (int rp = rb0 / 2 + F.wave; rp < rb1 / 2; rp += 8) {
        f32x4 va[4], vb[4];
#pragma unroll
        for (int rr = 0; rr < 2; ++rr) {
            const int row = rp * 2 + rr; const bool isc = row >= TL; const int b = isc ? (row - TL) >> 8 : row >> 11;
            const float* md = MOD + (size_t)(isc ? 8 : b) * 6144;
            f32x4 y[4]; float s = 0.f;
#pragma unroll
            for (int i = 0; i < 4; ++i) { const int k = i * 256 + lane * 4;
                const u32x2 yw = yq[rr][i];
                const f32x4 yv = (f32x4){__uint_as_float(yw.x << 16), __uint_as_float(yw.x & 0xffff0000u), __uint_as_float(yw.y << 16), __uint_as_float(yw.y & 0xffff0000u)};
                y[i] = xq[rr][i] * ALPHA + *(const f32x4*)(md + 2048 + k) * yv;
                s += (y[i][0] + y[i][1]) + (y[i][2] + y[i][3]); }
            const float mu = wsum(s) * (1.0f / 1024.0f); float q = 0.f;
#pragma unroll
            for (int i = 0; i < 4; ++i) { const f32x4 dd = y[i] - mu; q += (dd[0] * dd[0] + dd[1] * dd[1]) + (dd[2] * dd[2] + dd[3] * dd[3]); }
            const float rstd = rsqrtf(wsum(q) * (1.0f / 1024.0f) + LN_EPS);
#pragma unroll
            for (int i = 0; i < 4; ++i) { const int k = i * 256 + lane * 4;
                const f32x4 x1 = (y[i] - mu) * rstd * *(const f32x4*)(lng + k) + *(const f32x4*)(lnb + k);
                *(f32x4*)(X1 + (size_t)row * DM + k) = x1;
                const f32x4 v = x1 * (*(const f32x4*)(md + 4096 + k) + 1.0f) + *(const f32x4*)(md + 3072 + k);
                u32x2 w; w.x = pk2(v[0], v[1]); w.y = pk2(v[2], v[3]);
                *(u32x2*)(VB + (size_t)row * DM + k) = w;
                if (rr == 0) va[i] = v; else vb[i] = v; }
        }
        if (rp + 8 < rb1 / 2) LN_LOAD_PAIR(rp + 8);
        float pa[32], pb[32];
#pragma unroll
        for (int e = 0; e < 32; ++e) { f32x2 sa = (f32x2){0.f, 0.f}, sb = sa;
#pragma unroll
            for (int i = 0; i < 4; ++i) { const f32x4 wv = *(const LAS f32x4*)(rwt + e * DM + i * 256 + lane * 4);
                const f32x2 w01 = (f32x2){wv[0], wv[1]}, w23 = (f32x2){wv[2], wv[3]};
                sa += (f32x2){va[i][0], va[i][1]} * w01; sa += (f32x2){va[i][2], va[i][3]} * w23;
                sb += (f32x2){vb[i][0], vb[i][1]} * w01; sb += (f32x2){vb[i][2], vb[i][3]} * w23; }
            pa[e] = sa.x + sa.y; pb[e] = sb.x + sb.y; asm volatile("" ::: "memory"); }
#define RS_STEP(N, OFF) { const bool up = (lane & (OFF)) != 0; \
            _Pragma("unroll") for (int e = 0; e < (N); ++e) { \
                const float ka = up ? pa[e + (N)] : pa[e], sa_ = up ? pa[e] : pa[e + (N)]; const float kb = up ? pb[e + (N)] : pb[e], sb_ = up ? pb[e] : pb[e + (N)]; \
                pa[e] = ka + __shfl_xor(sa_, (OFF)); pb[e] = kb + __shfl_xor(sb_, (OFF)); } }
        RS_STEP(16, 32) RS_STEP(8, 16) RS_STEP(4, 8) RS_STEP(2, 4) RS_STEP(1, 2)
#undef RS_STEP
        const int e = lane >> 1;
        float lga = pa[0] + __shfl_xor(pa[0], 1) + rb[e], lgb = pb[0] + __shfl_xor(pb[0], 1) + rb[e];
#pragma unroll
        for (int rr = 0; rr < 2; ++rr) {
            const int row = rp * 2 + rr; float val = rr ? lgb : lga; float sv[4]; int si[4];
#pragma unroll
            for (int kk = 0; kk < 4; ++kk) {
                float bv = val; int bi = e;
#pragma unroll
                for (int off = 32; off >= 2; off >>= 1) { const float ov = __shfl_xor(bv, off); const int oi = __shfl_xor(bi, off); if (ov > bv || (ov == bv && oi < bi)) { bv = ov; bi = oi; } }
                sv[kk] = bv; si[kk] = bi; if (e == bi) val = -3.0e38f;
            }
            const float e1 = __expf(sv[1] - sv[0]), e2 = __expf(sv[2] - sv[0]), e3 = __expf(sv[3] - sv[0]); const float inv = 1.0f / (1.0f + e1 + e2 + e3);
            if (lane == 0) {
                *(int4*)(RI + (size_t)row * 4) = make_int4(si[0], si[1], si[2], si[3]);
                *(f32x4*)(RW + (size_t)row * 4) = (f32x4){inv, e1 * inv, e2 * inv, e3 * inv};
                atomicAdd((unsigned*)(lcnt + si[0]), 1u); atomicAdd((unsigned*)(lcnt + si[1]), 1u); atomicAdd((unsigned*)(lcnt + si[2]), 1u); atomicAdd((unsigned*)(lcnt + si[3]), 1u);
            }
        }
    }
#undef LN_LOAD_PAIR
    __syncthreads();
    if (F.tid < 32) WSP(unsigned, WS_BC)[((size_t)LAYER * 1024 + F.bid) * 32 + F.tid] = lcnt[F.tid];
}

template <int LAYER>
DI void p8_assign(const Fr& F, int nrows) {
    unsigned* NT = WSP(unsigned, WS_CTL) + CW_NT + LAYER; const unsigned* BC = WSP(unsigned, WS_BC) + (size_t)LAYER * 1024 * 32;
    LAS int* offs = (LAS int*)F.lds;
    LAS unsigned* lcnt = (LAS unsigned*)(offs + 64);
    LAS int* lpos = (LAS int*)(offs + 192);
    { LAS unsigned* pt = (LAS unsigned*)(offs + 1024); const int e = F.tid & 31, sg = F.tid >> 5; unsigned tot = 0, pre = 0;
      for (int bb = sg; bb < F.G; bb += 16) { const unsigned c = BC[bb * 32 + e]; tot += c; pre += (bb < F.bid) ? c : 0u; }
      pt[sg * 32 + e] = tot; pt[512 + sg * 32 + e] = pre;
      __syncthreads();
      if (F.tid < 32) { unsigned t2 = 0, p2 = 0; for (int g = 0; g < 16; ++g) { t2 += pt[g * 32 + F.tid]; p2 += pt[512 + g * 32 + F.tid]; } lcnt[64 + F.tid] = t2; lcnt[32 + F.tid] = p2; lcnt[F.tid] = 0u; } }
    __syncthreads();
    if (F.tid == 0) { int o = 0; for (int e = 0; e < NEXP; ++e) { offs[e] = o; o += (int)((lcnt[64 + e] + 255u) & ~255u); } offs[32] = o; }
    __syncthreads();
    int* TILE_E = WSP(int, WS_TILEE); const int ntile = offs[32] >> 8;
    if (F.bid == 0) { for (int tl = F.tid; tl < ntile; tl += NTHR) { int e = 0; while (e < 31 && offs[e + 1] <= tl * 256) ++e; TILE_E[tl] = e; } if (F.tid == 0) *NT = (unsigned)ntile; }
    bf16_t* VBG = WSP(bf16_t, WS_VBG); const bf16_t* VB = WSP(bf16_t, WS_VB);
    constexpr bool F8 = (LAYER == 1) ? (MK_FP8_L1 != 0) : (MK_FP8_L0 != 0);
    unsigned char* VBG8 = WSP(unsigned char, WS_VBG);
    for (int e = F.bid; e < NEXP; e += F.G) { const int r0 = offs[e] + (int)lcnt[64 + e], r1 = offs[e + 1];
        for (int r = r0 + F.wave; r < r1; r += 8) { u32x4 zz = (u32x4){0u, 0u, 0u, 0u};
            if (F8) *(u32x4*)(VBG8 + (size_t)r * DM + F.lane * 16) = zz;
            else { *(u32x4*)(VBG + (size_t)r * DM + F.lane * 8) = zz; *(u32x4*)(VBG + (size_t)r * DM + 512 + F.lane * 8) = zz; } } }
    const int* RI = WSP(int, WS_RI); int* SP = WSP(int, WS_SP);
    const int per = 2 * ((nrows / 2 + F.G - 1) / F.G), rb0 = (F.bid * per < nrows) ? F.bid * per : nrows, rb1 = (rb0 + per < nrows) ? rb0 + per : nrows; const int nslot = (rb1 > rb0 ? rb1 - rb0 : 0) * 4;
    if (F.tid < nslot) { const int my_e = RI[(size_t)rb0 * 4 + F.tid]; const int my_rank = (int)atomicAdd((unsigned*)(lcnt + my_e), 1u);
        const int pos = offs[my_e] + (int)lcnt[32 + my_e] + my_rank; lpos[F.tid] = pos; SP[(size_t)rb0 * 4 + F.tid] = pos; }
    __syncthreads();
    for (int rl = F.wave; rl < rb1 - rb0; rl += 8) { const int row = rb0 + rl;
        const u32x4 v0 = *(const u32x4*)(VB + (size_t)row * DM + F.lane * 8), v1 = *(const u32x4*)(VB + (size_t)row * DM + 512 + F.lane * 8);
        u32x2 q0 = (u32x2){0u, 0u}, q1 = q0;
        if (F8) { q0.x = pk4_fp8(__uint_as_float(v0.x << 16), __uint_as_float(v0.x & 0xffff0000u), __uint_as_float(v0.y << 16), __uint_as_float(v0.y & 0xffff0000u));
                  q0.y = pk4_fp8(__uint_as_float(v0.z << 16), __uint_as_float(v0.z & 0xffff0000u), __uint_as_float(v0.w << 16), __uint_as_float(v0.w & 0xffff0000u));
                  q1.x = pk4_fp8(__uint_as_float(v1.x << 16), __uint_as_float(v1.x & 0xffff0000u), __uint_as_float(v1.y << 16), __uint_as_float(v1.y & 0xffff0000u));
                  q1.y = pk4_fp8(__uint_as_float(v1.z << 16), __uint_as_float(v1.z & 0xffff0000u), __uint_as_float(v1.w << 16), __uint_as_float(v1.w & 0xffff0000u)); }
#pragma unroll
        for (int k = 0; k < 4; ++k) { const int pos = lpos[rl * 4 + k];
            if (F8) { *(u32x2*)(VBG8 + (size_t)pos * DM + F.lane * 8) = q0; *(u32x2*)(VBG8 + (size_t)pos * DM + 512 + F.lane * 8) = q1; }
            else { *(u32x4*)(VBG + (size_t)pos * DM + F.lane * 8) = v0; *(u32x4*)(VBG + (size_t)pos * DM + 512 + F.lane * 8) = v1; } }
    }
    __syncthreads();
}

template <int LAYER>
DI void p11_combine(const Fr& F, int nrows, float* xout) {
    const float* MOD = WSP(float, WS_MOD) + (size_t)LAYER * 9 * 6144;
    const float* X1 = WSP(float, WS_X1); const bf16_t* YS = WSP(bf16_t, WS_YS);
    const int* SP = WSP(int, WS_SP); const float* RW = WSP(float, WS_RW);
    const float* lng = INP(6) + (size_t)(LAYER * 2 + 1) * DM; const float* lnb = INP(7) + (size_t)(LAYER * 2 + 1) * DM;
    const float* MODN = WSP(float, WS_MOD) + (size_t)1 * 9 * 6144; const float* POS = WSP(float, WS_POS); bf16_t* UN = WSP(bf16_t, A1_U);
    constexpr bool YF8 = MK_FP8_YS && ((LAYER == 0) ? (MK_FP8_L0 != 0) : (MK_FP8_L1 != 0));
    u32x2 ysq[4][4]; f32x4 x1q[4], posq[4]; int4 spn = make_int4(0, 0, 0, 0); f32x4 rwq = (f32x4){0.f, 0.f, 0.f, 0.f}, rwn = rwq;
#define CMB_LOAD_ROW(ROW, SPV) do { const int spa_[4] = {(SPV).x, (SPV).y, (SPV).z, (SPV).w}; \
        _Pragma("unroll") for (int i_ = 0; i_ < 4; ++i_) { const int k_ = i_ * 256 + F.lane * 4; x1q[i_] = *(const f32x4*)(X1 + (size_t)(ROW) * DM + k_); \
            if (LAYER == 0) posq[i_] = ((ROW) >= TL) ? (f32x4){0.f, 0.f, 0.f, 0.f} : *(const f32x4*)(POS + (size_t)((ROW) & 2047) * DM + k_); \
            _Pragma("unroll") for (int j_ = 0; j_ < 4; ++j_) { if (YF8) ysq[j_][i_].x = *(const unsigned*)((const unsigned char*)YS + (size_t)spa_[j_] * DM + k_); else ysq[j_][i_] = *(const u32x2*)(YS + (size_t)spa_[j_] * DM + k_); } } } while (0)
    int row = F.gwave;
    if (row < nrows) { const int4 sp0 = *(const int4*)(SP + (size_t)row * 4); rwq = *(const f32x4*)(RW + (size_t)row * 4); CMB_LOAD_ROW(row, sp0);
        if (row + F.nwaves < nrows) { spn = *(const int4*)(SP + (size_t)(row + F.nwaves) * 4); rwn = *(const f32x4*)(RW + (size_t)(row + F.nwaves) * 4); } }
    for (; row < nrows; row += F.nwaves) {
        const bool isc = row >= TL; const int b = isc ? (row - TL) >> 8 : row >> 11;
        const float* md = MOD + (size_t)(isc ? 8 : b) * 6144;
        f32x4 y[4], pcur[4]; float s = 0.f;
#pragma unroll
        for (int i = 0; i < 4; ++i) { const int k = i * 256 + F.lane * 4; f32x4 f = (f32x4){0.f, 0.f, 0.f, 0.f};
#pragma unroll
            for (int j = 0; j < 4; ++j) { const u32x2 w = ysq[j][i];
                if (YF8) { const f32x2 lo = __builtin_amdgcn_cvt_pk_f32_fp8((int)w.x, false), hi = __builtin_amdgcn_cvt_pk_f32_fp8((int)w.x, true); f += (f32x4){lo.x, lo.y, hi.x, hi.y} * (rwq[j] * (1.0f / YS_F8S)); }
                else f += (f32x4){__uint_as_float(w.x << 16), __uint_as_float(w.x & 0xffff0000u), __uint_as_float(w.y << 16), __uint_as_float(w.y & 0xffff0000u)} * rwq[j]; }
            y[i] = x1q[i] * ALPHA + *(const f32x4*)(md + 5120 + k) * f; if (LAYER == 0) pcur[i] = posq[i];
            s += (y[i][0] + y[i][1]) + (y[i][2] + y[i][3]); }
        { const int rn = row + F.nwaves; if (rn < nrows) { const int4 spv = spn; rwq = rwn; CMB_LOAD_ROW(rn, spv);
              const int rn2 = rn + F.nwaves; if (rn2 < nrows) { spn = *(const int4*)(SP + (size_t)rn2 * 4); rwn = *(const f32x4*)(RW + (size_t)rn2 * 4); } } }
        const float mu = wsum(s) * (1.0f / 1024.0f); float q = 0.f;
#pragma unroll
        for (int i = 0; i < 4; ++i) { const f32x4 dd = y[i] - mu; q += (dd[0] * dd[0] + dd[1] * dd[1]) + (dd[2] * dd[2] + dd[3] * dd[3]); }
        const float rstd = rsqrtf(wsum(q) * (1.0f / 1024.0f) + LN_EPS);
#pragma unroll
        for (int i = 0; i < 4; ++i) { const int k = i * 256 + F.lane * 4;
            const f32x4 x2 = (y[i] - mu) * rstd * *(const f32x4*)(lng + k) + *(const f32x4*)(lnb + k);
            *(f32x4*)(xout + (size_t)row * DM + k) = x2;
            if (LAYER == 0) {
                const float* mn = MODN + (size_t)(isc ? 8 : b) * 6144;
                const f32x4 u = x2 * (*(const f32x4*)(mn + 1024 + k) + 1.0f) + *(const f32x4*)(mn + k) + pcur[i];
                u32x2 w; w.x = pk2(u[0], u[1]); w.y = pk2(u[2], u[3]);
                *(u32x2*)(UN + (size_t)row * DM + k) = w;
            } }
    }
#undef CMB_LOAD_ROW
}

DI void p13_lru_conv(const Fr& F) {
    const bf16_t* P1 = WSP(bf16_t, A1_P); float* XC = WSP(float, A1_XC); bf16_t* XCB = WSP(bf16_t, A1_XCB); const float* cw = INP(25); const float* cb = INP(26);
    for (int u = F.bid; u < (TT / 64) * 4; u += F.G) {
        const int rt = u >> 2, c = (u & 3) * 256 + F.lane * 4, row0 = rt * 64 + F.wave * 8; const bool isc = row0 >= TL; const int L = isc ? CTXL : SEQ;
        const int t0 = isc ? ((row0 - TL) & 255) : (row0 & 2047);
        f32x4 w[4]; const f32x4 bv = *(const f32x4*)(cb + c);
#pragma unroll
        for (int i = 0; i < 4; ++i) w[i] = *(const f32x4*)(cw + i * DM + c);
        f32x4 p[11];
#pragma unroll
        for (int rr = 0; rr < 11; ++rr) { const int tl = t0 + rr - 2; u32x2 pv = (u32x2){0u, 0u}; if (tl >= 0 && tl < L) pv = *(const u32x2*)(P1 + (size_t)(row0 + rr - 2) * 2048 + c);
            p[rr] = (f32x4){__uint_as_float(pv.x << 16), __uint_as_float(pv.x & 0xffff0000u), __uint_as_float(pv.y << 16), __uint_as_float(pv.y & 0xffff0000u)}; }
#pragma unroll
        for (int j = 0; j < 8; ++j) { const f32x4 a = bv + w[0] * p[j] + w[1] * p[j + 1] + w[2] * p[j + 2] + w[3] * p[j + 3];
            *(f32x4*)(XC + (size_t)(row0 + j) * DM + c) = a; u32x2 o; o.x = pk2(a[0], a[1]); o.y = pk2(a[2], a[3]); *(u32x2*)(XCB + (size_t)(row0 + j) * DM + c) = o; }
    }
}
#define LRU_SG(x) (x)
DI void p15_lru_scan(const Fr& F) {
    const unsigned* AB = WSP(unsigned, A1_RG); bf16_t* HS = WSP(bf16_t, A1_HS);
    LAS float* agg = (LAS float*)F.lds;
    for (int u = F.bid; u < NB * 2 * 16; u += F.G) {
        const int cg = u & 15, d = (u >> 4) & 1, b = u >> 5; const int pr = F.lane & 31, j = F.wave * 2 + (F.lane >> 5), col = cg * 64 + pr * 2;
        const unsigned* ab = AB + (size_t)d * TT * DM + col;
        float As0 = 0.f, As1 = 0.f, Bp0 = 0.f, Bp1 = 0.f;
#pragma unroll 16
        for (int s = 0; s < 144; ++s) { const u32x2 v = *(const u32x2*)(ab + (size_t)row_of(b, d, j * 144 + s) * DM);
            const float la0 = __uint_as_float(v.x << 16), bc0 = __uint_as_float(v.x & 0xffff0000u), la1 = __uint_as_float(v.y << 16), bc1 = __uint_as_float(v.y & 0xffff0000u);
            As0 += la0; Bp0 = __expf(la0) * Bp0 + bc0; As1 += la1; Bp1 = __expf(la1) * Bp1 + bc1; }
        *(LAS f32x4*)(agg + (j * 32 + pr) * 4) = (f32x4){__expf(As0), Bp0, __expf(As1), Bp1};
        __syncthreads();
        float h0 = 0.f, h1 = 0.f;
        for (int m = 0; m < j; ++m) { const f32x4 g = *(const LAS f32x4*)(agg + (m * 32 + pr) * 4); h0 = g[0] * h0 + g[1]; h1 = g[2] * h1 + g[3]; }
#pragma unroll 16
        for (int s = 0; s < 144; ++s) { const int p = j * 144 + s; const int row = row_of(b, d, p); const u32x2 v = *(const u32x2*)(ab + (size_t)row * DM);
            const float la0 = __uint_as_float(v.x << 16), bc0 = __uint_as_float(v.x & 0xffff0000u), la1 = __uint_as_float(v.y << 16), bc1 = __uint_as_float(v.y & 0xffff0000u);
            h0 = __expf(la0) * h0 + bc0; h1 = __expf(la1) * h1 + bc1;
            if (p >= CTXL) *(unsigned*)(HS + ((size_t)d * TL + row) * DM + col) = pk2(h0, h1); }
        __syncthreads();
    }
}
DI void p16_lru_gate(const Fr& F) {
    const bf16_t* HS = WSP(bf16_t, A1_HS); const bf16_t* P1 = WSP(bf16_t, A1_P); bf16_t* HG = WSP(bf16_t, A1_HG);
    for (int i = F.bid * NTHR + F.tid; i < TL * DM / 8; i += F.G * NTHR) {
        const int row = i >> 7, c = (i & 127) * 8;
        const u32x4 h0 = *(const u32x4*)(HS + (size_t)row * DM + c), h1 = *(const u32x4*)(HS + ((size_t)TL + row) * DM + c), gt = *(const u32x4*)(P1 + (size_t)row * 2048 + 1024 + c);
        u32x4 o;
#pragma unroll
        for (int q = 0; q < 4; ++q) {
            const float ha = __uint_as_float(h0[q] << 16) + __uint_as_float(h1[q] << 16), hb2 = __uint_as_float(h0[q] & 0xffff0000u) + __uint_as_float(h1[q] & 0xffff0000u);
            o[q] = pk2(ha * gelu_tanh(__uint_as_float(gt[q] << 16)), hb2 * gelu_tanh(__uint_as_float(gt[q] & 0xffff0000u))); }
        *(u32x4*)(HG + (size_t)row * DM + c) = o;
    }
}

#ifndef MK_DIAG
#define MK_DIAG 0
#endif
#ifndef MK_DIAG_SUB
#define MK_DIAG_SUB 0
#endif
constexpr int CW_DIAG = 4096 + 256;
DI void diag_max(const Fr& F, float v) { if (v == v) atomicMax(WSP(unsigned, WS_CTL) + CW_DIAG, __float_as_uint(fabsf(v))); else atomicMax(WSP(unsigned, WS_CTL) + CW_DIAG, 0x7f000000u); }
DI void diag_lru_gates(const Fr& F) {
    const bf16_t* RG = WSP(bf16_t, A1_RG); const float* XC = WSP(float, A1_XC);
    for (int smp = F.bid * NTHR + F.tid; smp < 262144; smp += F.G * NTHR) {
        const unsigned hsh = (unsigned)smp * 2654435761u; const int row = (int)(hsh % (unsigned)TT); const int tcol = (int)((hsh >> 7) % 4096u);
        const int t = tcol >> 10, col = tcol & 1023, h = col >> 8, j = col & 255;
        const float* W = (t < 2 ? INP(27) : INP(29)) + (size_t)((t & 1) * 4 + h) * 65536 + j;
        float acc = (t < 2 ? INP(28) : INP(30))[(t & 1) * DM + col];
        for (int i = 0; i < 256; ++i) acc += XC[(size_t)row * DM + h * 256 + i] * W[(size_t)i * 256];
        const float df = sigm(acc) - LRU_SG(bf2f(RG[(size_t)row * 4096 + tcol]));
#if MK_DIAG_SUB == 0
        diag_max(F, df);
#elif MK_DIAG_SUB == 1
        if (!(fabsf(df) < 0.05f)) atomicAdd(WSP(unsigned, WS_CTL) + CW_DIAG + 1, 1u);
#elif MK_DIAG_SUB == 2
        if (!(fabsf(df) < 0.05f)) atomicMax(WSP(unsigned, WS_CTL) + CW_DIAG + 1, (unsigned)(tcol >> 8) + 1u);
#elif MK_DIAG_SUB == 3
        if (!(fabsf(df) < 0.05f)) atomicMax(WSP(unsigned, WS_CTL) + CW_DIAG + 1, (unsigned)(row >> 8) + 1u);
#elif MK_DIAG_SUB == 4
        if (!(fabsf(df) < 0.05f)) { const int uid = (row >> 8) * 16 + (tcol >> 8); atomicOr(WSP(unsigned, WS_CTL) + CW_DIAG + 8 + (uid >> 5), 1u << (uid & 31)); }
#elif MK_DIAG_SUB == 5
        if (!(fabsf(df) < 0.05f)) { const int uid = row & 255; atomicOr(WSP(unsigned, WS_CTL) + CW_DIAG + 8 + (uid >> 5), 1u << (uid & 31)); }
#elif MK_DIAG_SUB == 6
        if (!(fabsf(df) < 0.05f)) { const int uid = tcol & 255; atomicOr(WSP(unsigned, WS_CTL) + CW_DIAG + 8 + (uid >> 5), 1u << (uid & 31)); }
#endif
    }
}
DI void diag_lru_scan(const Fr& F) {
    const bf16_t* RG = WSP(bf16_t, A1_RG); const float* XC = WSP(float, A1_XC); const float* HS = WSP(float, A1_HS);
    for (int u = F.bid * NTHR + F.tid; u < NB * 2 * DM; u += F.G * NTHR) {
        const int col = u & 1023, d = (u >> 10) & 1, b = u >> 11; const float sp = softplus_(INP(31)[d * DM + col]);
        float hst = 0.f, md = 0.f;
        for (int p = 0; p < CTXL + SEQ; ++p) { const int row = row_of(b, d, p);
            const float r = LRU_SG(bf2f(RG[(size_t)row * 4096 + d * 1024 + col])), ig = LRU_SG(bf2f(RG[(size_t)row * 4096 + (2 + d) * 1024 + col])), x = XC[(size_t)row * DM + col];
            const float la = -8.0f * r * sp, a = expf(la), bc = sqrtf(fmaxf(-expm1f(2.0f * la), 0.f)) * (ig * x);
            hst = a * hst + bc;
            if (p >= CTXL) { const float df = fabsf(hst - HS[((size_t)d * TL + row) * DM + col]); md = (df > md || df != df) ? df : md; } }
        diag_max(F, md);
    }
}
DI void diag_hyena(const Fr& F) {
    for (int i = F.bid * NTHR + F.tid; i < 512 * TC + 262144; i += F.G * NTHR) {
        const bool lat = i >= 512 * TC; int c, b, t, L;
        if (!lat) { c = i / TC; b = (i % TC) >> 8; t = i & 255; L = CTXL; }
        else { const unsigned hsh = (unsigned)(i - 512 * TC) * 2654435761u; c = (int)(hsh % 512u); b = (int)((hsh >> 9) & 7u); t = (int)((hsh >> 12) % (unsigned)SEQ); L = SEQ; }
        const float* HFt = (lat ? WSP(float, WS_HFL) : WSP(float, WS_HFC)) + (size_t)c * L; const float* HBt = (lat ? WSP(float, WS_HBL) : WSP(float, WS_HBC)) + (size_t)c * L;
        const bf16_t* vx = lat ? WSP(bf16_t, A0_VXTL) + (size_t)c * TL + b * SEQ : WSP(bf16_t, A0_VXTC) + (size_t)c * TC + b * CTXL;
        float acc = 0.f;
        for (int s2 = 0; s2 < L; ++s2) { const float hh = (s2 <= t) ? HFt[t - s2] : HBt[s2 - t]; acc += hh * bf2f(vx[s2]); }
        const float got = lat ? WSP(float, A0_YHTL)[(size_t)c * TL + b * SEQ + t] : WSP(float, A0_YHTC)[(size_t)c * TC + b * CTXL + t];
#if MK_DIAG_SUB == 0
        if (!lat) diag_max(F, acc - got);
#elif MK_DIAG_SUB == 1
        if (!lat) diag_max(F, acc);
#elif MK_DIAG_SUB == 2
        if (lat) diag_max(F, acc - got);
#else
        if (lat) diag_max(F, acc);
#endif
    }
}
DI void diag_fill(const Fr& F, float* out) {
#if MK_DIAG_SUB == 0 || MK_DIAG == 3
    const float v = 1.0f + 1000.0f * __uint_as_float(WSP(unsigned, WS_CTL)[CW_DIAG]);
#elif MK_DIAG_SUB >= 4
    unsigned cntb = 0; for (int i = 0; i < 40; ++i) cntb += __popc(WSP(unsigned, WS_CTL)[CW_DIAG + 8 + i]);
    const float v = 1.0f + (float)cntb;
#else
    const float v = 1.0f + (float)WSP(unsigned, WS_CTL)[CW_DIAG + 1];
#endif
    for (int i = F.bid * NTHR + F.tid; i < TL * DM; i += F.G * NTHR) out[i] = v;
}
enum { PH_PRO = 0, PH_MOD0, PH_INPROJ0, PH_PREP0, PH_CORE0, PH_MIX0, PH_OUTPROJ0, PH_LN0, PH_ASG0, PH_MOE1_0, PH_MOE2_0, PH_CMB0,
       PH_INPROJ1, PH_CONV1, PH_GATES1, PH_SCAN1, PH_GATE1, PH_OUTPROJ1, PH_LN1, PH_ASG1, PH_MOE1_1, PH_MOE2_1, PH_CMB1, NPH };
__global__ void __launch_bounds__(NTHR, 2) mk_fwd(Args args) {
    extern __shared__ __attribute__((aligned(16))) unsigned char lds_raw[];
    Fr F;
    F.a = &args; F.lds = (LAS unsigned char*)lds_raw; F.ws = args.ws;
    F.tid = threadIdx.x; F.lane = F.tid & 63; F.wave = __builtin_amdgcn_readfirstlane(F.tid >> 6); F.G = gridDim.x; F.bid = blockIdx.x;
    F.gwave = F.bid * 8 + F.wave; F.nwaves = F.G * 8;
    volatile LAS unsigned* xbw = (volatile LAS unsigned*)(F.lds + LDS_CTL_OFF);
    if (F.tid < 4) xbw[F.tid] = 0u;
    __syncthreads();
#if MK_ONE_LAUNCH
    XcdBarrier bar = xcd_barrier_post(WSP(unsigned, WS_CTL) + CW_BAR, xbw);
#if MK_BG_CONV
#define GRID_BAR() xcd_barrier_work(bar, F)
#else
#define GRID_BAR() xcd_barrier(bar)
#endif
#else
#define GRID_BAR() do {} while (0)
#endif
    const int lo = args.ph_lo, hi = args.ph_hi;
#ifndef MK_PH_MASK
#define MK_PH_MASK 0xFFFFFFFFu
#endif
#define IN(k) (((MK_PH_MASK >> (k)) & 1u) && lo <= (k) && (k) < hi)
#define SEAM(k) do { if (IN((k) + 1)) { GRID_BAR(); } } while (0)
    LAS unsigned char* glds = F.lds;

    if (IN(PH_PRO)) { p0_prologue(F); SEAM(PH_PRO); }
    if (IN(PH_MOD0)) { p1_mod0(F); SEAM(PH_MOD0); }
    if (IN(PH_INPROJ0)) {
        __syncthreads();
        pg8::Gemm g{WSP(bf16_t, A0_U), WSP(bf16_t, WS_WEVIN), TT, NP0, DM, DM}; pg8::StaticOrder S; S.init(TT, NP0, F.G, F.bid);
        pg8::EpiBf16 E{WSP(bf16_t, A0_P), NP0, nullptr, 0};
        pg8::gemm_phase(glds, g, S, E); SEAM(PH_INPROJ0);
    }
    if (IN(PH_PREP0)) { p3_prep(F); SEAM(PH_PREP0); }
    if (IN(PH_CORE0)) { __syncthreads(); p4_mix_core(F); SEAM(PH_CORE0); }
#if MK_DIAG == 3
    if (IN(PH_MIX0)) { diag_hyena(F); p5_mix(F); SEAM(PH_MIX0); }
#else
    if (IN(PH_MIX0)) { p5_mix(F); SEAM(PH_MIX0); }
#endif
    if (IN(PH_OUTPROJ0)) {
        __syncthreads();
        pg8::Gemm g{WSP(bf16_t, A0_MIX), WSP(bf16_t, WS_WEVOUT), TT, DM, MIXW, MIXW}; pg8::StaticOrder S; S.init(TT, DM, F.G, F.bid);
        pg8::EpiBf16 E{WSP(bf16_t, A0_Y), DM, nullptr, 0};
        pg8::gemm_phase(glds, g, S, E);
        if (F.G == 256 && !MK_BG_CONV && F.bid >= 32) moe_w_l1_part(F, 0, 0, L1W1_A, F.bid - 32, 224);
        SEAM(PH_OUTPROJ0);
    }
    if (IN(PH_LN0)) { __syncthreads(); p7_ln_route<0>(F, INP(0), INP(2), WSP(bf16_t, A0_Y), TT); SEAM(PH_LN0); }
    if (IN(PH_ASG0)) { __syncthreads(); p8_assign<0>(F, TT);
#if MK_BG_CONV
        conv_drain(F, TQ_PER_LAYER);
#endif
        SEAM(PH_ASG0); }
    if (IN(PH_MOE1_0)) {
        __syncthreads();
        const int ntm = (int)WSP(unsigned, WS_CTL)[CW_NT + 0];
#if MK_FP8_L0
        pg8::Gemm g{WSP(bf16_t, WS_VBG), WSP(bf16_t, WS_WM1), ntm * 256, 2048, DM / 2, DM / 2}; pg8::MoeOrder S{WSP(int, WS_TILEE), ntm, 8, F.G, F.bid};
        pg8::EpiSwigluF8 E{WSP(unsigned char, WS_ACT), DM, INP(37), 2048, 1.0f / W1_F8S};
        pg8::gemm_phase<pg8::EpiSwigluF8, pg8::MoeOrder, true>(glds, g, S, E); SEAM(PH_MOE1_0);
#else
        pg8::Gemm g{WSP(bf16_t, WS_VBG), WSP(bf16_t, WS_WM1), ntm * 256, 2048, DM, DM}; pg8::MoeOrder S{WSP(int, WS_TILEE), ntm, 8, F.G, F.bid};
        pg8::EpiSwiglu E{WSP(bf16_t, WS_ACT), DM, INP(37), 2048};
        pg8::gemm_phase(glds, g, S, E); SEAM(PH_MOE1_0);
#endif
    }
    if (IN(PH_MOE2_0)) {
        __syncthreads();
        const int ntm = (int)WSP(unsigned, WS_CTL)[CW_NT + 0];
#if MK_FP8_L0
        pg8::Gemm g{WSP(bf16_t, WS_ACT), WSP(bf16_t, WS_WM2), ntm * 256, DM, DM / 2, DM / 2}; pg8::MoeOrder S{WSP(int, WS_TILEE), ntm, 4, F.G, F.bid};
#if MK_FP8_YS
        pg8::EpiF8 E{WSP(unsigned char, WS_YS), DM, INP(39), DM, 1.0f / W2_F8S, YS_F8S};
        pg8::gemm_phase<pg8::EpiF8, pg8::MoeOrder, true>(glds, g, S, E); SEAM(PH_MOE2_0);
#else
        pg8::EpiBf16 E{WSP(bf16_t, WS_YS), DM, INP(39), DM, 1.0f / W2_F8S};
        pg8::gemm_phase<pg8::EpiBf16, pg8::MoeOrder, true>(glds, g, S, E); SEAM(PH_MOE2_0);
#endif
#else
        pg8::Gemm g{WSP(bf16_t, WS_ACT), WSP(bf16_t, WS_WM2), ntm * 256, DM, DM, DM}; pg8::MoeOrder S{WSP(int, WS_TILEE), ntm, 4, F.G, F.bid};
        pg8::EpiBf16 E{WSP(bf16_t, WS_YS), DM, INP(39), DM};
        pg8::gemm_phase(glds, g, S, E); SEAM(PH_MOE2_0);
#endif
    }
    if (IN(PH_CMB0)) { p11_combine<0>(F, TT, WSP(float, WS_X2)); SEAM(PH_CMB0); }
    if (IN(PH_INPROJ1)) {
        __syncthreads();
        pg8::Gemm g{WSP(bf16_t, A1_U), WSP(bf16_t, WS_WODIN), TT, 2048, DM, DM}; pg8::StaticOrder S; S.init(TT, 2048, F.G, F.bid);
        pg8::EpiBf16 E{WSP(bf16_t, A1_P), 2048, INP(24), 0};
        pg8::gemm_phase(glds, g, S, E);
        if (F.G == 256 && !MK_BG_CONV && F.bid >= 64) moe_w_l1_part(F, 0, L1W1_A, L1W1_B, F.bid - 64, 192);
        SEAM(PH_INPROJ1);
    }
    if (IN(PH_CONV1)) { p13_lru_conv(F); SEAM(PH_CONV1); }
    if (IN(PH_GATES1)) {
        __syncthreads();
        pg8::Gemm g{WSP(bf16_t, A1_XCB), WSP(bf16_t, WS_WLRU), TT, 4096, 256, DM}; pg8::LruOrder S; S.init(TT, 4096, F.G, F.bid);
        pg8::EpiLruAB E{WSP(unsigned, A1_RG), WSP(float, WS_BLRU), WSP(float, WS_BLRU) + 4096, WSP(bf16_t, A1_XCB), TT};
        pg8::gemm_phase(glds, g, S, E); SEAM(PH_GATES1);
    }
#if MK_DIAG == 1
    if (IN(PH_SCAN1)) { diag_lru_gates(F); SEAM(PH_SCAN1); }
#else
    if (IN(PH_SCAN1)) { __syncthreads(); p15_lru_scan(F); SEAM(PH_SCAN1); }
#endif
#if MK_DIAG == 2
    if (IN(PH_GATE1)) { diag_lru_scan(F); SEAM(PH_GATE1); }
#else
    if (IN(PH_GATE1)) { p16_lru_gate(F); SEAM(PH_GATE1); }
#endif
    if (IN(PH_OUTPROJ1)) {
        __syncthreads();
        pg8::Gemm g{WSP(bf16_t, A1_HG), WSP(bf16_t, WS_WODOUT), TL, DM, DM, DM}; pg8::StaticOrder S; S.init(TL, DM, F.G, F.bid);
        pg8::EpiBf16 E{WSP(bf16_t, A1_Y), DM, INP(33), 0};
        pg8::gemm_phase(glds, g, S, E); SEAM(PH_OUTPROJ1);
    }
    if (IN(PH_LN1)) { __syncthreads(); p7_ln_route<1>(F, WSP(float, WS_X2), WSP(float, WS_X2) + (size_t)TL * DM, WSP(bf16_t, A1_Y), TL); SEAM(PH_LN1); }
    if (IN(PH_ASG1)) { __syncthreads(); p8_assign<1>(F, TL);
#if MK_BG_CONV
        conv_drain(F, TQ_TOTAL);
#endif
        SEAM(PH_ASG1); }
    if (IN(PH_MOE1_1)) {
        __syncthreads();
        const int ntm = (int)WSP(unsigned, WS_CTL)[CW_NT + 1];
#if MK_FP8_L1
        pg8::Gemm g{WSP(bf16_t, WS_VBG), (const bf16_t*)(WSP(unsigned char, WS_WM1) + (size_t)32 * 2048 * DM * 2), ntm * 256, 2048, DM / 2, DM / 2}; pg8::MoeOrder S{WSP(int, WS_TILEE), ntm, 8, F.G, F.bid};
        pg8::EpiSwigluF8 E{WSP(unsigned char, WS_ACT), DM, INP(37) + (size_t)32 * 2048, 2048, 1.0f / W1_F8S};
        pg8::gemm_phase<pg8::EpiSwigluF8, pg8::MoeOrder, true>(glds, g, S, E); SEAM(PH_MOE1_1);
#else
        pg8::Gemm g{WSP(bf16_t, WS_VBG), WSP(bf16_t, WS_WM1) + (size_t)32 * 2048 * DM, ntm * 256, 2048, DM, DM}; pg8::MoeOrder S{WSP(int, WS_TILEE), ntm, 8, F.G, F.bid};
        pg8::EpiSwiglu E{WSP(bf16_t, WS_ACT), DM, INP(37) + (size_t)32 * 2048, 2048};
        pg8::gemm_phase(glds, g, S, E); SEAM(PH_MOE1_1);
#endif
    }
    if (IN(PH_MOE2_1)) {
        __syncthreads();
        const int ntm = (int)WSP(unsigned, WS_CTL)[CW_NT + 1];
#if MK_FP8_L1
        pg8::Gemm g{WSP(bf16_t, WS_ACT), (const bf16_t*)(WSP(unsigned char, WS_WM2) + (size_t)32 * DM * DM * 2), ntm * 256, DM, DM / 2, DM / 2}; pg8::MoeOrder S{WSP(int, WS_TILEE), ntm, 4, F.G, F.bid};
#if MK_FP8_YS
        pg8::EpiF8 E{WSP(unsigned char, WS_YS), DM, INP(39) + (size_t)32 * DM, DM, 1.0f / W2_F8S, YS_F8S};
        pg8::gemm_phase<pg8::EpiF8, pg8::MoeOrder, true>(glds, g, S, E); SEAM(PH_MOE2_1);
#else
        pg8::EpiBf16 E{WSP(bf16_t, WS_YS), DM, INP(39) + (size_t)32 * DM, DM, 1.0f / W2_F8S};
        pg8::gemm_phase<pg8::EpiBf16, pg8::MoeOrder, true>(glds, g, S, E); SEAM(PH_MOE2_1);
#endif
#else
        pg8::Gemm g{WSP(bf16_t, WS_ACT), WSP(bf16_t, WS_WM2) + (size_t)32 * DM * DM, ntm * 256, DM, DM, DM}; pg8::MoeOrder S{WSP(int, WS_TILEE), ntm, 4, F.G, F.bid};
        pg8::EpiBf16 E{WSP(bf16_t, WS_YS), DM, INP(39) + (size_t)32 * DM, DM};
        pg8::gemm_phase(glds, g, S, E); SEAM(PH_MOE2_1);
#endif
    }
#if MK_DIAG
    if (IN(PH_CMB1)) { diag_fill(F, args.out); }
#else
    if (IN(PH_CMB1)) { p11_combine<1>(F, TL, args.out); }
#endif
#undef IN
#undef SEAM
}

extern "C" void kernel_launch(void* const* d_in, const int* in_sizes, int n_in, void* d_out, int out_size, void* d_ws, size_t ws_size, hipStream_t stream) {
    static int grid = 0;
    if (grid == 0) {
        static const int exp_sizes[40] = {16777216, 8192, 2097152, 1024, 12582912, 12288, 4096, 4096, 3686400, 1048576, 6144, 8, 8, 128, 4608, 1536, 2112, 64, 8192, 128, 65536, 64, 512,
            2097152, 2048, 4096, 1024, 524288, 2048, 524288, 2048, 2048, 1048576, 1024, 65536, 64, 134217728, 131072, 67108864, 65536};
        bool ok_sizes = (n_in == 40);
        for (int i = 0; ok_sizes && i < 40; ++i) if (in_sizes[i] != exp_sizes[i]) { fprintf(stderr, "kernel_launch: input %d has %d elements, expected %d\n", i, in_sizes[i], exp_sizes[i]); ok_sizes = false; }
        if (!ok_sizes || out_size != TL * DM || ws_size < WS_END) { fprintf(stderr, "kernel_launch: unexpected shapes: n_in %d out %d ws %zu (need %zu)\n", n_in, out_size, ws_size, (size_t)WS_END); grid = -1; return; }
        int dev = 0, cus = 0, per_cu = 0;
        if (hipGetDevice(&dev) != hipSuccess || hipDeviceGetAttribute(&cus, hipDeviceAttributeMultiprocessorCount, dev) != hipSuccess) { grid = -1; return; }
        if (hipFuncSetAttribute((const void*)mk_fwd, hipFuncAttributeMaxDynamicSharedMemorySize, LDS_BYTES) != hipSuccess) { fprintf(stderr, "kernel_launch: hipFuncSetAttribute failed\n"); grid = -1; return; }
        if (hipOccupancyMaxActiveBlocksPerMultiprocessor(&per_cu, (const void*)mk_fwd, NTHR, LDS_BYTES) != hipSuccess || per_cu < 1) { fprintf(stderr, "kernel_launch: occupancy query says %d\n", per_cu); }
        (void)hipGetLastError();
        grid = cus;
    }
    if (grid < 0) return;
    (void)hipMemsetAsync((char*)d_ws + WS_CTL, 0, CTL_BYTES, stream);
    Args a{};
    for (int i = 0; i < 40; ++i) a.in[i] = (const float*)d_in[i];
    a.out = (float*)d_out; a.ws = (unsigned char*)d_ws;
#if MK_ONE_LAUNCH
    a.ph_lo = 0; a.ph_hi = NPH;
    hipLaunchKernelGGL(mk_fwd, dim3(grid), dim3(NTHR), LDS_BYTES, stream, a);
#else
#ifndef MK_MAXPH
#define MK_MAXPH NPH
#endif
#ifndef MK_REPEAT
#define MK_REPEAT -1
#endif
    for (int p = 0; p < MK_MAXPH; ++p) { a.ph_lo = p; a.ph_hi = p + 1; hipLaunchKernelGGL(mk_fwd, dim3(grid), dim3(NTHR), LDS_BYTES, stream, a);
        if (p == MK_REPEAT) { a.flags = 1; hipLaunchKernelGGL(mk_fwd, dim3(grid), dim3(NTHR), LDS_BYTES, stream, a); a.flags = 0; } }
#endif
}
```

```cpp
#include <hip/hip_runtime.h>
#include <cstdio>
#include <cstdint>

#ifndef MK_ONE_LAUNCH
#define MK_ONE_LAUNCH 1
#endif

#define LAS __attribute__((address_space(3)))
#define DI __device__ __forceinline__
typedef unsigned short bf16_t;
typedef float f32x4 __attribute__((ext_vector_type(4)));
typedef float f32x2 __attribute__((ext_vector_type(2)));
typedef unsigned u32x4 __attribute__((ext_vector_type(4)));
typedef unsigned u32x2 __attribute__((ext_vector_type(2)));

constexpr int DM = 1024, NB = 8, SEQ = 2048, CTXL = 256;
constexpr int TL = NB * SEQ;
constexpr int TC = NB * CTXL;
constexpr int TT = TL + TC;
constexpr int EVEN_IN = 3600, DN_GATE_COL = 2048, HY_COL = 2064;
constexpr int NP0 = 3584;
constexpr int MIXW = 1024;
constexpr int NEXP = 32, TOPK = 4;
constexpr int MOE_ROWS = 82176;
constexpr float ALPHA = 1.4142135623730951f;
constexpr float LN_EPS = 1e-5f, RMS_EPS = 1e-6f;

constexpr size_t al(size_t x) { return (x + 255) & ~(size_t)255; }
constexpr size_t WS_CTL   = 0;
constexpr size_t WS_MOD   = 65536;
constexpr size_t WS_POS   = WS_MOD + al((size_t)2 * 9 * 6144 * 4);
constexpr size_t WS_HFL   = WS_POS + (size_t)SEQ * DM * 4;
constexpr size_t WS_HBL   = WS_HFL + (size_t)SEQ * 512 * 4;
constexpr size_t WS_HFC   = WS_HBL + (size_t)SEQ * 512 * 4;
constexpr size_t WS_HBC   = WS_HFC + (size_t)CTXL * 512 * 4;
constexpr size_t WS_WEVIN = WS_HBC + (size_t)CTXL * 512 * 4;
constexpr size_t WS_WEVOUT= WS_WEVIN + (size_t)NP0 * DM * 2;
constexpr size_t WS_WODIN = WS_WEVOUT + (size_t)DM * MIXW * 2;
constexpr size_t WS_WODOUT= WS_WODIN + (size_t)2048 * DM * 2;
constexpr size_t WS_WLRU  = WS_WODOUT + (size_t)DM * DM * 2;
constexpr size_t WS_BLRU  = WS_WLRU + (size_t)4096 * 256 * 2;
constexpr size_t WS_RWT   = WS_BLRU + 8192 * 4;
constexpr size_t WS_WGT   = WS_RWT + (size_t)2 * 32 * 1024 * 4;
constexpr size_t WS_HID   = WS_WGT + (size_t)16 * 1024 * 4;
constexpr size_t WS_WM1   = WS_HID + (size_t)(SEQ + CTXL) * 64 * 4;
constexpr size_t WS_WM2   = WS_WM1 + (size_t)64 * 2048 * DM * 2;
constexpr size_t WS_X1    = WS_WM2 + (size_t)64 * DM * DM * 2;
constexpr size_t WS_X2    = WS_X1 + (size_t)TT * DM * 4;
constexpr size_t WS_VB    = WS_X2 + (size_t)TT * DM * 4;
constexpr size_t WS_RI    = WS_VB + (size_t)TT * DM * 2;
constexpr size_t WS_RW    = WS_RI + (size_t)TT * 16;
constexpr size_t WS_SP    = WS_RW + (size_t)TT * 16;
constexpr size_t WS_TILEE = WS_SP + (size_t)TT * 16;
constexpr size_t WS_BC    = WS_TILEE + 4096;
constexpr size_t WS_ROWTOK= WS_BC + (size_t)2 * 1024 * 32 * 4;
constexpr size_t WS_VBG   = WS_ROWTOK + (size_t)MOE_ROWS * 4;
constexpr size_t WS_ACT   = WS_VBG + (size_t)MOE_ROWS * DM * 2;
constexpr size_t WS_YS    = WS_ACT + (size_t)MOE_ROWS * DM * 2;
constexpr size_t WS_ARENA = WS_YS + (size_t)MOE_ROWS * DM * 2;
constexpr size_t A0_U     = WS_ARENA;
constexpr size_t A0_P     = A0_U + (size_t)TT * DM * 2;
constexpr size_t A0_GATES = A0_P + (size_t)TT * NP0 * 2;
constexpr size_t A0_QN    = A0_GATES + (size_t)TT * 64;
constexpr size_t A0_KN    = A0_QN + (size_t)TT * 512 * 4;
constexpr size_t A0_VV    = A0_KN + (size_t)TT * 512 * 4;
constexpr size_t A0_GG    = A0_VV + (size_t)TT * 512 * 4;
constexpr size_t A0_BB    = A0_GG + (size_t)2 * TT * 16;
constexpr size_t A0_OD    = A0_BB + (size_t)2 * TT * 16;
constexpr size_t A0_VX    = A0_OD + (size_t)2 * TT * 512 * 4;
constexpr size_t A0_X0    = A0_VX + (size_t)TT * 512 * 4;
constexpr size_t A0_YH    = A0_X0 + (size_t)TT * 512 * 4;
constexpr size_t A0_MIX   = A0_YH + (size_t)TT * 512 * 4;
constexpr size_t A0_Y     = A0_MIX + (size_t)TT * MIXW * 2;
constexpr size_t A0_QB    = A0_Y + (size_t)TT * DM * 4;
constexpr size_t A0_KB    = A0_QB + (size_t)TT * 512 * 2;
constexpr size_t A0_VB3   = A0_KB + (size_t)TT * 512 * 2;
constexpr int    DN_CU    = NB * 4 * 2 * 36;
constexpr size_t A0_WQ    = A0_VB3 + (size_t)TT * 512 * 2;
constexpr size_t A0_KDT   = A0_WQ + (size_t)DN_CU * 32768;
constexpr size_t A0_ATT   = A0_KDT + (size_t)DN_CU * 16384;
constexpr size_t A0_UU    = A0_ATT + (size_t)DN_CU * 8192;
constexpr size_t A0_GL    = A0_UU + (size_t)DN_CU * 32768;
constexpr size_t A0_VXTL  = A0_GL + al((size_t)DN_CU * 4);
constexpr size_t A0_VXTC  = A0_VXTL + (size_t)512 * TL * 2;
constexpr size_t A0_YHTL  = A0_VXTC + (size_t)512 * TC * 2;
constexpr size_t A0_YHTC  = A0_YHTL + (size_t)512 * TL * 4;
constexpr size_t A0_END   = A0_YHTC + (size_t)512 * TC * 4;
constexpr size_t A1_U     = WS_ARENA;
constexpr size_t A1_P     = A1_U + (size_t)TT * DM * 2;
constexpr size_t A1_XC    = A1_P + (size_t)TT * 2048 * 4;
constexpr size_t A1_XCB   = A1_XC + (size_t)TT * DM * 4;
constexpr size_t A1_RG    = A1_XCB + (size_t)TT * DM * 2;
constexpr size_t A1_HS    = A1_RG + (size_t)TT * 4096 * 2;
constexpr size_t A1_HG    = A1_HS + (size_t)2 * TL * DM * 4;
constexpr size_t A1_Y     = A1_HG + (size_t)TL * DM * 2;
constexpr size_t A1_END   = A1_Y + (size_t)TL * DM * 4;
constexpr size_t WS_END   = (A0_END > A1_END ? A0_END : A1_END);

constexpr int CW_BAR = 0;
constexpr int CW_CNT = 4096;
constexpr int CW_CUR = 4096 + 64;
constexpr int CW_NT  = 4096 + 128;
constexpr int CW_TQ  = 4096 + 192;
constexpr size_t CTL_BYTES = 65536;

DI float bf2f(bf16_t b) { return __uint_as_float(((unsigned)b) << 16); }
typedef __bf16 bf16x2_t __attribute__((ext_vector_type(2)));
DI unsigned pk2(float lo, float hi) { const f32x2 v = {lo, hi}; return __builtin_bit_cast(unsigned, __builtin_convertvector(v, bf16x2_t)); }
DI bf16_t f2bf(float f) { return (bf16_t)(pk2(f, 0.f) & 0xffffu); }
DI unsigned pk4_fp8(float a, float b, float c, float d) { int w = 0; w = __builtin_amdgcn_cvt_pk_fp8_f32(a, b, w, false); w = __builtin_amdgcn_cvt_pk_fp8_f32(c, d, w, true); return (unsigned)w; }
#ifndef MK_FP8_L1
#define MK_FP8_L1 1
#endif
#ifndef MK_FP8_L0
#define MK_FP8_L0 1
#endif
#ifndef MK_GATHER
#define MK_GATHER 1
#endif
#ifndef MK_FP8_YS
#define MK_FP8_YS 1
#endif
constexpr float W1_F8S = 32.0f, W2_F8S = 64.0f, YS_F8S = 16.0f;
DI float sigm(float x) { return __builtin_amdgcn_rcpf(1.0f + __expf(-x)); }
DI float silu_(float x) { return x * sigm(x); }
DI float softplus_(float x) { return fmaxf(x, 0.f) + log1pf(__expf(-fabsf(x))); }
DI float gelu_tanh(float x) { return x * sigm(1.5957691216057308f * (x + 0.044715f * x * x * x)); }
DI float wsum(float v) { v += __shfl_xor(v, 32); v += __shfl_xor(v, 16); v += __shfl_xor(v, 8); v += __shfl_xor(v, 4); v += __shfl_xor(v, 2); v += __shfl_xor(v, 1); return v; }

DI int row_of(int b, int d, int p) {
    if (p < CTXL) return TL + b * CTXL + (d ? (CTXL - 1 - p) : p);
    const int q = p - CTXL; return b * SEQ + (d ? (SEQ - 1 - q) : q);
}
static_assert(WS_END <= (size_t)2147483648ull, "workspace map exceeds 4x the largest tensor");
#define XB_TMO      128
#define XB_XCNT(j)  (256  + 64 * (j))
#define XB_XSUB(j)  (1280 + 64 * (j))
#define XB_XGEN(j)  (2304 + 64 * (j))
#define XB_TOP      3328
#define XB_TOPGEN   3392
#define XCD_BAR_WORDS 3456
#define XB_SPIN_CAP (1u << 18)

__device__ __forceinline__ unsigned xb_ld(unsigned* p)              { return __hip_atomic_load(p, __ATOMIC_RELAXED, __HIP_MEMORY_SCOPE_AGENT); }
__device__ __forceinline__ unsigned xb_add(unsigned* p, unsigned v) { return __hip_atomic_fetch_add(p, v, __ATOMIC_RELAXED, __HIP_MEMORY_SCOPE_AGENT); }
__device__ __forceinline__ unsigned xb_xcc_id() { return (unsigned)__builtin_amdgcn_s_getreg((3 << 11) | 20) & 0xFu; }
#define XB_SPIN(cond, bar) do { unsigned _sp = 0; while (cond) { __builtin_amdgcn_s_sleep(1); \
    if ((++_sp & 255u) == 0u) { if (xb_ld(&(bar)[XB_TMO])) break; if (_sp > XB_SPIN_CAP) { atomicAdd(&(bar)[XB_TMO], 1u); break; } } } } while (0)

struct XcdBarrier {
    unsigned* bar; unsigned x;
    volatile LAS unsigned* st;
};

__device__ __forceinline__ XcdBarrier xcd_barrier_post(unsigned* bar, volatile LAS unsigned* st) {
    XcdBarrier b; b.bar = bar; b.x = xb_xcc_id(); b.st = st;
    if (threadIdx.x == 0) (void)xb_add(&bar[XB_XCNT(b.x)], 1u);
    return b;
}
__device__ __forceinline__ void xcd_barrier_complete(unsigned* bar, unsigned x, unsigned& nloc, unsigned& nx) {
    const unsigned G = gridDim.x * gridDim.y * gridDim.z;
    unsigned sum, cnt, mine, sp = 0u;
    for (;;) {
        sum = 0u; cnt = 0u; mine = 0u;
#pragma unroll
        for (unsigned j = 0; j < 16; ++j) { const unsigned c = xb_ld(&bar[XB_XCNT(j)]); sum += c; cnt += (c > 0u) ? 1u : 0u; mine = (j == x) ? c : mine; }
        if (sum == G) break;
        __builtin_amdgcn_s_sleep(1);
        if ((++sp & 255u) == 0u) { if (xb_ld(&bar[XB_TMO])) break; if (sp > XB_SPIN_CAP) { atomicAdd(&bar[XB_TMO], 1u); break; } }
    }
    nloc = mine > 0u ? mine : 1u; nx = cnt > 0u ? cnt : 1u;
}

__device__ __forceinline__ void xcd_barrier(const XcdBarrier& b) {
    asm volatile("s_waitcnt vmcnt(0)" ::: "memory");
    __syncthreads();
    if (threadIdx.x == 0) {
        unsigned* bar = b.bar;
        __builtin_amdgcn_s_waitcnt(0);
        unsigned nloc = b.st[0], nx = b.st[1];
        if (nloc == 0u) { xcd_barrier_complete(bar, b.x, nloc, nx); b.st[0] = nloc; b.st[1] = nx; }
        const unsigned old = xb_add(&bar[XB_XSUB(b.x)], 1u);
        const unsigned gen = old / nloc;
        if (old + 1u == (gen + 1u) * nloc) {
            __builtin_amdgcn_fence(__ATOMIC_RELEASE, "agent");
            asm volatile("s_waitcnt vmcnt(0)" ::: "memory");
            const unsigned og = xb_add(&bar[XB_TOP], 1u);
            const unsigned tg = og / nx;
            if (og + 1u == (tg + 1u) * nx) xb_add(&bar[XB_TOPGEN], 1u);
            else XB_SPIN(xb_ld(&bar[XB_TOPGEN]) == tg, bar);
            __builtin_amdgcn_fence(__ATOMIC_ACQUIRE, "agent");
            xb_add(&bar[XB_XGEN(b.x)], 1u);
            asm volatile("s_waitcnt vmcnt(0)" ::: "memory");
        } else {
            XB_SPIN(xb_ld(&bar[XB_XGEN(b.x)]) == gen, bar);
            __builtin_amdgcn_fence(__ATOMIC_ACQUIRE, "agent");
            asm volatile("s_waitcnt vmcnt(0)" ::: "memory");
        }
    }
    __syncthreads();
}

DI void st16_wt(void* p, u32x4 v) { asm volatile("global_store_dwordx4 %0, %1, off sc1\n\ts_nop 1" :: "v"(p), "v"(v) : "memory"); }
namespace pg8 {
typedef short bf16x8 __attribute__((ext_vector_type(8)));
constexpr int BM = 256, BK = 64, HALF = 128, HTB = HALF * BK * 2, STAGE_BYTES = 8 * HTB, NXCD = 8, WGM = 8;

__host__ __device__ __forceinline__ int lds_byte(int r, int c) { const int st = (r >> 4) * 2 + (c >> 5), rr = r & 15, cc = c & 31, ob = rr * 64 + cc * 2; return st * 1024 + (ob ^ (((ob >> 9) & 1) << 5)); }
__host__ __device__ __forceinline__ void stage_rc(int b, int& R, int& C) { const int st = b / 1024, sb = b % 1024, swz = sb ^ (((sb >> 9) & 1) << 5); R = (st >> 1) * 16 + swz / 64; C = (st & 1) * 32 + (swz % 64) / 2; }
__host__ __device__ __forceinline__ int perm32(int rho) { const int n = rho >> 4, i = rho & 15; return 8 * (i >> 2) + 4 * n + (i & 3); }

struct Unit { int pm, pn, e; };
struct Gemm { const bf16_t* A; const bf16_t* Bt; int M, N, K, lda; const int* rt = nullptr; };

struct StaticOrder {
    int nM, nN, nwg, G, c;
    __device__ void init(int M, int N, int G_, int c_) { nM = M / BM; nN = N / BM; nwg = nM * nN; G = G_; c = c_; }
    __device__ bool next(int i, Unit& u) const {
        const long L = (long)i * G + c; if (L >= nwg) return false;
        int wgid = (int)L; { const int q = nwg / NXCD, r = nwg % NXCD, xcd = wgid % NXCD, off = wgid / NXCD; wgid = (xcd < r ? xcd * (q + 1) : r * (q + 1) + (xcd - r) * q) + off; }
        const int nig = WGM * nN, gid = wgid / nig, fm = gid * WGM, gsz = (nM - fm) < WGM ? (nM - fm) : WGM;
        u.pm = fm + ((wgid % nig) % gsz); u.pn = (wgid % nig) / gsz; u.e = 0; return true;
    }
    __device__ __forceinline__ const char* a_ptr(const Gemm& g, const Unit& u) const { return (const char*)g.A + (size_t)u.pm * BM * g.lda * 2; }
    __device__ __forceinline__ const char* b_ptr(const Gemm& g, const Unit& u) const { return (const char*)g.Bt + (size_t)u.pn * BM * g.K * 2; }
};
struct LruOrder : StaticOrder {
    __device__ __forceinline__ const char* a_ptr(const Gemm& g, const Unit& u) const { return (const char*)g.A + (size_t)u.pm * BM * g.lda * 2 + (size_t)((u.pn >> 1) & 3) * 512; }
};
struct MoeOrder {
    const int* tile_e; int ntm, nN, G, c;
    __device__ bool next(int i, Unit& u) const {
        if ((G & 7) == 0 && ((G >> 3) % nN) == 0) {
            const int x = c & 7, s = c >> 3, mpr = (G >> 3) / nN;
            u.pm = i * (8 * mpr) + x * mpr + s / nN; u.pn = s % nN; if (u.pm >= ntm) return false;
        } else { const long L = (long)i * G + c; if (L >= (long)ntm * nN) return false; u.pm = (int)(L / nN); u.pn = (int)(L % nN); }
        u.e = tile_e[u.pm]; return true;
    }
    __device__ __forceinline__ const char* a_ptr(const Gemm& g, const Unit& u) const { return (const char*)g.A + (size_t)u.pm * BM * g.lda * 2; }
    __device__ __forceinline__ const char* b_ptr(const Gemm& g, const Unit& u) const { return (const char*)g.Bt + ((size_t)u.e * g.N + (size_t)u.pn * BM) * g.K * 2; }
};

__device__ __forceinline__ unsigned cvt_pk_bf16(float lo, float hi) { return pk2(lo, hi); }

struct EpiF32 {
    static constexpr bool PERM = false;
    float* C; int ldc; const float* bias;
    __device__ __forceinline__ void operator()(const f32x4 (&acc)[2][2][4][2], const Unit& u, int wr, int wc, int fr, int fq) const {
        const int row0 = u.pm * BM + wr * 64 + fr, col0 = u.pn * BM + wc * 32 + 4 * fq;
        f32x4 bv[2][2];
#pragma unroll
        for (int bj = 0; bj < 2; ++bj)
#pragma unroll
            for (int n = 0; n < 2; ++n) bv[bj][n] = bias ? *(const f32x4*)(bias + col0 + bj * HALF + n * 16) : (f32x4){0.f, 0.f, 0.f, 0.f};
#pragma unroll
        for (int ai = 0; ai < 2; ++ai)
#pragma unroll
            for (int m = 0; m < 4; ++m) { float* rowp = C + (size_t)(row0 + ai * HALF + m * 16) * ldc + col0;
#pragma unroll
                for (int bj = 0; bj < 2; ++bj)
#pragma unroll
                    for (int n = 0; n < 2; ++n) *(f32x4*)(rowp + bj * HALF + n * 16) = acc[ai][bj][m][n] + bv[bj][n]; }
    }
};
struct EpiBf16 {
    static constexpr bool PERM = true;
    bf16_t* O; int ldc; const float* bias; int bias_estride; float scale = 1.0f;
    __device__ __forceinline__ void operator()(const f32x4 (&acc)[2][2][4][2], const Unit& u, int wr, int wc, int fr, int fq) const {
        const int row0 = u.pm * BM + wr * 64 + fr; const int col0 = u.pn * BM + wc * 32 + 8 * fq;
        f32x4 bv[2][2];
#pragma unroll
        for (int bj = 0; bj < 2; ++bj)
#pragma unroll
            for (int n = 0; n < 2; ++n) bv[bj][n] = bias ? *(const f32x4*)(bias + (size_t)u.e * bias_estride + col0 + bj * HALF + 4 * n) : (f32x4){0.f, 0.f, 0.f, 0.f};
#pragma unroll
        for (int ai = 0; ai < 2; ++ai)
#pragma unroll
            for (int m = 0; m < 4; ++m) { bf16_t* rowp = O + (size_t)(row0 + ai * HALF + m * 16) * ldc + col0;
#pragma unroll
                for (int bj = 0; bj < 2; ++bj) { const f32x4 v0 = acc[ai][bj][m][0] * scale + bv[bj][0], v1 = acc[ai][bj][m][1] * scale + bv[bj][1];
                    u32x4 w; w.x = cvt_pk_bf16(v0[0], v0[1]); w.y = cvt_pk_bf16(v0[2], v0[3]); w.z = cvt_pk_bf16(v1[0], v1[1]); w.w = cvt_pk_bf16(v1[2], v1[3]);
                    st16_wt(rowp + bj * HALF, w); } }
    }
};
__device__ __forceinline__ float sigm_fast(float x) { return __builtin_amdgcn_rcpf(1.0f + __expf(-x)); }
__device__ __forceinline__ unsigned cvt_pk_bf16_trans(float lo, float hi) { return pk2(lo, hi); }
struct EpiSigmoid {
    static constexpr bool PERM = true;
    bf16_t* O; int ldc; const float* bias;
    __device__ __forceinline__ void operator()(const f32x4 (&acc)[2][2][4][2], const Unit& u, int wr, int wc, int fr, int fq) const {
        const int row0 = u.pm * BM + wr * 64 + fr; const int col0 = u.pn * BM + wc * 32 + 8 * fq;
#pragma unroll
        for (int bj = 0; bj < 2; ++bj) {
            const f32x4 b0 = *(const f32x4*)(bias + col0 + bj * HALF), b1 = *(const f32x4*)(bias + col0 + bj * HALF + 4);
#pragma unroll
            for (int ai = 0; ai < 2; ++ai)
#pragma unroll
                for (int m = 0; m < 4; ++m) { bf16_t* rowp = O + (size_t)(row0 + ai * HALF + m * 16) * ldc + col0 + bj * HALF;
                    const f32x4 v0 = acc[ai][bj][m][0] + b0, v1 = acc[ai][bj][m][1] + b1; u32x4 w;
                    w.x = cvt_pk_bf16_trans(sigm_fast(v0[0]), sigm_fast(v0[1])); w.y = cvt_pk_bf16_trans(sigm_fast(v0[2]), sigm_fast(v0[3]));
                    w.z = cvt_pk_bf16_trans(sigm_fast(v1[0]), sigm_fast(v1[1])); w.w = cvt_pk_bf16_trans(sigm_fast(v1[2]), sigm_fast(v1[3]));
                    *(u32x4*)rowp = w; asm volatile("" ::: "memory"); }
        }
    }
};
struct EpiLruAB {
    static constexpr bool PERM = true;
    unsigned* AB; const float* bias; const float* sp8; const bf16_t* xcb; int rows;
    __device__ __forceinline__ void operator()(const f32x4 (&acc)[2][2][4][2], const Unit& u, int wr, int wc, int fr, int fq) const {
        const int row0 = u.pm * BM + wr * 64 + fr;
        u32x2 xq[2][2][4];
#pragma unroll
        for (int bj = 0; bj < 2; ++bj) { const int n0 = u.pn * BM + bj * HALF + wc * 32 + 8 * fq; const int ch = ((n0 >> 9) & 3) * 256 + ((n0 & 511) >> 1);
#pragma unroll
            for (int ai = 0; ai < 2; ++ai)
#pragma unroll
                for (int m = 0; m < 4; ++m) xq[bj][ai][m] = *(const u32x2*)(xcb + (size_t)(row0 + ai * HALF + m * 16) * 1024 + ch); }
        f32x4 bq0[2], bq1[2], spq[2];
#pragma unroll
        for (int bj = 0; bj < 2; ++bj) { const int n0 = u.pn * BM + bj * HALF + wc * 32 + 8 * fq; const int d = n0 >> 11, ch = ((n0 >> 9) & 3) * 256 + ((n0 & 511) >> 1);
            bq0[bj] = *(const f32x4*)(bias + n0); bq1[bj] = *(const f32x4*)(bias + n0 + 4); spq[bj] = *(const f32x4*)(sp8 + d * 1024 + ch); }
#pragma unroll
        for (int bj = 0; bj < 2; ++bj) {
            const int n0 = u.pn * BM + bj * HALF + wc * 32 + 8 * fq; const int d = n0 >> 11, ch = ((n0 >> 9) & 3) * 256 + ((n0 & 511) >> 1);
            const f32x4 b0 = bq0[bj], b1 = bq1[bj], sp = spq[bj];
#pragma unroll
            for (int ai = 0; ai < 2; ++ai)
#pragma unroll
                for (int m = 0; m < 4; ++m) { const int row = row0 + ai * HALF + m * 16;
                    const f32x4 v0 = acc[ai][bj][m][0] + b0, v1 = acc[ai][bj][m][1] + b1;
                    const u32x2 xr = xq[bj][ai][m];
                    const float x0 = __uint_as_float(xr.x << 16), x1 = __uint_as_float(xr.x & 0xffff0000u), x2 = __uint_as_float(xr.y << 16), x3 = __uint_as_float(xr.y & 0xffff0000u);
                    float la[4], cc[4]; const f32x2 rr2[2] = {(f32x2){v0[0], v0[2]}, (f32x2){v1[0], v1[2]}}, ii2[2] = {(f32x2){v0[1], v0[3]}, (f32x2){v1[1], v1[3]}}, xx2[2] = {(f32x2){x0, x1}, (f32x2){x2, x3}};
#pragma unroll
                    for (int q2 = 0; q2 < 2; ++q2) { const f32x2 tr = rr2[q2] * (-1.4426950408889634f), ti = ii2[q2] * (-1.4426950408889634f);
                        f32x2 er, ei; er.x = __builtin_amdgcn_exp2f(tr.x); er.y = __builtin_amdgcn_exp2f(tr.y); ei.x = __builtin_amdgcn_exp2f(ti.x); ei.y = __builtin_amdgcn_exp2f(ti.y);
                        const f32x2 dr = er + 1.0f, di = ei + 1.0f, dd = dr * di; f32x2 R; R.x = __builtin_amdgcn_rcpf(dd.x); R.y = __builtin_amdgcn_rcpf(dd.y);
                        const f32x2 l2 = (f32x2){sp[2 * q2], sp[2 * q2 + 1]} * (R * di), c2 = (R * dr) * xx2[q2];
                        la[2 * q2] = l2.x; la[2 * q2 + 1] = l2.y; cc[2 * q2] = c2.x; cc[2 * q2 + 1] = c2.y; }
                    u32x4 w; w.x = cvt_pk_bf16(la[0], cc[0]); w.y = cvt_pk_bf16(la[1], cc[1]); w.z = cvt_pk_bf16(la[2], cc[2]); w.w = cvt_pk_bf16(la[3], cc[3]);
                    *(u32x4*)(AB + (((size_t)d * 32 + (ch >> 5)) * rows + row) * 32 + (ch & 31)) = w; }
        }
    }
};
__device__ __forceinline__ float swiglu_(float g, float l) {
    const float glu = fminf(g, 7.0f), lin = fminf(fmaxf(l, -7.0f), 7.0f);
    return glu * __builtin_amdgcn_rcpf(1.0f + __expf(-1.702f * glu)) * (lin + 1.0f);
}
__device__ __forceinline__ f32x2 swiglu2_(f32x2 g, f32x2 l) {
    const f32x2 glu = __builtin_elementwise_min(g, (f32x2){7.0f, 7.0f});
    const f32x2 lin = __builtin_elementwise_min(__builtin_elementwise_max(l, (f32x2){-7.0f, -7.0f}), (f32x2){7.0f, 7.0f});
    const f32x2 t = glu * (-1.702f * 1.4426950408889634f);
    f32x2 e; e.x = __builtin_amdgcn_exp2f(t.x); e.y = __builtin_amdgcn_exp2f(t.y);
    const f32x2 d = e + 1.0f;
    f32x2 r; r.x = __builtin_amdgcn_rcpf(d.x); r.y = __builtin_amdgcn_rcpf(d.y);
    return glu * r * (lin + 1.0f);
}
struct EpiSwiglu {
    static constexpr bool PERM = true;
    bf16_t* O; int ldo; const float* bias; int bias_estride;
    __device__ __forceinline__ void operator()(const f32x4 (&acc)[2][2][4][2], const Unit& u, int wr, int wc, int fr, int fq) const {
        const int row0 = u.pm * BM + wr * 64 + fr; const int col0 = u.pn * BM + wc * 32 + 8 * fq;
        f32x4 bv[2][2];
#pragma unroll
        for (int bj = 0; bj < 2; ++bj)
#pragma unroll
            for (int n = 0; n < 2; ++n) bv[bj][n] = *(const f32x4*)(bias + (size_t)u.e * bias_estride + col0 + bj * HALF + 4 * n);
#pragma unroll
        for (int ai = 0; ai < 2; ++ai)
#pragma unroll
            for (int m = 0; m < 4; ++m) { bf16_t* rowp = O + (size_t)(row0 + ai * HALF + m * 16) * ldo + (col0 >> 1);
#pragma unroll
                for (int bj = 0; bj < 2; ++bj) { const f32x4 v0 = acc[ai][bj][m][0] + bv[bj][0], v1 = acc[ai][bj][m][1] + bv[bj][1];
                    const f32x2 s0 = swiglu2_((f32x2){v0[0], v0[2]}, (f32x2){v0[1], v0[3]}), s1 = swiglu2_((f32x2){v1[0], v1[2]}, (f32x2){v1[1], v1[3]});
                    u32x2 w; w.x = cvt_pk_bf16(s0.x, s0.y); w.y = cvt_pk_bf16(s1.x, s1.y);
                    *(u32x2*)(rowp + bj * (HALF / 2)) = w; } }
    }
};

typedef int v8i_t __attribute__((ext_vector_type(8)));
typedef int v4i_t __attribute__((ext_vector_type(4)));
struct Frag2 { bf16x8 k[2]; };
template <class Epi, class Sched, bool FP8 = false, bool GATHER = false>
__device__ __forceinline__ void gemm_phase(LAS unsigned char* lds, const Gemm g, const Sched& S, const Epi& E) {
    const int tid = threadIdx.x, wid = __builtin_amdgcn_readfirstlane(tid >> 6), lane = tid & 63, wr = wid >> 2, wc = wid & 3, fr = lane & 15, fq = lane >> 4;
    const int K = g.K, nt = K / BK;
    unsigned voffA[2], voffB[2]; int gR[2], gC[2];
#pragma unroll
    for (int i = 0; i < 2; ++i) { int R, C; stage_rc(tid * 16 + i * 8192, R, C); const int Rb = Epi::PERM ? ((R & ~31) + perm32(R & 31)) : R; gR[i] = R; gC[i] = C * 2;
        voffA[i] = (unsigned)(R * g.lda + C) * 2u; voffB[i] = (unsigned)(Rb * K + C) * 2u; }
    unsigned vg[2][2], vgn[2][2]; int rawn[2][2];
    const size_t kstep = (size_t)(BK * 2);
    const size_t hstep = (size_t)HALF * K * 2, hstepA = (size_t)HALF * g.lda * 2;
    const unsigned ldsw = (unsigned)wid * 1024u;
    const int aoff = lds_byte(wr * 64 + fr, fq * 8), boff = lds_byte(wc * 32 + fr, fq * 8);
#define PG8_SA(b, h) (((b) * 2 + (h)) * HTB)
#define PG8_SB(b, h) ((4 + (b) * 2 + (h)) * HTB)
#define PG8_STAGE(bufoff, gbase, voff) do { _Pragma("unroll") for (int _i = 0; _i < 2; ++_i) \
        __builtin_amdgcn_global_load_lds((const unsigned*)((const char*)(gbase) + (voff)[_i]), (LAS unsigned*)(lds + (bufoff) + ldsw + _i * 8192), 16, 0, 0); } while (0)
#define PG8_LD2(p) __builtin_shufflevector(*(const LAS v4i_t*)(p), *(const LAS v4i_t*)((p) + 1024), 0, 1, 2, 3, 4, 5, 6, 7)
#define PG8_LDA(dst, b, h) do { _Pragma("unroll") for (int m = 0; m < 4; ++m) { if constexpr (FP8) dst##8[m] = PG8_LD2(lds + PG8_SA(b, h) + aoff + m * 2048); \
        else { _Pragma("unroll") for (int k = 0; k < 2; ++k) dst[m].k[k] = *(const LAS bf16x8*)(lds + PG8_SA(b, h) + aoff + m * 2048 + k * 1024); } } } while (0)
#define PG8_LDB(dst, b, h) do { _Pragma("unroll") for (int n = 0; n < 2; ++n) { if constexpr (FP8) dst##8[n] = PG8_LD2(lds + PG8_SB(b, h) + boff + n * 2048); \
        else { _Pragma("unroll") for (int k = 0; k < 2; ++k) dst[n].k[k] = *(const LAS bf16x8*)(lds + PG8_SB(b, h) + boff + n * 2048 + k * 1024); } } } while (0)
#define PG8_MMA(ai, bj, At, Bt) do { __builtin_amdgcn_s_setprio(1); _Pragma("unroll") for (int m = 0; m < 4; ++m) _Pragma("unroll") for (int n = 0; n < 2; ++n) { \
        if constexpr (FP8) asm volatile("v_mfma_scale_f32_16x16x128_f8f6f4 %0, %1, %2, %0, %3, %3 op_sel_hi:[0,0,0]" : "+v"(acc[ai][bj][m][n]) : "v"(Bt##8[n]), "v"(At##8[m]), "v"(f8scale)); \
        else { _Pragma("unroll") for (int k = 0; k < 2; ++k) acc[ai][bj][m][n] = __builtin_amdgcn_mfma_f32_16x16x32_bf16(Bt[n].k[k], At[m].k[k], acc[ai][bj][m][n], 0, 0, 0); } } \
        __builtin_amdgcn_s_setprio(0); } while (0)
#define PG8_WAIT_V(n) asm volatile("s_waitcnt vmcnt(" #n ")" ::: "memory")
#define PG8_WAIT_L(n) asm volatile("s_waitcnt lgkmcnt(" #n ")" ::: "memory")
#define PG8_BAR __builtin_amdgcn_s_barrier()
#define PG8_SCHED __builtin_amdgcn_sched_barrier(0)
    Unit cur, nxt; int ui = 0;
    if (!S.next(0, cur)) return;
    f32x4 acc[2][2][4][2];
#pragma unroll
    for (int a = 0; a < 2; ++a)
#pragma unroll
        for (int b = 0; b < 2; ++b)
#pragma unroll
            for (int m = 0; m < 4; ++m)
#pragma unroll
                for (int n = 0; n < 2; ++n) acc[a][b][m][n] = (f32x4){0.f, 0.f, 0.f, 0.f};
    Frag2 At[4], B0[2], B1[2]; v8i_t At8[4], B08[2], B18[2];
    int f8scale = 0x7f7f7f7f; asm volatile("" : "+v"(f8scale));
    const char* cA = GATHER ? (const char*)g.A : S.a_ptr(g, cur); const char* cB = S.b_ptr(g, cur);
#define PG8_ROWS(dst, PM) do { _Pragma("unroll") for (int h_ = 0; h_ < 2; ++h_) _Pragma("unroll") for (int i_ = 0; i_ < 2; ++i_) dst[h_][i_] = g.rt[(PM) * BM + h_ * HALF + gR[i_]]; } while (0)
#define PG8_OFFS(dst, src) do { _Pragma("unroll") for (int h_ = 0; h_ < 2; ++h_) _Pragma("unroll") for (int i_ = 0; i_ < 2; ++i_) dst[h_][i_] = (unsigned)src[h_][i_] * (unsigned)(g.lda * 2) + (unsigned)gC[i_]; } while (0)
    if constexpr (GATHER) { int r0[2][2]; PG8_ROWS(r0, cur.pm); PG8_OFFS(vg, r0); Unit t1; if (S.next(1, t1)) PG8_ROWS(rawn, t1.pm); else PG8_ROWS(rawn, cur.pm); }
#define PG8_STAGE_A(bufoff, P, h, CUR) do { if constexpr (GATHER) { if (CUR) PG8_STAGE(bufoff, P, vg[h]); else PG8_STAGE(bufoff, P, vgn[h]); } else PG8_STAGE(bufoff, (P) + ((h) ? hstepA : 0), voffA); } while (0)
    PG8_STAGE(PG8_SB(0, 0), cB, voffB); PG8_STAGE_A(PG8_SA(0, 0), cA, 0, true); PG8_STAGE(PG8_SB(0, 1), cB + hstep, voffB); PG8_STAGE_A(PG8_SA(0, 1), cA, 1, true);
    if (wr == 1) PG8_BAR;
    PG8_WAIT_V(4); PG8_BAR;
    PG8_STAGE(PG8_SB(1, 0), cB + kstep, voffB); PG8_STAGE_A(PG8_SA(1, 0), cA + kstep, 0, true); PG8_STAGE(PG8_SB(1, 1), cB + hstep + kstep, voffB);
    PG8_WAIT_V(6); PG8_BAR;
    for (;;) {
        const bool has_next = S.next(ui + 1, nxt);
        const char* nA = GATHER ? cA : (has_next ? S.a_ptr(g, nxt) : cA); const char* nB = has_next ? S.b_ptr(g, nxt) : cB;
        if constexpr (GATHER) { PG8_OFFS(vgn, rawn);
            Unit t2; if (S.next(ui + 2, t2)) PG8_ROWS(rawn, t2.pm); }
#pragma unroll 1
        for (int t = 0; t < nt; t += 2) {
            const bool last = (t == nt - 2);
            const char* a1 = cA + (size_t)(t + 1) * kstep;
            const char* a2 = last ? nA : cA + (size_t)(t + 2) * kstep; const char* b2 = last ? nB : cB + (size_t)(t + 2) * kstep;
            const char* a3 = a2 + kstep; const char* b3 = b2 + kstep;
            PG8_LDB(B0, 0, 0); PG8_SCHED; PG8_LDA(At, 0, 0); PG8_STAGE_A(PG8_SA(1, 1), a1, 1, true);
            PG8_WAIT_L(8); PG8_BAR; PG8_WAIT_L(0); PG8_MMA(0, 0, At, B0); PG8_BAR; PG8_SCHED;
            PG8_LDB(B1, 0, 1); PG8_STAGE(PG8_SB(0, 0), b2, voffB);
            PG8_BAR; PG8_WAIT_L(0); PG8_MMA(0, 1, At, B1); PG8_BAR;
            PG8_LDA(At, 0, 1); PG8_STAGE_A(PG8_SA(0, 0), a2, 0, !last);
            PG8_BAR; PG8_WAIT_L(0); PG8_MMA(1, 0, At, B0); PG8_BAR; PG8_SCHED;
            PG8_STAGE(PG8_SB(0, 1), b2 + hstep, voffB);
            PG8_WAIT_V(6); PG8_BAR; PG8_MMA(1, 1, At, B1); PG8_BAR;
            PG8_LDB(B0, 1, 0); PG8_SCHED; PG8_LDA(At, 1, 0); PG8_STAGE_A(PG8_SA(0, 1), a2, 1, !last);
            PG8_WAIT_L(8); PG8_BAR; PG8_WAIT_L(0); PG8_MMA(0, 0, At, B0); PG8_BAR; PG8_SCHED;
            PG8_LDB(B1, 1, 1); PG8_STAGE(PG8_SB(1, 0), b3, voffB);
            PG8_BAR; PG8_WAIT_L(0); PG8_MMA(0, 1, At, B1); PG8_BAR;
            PG8_LDA(At, 1, 1); PG8_STAGE_A(PG8_SA(1, 0), a3, 0, !last);
            PG8_BAR; PG8_WAIT_L(0); PG8_MMA(1, 0, At, B0); PG8_BAR; PG8_SCHED;
            PG8_STAGE(PG8_SB(1, 1), b3 + hstep, voffB);
            PG8_WAIT_V(6); PG8_BAR; PG8_MMA(1, 1, At, B1); PG8_BAR;
        }
        if constexpr (FP8) asm volatile("s_nop 15\n\ts_nop 15" ::: "memory");
        E(acc, cur, wr, wc, fr, fq);
        if (!has_next) break;
#pragma unroll
        for (int a = 0; a < 2; ++a)
#pragma unroll
            for (int b = 0; b < 2; ++b)
#pragma unroll
                for (int m = 0; m < 4; ++m)
#pragma unroll
                    for (int n = 0; n < 2; ++n) acc[a][b][m][n] = (f32x4){0.f, 0.f, 0.f, 0.f};
        cur = nxt; cA = nA; cB = nB; ++ui;
        if constexpr (GATHER) { _Pragma("unroll") for (int h_ = 0; h_ < 2; ++h_) _Pragma("unroll") for (int i_ = 0; i_ < 2; ++i_) vg[h_][i_] = vgn[h_][i_]; }
    }
    PG8_WAIT_V(0);
    if (wr == 0) PG8_BAR;
    PG8_BAR;
#undef PG8_SA
#undef PG8_SB
#undef PG8_STAGE
#undef PG8_STAGE_A
#undef PG8_ROWS
#undef PG8_OFFS
#undef PG8_LD2
#undef PG8_LDA
#undef PG8_LDB
#undef PG8_MMA
#undef PG8_WAIT_V
#undef PG8_WAIT_L
#undef PG8_BAR
#undef PG8_SCHED
}
struct EpiF8 {
    static constexpr bool PERM = true;
    unsigned char* O; int ldc; const float* bias; int bias_estride; float scale, oscale;
    __device__ __forceinline__ void operator()(const f32x4 (&acc)[2][2][4][2], const Unit& u, int wr, int wc, int fr, int fq) const {
        const int row0 = u.pm * BM + wr * 64 + fr; const int col0 = u.pn * BM + wc * 32 + 8 * fq;
        f32x4 bv[2][2];
#pragma unroll
        for (int bj = 0; bj < 2; ++bj)
#pragma unroll
            for (int n = 0; n < 2; ++n) bv[bj][n] = *(const f32x4*)(bias + (size_t)u.e * bias_estride + col0 + bj * HALF + 4 * n) * oscale;
        const float sc = scale * oscale;
#pragma unroll
        for (int ai = 0; ai < 2; ++ai)
#pragma unroll
            for (int m = 0; m < 4; ++m) { unsigned char* rowp = O + (size_t)(row0 + ai * HALF + m * 16) * ldc + col0;
#pragma unroll
                for (int bj = 0; bj < 2; ++bj) { const f32x4 v0 = acc[ai][bj][m][0] * sc + bv[bj][0], v1 = acc[ai][bj][m][1] * sc + bv[bj][1];
                    u32x2 w; w.x = pk4_fp8(v0[0], v0[1], v0[2], v0[3]); w.y = pk4_fp8(v1[0], v1[1], v1[2], v1[3]);
                    *(u32x2*)(rowp + bj * HALF) = w; } }
    }
};
struct EpiSwigluF8 {
    static constexpr bool PERM = true;
    unsigned char* O; int ldo; const float* bias; int bias_estride; float scale;
    __device__ __forceinline__ void operator()(const f32x4 (&acc)[2][2][4][2], const Unit& u, int wr, int wc, int fr, int fq) const {
        const int row0 = u.pm * BM + wr * 64 + fr; const int col0 = u.pn * BM + wc * 32 + 8 * fq;
        f32x4 bv[2][2];
#pragma unroll
        for (int bj = 0; bj < 2; ++bj)
#pragma unroll
            for (int n = 0; n < 2; ++n) bv[bj][n] = *(const f32x4*)(bias + (size_t)u.e * bias_estride + col0 + bj * HALF + 4 * n);
#pragma unroll
        for (int ai = 0; ai < 2; ++ai)
#pragma unroll
            for (int m = 0; m < 4; ++m) { unsigned char* rowp = O + (size_t)(row0 + ai * HALF + m * 16) * ldo + (col0 >> 1);
#pragma unroll
                for (int bj = 0; bj < 2; ++bj) { const f32x4 v0 = acc[ai][bj][m][0] * scale + bv[bj][0], v1 = acc[ai][bj][m][1] * scale + bv[bj][1];
                    const f32x2 s0 = swiglu2_((f32x2){v0[0], v0[2]}, (f32x2){v0[1], v0[3]}), s1 = swiglu2_((f32x2){v1[0], v1[2]}, (f32x2){v1[1], v1[3]});
                    *(unsigned*)(rowp + bj * (HALF / 2)) = pk4_fp8(s0.x, s0.y, s1.x, s1.y); } }
    }
};
}
constexpr int NTHR = 512;
constexpr int LDS_MAIN = 131072;
constexpr int LDS_CTL_OFF = 8 * 64 * 65 * 4;
constexpr int LDS_BYTES = LDS_CTL_OFF + 256 + 8192;
struct Args { const float* in[40]; float* out; unsigned char* ws; int ph_lo, ph_hi; int flags, pad; };

struct Fr {
    const Args* a; LAS unsigned char* lds; unsigned char* ws; int tid, lane, wave, G, bid; int gwave, nwaves;
};
#define WSP(T, off) ((T*)(F.ws + (off)))
#define INP(i) (F.a->in[i])

typedef float f32x16 __attribute__((ext_vector_type(16)));
typedef short bf16x8v __attribute__((ext_vector_type(8)));
#define MFMA32(a, b, c) __builtin_amdgcn_mfma_f32_32x32x16_bf16((a), (b), (c), 0, 0, 0)
DI int crow(int reg, int h) { return (reg & 3) + 8 * (reg >> 2) + 4 * h; }
DI int afrag_off(int m, int k, int nks) { return ((m >> 5) * nks + (k >> 4)) * 1024 + ((m & 31) + 32 * ((k >> 3) & 1)) * 16 + (k & 7) * 2; }
DI f32x16 zero16() { f32x16 z;
#pragma unroll
    for (int i = 0; i < 16; ++i) z[i] = 0.f; return z; }
DI bf16x8v scale8(u32x4 raw, const float (&s)[8], bool rev) {
    float v[8];
    v[0] = __uint_as_float(raw.x << 16); v[1] = __uint_as_float(raw.x & 0xffff0000u); v[2] = __uint_as_float(raw.y << 16); v[3] = __uint_as_float(raw.y & 0xffff0000u);
    v[4] = __uint_as_float(raw.z << 16); v[5] = __uint_as_float(raw.z & 0xffff0000u); v[6] = __uint_as_float(raw.w << 16); v[7] = __uint_as_float(raw.w & 0xffff0000u);
    u32x4 o;
    if (!rev) { o.x = pk2(v[0] * s[0], v[1] * s[1]); o.y = pk2(v[2] * s[2], v[3] * s[3]); o.z = pk2(v[4] * s[4], v[5] * s[5]); o.w = pk2(v[6] * s[6], v[7] * s[7]); }
    else      { o.x = pk2(v[7] * s[0], v[6] * s[1]); o.y = pk2(v[5] * s[2], v[4] * s[3]); o.z = pk2(v[3] * s[4], v[2] * s[5]); o.w = pk2(v[1] * s[6], v[0] * s[7]); }
    return __builtin_bit_cast(bf16x8v, o);
}

constexpr int DA_QS = 0, DA_KS = 17408, DA_KT = 34816, DA_VT = 53248, DA_AF = 71680, DA_AR = 89088, DA_TF = 106496, DA_TR = 115712, DA_SC = 124928;
constexpr int DA_RS = 272, DA_TS = 144;

DI void dnA_unit(const Fr& F, int unit) {
    const int tc = unit % 36, h = (unit / 36) & 3, b = unit / 144;
    const int row0 = (tc < 4) ? TL + b * CTXL + tc * 64 : b * SEQ + (tc - 4) * 64;
    LAS unsigned char* L = F.lds;
    LAS float* sc = (LAS float*)(L + DA_SC);
    int lane = F.lane, w = F.wave, r = lane & 31, hh = lane >> 5;
#define DN_RELAUNDER() do { int tz_ = threadIdx.x; asm volatile("" : "+v"(tz_)); lane = tz_ & 63; r = lane & 31; hh = lane >> 5; } while (0)
    {
        const bf16_t* P = WSP(bf16_t, A0_P); const float* cw = INP(10);
        const bool isc = tc < 4; const int Lq = isc ? CTXL : SEQ; const int t0 = (isc ? tc * 64 : (tc - 4) * 64) + w * 8, rowb = row0 + w * 8;
        unsigned praw[3][11];
#pragma unroll
        for (int s = 0; s < 3; ++s)
#pragma unroll
            for (int rr = 0; rr < 11; ++rr) { const int tl = t0 + rr - 2; praw[s][rr] = (tl >= 0 && tl < Lq) ? *(const unsigned*)(P + (size_t)(rowb + rr - 2) * NP0 + s * 512 + h * 128 + lane * 2) : 0u; }
        float c0[3][8], c1[3][8];
#pragma unroll
        for (int s = 0; s < 3; ++s) {
            const int col = s * 512 + h * 128 + lane * 2;
            f32x2 wv[4], pv[11];
#pragma unroll
            for (int i = 0; i < 4; ++i) wv[i] = *(const f32x2*)(cw + i * 1536 + col);
#pragma unroll
            for (int rr = 0; rr < 11; ++rr) pv[rr] = (f32x2){__uint_as_float(praw[s][rr] << 16), __uint_as_float(praw[s][rr] & 0xffff0000u)};
#pragma unroll
            for (int j = 0; j < 8; ++j) {
                const f32x2 av = wv[0] * pv[j] + wv[1] * pv[j + 1] + wv[2] * pv[j + 2] + wv[3] * pv[j + 3];
                const f32x2 t = av * (-1.4426950408889634f); f32x2 e2; e2.x = __builtin_amdgcn_exp2f(t.x); e2.y = __builtin_amdgcn_exp2f(t.y);
                const f32x2 d2 = e2 + 1.0f; f32x2 r2; r2.x = __builtin_amdgcn_rcpf(d2.x); r2.y = __builtin_amdgcn_rcpf(d2.y);
                const f32x2 cv = av * r2; c0[s][j] = cv.x; c1[s][j] = cv.y; }
        }
        float ga[16];
#pragma unroll
        for (int g = 0; g < 16; ++g) ga[g] = c0[g >> 3][g & 7] * c0[g >> 3][g & 7] + c1[g >> 3][g & 7] * c1[g >> 3][g & 7];
#define RS16(N, OFF) { const bool up = (lane & (OFF)) != 0; _Pragma("unroll") for (int g = 0; g < (N); ++g) { const float kp = up ? ga[g + (N)] : ga[g], sd = up ? ga[g] : ga[g + (N)]; ga[g] = kp + __shfl_xor(sd, (OFF)); } }
        RS16(8, 32) RS16(4, 16) RS16(2, 8) RS16(1, 4)
#undef RS16
        float tot = ga[0]; tot += __shfl_xor(tot, 2); tot += __shfl_xor(tot, 1);
        const float rnl = rsqrtf(tot + RMS_EPS) * ((lane < 32) ? 0.08838834764831845f : 1.0f);
#pragma unroll
        for (int s = 0; s < 3; ++s) {
#pragma unroll
            for (int j = 0; j < 8; ++j) {
                float a0 = c0[s][j], a1 = c1[s][j];
                if (s < 2) { const float rn = __int_as_float(__builtin_amdgcn_readlane(__float_as_int(rnl), 4 * (s * 8 + j))); a0 *= rn; a1 *= rn; }
                const int i = w * 8 + j; const unsigned pk = pk2(a0, a1);
                if (s == 0) *(LAS unsigned*)(L + DA_QS + i * DA_RS + lane * 4) = pk;
                if (s == 1) { *(LAS unsigned*)(L + DA_KS + i * DA_RS + lane * 4) = pk;
                    *(LAS bf16_t*)(L + DA_KT + (2 * lane) * DA_TS + i * 2) = (bf16_t)(pk & 0xffff); *(LAS bf16_t*)(L + DA_KT + (2 * lane + 1) * DA_TS + i * 2) = (bf16_t)(pk >> 16); }
                if (s == 2) { *(LAS bf16_t*)(L + DA_VT + (2 * lane) * DA_TS + i * 2) = (bf16_t)(pk & 0xffff); *(LAS bf16_t*)(L + DA_VT + (2 * lane + 1) * DA_TS + i * 2) = (bf16_t)(pk >> 16); }
            }
        }
    }
    if (w < 2) {
        const int tok = w ? 63 - lane : lane; const float* gp = WSP(float, A0_GATES) + (size_t)(row0 + tok) * 16 + w * 8;
        float x = -expf(INP(11)[w * 4 + h]) * softplus_(gp[h] + INP(12)[w * 4 + h]);
#pragma unroll
        for (int off = 1; off < 64; off <<= 1) { const float y = __shfl_up(x, off); if (lane >= off) x += y; }
        sc[w * 64 + tok] = x;
        sc[128 + w * 64 + tok] = sigm(gp[4 + h]);
    }
    __syncthreads();
    DN_RELAUNDER();
    {
        const int which = w >> 2, mt = (w >> 1) & 1, nt = w & 1;
        f32x16 acc = zero16();
        const LAS unsigned char* bsrc = L + (which ? DA_QS : DA_KS);
#pragma unroll
        for (int ks = 0; ks < 8; ++ks) {
            const bf16x8v a = *(const LAS bf16x8v*)(L + DA_KS + (mt * 32 + r) * DA_RS + (ks * 16 + 8 * hh) * 2);
            const bf16x8v bb = *(const LAS bf16x8v*)(bsrc + (nt * 32 + r) * DA_RS + (ks * 16 + 8 * hh) * 2);
            acc = MFMA32(a, bb, acc);
        }
        if (which == 0) {
            const int j = nt * 32 + r; const float gfj = sc[j], grj = sc[64 + j];
            LAS float* Af = (LAS float*)(L + DA_AF); LAS float* Ar = (LAS float*)(L + DA_AR);
#pragma unroll
            for (int reg = 0; reg < 16; ++reg) { const int i = mt * 32 + crow(reg, hh); const float kk = acc[reg];
                Af[i * 68 + j] = (j < i) ? sc[128 + i] * kk * __expf(sc[i] - gfj) : 0.f;
                Ar[(63 - i) * 68 + (63 - j)] = (j > i) ? sc[192 + i] * kk * __expf(sc[64 + i] - grj) : 0.f; }
        } else {
            const int i = nt * 32 + r; const float gfi = sc[i], gri = sc[64 + i];
            const size_t cuf = ((size_t)((b * 4 + h) * 2 + 0) * 36 + tc), cur = ((size_t)((b * 4 + h) * 2 + 1) * 36 + ((tc < 4) ? 3 - tc : 4 + 35 - tc));
            unsigned char* attf = WSP(unsigned char, A0_ATT) + cuf * 8192; unsigned char* attr = WSP(unsigned char, A0_ATT) + cur * 8192;
#pragma unroll
            for (int g4 = 0; g4 < 4; ++g4) {
                const int j0 = mt * 32 + 8 * g4 + 4 * hh; float vf[4], vr[4];
#pragma unroll
                for (int e = 0; e < 4; ++e) { const int j = j0 + e; const float a = acc[4 * g4 + e];
                    vf[e] = (j <= i) ? a * __expf(gfi - sc[j]) : 0.f; vr[e] = (j >= i) ? a * __expf(gri - sc[64 + j]) : 0.f; }
                u32x2 wf; wf.x = pk2(vf[0], vf[1]); wf.y = pk2(vf[2], vf[3]);
                *(u32x2*)(attf + afrag_off(i, j0, 4)) = wf;
                u32x2 wr; wr.x = pk2(vr[3], vr[2]); wr.y = pk2(vr[1], vr[0]);
                *(u32x2*)(attr + afrag_off(63 - i, 60 - j0, 4)) = wr;
            }
        }
    }
    __syncthreads();
    DN_RELAUNDER();
    if (w < 2) {
        LAS float* A = (LAS float*)(L + (w ? DA_AR : DA_AF)); LAS unsigned char* T = L + (w ? DA_TR : DA_TF);
        const int fr = lane & 15, fq = lane >> 4;
        {
            float tcol[16]; LAS float* Ab = A + (16 * fq) * 68 + 16 * fq;
#pragma unroll
            for (int rr = 0; rr < 16; ++rr) {
                float s0 = (rr == fr) ? 1.0f : 0.0f, s1 = 0.f;
#pragma unroll
                for (int j4 = 0; j4 < (rr + 3) / 4; ++j4) { const f32x4 a4 = *(const LAS f32x4*)(Ab + rr * 68 + j4 * 4);
                    if (j4 * 4 + 0 < rr) s0 -= a4[0] * tcol[j4 * 4 + 0];
                    if (j4 * 4 + 1 < rr) s1 -= a4[1] * tcol[j4 * 4 + 1];
                    if (j4 * 4 + 2 < rr) s0 -= a4[2] * tcol[j4 * 4 + 2];
                    if (j4 * 4 + 3 < rr) s1 -= a4[3] * tcol[j4 * 4 + 3]; }
                tcol[rr] = s0 + s1;
            }
            asm volatile("" ::: "memory");
#pragma unroll
            for (int rr = 0; rr < 16; ++rr) Ab[rr * 68 + fr] = tcol[rr];
            asm volatile("" ::: "memory");
        }
#pragma unroll
        for (int bi = 1; bi < 4; ++bi)
#pragma unroll
            for (int bj = 0; bj < bi; ++bj) {
                f32x4 acc = (f32x4){0.f, 0.f, 0.f, 0.f};
#pragma unroll
                for (int bk = bj; bk < bi; ++bk)
#pragma unroll
                    for (int kk = 0; kk < 4; ++kk) { const float av = A[(16 * bi + fr) * 68 + 16 * bk + 4 * kk + fq], bv = A[(16 * bk + 4 * kk + fq) * 68 + 16 * bj + fr];
                        acc = __builtin_amdgcn_mfma_f32_16x16x4f32(av, bv, acc, 0, 0, 0); }
                asm volatile("" ::: "memory");
#pragma unroll
                for (int r4 = 0; r4 < 4; ++r4) A[(16 * bi + 4 * fq + r4) * 68 + 16 * bj + fr] = acc[r4];
                asm volatile("" ::: "memory");
                f32x4 tij = (f32x4){0.f, 0.f, 0.f, 0.f};
#pragma unroll
                for (int kk = 0; kk < 4; ++kk) { const float av = A[(16 * bi + fr) * 68 + 16 * bi + 4 * kk + fq], bv = A[(16 * bi + 4 * kk + fq) * 68 + 16 * bj + fr];
                    tij = __builtin_amdgcn_mfma_f32_16x16x4f32(av, bv, tij, 0, 0, 0); }
                asm volatile("" ::: "memory");
#pragma unroll
                for (int r4 = 0; r4 < 4; ++r4) A[(16 * bi + 4 * fq + r4) * 68 + 16 * bj + fr] = -tij[r4];
                asm volatile("" ::: "memory");
            }
#pragma unroll 8
        for (int i = 0; i < 64; ++i) *(LAS bf16_t*)(T + i * DA_TS + lane * 2) = f2bf(A[i * 68 + lane]);
    } else {
        for (int p = (w * 64 + lane) - 128; p < 4096; p += NTHR - 128) {
            const int d = p >> 11, kind = (p >> 10) & 1, q = p & 1023;
            const size_t cu = ((size_t)((b * 4 + h) * 2 + d) * 36 + (d ? ((tc < 4) ? 3 - tc : 4 + 35 - tc) : tc));
            const LAS float* gc = sc + d * 64;
            if (kind == 0) {
                const int ip = q >> 4, c8 = (q & 15) * 8, i = d ? 63 - ip : ip; const float e = __expf(gc[i]);
                const u32x4 raw = *(const LAS u32x4*)(L + DA_QS + i * DA_RS + c8 * 2); const float s8[8] = {e, e, e, e, e, e, e, e};
                *(bf16x8v*)(WSP(unsigned char, A0_WQ) + cu * 32768 + afrag_off(64 + ip, c8, 8)) = scale8(raw, s8, false);
            } else {
                const int dk = q >> 3, i8 = (q & 7) * 8; const float gl = d ? gc[0] : gc[63]; float s8[8];
#pragma unroll
                for (int e = 0; e < 8; ++e) { const int i = d ? 63 - (i8 + e) : i8 + e; s8[e] = __expf(gl - gc[i]); }
                const u32x4 raw = *(const LAS u32x4*)(L + DA_KT + dk * DA_TS + (d ? 56 - i8 : i8) * 2);
                *(bf16x8v*)(WSP(unsigned char, A0_KDT) + cu * 16384 + afrag_off(dk, i8, 4)) = scale8(raw, s8, d != 0);
            }
        }
    }
    __syncthreads();
#pragma unroll 1
    for (int d = 0; d < 2; ++d) {
        DN_RELAUNDER();
        const size_t cu = ((size_t)((b * 4 + h) * 2 + d) * 36 + (d ? ((tc < 4) ? 3 - tc : 4 + 35 - tc) : tc));
        const LAS unsigned char* T = L + (d ? DA_TR : DA_TF); const LAS float* gc = sc + d * 64; const LAS float* be = sc + 128 + d * 64;
        {
            const int mt = w >> 2, nt = w & 3; f32x16 acc = zero16();
#pragma unroll
            for (int ks = 0; ks < 4; ++ks) {
                const bf16x8v a = *(const LAS bf16x8v*)(T + (mt * 32 + r) * DA_TS + (ks * 16 + 8 * hh) * 2);
                const int jp = ks * 16 + 8 * hh; float s8[8];
#pragma unroll
                for (int e = 0; e < 8; ++e) s8[e] = be[d ? 63 - (jp + e) : jp + e];
                const u32x4 raw = *(const LAS u32x4*)(L + DA_VT + (nt * 32 + r) * DA_TS + (d ? 56 - jp : jp) * 2);
                acc = MFMA32(a, scale8(raw, s8, d != 0), acc);
            }
            bf16_t* uu = WSP(bf16_t, A0_UU) + cu * 8192 + ((size_t)(mt * 4 + nt) * 64 + lane) * 16;
#pragma unroll
            for (int g8 = 0; g8 < 2; ++g8) { u32x4 o; o.x = pk2(acc[8 * g8], acc[8 * g8 + 1]); o.y = pk2(acc[8 * g8 + 2], acc[8 * g8 + 3]); o.z = pk2(acc[8 * g8 + 4], acc[8 * g8 + 5]); o.w = pk2(acc[8 * g8 + 6], acc[8 * g8 + 7]);
                *(u32x4*)(uu + 8 * g8) = o; }
        }
        {
            const int mt = w >> 1, nt = w & 1; f32x16 acc = zero16();
#pragma unroll
            for (int ks = 0; ks < 4; ++ks) {
                const int jp = ks * 16 + 8 * hh; float s8[8];
#pragma unroll
                for (int e = 0; e < 8; ++e) { const int j = d ? 63 - (jp + e) : jp + e; s8[e] = be[j] * __expf(gc[j]); }
                const u32x4 raw = *(const LAS u32x4*)(L + DA_KT + (mt * 32 + r) * DA_TS + (d ? 56 - jp : jp) * 2);
                const bf16x8v bb = *(const LAS bf16x8v*)(T + (nt * 32 + r) * DA_TS + (ks * 16 + 8 * hh) * 2);
                acc = MFMA32(scale8(raw, s8, d != 0), bb, acc);
            }
            unsigned char* wq = WSP(unsigned char, A0_WQ) + cu * 32768; const int ip = nt * 32 + r;
#pragma unroll
            for (int g4 = 0; g4 < 4; ++g4) { const int k0 = mt * 32 + 8 * g4 + 4 * hh; u32x2 o; o.x = pk2(acc[4 * g4], acc[4 * g4 + 1]); o.y = pk2(acc[4 * g4 + 2], acc[4 * g4 + 3]);
                *(u32x2*)(wq + afrag_off(ip, k0, 8)) = o; }
        }
        if (F.tid == 0) WSP(float, A0_GL)[cu] = __expf(d ? gc[0] : gc[63]);
    }
    __syncthreads();
#undef DN_RELAUNDER
}

constexpr int DB_ST = 0, DB_VN = 34816;
constexpr int DB_OT = 53248, DB_OTS = 132;
DI void dnB_chain(const Fr& F, int unit) {
    const int d = unit & 1, h = (unit >> 1) & 3, b = unit >> 3;
    LAS unsigned char* L = F.lds; const int lane = F.lane, w = F.wave, r = lane & 31, hh = lane >> 5;
    const int mt = w >> 1, ntb = (w & 1) * 2;
    for (int i = F.tid; i < DB_VN / 16; i += NTHR) *(LAS u32x4*)(L + i * 16) = (u32x4){0u, 0u, 0u, 0u};
    f32x16 S0 = zero16(), S1 = zero16();
    const unsigned char* WQ = WSP(unsigned char, A0_WQ) + (size_t)unit * 36 * 32768; const unsigned char* KDT = WSP(unsigned char, A0_KDT) + (size_t)unit * 36 * 16384;
    const unsigned char* ATT = WSP(unsigned char, A0_ATT) + (size_t)unit * 36 * 8192; const bf16_t* UU = WSP(bf16_t, A0_UU) + (size_t)unit * 36 * 8192; const float* GL = WSP(float, A0_GL) + (size_t)unit * 36;
    bf16_t* OD = WSP(bf16_t, A0_OD) + (size_t)d * TT * 512;
    __syncthreads();
    bf16x8v wqf[8], kdf[4], atf[4]; u32x4 u0b[2], u1b[2]; float gl;
    {
        const unsigned char* wq = WQ + (size_t)(mt * 8) * 1024 + lane * 16; const unsigned char* kd = KDT + (size_t)(mt * 4) * 1024 + lane * 16;
        const unsigned char* at = ATT + (size_t)((mt & 1) * 4) * 1024 + lane * 16; const bf16_t* u0 = UU + ((size_t)((mt & 1) * 4 + ntb) * 64 + lane) * 16;
#pragma unroll
        for (int ks = 0; ks < 8; ++ks) wqf[ks] = *(const bf16x8v*)(wq + ks * 1024);
#pragma unroll
        for (int k2 = 0; k2 < 2; ++k2) { u0b[k2] = *(const u32x4*)(u0 + 8 * k2); u1b[k2] = *(const u32x4*)(u0 + 64 * 16 + 8 * k2); }
        gl = GL[0];
#pragma unroll
        for (int ks = 0; ks < 4; ++ks) kdf[ks] = *(const bf16x8v*)(kd + ks * 1024);
#pragma unroll
        for (int ks = 0; ks < 4; ++ks) atf[ks] = *(const bf16x8v*)(at + ks * 1024);
    }
#pragma unroll 1
    for (int n = 0; n < 36; ++n) {
        const int nn = (n + 1 < 36) ? n + 1 : n;
        const unsigned char* wq = WQ + (size_t)nn * 32768 + (size_t)(mt * 8) * 1024 + lane * 16;
        const unsigned char* kd = KDT + (size_t)nn * 16384 + (size_t)(mt * 4) * 1024 + lane * 16;
        const unsigned char* at = ATT + (size_t)nn * 8192 + (size_t)((mt & 1) * 4) * 1024 + lane * 16;
        const bf16_t* u0 = UU + (size_t)nn * 8192 + ((size_t)((mt & 1) * 4 + ntb) * 64 + lane) * 16;
        f32x16 P0 = zero16(), P1 = zero16();
#pragma unroll
        for (int ks = 0; ks < 8; ++ks) {
            const bf16x8v b0 = *(const LAS bf16x8v*)(L + DB_ST + (ntb * 32 + r) * 272 + (ks * 16 + 8 * hh) * 2);
            const bf16x8v b1 = *(const LAS bf16x8v*)(L + DB_ST + ((ntb + 1) * 32 + r) * 272 + (ks * 16 + 8 * hh) * 2);
            P0 = MFMA32(wqf[ks], b0, P0); P1 = MFMA32(wqf[ks], b1, P1);
        }
#pragma unroll
        for (int ks = 0; ks < 8; ++ks) wqf[ks] = *(const bf16x8v*)(wq + ks * 1024);
        if (w < 4) {
#pragma unroll
            for (int g4 = 0; g4 < 4; ++g4) {
                const unsigned ua = u0b[g4 >> 1][(g4 & 1) * 2], ub = u0b[g4 >> 1][(g4 & 1) * 2 + 1], uc = u1b[g4 >> 1][(g4 & 1) * 2], ud = u1b[g4 >> 1][(g4 & 1) * 2 + 1];
                const f32x4 a0 = (f32x4){__uint_as_float(ua << 16), __uint_as_float(ua & 0xffff0000u), __uint_as_float(ub << 16), __uint_as_float(ub & 0xffff0000u)};
                const f32x4 a1 = (f32x4){__uint_as_float(uc << 16), __uint_as_float(uc & 0xffff0000u), __uint_as_float(ud << 16), __uint_as_float(ud & 0xffff0000u)}; const int i0 = mt * 32 + 8 * g4 + 4 * hh;
                u32x2 o0, o1; o0.x = pk2(a0[0] - P0[4 * g4], a0[1] - P0[4 * g4 + 1]); o0.y = pk2(a0[2] - P0[4 * g4 + 2], a0[3] - P0[4 * g4 + 3]);
                o1.x = pk2(a1[0] - P1[4 * g4], a1[1] - P1[4 * g4 + 1]); o1.y = pk2(a1[2] - P1[4 * g4 + 2], a1[3] - P1[4 * g4 + 3]);
                *(LAS u32x2*)(L + DB_VN + (ntb * 32 + r) * 144 + i0 * 2) = o0; *(LAS u32x2*)(L + DB_VN + ((ntb + 1) * 32 + r) * 144 + i0 * 2) = o1;
            }
        }
        asm volatile("" ::: "memory");
#pragma unroll
        for (int k2 = 0; k2 < 2; ++k2) { u0b[k2] = *(const u32x4*)(u0 + 8 * k2); u1b[k2] = *(const u32x4*)(u0 + 64 * 16 + 8 * k2); }
        __syncthreads();
#pragma unroll
        for (int i = 0; i < 16; ++i) { S0[i] *= gl; S1[i] *= gl; }
        gl = GL[nn];
#pragma unroll
        for (int ks = 0; ks < 4; ++ks) {
            const bf16x8v b0 = *(const LAS bf16x8v*)(L + DB_VN + (ntb * 32 + r) * 144 + (ks * 16 + 8 * hh) * 2);
            const bf16x8v b1 = *(const LAS bf16x8v*)(L + DB_VN + ((ntb + 1) * 32 + r) * 144 + (ks * 16 + 8 * hh) * 2);
            S0 = MFMA32(kdf[ks], b0, S0); S1 = MFMA32(kdf[ks], b1, S1);
            if (w >= 4) { P0 = MFMA32(atf[ks], b0, P0); P1 = MFMA32(atf[ks], b1, P1); }
        }
        asm volatile("" ::: "memory");
#pragma unroll
        for (int ks = 0; ks < 4; ++ks) kdf[ks] = *(const bf16x8v*)(kd + ks * 1024);
#pragma unroll
        for (int ks = 0; ks < 4; ++ks) atf[ks] = *(const bf16x8v*)(at + ks * 1024);
        if (w >= 4) {
            LAS float* ot = (LAS float*)(L + DB_OT) + ((mt - 2) * 32 + 4 * hh) * DB_OTS + ntb * 32 + r;
#pragma unroll
            for (int reg = 0; reg < 16; ++reg) { LAS float* o = ot + ((reg & 3) + 8 * (reg >> 2)) * DB_OTS; o[0] = P0[reg]; o[32] = P1[reg]; }
        }
#pragma unroll
        for (int g4 = 0; g4 < 4; ++g4) { const int k0 = mt * 32 + 8 * g4 + 4 * hh;
            u32x2 o0, o1; o0.x = pk2(S0[4 * g4], S0[4 * g4 + 1]); o0.y = pk2(S0[4 * g4 + 2], S0[4 * g4 + 3]); o1.x = pk2(S1[4 * g4], S1[4 * g4 + 1]); o1.y = pk2(S1[4 * g4 + 2], S1[4 * g4 + 3]);
            *(LAS u32x2*)(L + DB_ST + (ntb * 32 + r) * 272 + k0 * 2) = o0; *(LAS u32x2*)(L + DB_ST + ((ntb + 1) * 32 + r) * 272 + k0 * 2) = o1; }
        __syncthreads();
#pragma unroll
        for (int q = 0; q < 4; ++q) { const int ip = w * 8 + q * 2 + hh;
            const f32x4 v = *(const LAS f32x4*)((LAS float*)(L + DB_OT) + ip * DB_OTS + r * 4); u32x2 ov; ov.x = pk2(v[0], v[1]); ov.y = pk2(v[2], v[3]);
            *(u32x2*)(OD + (size_t)row_of(b, d, n * 64 + ip) * 512 + h * 128 + r * 4) = ov; }
    }
}
#ifndef MK_DN_NAIVE
#define MK_DN_NAIVE 0
#endif
DI void tconv(const Fr& F, const float* src, size_t sbs, int ld, int col0, int K, int N, bf16_t* dst, size_t dbs, int nb, int drs = 0, long u0 = 0, long u1 = -1, int vbid = -1, int vG = 0) {
    if (drs == 0) drs = K;
    LAS float* tile = (LAS float*)F.lds;
    const int tk = K / 64, tn = N / 256, per = tk * tn; const long total = (u1 >= 0) ? u1 : (long)nb * per;
    const int rr = F.tid >> 6, c4 = (F.tid & 63) * 4; const int ustep = (vbid >= 0) ? vG : F.G;
    f32x4 v[8];
    long u = u0 + ((vbid >= 0) ? vbid : F.bid);
    if (u < total) { const int b = (int)(u / per), r = (int)(u % per), kt = r / tn, nt_ = r % tn; const float* sp = src + (size_t)b * sbs + (size_t)(kt * 64) * ld + col0 + nt_ * 256;
#pragma unroll
        for (int h = 0; h < 8; ++h) v[h] = __builtin_nontemporal_load((const f32x4*)(sp + (size_t)(rr + 8 * h) * ld + c4)); }
    for (; u < total; u += ustep) {
        const int b = (int)(u / per), r = (int)(u % per), kt = r / tn, nt_ = r % tn;
#pragma unroll
        for (int h = 0; h < 8; ++h) { LAS float* tp = tile + (rr + 8 * h) * 257 + c4; tp[0] = v[h][0]; tp[1] = v[h][1]; tp[2] = v[h][2]; tp[3] = v[h][3]; }
        __syncthreads();
        const long un = u + ustep;
        if (un < total) { const int b2 = (int)(un / per), r2 = (int)(un % per), kt2 = r2 / tn, nt2 = r2 % tn; const float* sp = src + (size_t)b2 * sbs + (size_t)(kt2 * 64) * ld + col0 + nt2 * 256;
#pragma unroll
            for (int h = 0; h < 8; ++h) v[h] = __builtin_nontemporal_load((const f32x4*)(sp + (size_t)(rr + 8 * h) * ld + c4)); }
        {
#pragma unroll
            for (int q = 0; q < 4; ++q) { const int n = (F.tid >> 3) + 64 * q, k8 = (F.tid & 7) * 8; float x[8];
#pragma unroll
                for (int j = 0; j < 8; ++j) x[j] = tile[(k8 + j) * 257 + n];
                u32x4 w; w.x = pk2(x[0], x[1]); w.y = pk2(x[2], x[3]); w.z = pk2(x[4], x[5]); w.w = pk2(x[6], x[7]);
                *(u32x4*)(dst + (size_t)b * dbs + (size_t)(nt_ * 256 + n) * drs + kt * 64 + k8) = w; } }
        __syncthreads();
    }
}

#ifndef MK_BG_CONV
#define MK_BG_CONV 0
#endif
constexpr int TQ_PER_LAYER = 32 * 768, TQ_TOTAL = 2 * TQ_PER_LAYER;
DI void conv_chunk_wave(const Fr& F, int c, LAS float* tile  ) {
    const int l = c / TQ_PER_LAYER, r = c % TQ_PER_LAYER, e = r / 768, q = r % 768; const int lane = F.lane;
    const bool is2 = q >= 512; const int qq = is2 ? q - 512 : q; const int N = is2 ? DM : 2048; const int nts = N / 64;
    const int kt = qq / nts, nt_ = qq % nts;
    const float* src = (is2 ? INP(38) + ((size_t)l * 32 + e) * DM * DM : INP(36) + ((size_t)l * 32 + e) * DM * 2048) + (size_t)(kt * 64) * N + nt_ * 64;
    bf16_t* dst = (is2 ? WSP(bf16_t, WS_WM2) + ((size_t)l * 32 + e) * DM * DM : WSP(bf16_t, WS_WM1) + ((size_t)l * 32 + e) * 2048 * DM) + (size_t)(nt_ * 64) * DM + kt * 64;
    const int rs = lane >> 4, c4 = (lane & 15) * 4;
    f32x4 v[16];
#pragma unroll
    for (int j = 0; j < 16; ++j) v[j] = __builtin_nontemporal_load((const f32x4*)(src + (size_t)(rs + 4 * j) * N + c4));
#pragma unroll
    for (int j = 0; j < 16; ++j) { LAS float* tp = tile + (rs + 4 * j) * 65 + c4; tp[0] = v[j][0]; tp[1] = v[j][1]; tp[2] = v[j][2]; tp[3] = v[j][3]; }
#pragma unroll
    for (int j = 0; j < 8; ++j) { const int n = (lane >> 3) + 8 * j, k8 = (lane & 7) * 8; float x[8];
#pragma unroll
        for (int i = 0; i < 8; ++i) x[i] = tile[(k8 + i) * 65 + n];
        u32x4 w; w.x = pk2(x[0], x[1]); w.y = pk2(x[2], x[3]); w.z = pk2(x[4], x[5]); w.w = pk2(x[6], x[7]);
        *(u32x4*)(dst + (size_t)n * DM + k8) = w; }
}
DI int conv_claim(const Fr& F) { int c = 0; if (F.lane == 0) c = (int)__hip_atomic_fetch_add(WSP(unsigned, WS_CTL) + CW_TQ, 1u, __ATOMIC_RELAXED, __HIP_MEMORY_SCOPE_AGENT); return __builtin_amdgcn_readfirstlane(c); }
DI void conv_drain(const Fr& F, int upto) {
    LAS float* tile = (LAS float*)F.lds + F.wave * (64 * 65);
    for (;;) { const int c = conv_claim(F); if (c >= TQ_TOTAL) break; conv_chunk_wave(F, c, tile); if (c >= upto) break; }
}
DI void xcd_barrier_work(const XcdBarrier& b, const Fr& F) {
    asm volatile("s_waitcnt vmcnt(0)" ::: "memory");
    if (threadIdx.x == 0) b.st[2] = 0u;
    __syncthreads();
    if (F.wave == 0) {
        if (threadIdx.x == 0) {
            unsigned* bar = b.bar;
            __builtin_amdgcn_s_waitcnt(0);
            unsigned nloc = b.st[0], nx = b.st[1];
            if (nloc == 0u) { xcd_barrier_complete(bar, b.x, nloc, nx); b.st[0] = nloc; b.st[1] = nx; }
            const unsigned old = xb_add(&bar[XB_XSUB(b.x)], 1u);
            const unsigned gen = old / nloc;
            if (old + 1u == (gen + 1u) * nloc) {
                __builtin_amdgcn_fence(__ATOMIC_RELEASE, "agent");
                asm volatile("s_waitcnt vmcnt(0)" ::: "memory");
                const unsigned og = xb_add(&bar[XB_TOP], 1u);
                const unsigned tg = og / nx;
                if (og + 1u == (tg + 1u) * nx) xb_add(&bar[XB_TOPGEN], 1u);
                else XB_SPIN(xb_ld(&bar[XB_TOPGEN]) == tg, bar);
                __builtin_amdgcn_fence(__ATOMIC_ACQUIRE, "agent");
                xb_add(&bar[XB_XGEN(b.x)], 1u);
                asm volatile("s_waitcnt vmcnt(0)" ::: "memory");
            } else {
                XB_SPIN(xb_ld(&bar[XB_XGEN(b.x)]) == gen, bar);
                __builtin_amdgcn_fence(__ATOMIC_ACQUIRE, "agent");
                asm volatile("s_waitcnt vmcnt(0)" ::: "memory");
            }
            b.st[2] = 1u;
        }
    } else {
        LAS float* tile = (LAS float*)F.lds + F.wave * (64 * 65);
        while (b.st[2] == 0u) { const int c = conv_claim(F); if (c >= TQ_TOTAL) break; conv_chunk_wave(F, c, tile); }
    }
    __syncthreads();
}

DI void tconv8(const Fr& F, const float* src, size_t sbs, int ld, int K, int N, unsigned char* dst, size_t dbs, int nb, float scale, long u0, long u1, int vbid, int vG) {
    LAS float* tile = (LAS float*)F.lds;
    const int tk = K / 128, tn = N / 128, per = tk * tn; const long total = (u1 >= 0) ? u1 : (long)nb * per;
    const int rr = F.tid >> 5, c4 = (F.tid & 31) * 4; const int ustep = (vbid >= 0) ? vG : F.G;
    f32x4 va[8], vb[8];
    long u = u0 + ((vbid >= 0) ? vbid : F.bid);
#define TC8_LOAD(V, U) do { const long u_ = (U); if (u_ < total) { const int b_ = (int)(u_ / per), r_ = (int)(u_ % per), kt_ = r_ / tn, nt2_ = r_ % tn; const float* sp_ = src + (size_t)b_ * sbs + (size_t)(kt_ * 128) * ld + nt2_ * 128; \
        _Pragma("unroll") for (int h_ = 0; h_ < 8; ++h_) V[h_] = __builtin_nontemporal_load((const f32x4*)(sp_ + (size_t)(rr + 16 * h_) * ld + c4)); } } while (0)
#define TC8_BODY(V) do { const int b = (int)(u / per), r = (int)(u % per), kt = r / tn, nt_ = r % tn; \
        _Pragma("unroll") for (int h = 0; h < 8; ++h) { LAS float* tp = tile + (rr + 16 * h) * 129 + c4; tp[0] = V[h][0]; tp[1] = V[h][1]; tp[2] = V[h][2]; tp[3] = V[h][3]; } \
        TC8_LOAD(V, u + 2 * (long)ustep); \
        __syncthreads(); \
        _Pragma("unroll") for (int q = 0; q < 2; ++q) { const int n = (F.tid >> 3) + 64 * q, k16 = (F.tid & 7) * 16; float x[16]; \
            _Pragma("unroll") for (int j = 0; j < 16; ++j) x[j] = tile[(k16 + j) * 129 + n] * scale; \
            u32x4 w; w.x = pk4_fp8(x[0], x[1], x[2], x[3]); w.y = pk4_fp8(x[4], x[5], x[6], x[7]); w.z = pk4_fp8(x[8], x[9], x[10], x[11]); w.w = pk4_fp8(x[12], x[13], x[14], x[15]); \
            *(u32x4*)(dst + (size_t)b * dbs + (size_t)(nt_ * 128 + n) * K + kt * 128 + k16) = w; } \
        __syncthreads(); } while (0)
    TC8_LOAD(va, u); TC8_LOAD(vb, u + ustep);
    for (;;) {
        if (u >= total) break;
        TC8_BODY(va); u += ustep;
        if (u >= total) break;
        TC8_BODY(vb); u += ustep;
    }
#undef TC8_LOAD
#undef TC8_BODY
}
constexpr int L1W1_A = 1344, L1W1_B = 2304, L1W2_A = 2048, L1W1_C = 2304, L1W1_D = 608;
DI void moe_w_l1_part(const Fr& F, int which, long u0, long u1, int vbid, int vG) {
#if MK_FP8_L1
    if (which == 0) tconv8(F, INP(36) + (size_t)32 * DM * 2048, (size_t)DM * 2048, 2048, DM, 2048, WSP(unsigned char, WS_WM1) + (size_t)32 * 2048 * DM * 2, (size_t)2048 * DM, 32, W1_F8S, u0, u1, vbid, vG);
    else tconv8(F, INP(38) + (size_t)32 * DM * DM, (size_t)DM * DM, DM, DM, DM, WSP(unsigned char, WS_WM2) + (size_t)32 * DM * DM * 2, (size_t)DM * DM, 32, W2_F8S, u0, u1, vbid, vG);
#else
    if (which == 0) tconv(F, INP(36) + (size_t)32 * DM * 2048, (size_t)DM * 2048, 2048, 0, DM, 2048, WSP(bf16_t, WS_WM1) + (size_t)32 * 2048 * DM, (size_t)2048 * DM, 32, 0, u0, u1, vbid, vG);
    else tconv(F, INP(38) + (size_t)32 * DM * DM, (size_t)DM * DM, DM, 0, DM, DM, WSP(bf16_t, WS_WM2) + (size_t)32 * DM * DM, (size_t)DM * DM, 32, 0, u0, u1, vbid, vG);
#endif
}
#ifndef MK_P0_MASK
#define MK_P0_MASK 31
#endif
#ifndef MK_P0_TWICE
#define MK_P0_TWICE 0
#endif
DI void p0_prologue(const Fr& F) {
    for (int rep_ = 0; rep_ < ((MK_P0_TWICE & 2) ? 2 : 1); ++rep_) {
    for (int tix = F.bid; tix < 544; tix += F.G) {
        if (tix < 128)      tconv(F, INP(8), 0, EVEN_IN, 0, DM, 2048, WSP(bf16_t, WS_WEVIN), 0, 1, 0, tix, tix + 1, 0, 1);
        else if (tix < 224) tconv(F, INP(8), 0, EVEN_IN, HY_COL, DM, 1536, WSP(bf16_t, WS_WEVIN) + (size_t)2048 * DM, 0, 1, 0, tix - 128, tix - 127, 0, 1);
        else if (tix < 288) tconv(F, INP(9), 0, DM, 0, MIXW, DM, WSP(bf16_t, WS_WEVOUT), 0, 1, 0, tix - 224, tix - 223, 0, 1);
        else if (tix < 416) tconv(F, INP(23), 0, 2048, 0, DM, 2048, WSP(bf16_t, WS_WODIN), 0, 1, 0, tix - 288, tix - 287, 0, 1);
        else if (tix < 480) tconv(F, INP(32), 0, DM, 0, DM, DM, WSP(bf16_t, WS_WODOUT), 0, 1, 0, tix - 416, tix - 415, 0, 1);
        else {
            const int th = (tix - 480) >> 2, kt = (tix - 480) & 3, g = th >> 3, d = (th >> 2) & 1, h = th & 3;
            tconv(F, (g ? INP(29) : INP(27)) + (size_t)(d * 4 + h) * 65536, 0, 256, 0, 256, 256, WSP(bf16_t, WS_WLRU) + ((size_t)(d * 4 + h) * 512 + g) * 256, 0, 1, 512, kt, kt + 1, 0, 1); }
    }
    for (int i = F.bid * NTHR + F.tid; i < 4096; i += F.G * NTHR) { const int g = i & 1, j = (i >> 1) & 255, h = (i >> 9) & 3, d = i >> 11;
        WSP(float, WS_BLRU)[i] = (g ? INP(30) : INP(28))[d * DM + h * 256 + j];
        if (i < 2048) WSP(float, WS_BLRU)[4096 + i] = -8.0f * softplus_(INP(31)[i]); }
    }
    for (int i = F.bid * NTHR + F.tid; i < 2 * DM * NEXP; i += F.G * NTHR) { const int l = i >> 15, k = (i >> 5) & 1023, e = i & 31; WSP(float, WS_RWT)[(size_t)l * 32768 + e * DM + k] = INP(34)[i]; }
    for (int i = F.bid * NTHR + F.tid; i < 16 * DM; i += F.G * NTHR) { const int k = i >> 4, g = i & 15; WSP(float, WS_WGT)[g * DM + k] = INP(8)[(size_t)k * EVEN_IN + DN_GATE_COL + g]; }
#if !MK_BG_CONV
#if MK_FP8_L0
    tconv8(F, INP(36), (size_t)DM * 2048, 2048, DM, 2048, WSP(unsigned char, WS_WM1), (size_t)2048 * DM, 32, W1_F8S, 0, -1, -1, 0);
    tconv8(F, INP(38), (size_t)DM * DM, DM, DM, DM, WSP(unsigned char, WS_WM2), (size_t)DM * DM, 32, W2_F8S, 0, -1, -1, 0);
#else
    tconv(F, INP(36), (size_t)DM * 2048, 2048, 0, DM, 2048, WSP(bf16_t, WS_WM1), (size_t)2048 * DM, 32);
    tconv(F, INP(38), (size_t)DM * DM, DM, 0, DM, DM, WSP(bf16_t, WS_WM2), (size_t)DM * DM, 32);
#endif
    if (F.G == 256) { if (L1W1_B < L1W1_C) moe_w_l1_part(F, 0, L1W1_B, L1W1_C, F.bid, F.G); if (L1W2_A < 2048) moe_w_l1_part(F, 1, L1W2_A, 2048, F.bid, F.G); } else { moe_w_l1_part(F, 0, 0, 4096, F.bid, F.G); moe_w_l1_part(F, 1, 0, 2048, F.bid, F.G); }
#endif
    for (int rep_ = 0; rep_ < ((MK_P0_TWICE & 4) ? 2 : 1); ++rep_)
    if (MK_P0_MASK & 4) {
        LAS float* sl = (LAS float*)F.lds;
        LAS float* part = sl + 9 * 1024;
        for (int i = F.tid; i < 9 * 1024; i += NTHR) { const int r = i >> 10, k = i & 1023; const float v = (r < 8) ? INP(1)[r * DM + k] : INP(3)[k]; sl[i] = silu_(v); }
        __syncthreads();
        float* MOD = WSP(float, WS_MOD);
        for (int u = F.bid; u < 192; u += F.G) {
            const int l = u / 96, n0 = (u % 96) * 64;
            const float* W = INP(4) + (size_t)l * DM * 6144 + n0 + F.lane;
            float acc[9];
#pragma unroll
            for (int r = 0; r < 9; ++r) acc[r] = 0.f;
#pragma unroll 16
            for (int k = F.wave * 128; k < F.wave * 128 + 128; ++k) { const float w = W[(size_t)k * 6144];
#pragma unroll
                for (int r = 0; r < 9; ++r) acc[r] += sl[r * 1024 + k] * w; }
#pragma unroll
            for (int r = 0; r < 9; ++r) part[(F.wave * 9 + r) * 64 + F.lane] = acc[r];
            __syncthreads();
            for (int i = F.tid; i < 9 * 64; i += NTHR) { const int r = i >> 6, ln = i & 63; float s = INP(5)[(size_t)l * 6144 + n0 + ln];
#pragma unroll
                for (int w = 0; w < 8; ++w) s += part[(w * 9 + r) * 64 + ln];
                MOD[((size_t)l * 9 + r) * 6144 + n0 + ln] = s; }
            __syncthreads();
        }
    }
    if (MK_P0_MASK & 8) {
        float* POS = WSP(float, WS_POS);
        for (int i = F.bid * NTHR + F.tid; i < 96 * 512; i += F.G * NTHR) {
            const int p = i >> 9, d = i & 511, fi = d & 255;
            const float omega = 1.0f / powf(10000.0f, (float)fi / 256.0f);
            const float ang = (float)((p < 32) ? p : p - 32) * omega;
            POS[i] = (d & 256) ? cosf(ang) : sinf(ang);
        }
    }
    for (int rep_ = 0; rep_ < ((MK_P0_TWICE & 1) ? 2 : 1); ++rep_)
    if (MK_P0_MASK & 16) {
        const int f = F.lane; const float fr = INP(21)[f];
        for (int u = F.gwave; u < SEQ + CTXL; u += F.nwaves) {
            const bool isc = u >= SEQ; const int L = isc ? CTXL : SEQ, i = isc ? u - SEQ : u;
            const float t = (float)i / (float)(L - 1), wpos = 6.283185307179586f * (float)i / (float)L;
            float zv = t;
            if (f >= 1 && f < 33) { const float fb = 1e-4f + (float)((f - 1) & 15) * ((15.0f - 1e-4f) / 15.0f); zv = (f < 17) ? cosf(fb * wpos) : -sinf(fb * wpos); }
            float s = INP(17)[f];
#pragma unroll 11
            for (int e = 0; e < 33; ++e) s += __shfl(zv, e) * INP(16)[e * 64 + f];
            float hcur = sinf(fr * s);
#pragma unroll 1
            for (int ly = 0; ly < 2; ++ly) { float s2 = INP(19)[ly * 64 + f];
#pragma unroll 16
                for (int e = 0; e < 64; ++e) s2 += __shfl(hcur, e) * INP(18)[ly * 4096 + e * 64 + f];
                hcur = sinf(fr * s2); }
            WSP(float, WS_HID)[(size_t)u * 64 + f] = hcur;
        }
    }
}
DI void hy_filter_out(const Fr& F) {
    LAS float* wsl = (LAS float*)F.lds;
    const float MIN_DECAY = -3.0701134573253942f, MAX_DECAY = -15.350567286626972f;
    for (int u = F.bid; u < 256; u += F.G) {
        __syncthreads();
        if (F.tid < 256) { const int g = F.tid >> 2, j = F.tid & 3; wsl[g * 4 + j] = INP(20)[g * 1024 + u * 4 + j]; }
        __syncthreads();
        const float* HID = WSP(float, WS_HID);
        for (int lg = F.tid; lg < SEQ + CTXL; lg += NTHR) {
            const bool isc = lg >= SEQ; const int L = isc ? CTXL : SEQ, i = isc ? lg - SEQ : lg; const float t = (float)i / (float)(L - 1);
            f32x4 hv[16];
#pragma unroll
            for (int q = 0; q < 16; ++q) hv[q] = *(const f32x4*)(HID + (size_t)lg * 64 + q * 4);
            f32x4 a0 = (f32x4){0.f, 0.f, 0.f, 0.f};
#pragma unroll
            for (int q = 0; q < 16; ++q)
#pragma unroll
                for (int e = 0; e < 4; ++e) { const LAS f32x4* wp = (const LAS f32x4*)(wsl + (q * 4 + e) * 4); a0 += wp[0] * hv[q][e]; if (e == 3) asm volatile("" ::: "memory"); }
#pragma unroll
            for (int j = 0; j < 4; ++j) { const int col = u * 4 + j, c = col & 511; const float delta = fabsf(MIN_DECAY + (float)c * ((MAX_DECAY - MIN_DECAY) / 511.0f));
                const float v = a0[j] * expf(-t * delta);
                float* dst = (col < 512) ? (isc ? WSP(float, WS_HFC) : WSP(float, WS_HFL)) : (isc ? WSP(float, WS_HBC) : WSP(float, WS_HBL));
                dst[(size_t)c * L + i] = v; }
        }
    }
    __syncthreads();
}

DI void p1_mod0(const Fr& F) {
    hy_filter_out(F);
    LAS float* wgt = (LAS float*)F.lds;
    { const f32x4* src = WSP(f32x4, WS_WGT);
#pragma unroll
      for (int it = 0; it < 8; ++it) *(LAS f32x4*)(wgt + (F.tid + it * NTHR) * 4) = src[F.tid + it * NTHR]; }
    __syncthreads();
    const float* MOD = WSP(float, WS_MOD); const float* POS = WSP(float, WS_POS);
    bf16_t* U = WSP(bf16_t, A0_U); float* GATES = WSP(float, A0_GATES);
    f32x4 xn[4], pn[4];
#define MOD0_REQ(ROW) do { const int row_ = (ROW); const bool isc_ = row_ >= TL; const float* xin_ = isc_ ? INP(2) + (size_t)(row_ - TL) * DM : INP(0) + (size_t)row_ * DM; \
        _Pragma("unroll") for (int i_ = 0; i_ < 4; ++i_) { const int k_ = i_ * 256 + F.lane * 4; xn[i_] = *(const f32x4*)(xin_ + k_); \
            pn[i_] = isc_ ? (f32x4){0.f, 0.f, 0.f, 0.f} : *(const f32x4*)(POS + (size_t)((i_ < 2) ? ((row_ & 2047) >> 6) : 32 + (row_ & 63)) * 512 + (k_ & 511)); } } while (0)
    if (F.gwave < TT) MOD0_REQ(F.gwave);
    for (int row = F.gwave; row < TT; row += F.nwaves) {
        const bool isc = row >= TL; const int b = isc ? (row - TL) >> 8 : row >> 11;
        const float* md = MOD + (size_t)(isc ? 8 : b) * 6144;
        f32x4 xv[4], pv[4], shv[4], scv[4];
#pragma unroll
        for (int i = 0; i < 4; ++i) { const int k = i * 256 + F.lane * 4; xv[i] = xn[i]; pv[i] = pn[i]; shv[i] = *(const f32x4*)(md + k); scv[i] = *(const f32x4*)(md + 1024 + k); }
        if (row + F.nwaves < TT) MOD0_REQ(row + F.nwaves);
        float ga[16];
#pragma unroll
        for (int g = 0; g < 16; ++g) ga[g] = 0.f;
#pragma unroll
        for (int i = 0; i < 4; ++i) {
            const int k = i * 256 + F.lane * 4;
            const f32x4 u = xv[i] * (scv[i] + 1.0f) + shv[i] + pv[i];
            u32x2 w; w.x = pk2(u[0], u[1]); w.y = pk2(u[2], u[3]);
            *(u32x2*)(U + (size_t)row * DM + k) = w;
#pragma unroll
            for (int g = 0; g < 16; ++g) { const f32x4 wv = *(const LAS f32x4*)(wgt + g * 1024 + k); ga[g] += u[0] * wv[0] + u[1] * wv[1] + u[2] * wv[2] + u[3] * wv[3]; }
            asm volatile("" ::: "memory");
        }
#define RS16(N, OFF) { const bool up = (F.lane & (OFF)) != 0; _Pragma("unroll") for (int g = 0; g < (N); ++g) { const float kp = up ? ga[g + (N)] : ga[g], sd = up ? ga[g] : ga[g + (N)]; ga[g] = kp + __shfl_xor(sd, (OFF)); } }
        RS16(8, 32) RS16(4, 16) RS16(2, 8) RS16(1, 4)
#undef RS16
        float tot = ga[0]; tot += __shfl_xor(tot, 2); tot += __shfl_xor(tot, 1);
        if ((F.lane & 3) == 0) GATES[(size_t)row * 16 + (F.lane >> 2)] = tot;
    }
#undef MOD0_REQ
}

#ifndef MK_PREP_TWICE
#define MK_PREP_TWICE 0
#endif
DI void p3_prep(const Fr& F) {
#if !MK_DN_NAIVE
    __syncthreads();
    for (int u = F.bid; u < NB * 4 * 36; u += F.G) dnA_unit(F, u);
#if MK_PREP_TWICE == 1
    for (int u = F.bid; u < NB * 4 * 36; u += F.G) dnA_unit(F, u);
#endif
#endif
    const bf16_t* P = WSP(bf16_t, A0_P); const float* GATES = WSP(float, A0_GATES);
    float* QN = WSP(float, A0_QN); float* KN = WSP(float, A0_KN); float* VV = WSP(float, A0_VV);
    float* GG = WSP(float, A0_GG); float* BB = WSP(float, A0_BB);
    const float* cw = INP(10);
#if MK_DN_NAIVE
    for (int u = F.bid; u < (TT / 64) * 4; u += F.G) {
        const int rt = u >> 2, h = u & 3, row0 = rt * 64 + F.wave * 8; const bool isc = row0 >= TL; const int L = isc ? CTXL : SEQ;
        const int t0 = isc ? ((row0 - TL) & 255) : (row0 & 2047);
#pragma unroll 1
        for (int s = 0; s < 3; ++s) {
            const int col = s * 512 + h * 128 + F.lane * 2;
            float w0[4], w1[4];
#pragma unroll
            for (int i = 0; i < 4; ++i) { w0[i] = cw[i * 1536 + col]; w1[i] = cw[i * 1536 + col + 1]; }
            float p0[11], p1[11];
#pragma unroll
            for (int rr = 0; rr < 11; ++rr) { const int tl = t0 + rr - 2; unsigned pv = 0u; if (tl >= 0 && tl < L) pv = *(const unsigned*)(P + (size_t)(row0 + rr - 2) * NP0 + col);
                p0[rr] = __uint_as_float(pv << 16); p1[rr] = __uint_as_float(pv & 0xffff0000u); }
            bf16_t* dstb = (s == 0 ? WSP(bf16_t, A0_QB) : (s == 1 ? WSP(bf16_t, A0_KB) : WSP(bf16_t, A0_VB3))) + (size_t)row0 * 512 + h * 128 + F.lane * 2;
#pragma unroll
            for (int j = 0; j < 8; ++j) {
                float a0 = w0[0] * p0[j] + w0[1] * p0[j + 1] + w0[2] * p0[j + 2] + w0[3] * p0[j + 3];
                float a1 = w1[0] * p1[j] + w1[1] * p1[j + 1] + w1[2] * p1[j + 2] + w1[3] * p1[j + 3];
                a0 = silu_(a0); a1 = silu_(a1);
                if (s < 2) { const float ss = wsum(a0 * a0 + a1 * a1); float r = rsqrtf(ss + RMS_EPS); if (s == 0) r *= 0.08838834764831845f; a0 *= r; a1 *= r; }
#if MK_DN_NAIVE
                { float* dst = (s == 0 ? QN : (s == 1 ? KN : VV)) + (size_t)(row0 + j) * 512 + h * 128 + F.lane * 2; *(f32x2*)dst = (f32x2){a0, a1}; }
#endif
                *(unsigned*)(dstb + (size_t)j * 512) = pk2(a0, a1);
            }
        }
        if (F.lane < 16) { const int d = F.lane & 1, row = row0 + (F.lane >> 1);
            const float gd = GATES[(size_t)row * 16 + d * 8 + h], gb = GATES[(size_t)row * 16 + d * 8 + 4 + h];
            GG[((size_t)d * TT + row) * 4 + h] = -expf(INP(11)[d * 4 + h]) * softplus_(gd + INP(12)[d * 4 + h]);
            BB[((size_t)d * TT + row) * 4 + h] = sigm(gb); }
    }
#endif
    bf16_t* VX = WSP(bf16_t, A0_VX); bf16_t* X0 = WSP(bf16_t, A0_X0);
    const float* hw = INP(14); const float* hb = INP(15);
    LAS bf16_t* tile = (LAS bf16_t*)F.lds;
    __syncthreads();
    const bool bal = (F.G == 256) && !MK_DN_NAIVE; const int hu0 = bal ? (F.bid < 128 ? F.bid : 384 + (F.bid - 128)) : F.bid, hu1 = bal ? (F.bid < 128 ? 384 : 1152) : (TT / 64) * 4, hus = bal ? 128 : F.G;
    for (int u = hu0; u < hu1; u += hus) {
        const int rt = u >> 2, ct = u & 3, row0 = rt * 64; const bool isc = row0 >= TL; const int L = isc ? CTXL : SEQ;
        const int t0 = isc ? ((row0 - TL) & 255) : (row0 & 2047);
        const int cl = F.tid & 63, rg = F.tid >> 6, c = ct * 128 + cl * 2;
        unsigned praw[3][10];
#pragma unroll
        for (int rr = 0; rr < 10; ++rr) { const int tl = t0 + rg * 8 + rr - 1; const bool ok = tl >= 0 && tl < L;
#pragma unroll
            for (int sg = 0; sg < 3; ++sg) praw[sg][rr] = ok ? *(const unsigned*)(P + (size_t)(row0 + rg * 8 + rr - 1) * NP0 + 2048 + sg * 512 + c) : 0u; }
        f32x2 w3[3][3], b3[3];
#pragma unroll
        for (int sg = 0; sg < 3; ++sg) { b3[sg] = *(const f32x2*)(hb + sg * 512 + c);
#pragma unroll
            for (int j = 0; j < 3; ++j) w3[sg][j] = *(const f32x2*)(hw + j * 1536 + sg * 512 + c); }
#pragma unroll
        for (int j = 0; j < 8; ++j) { f32x2 r3[3];
#pragma unroll
            for (int sg = 0; sg < 3; ++sg) { r3[sg] = b3[sg];
#pragma unroll
                for (int q = 0; q < 3; ++q) { const unsigned pw = praw[sg][j + q]; r3[sg] += w3[sg][q] * (f32x2){__uint_as_float(pw << 16), __uint_as_float(pw & 0xffff0000u)}; } }
            const size_t o = (size_t)(row0 + rg * 8 + j) * 512 + c; const f32x2 vx = r3[2] * r3[1];
            *(unsigned*)(X0 + o) = pk2(r3[0][0], r3[0][1]);
            const unsigned pk = pk2(vx[0], vx[1]); *(unsigned*)(VX + o) = pk;
            tile[(cl * 2) * 72 + rg * 8 + j] = (bf16_t)(pk & 0xffffu); tile[(cl * 2 + 1) * 72 + rg * 8 + j] = (bf16_t)(pk >> 16); }
        __syncthreads();
        { const int c2 = F.tid >> 2, seg = F.tid & 3; const u32x4 v0 = *(const LAS u32x4*)(tile + c2 * 72 + seg * 16), v1 = *(const LAS u32x4*)(tile + c2 * 72 + seg * 16 + 8);
          bf16_t* dst = isc ? WSP(bf16_t, A0_VXTC) + (size_t)(ct * 128 + c2) * TC + (row0 - TL) : WSP(bf16_t, A0_VXTL) + (size_t)(ct * 128 + c2) * TL + row0;
          *(u32x4*)(dst + seg * 16) = v0; *(u32x4*)(dst + seg * 16 + 8) = v1; }
        __syncthreads();
    }
}

DI void dn_chain(const Fr& F, int unit) {
    const int b = unit >> 3, h = (unit >> 1) & 3, d = unit & 1;
    const float* QN = WSP(float, A0_QN); const float* KN = WSP(float, A0_KN); const float* VV = WSP(float, A0_VV);
    const float* GG = WSP(float, A0_GG) + (size_t)d * TT * 4; const float* BB = WSP(float, A0_BB) + (size_t)d * TT * 4;
    float* OD = WSP(float, A0_OD) + (size_t)d * TT * 512;
    LAS float* qs = (LAS float*)F.lds; LAS float* ks = qs + 128; LAS float* vs = ks + 128; LAS float* red1 = vs + 128; LAS float* red2 = red1 + 512; LAS float* scal = red2 + 512;
    const int dv = F.tid & 127, kb = F.tid >> 7;
    float S[32];
#pragma unroll
    for (int i = 0; i < 32; ++i) S[i] = 0.f;
    for (int p = 0; p < CTXL + SEQ; ++p) {
        const int row = row_of(b, d, p);
        if (F.tid < 128) qs[F.tid] = QN[(size_t)row * 512 + h * 128 + F.tid];
        else if (F.tid < 256) ks[F.tid - 128] = KN[(size_t)row * 512 + h * 128 + F.tid - 128];
        else if (F.tid < 384) vs[F.tid - 256] = VV[(size_t)row * 512 + h * 128 + F.tid - 256];
        else if (F.tid == 384) scal[0] = expf(GG[(size_t)row * 4 + h]);
        else if (F.tid == 385) scal[1] = BB[(size_t)row * 4 + h];
        __syncthreads();
        float part = 0.f;
#pragma unroll
        for (int i = 0; i < 32; ++i) part += ks[kb * 32 + i] * S[i];
        red1[kb * 128 + dv] = part;
        __syncthreads();
        const float kS = red1[dv] + red1[128 + dv] + red1[256 + dv] + red1[384 + dv];
        const float eg = scal[0], beta = scal[1];
        const float delta = beta * (vs[dv] - eg * kS);
        float op = 0.f;
#pragma unroll
        for (int i = 0; i < 32; ++i) { S[i] = eg * S[i] + ks[kb * 32 + i] * delta; op += qs[kb * 32 + i] * S[i]; }
        red2[kb * 128 + dv] = op;
        __syncthreads();
        if (kb == 0) OD[(size_t)row * 512 + h * 128 + dv] = red2[dv] + red2[128 + dv] + red2[256 + dv] + red2[384 + dv];
    }
    __syncthreads();
}
constexpr int HY_RS_LAT = 2 * (2 * SEQ + 64) + 64, HY_RS_CTX = 2 * (2 * CTXL + 64) + 64;
DI void hy_mfma_unit(const Fr& F, int c) {
    typedef short bf16x8h __attribute__((ext_vector_type(8)));
    LAS unsigned char* Lm = F.lds;
    const int lane = F.lane, w = F.wave, m = lane & 15, q = lane >> 4, ml = m & 7, mh = m >> 3, n8 = lane & 7;
#pragma unroll 1
    for (int kind = 0; kind < 2; ++kind) {
        const int L = kind ? CTXL : SEQ, RS = kind ? HY_RS_CTX : HY_RS_LAT;
        const float* HFt = (kind ? WSP(float, WS_HFC) : WSP(float, WS_HFL)) + (size_t)c * L; const float* HBt = (kind ? WSP(float, WS_HBC) : WSP(float, WS_HBL)) + (size_t)c * L;
        LAS unsigned char* Rsh = Lm; LAS unsigned char* Vt = Lm + 8 * HY_RS_LAT;
        const int VS = L * 2 + 32;
        __syncthreads();
#pragma unroll 1
        for (int it = 0; it * NTHR < L + 32; ++it) {
            const int x2 = F.tid + it * NTHR; float r9[9];
#pragma unroll
            for (int k = 0; k < 9; ++k) { const int idx = 2 * x2 - 7 + k; const bool ok = idx > 0 && idx < 2 * L; const int i = ok ? idx - L : 0;
                const float* p = (i <= 0) ? HFt - i : HBt + i; const float v = *p; r9[k] = ok ? v : 0.f; }
            if (x2 < L + 32) {
#pragma unroll
                for (int a = 0; a < 8; ++a) *(LAS unsigned*)(Rsh + a * RS + x2 * 4) = pk2(r9[7 - a], r9[8 - a]); }
        }
        { const u32x4* src = (const u32x4*)(kind ? WSP(bf16_t, A0_VXTC) + (size_t)c * TC : WSP(bf16_t, A0_VXTL) + (size_t)c * TL);
          const int lg = kind ? 5 : 8;
          for (int i = F.tid; i < L; i += NTHR) *(LAS u32x4*)(Vt + (i >> lg) * VS + (i & ((1 << lg) - 1)) * 16) = src[i]; }
        __syncthreads();
        bf16_t* YT = kind ? WSP(bf16_t, A0_YHTC) + (size_t)c * TC : WSP(bf16_t, A0_YHTL) + (size_t)c * TL;
        const int ng = L / 128, nks = L / 32;
        for (int g = w; g < ng; g += 8) {
            const int mt0 = g * 8;
            const LAS unsigned char* abase = Rsh + ml * RS + (L - 16 * mt0 + 8 * q - 8 * mh) * 2;
            const LAS unsigned char* bbase = Vt + n8 * VS + (8 * q) * 2;
            bf16x8h fr[8]; f32x4 acc[8];
#pragma unroll
            for (int i = 0; i < 8; ++i) { acc[i] = (f32x4){0.f, 0.f, 0.f, 0.f}; fr[(8 - i) & 7] = *(const LAS bf16x8h*)(abase + (-i) * 32); }
            for (int ks4 = 0; ks4 < nks; ks4 += 4) {
#pragma unroll
                for (int kk = 0; kk < 4; ++kk) {
                    const int ks = ks4 + kk;
                    const bf16x8h bv = *(const LAS bf16x8h*)(bbase + ks * 64);
#pragma unroll
                    for (int i = 0; i < 8; ++i) acc[i] = __builtin_amdgcn_mfma_f32_16x16x32_bf16(fr[(2 * kk - i) & 7], bv, acc[i], 0, 0, 0);
                    fr[(2 * kk + 1) & 7] = *(const LAS bf16x8h*)(abase + (2 * ks + 1) * 32);
                    fr[(2 * kk + 2) & 7] = *(const LAS bf16x8h*)(abase + (2 * ks + 2) * 32);
                }
            }
            if (m < 8) {
#pragma unroll
                for (int i = 0; i < 8; ++i) { u32x2 yv; yv.x = pk2(acc[i][0], acc[i][1]); yv.y = pk2(acc[i][2], acc[i][3]); *(u32x2*)(YT + (size_t)m * L + 16 * (mt0 + i) + 4 * q) = yv; }
            }
        }
    }
    __syncthreads();
}
DI void p4a_dn_chunks(const Fr& F) {}
DI void p4_mix_core(const Fr& F) {
#if MK_DN_NAIVE
    for (int u = F.bid; u < 64 + 512; u += F.G) { if (u < 64) dn_chain(F, u); else hy_mfma_unit(F, u - 64); }
#else
    if (F.G >= 128) { if (F.bid < 64) dnB_chain(F, F.bid); else { for (int c = F.bid - 64; c < 512; c += F.G - 64) hy_mfma_unit(F, c);
            if (F.G == 256 && !MK_BG_CONV) { moe_w_l1_part(F, 1, 0, L1W2_A, F.bid - 64, F.G - 64); moe_w_l1_part(F, 0, L1W1_C, 4096 - L1W1_D, F.bid - 64, F.G - 64);
                if (F.bid >= 192) moe_w_l1_part(F, 0, 4096 - L1W1_D, 4096, F.bid - 192, 64); } } }
    else for (int u = F.bid; u < 64 + 512; u += F.G) { if (u < 64) dnB_chain(F, u); else hy_mfma_unit(F, u - 64); }
#endif
}

DI void p5_mix(const Fr& F) {
    const bf16_t* OD = WSP(bf16_t, A0_OD); const bf16_t* P = WSP(bf16_t, A0_P); bf16_t* MIX = WSP(bf16_t, A0_MIX);
    const bf16_t* VX = WSP(bf16_t, A0_VX); const bf16_t* X0 = WSP(bf16_t, A0_X0);
    const int hs = F.lane >> 5, l32 = F.lane & 31; const f32x4 gn = *(const f32x4*)(INP(13) + l32 * 4);
    u32x2 oan[2], obn[2]; u32x2 zn[2];
#define MIX_REQ(ROW) do { _Pragma("unroll") for (int hp_ = 0; hp_ < 2; ++hp_) { const int col_ = (hp_ * 2 + hs) * 128 + l32 * 4; oan[hp_] = *(const u32x2*)(OD + (size_t)(ROW) * 512 + col_); \
        obn[hp_] = *(const u32x2*)(OD + ((size_t)TT + (ROW)) * 512 + col_); zn[hp_] = *(const u32x2*)(P + (size_t)(ROW) * NP0 + 1536 + col_); } } while (0)
    if (F.gwave < TT) MIX_REQ(F.gwave);
    for (int row = F.gwave; row < TT; row += F.nwaves) {
        f32x4 oc[2]; u32x2 zc[2];
#pragma unroll
        for (int hp = 0; hp < 2; ++hp) { const u32x2 a_ = oan[hp], b_ = obn[hp];
            oc[hp] = (f32x4){__uint_as_float(a_.x << 16) + __uint_as_float(b_.x << 16), __uint_as_float(a_.x & 0xffff0000u) + __uint_as_float(b_.x & 0xffff0000u),
                             __uint_as_float(a_.y << 16) + __uint_as_float(b_.y << 16), __uint_as_float(a_.y & 0xffff0000u) + __uint_as_float(b_.y & 0xffff0000u)}; zc[hp] = zn[hp]; }
        if (row + F.nwaves < TT) MIX_REQ(row + F.nwaves);
#pragma unroll
        for (int hp = 0; hp < 2; ++hp) {
            const int col = (hp * 2 + hs) * 128 + l32 * 4;
            const f32x4 o = oc[hp];
            float ss = (o[0] * o[0] + o[1] * o[1]) + (o[2] * o[2] + o[3] * o[3]);
            ss += __shfl_xor(ss, 16); ss += __shfl_xor(ss, 8); ss += __shfl_xor(ss, 4); ss += __shfl_xor(ss, 2); ss += __shfl_xor(ss, 1);
            const float r = rsqrtf(ss * (1.0f / 128.0f) + RMS_EPS);
            const u32x2 zv = zc[hp];
            const float z0 = __uint_as_float(zv.x << 16), z1 = __uint_as_float(zv.x & 0xffff0000u), z2 = __uint_as_float(zv.y << 16), z3 = __uint_as_float(zv.y & 0xffff0000u);
            u32x2 w; w.x = pk2(o[0] * r * gn[0] * silu_(z0), o[1] * r * gn[1] * silu_(z1)); w.y = pk2(o[2] * r * gn[2] * silu_(z2), o[3] * r * gn[3] * silu_(z3));
            *(u32x2*)(MIX + (size_t)row * MIXW + col) = w;
        }
    }
#undef MIX_REQ
    LAS float* t2 = (LAS float*)F.lds;
    __syncthreads();
    u32x4 yq[2];
#define HYG_REQ(U) do { const int rt_ = (U) >> 2, ct_ = (U) & 3, row0_ = rt_ * 64; const bool isc_ = row0_ >= TL; const int c2_ = F.tid >> 2, seg_ = F.tid & 3; \
        const bf16_t* src_ = isc_ ? WSP(bf16_t, A0_YHTC) + (size_t)(ct_ * 128 + c2_) * TC + (row0_ - TL) : WSP(bf16_t, A0_YHTL) + (size_t)(ct_ * 128 + c2_) * TL + row0_; \
        _Pragma("unroll") for (int q_ = 0; q_ < 2; ++q_) yq[q_] = *(const u32x4*)(src_ + seg_ * 16 + q_ * 8); } while (0)
    if (F.bid < (TT / 64) * 4) HYG_REQ(F.bid);
    for (int u = F.bid; u < (TT / 64) * 4; u += F.G) {
        const int rt = u >> 2, ct = u & 3, row0 = rt * 64;
        { const int c2 = F.tid >> 2, seg = F.tid & 3; LAS float* tp = t2 + c2 * 65 + seg * 16;
#pragma unroll
          for (int q = 0; q < 2; ++q)
#pragma unroll
            for (int e = 0; e < 4; ++e) { const unsigned wv_ = yq[q][e]; tp[q * 8 + 2 * e] = __uint_as_float(wv_ << 16); tp[q * 8 + 2 * e + 1] = __uint_as_float(wv_ & 0xffff0000u); } }
        const int cl = F.tid & 63, rg = F.tid >> 6, c = ct * 128 + cl * 2; const f32x2 sk = *(const f32x2*)(INP(22) + c);
        unsigned x0q[8], vxq[8];
#pragma unroll
        for (int j = 0; j < 8; ++j) { const size_t o = (size_t)(row0 + rg * 8 + j) * 512 + c; x0q[j] = *(const unsigned*)(X0 + o); vxq[j] = *(const unsigned*)(VX + o); }
        __syncthreads();
        if (u + F.G < (TT / 64) * 4) HYG_REQ(u + F.G);
#pragma unroll
        for (int j = 0; j < 8; ++j) { const int row = row0 + rg * 8 + j;
            const f32x2 yh = (f32x2){t2[(cl * 2) * 65 + rg * 8 + j], t2[(cl * 2 + 1) * 65 + rg * 8 + j]};
            const f32x2 x0v = (f32x2){__uint_as_float(x0q[j] << 16), __uint_as_float(x0q[j] & 0xffff0000u)}, vxv = (f32x2){__uint_as_float(vxq[j] << 16), __uint_as_float(vxq[j] & 0xffff0000u)};
            const f32x2 r = x0v * (yh + vxv * sk);
            *(unsigned*)(MIX + (size_t)row * MIXW + 512 + c) = pk2(r[0], r[1]); }
        __syncthreads();
    }
#undef HYG_REQ
}

template <int LAYER>
DI void p7_ln_route(const Fr& F, const float* xres_lat, const float* xres_ctx, const bf16_t* Y, int nrows) {
    const float* MOD = WSP(float, WS_MOD) + (size_t)LAYER * 9 * 6144;
    bf16_t* X1 = WSP(bf16_t, WS_X1); bf16_t* VB = WSP(bf16_t, WS_VB);
    int* RI = WSP(int, WS_RI); float* RW = WSP(float, WS_RW);
    const float* lng = INP(6) + (size_t)(LAYER * 2 + 0) * DM; const float* lnb = INP(7) + (size_t)(LAYER * 2 + 0) * DM;
    const float* rb = INP(35) + LAYER * NEXP;
    LAS float* rwt = (LAS float*)F.lds;
    { const f32x4* src = WSP(f32x4, WS_RWT) + (size_t)LAYER * 8192;
#pragma unroll
      for (int it = 0; it < 16; ++it) *(LAS f32x4*)(rwt + (F.tid + it * NTHR) * 4) = src[F.tid + it * NTHR]; }
    __syncthreads();
    const int lane = F.lane;
    LAS unsigned* lcnt = (LAS unsigned*)(F.lds + LDS_CTL_OFF + 64);
    if (F.tid < 32) lcnt[F.tid] = 0u;
    __syncthreads();
    const int per = 2 * ((nrows / 2 + F.G - 1) / F.G), rb0 = (F.bid * per < nrows) ? F.bid * per : nrows, rb1 = (rb0 + per < nrows) ? rb0 + per : nrows;
    f32x4 xq[2][4]; u32x2 xqb[2][4]; u32x2 yq[2][4];
#define LN_LOAD_PAIR(RP) do { _Pragma("unroll") for (int rr_ = 0; rr_ < 2; ++rr_) { const int row_ = (RP) * 2 + rr_; const bool isc_ = row_ >= TL; \
        const float* xr_ = isc_ ? xres_ctx + (size_t)(row_ - TL) * DM : xres_lat + (size_t)row_ * DM; \
        _Pragma("unroll") for (int i_ = 0; i_ < 4; ++i_) { if (LAYER == 0) xq[rr_][i_] = *(const f32x4*)(xr_ + i_ * 256 + lane * 4); else xqb[rr_][i_] = *(const u32x2*)((const bf16_t*)xres_lat + (size_t)row_ * DM + i_ * 256 + lane * 4); \
            yq[rr_][i_] = *(const u32x2*)(Y + (size_t)row_ * DM + i_ * 256 + lane * 4); } } } while (0)
    if (rb0 / 2 + F.wave < rb1 / 2) LN_LOAD_PAIR(rb0 / 2 + F.wave);
    for (int rp = rb0 / 2 + F.wave; rp < rb1 / 2; rp += 8) {
        f32x4 va[4], vb[4];
#pragma unroll
        for (int rr = 0; rr < 2; ++rr) {
            const int row = rp * 2 + rr; const bool isc = row >= TL; const int b = isc ? (row - TL) >> 8 : row >> 11;
            const float* md = MOD + (size_t)(isc ? 8 : b) * 6144;
            f32x4 y[4]; float s = 0.f;
#pragma unroll
            for (int i = 0; i < 4; ++i) { const int k = i * 256 + lane * 4;
                const u32x2 yw = yq[rr][i];
                const f32x4 yv = (f32x4){__uint_as_float(yw.x << 16), __uint_as_float(yw.x & 0xffff0000u), __uint_as_float(yw.y << 16), __uint_as_float(yw.y & 0xffff0000u)};
                const u32x2 xw = xqb[rr][i];
                const f32x4 xv = (LAYER == 0) ? xq[rr][i] : (f32x4){__uint_as_float(xw.x << 16), __uint_as_float(xw.x & 0xffff0000u), __uint_as_float(xw.y << 16), __uint_as_float(xw.y & 0xffff0000u)};
                y[i] = xv * ALPHA + *(const f32x4*)(md + 2048 + k) * yv;
                s += (y[i][0] + y[i][1]) + (y[i][2] + y[i][3]); }
            const float mu = wsum(s) * (1.0f / 1024.0f); float q = 0.f;
#pragma unroll
            for (int i = 0; i < 4; ++i) { const f32x4 dd = y[i] - mu; q += (dd[0] * dd[0] + dd[1] * dd[1]) + (dd[2] * dd[2] + dd[3] * dd[3]); }
            const float rstd = rsqrtf(wsum(q) * (1.0f / 1024.0f) + LN_EPS);
#pragma unroll
            for (int i = 0; i < 4; ++i) { const int k = i * 256 + lane * 4;
                const f32x4 x1 = (y[i] - mu) * rstd * *(const f32x4*)(lng + k) + *(const f32x4*)(lnb + k);
                { u32x2 w1; w1.x = pk2(x1[0], x1[1]); w1.y = pk2(x1[2], x1[3]); *(u32x2*)(X1 + (size_t)row * DM + k) = w1; }
                const f32x4 v = x1 * (*(const f32x4*)(md + 4096 + k) + 1.0f) + *(const f32x4*)(md + 3072 + k);
                if (MK_GATHER && ((LAYER == 0) ? (MK_FP8_L0 != 0) : (MK_FP8_L1 != 0))) *(unsigned*)((unsigned char*)VB + (size_t)row * DM + k) = pk4_fp8(v[0], v[1], v[2], v[3]);
                else { u32x2 w; w.x = pk2(v[0], v[1]); w.y = pk2(v[2], v[3]); *(u32x2*)(VB + (size_t)row * DM + k) = w; }
                if (rr == 0) va[i] = v; else vb[i] = v; }
        }
        if (rp + 8 < rb1 / 2) LN_LOAD_PAIR(rp + 8);
        float pa[32], pb[32];
#pragma unroll
        for (int e = 0; e < 32; ++e) { f32x2 sa = (f32x2){0.f, 0.f}, sb = sa;
#pragma unroll
            for (int i = 0; i < 4; ++i) { const f32x4 wv = *(const LAS f32x4*)(rwt + e * DM + i * 256 + lane * 4);
                const f32x2 w01 = (f32x2){wv[0], wv[1]}, w23 = (f32x2){wv[2], wv[3]};
                sa += (f32x2){va[i][0], va[i][1]} * w01; sa += (f32x2){va[i][2], va[i][3]} * w23;
                sb += (f32x2){vb[i][0], vb[i][1]} * w01; sb += (f32x2){vb[i][2], vb[i][3]} * w23; }
            pa[e] = sa.x + sa.y; pb[e] = sb.x + sb.y; if ((e & 3) == 3) asm volatile("" ::: "memory"); }
#define RS_STEP(N, OFF) { const bool up = (lane & (OFF)) != 0; \
            _Pragma("unroll") for (int e = 0; e < (N); ++e) { \
                const float ka = up ? pa[e + (N)] : pa[e], sa_ = up ? pa[e] : pa[e + (N)]; const float kb = up ? pb[e + (N)] : pb[e], sb_ = up ? pb[e] : pb[e + (N)]; \
                pa[e] = ka + __shfl_xor(sa_, (OFF)); pb[e] = kb + __shfl_xor(sb_, (OFF)); } }
        RS_STEP(16, 32) RS_STEP(8, 16) RS_STEP(4, 8) RS_STEP(2, 4) RS_STEP(1, 2)
#undef RS_STEP
        const int e = lane >> 1;
        float lga = pa[0] + __shfl_xor(pa[0], 1) + rb[e], lgb = pb[0] + __shfl_xor(pb[0], 1) + rb[e];
#pragma unroll
        for (int rr = 0; rr < 2; ++rr) {
            const int row = rp * 2 + rr; const float val = rr ? lgb : lga; float sv[4]; int si[4];
            unsigned ub = __float_as_uint(val); ub ^= (ub >> 31) ? 0xffffffffu : 0x80000000u;
            const unsigned key = (ub & ~31u) | (unsigned)(31 - e);
            int rank = 0;
#pragma unroll
            for (int j = 0; j < 32; ++j) { const unsigned kj = (unsigned)__builtin_amdgcn_readlane((int)key, 2 * j); rank += (kj > key) ? 1 : 0; }
#pragma unroll
            for (int kk = 0; kk < 4; ++kk) { const unsigned long long m = __ballot(rank == kk); const int src = __builtin_amdgcn_readfirstlane((int)__builtin_ctzll(m));
                si[kk] = src >> 1; sv[kk] = __int_as_float(__builtin_amdgcn_readlane(__float_as_int(val), src)); }
            const float e1 = __expf(sv[1] - sv[0]), e2 = __expf(sv[2] - sv[0]), e3 = __expf(sv[3] - sv[0]); const float inv = 1.0f / (1.0f + e1 + e2 + e3);
            if (lane == 0) {
                *(int4*)(RI + (size_t)row * 4) = make_int4(si[0], si[1], si[2], si[3]);
                *(f32x4*)(RW + (size_t)row * 4) = (f32x4){inv, e1 * inv, e2 * inv, e3 * inv};
                atomicAdd((unsigned*)(lcnt + si[0]), 1u); atomicAdd((unsigned*)(lcnt + si[1]), 1u); atomicAdd((unsigned*)(lcnt + si[2]), 1u); atomicAdd((unsigned*)(lcnt + si[3]), 1u);
            }
        }
    }
#undef LN_LOAD_PAIR
    __syncthreads();
    if (F.tid < 32) WSP(unsigned, WS_BC)[((size_t)LAYER * 1024 + F.bid) * 32 + F.tid] = lcnt[F.tid];
}

#ifndef MK_ROUTE_MFMA
#define MK_ROUTE_MFMA 1
#endif
constexpr int RT_RS = 2048 + 16, RT_LO = 16 * RT_RS, RT_PART = 32 * RT_RS;
template <int LAYER>
DI void p7m_ln_route(const Fr& F, const float* xres_lat, const float* xres_ctx, const bf16_t* Y, int nrows) {
    typedef short bf16x8h __attribute__((ext_vector_type(8)));
    const float* MOD = WSP(float, WS_MOD) + (size_t)LAYER * 9 * 6144;
    bf16_t* X1 = WSP(bf16_t, WS_X1); bf16_t* VB = WSP(bf16_t, WS_VB);
    int* RI = WSP(int, WS_RI); float* RW = WSP(float, WS_RW);
    const float* lng = INP(6) + (size_t)(LAYER * 2 + 0) * DM; const float* lnb = INP(7) + (size_t)(LAYER * 2 + 0) * DM;
    const float* rb = INP(35) + LAYER * NEXP;
    const int lane = F.lane, fr = lane & 15, fq = lane >> 4;
    LAS unsigned char* Lm = F.lds; LAS float* part = (LAS float*)(Lm + RT_PART);
    LAS unsigned* lcnt = (LAS unsigned*)(F.lds + LDS_CTL_OFF + 64);
    if (F.tid < 32) lcnt[F.tid] = 0u;
    bf16x8h wh[4][2], wl[4][2];
    { const float* RWT = WSP(float, WS_RWT) + (size_t)LAYER * 32768;
#pragma unroll
      for (int ks = 0; ks < 4; ++ks)
#pragma unroll
        for (int nt = 0; nt < 2; ++nt) { const float* p = RWT + (size_t)(nt * 16 + fr) * DM + F.wave * 128 + ks * 32 + fq * 8;
            const f32x4 a = *(const f32x4*)p, b = *(const f32x4*)(p + 4); const float w8[8] = {a[0], a[1], a[2], a[3], b[0], b[1], b[2], b[3]}; u32x4 h, l;
#pragma unroll
            for (int q = 0; q < 4; ++q) { const unsigned hp = pk2(w8[2 * q], w8[2 * q + 1]); h[q] = hp;
                l[q] = pk2(w8[2 * q] - __uint_as_float(hp << 16), w8[2 * q + 1] - __uint_as_float(hp & 0xffff0000u)); }
            wh[ks][nt] = __builtin_bit_cast(bf16x8h, h); wl[ks][nt] = __builtin_bit_cast(bf16x8h, l); } }
    __syncthreads();
    const int per = 2 * ((nrows / 2 + F.G - 1) / F.G), rb0 = (F.bid * per < nrows) ? F.bid * per : nrows, rb1 = (rb0 + per < nrows) ? rb0 + per : nrows;
    f32x4 xq[2][4]; u32x2 xqb[2][4]; u32x2 yq[2][4];
#define LN_LOAD_PAIR(RP) do { _Pragma("unroll") for (int rr_ = 0; rr_ < 2; ++rr_) { const int row_ = (RP) * 2 + rr_; const bool isc_ = row_ >= TL; \
        const float* xr_ = isc_ ? xres_ctx + (size_t)(row_ - TL) * DM : xres_lat + (size_t)row_ * DM; \
        _Pragma("unroll") for (int i_ = 0; i_ < 4; ++i_) { if (LAYER == 0) xq[rr_][i_] = *(const f32x4*)(xr_ + i_ * 256 + lane * 4); else xqb[rr_][i_] = *(const u32x2*)((const bf16_t*)xres_lat + (size_t)row_ * DM + i_ * 256 + lane * 4); \
            yq[rr_][i_] = *(const u32x2*)(Y + (size_t)row_ * DM + i_ * 256 + lane * 4); } } } while (0)
    if (rb0 / 2 + F.wave < rb1 / 2) LN_LOAD_PAIR(rb0 / 2 + F.wave);
    const int nrounds = (rb1 - rb0 + 15) >> 4;
#pragma unroll 1
    for (int rd = 0; rd < nrounds; ++rd) {
        const int rp = rb0 / 2 + rd * 8 + F.wave;
        if (rp < rb1 / 2) {
#pragma unroll
            for (int rr = 0; rr < 2; ++rr) {
                const int row = rp * 2 + rr; const bool isc = row >= TL; const int b = isc ? (row - TL) >> 8 : row >> 11;
                const float* md = MOD + (size_t)(isc ? 8 : b) * 6144;
                f32x4 y[4]; float s = 0.f;
#pragma unroll
                for (int i = 0; i < 4; ++i) { const int k = i * 256 + lane * 4;
                    const u32x2 yw = yq[rr][i];
                    const f32x4 yv = (f32x4){__uint_as_float(yw.x << 16), __uint_as_float(yw.x & 0xffff0000u), __uint_as_float(yw.y << 16), __uint_as_float(yw.y & 0xffff0000u)};
                    const u32x2 xw = xqb[rr][i];
                    const f32x4 xv = (LAYER == 0) ? xq[rr][i] : (f32x4){__uint_as_float(xw.x << 16), __uint_as_float(xw.x & 0xffff0000u), __uint_as_float(xw.y << 16), __uint_as_float(xw.y & 0xffff0000u)};
                    y[i] = xv * ALPHA + *(const f32x4*)(md + 2048 + k) * yv;
                    s += (y[i][0] + y[i][1]) + (y[i][2] + y[i][3]); }
                const float mu = wsum(s) * (1.0f / 1024.0f); float q = 0.f;
#pragma unroll
                for (int i = 0; i < 4; ++i) { const f32x4 dd = y[i] - mu; q += (dd[0] * dd[0] + dd[1] * dd[1]) + (dd[2] * dd[2] + dd[3] * dd[3]); }
                const float rstd = rsqrtf(wsum(q) * (1.0f / 1024.0f) + LN_EPS);
                LAS unsigned char* th = Lm + (2 * F.wave + rr) * RT_RS;
#pragma unroll
                for (int i = 0; i < 4; ++i) { const int k = i * 256 + lane * 4;
                    const f32x4 x1 = (y[i] - mu) * rstd * *(const f32x4*)(lng + k) + *(const f32x4*)(lnb + k);
                    { u32x2 w1; w1.x = pk2(x1[0], x1[1]); w1.y = pk2(x1[2], x1[3]); *(u32x2*)(X1 + (size_t)row * DM + k) = w1; }
                    const f32x4 v = x1 * (*(const f32x4*)(md + 4096 + k) + 1.0f) + *(const f32x4*)(md + 3072 + k);
                    if (MK_GATHER && ((LAYER == 0) ? (MK_FP8_L0 != 0) : (MK_FP8_L1 != 0))) *(unsigned*)((unsigned char*)VB + (size_t)row * DM + k) = pk4_fp8(v[0], v[1], v[2], v[3]);
                    else { u32x2 w; w.x = pk2(v[0], v[1]); w.y = pk2(v[2], v[3]); *(u32x2*)(VB + (size_t)row * DM + k) = w; }
                    u32x2 hv, lv; hv.x = pk2(v[0], v[1]); hv.y = pk2(v[2], v[3]);
                    lv.x = pk2(v[0] - __uint_as_float(hv.x << 16), v[1] - __uint_as_float(hv.x & 0xffff0000u)); lv.y = pk2(v[2] - __uint_as_float(hv.y << 16), v[3] - __uint_as_float(hv.y & 0xffff0000u));
                    *(LAS u32x2*)(th + k * 2) = hv; *(LAS u32x2*)(th + RT_LO + k * 2) = lv; }
            }
            if (rp + 8 < rb1 / 2) LN_LOAD_PAIR(rp + 8);
        }
        __syncthreads();
        {
            f32x4 acc0 = (f32x4){0.f, 0.f, 0.f, 0.f}, acc1 = acc0;
            const LAS unsigned char* ap = Lm + fr * RT_RS + (F.wave * 128 + fq * 8) * 2;
#pragma unroll
            for (int ks = 0; ks < 4; ++ks) { const bf16x8h ah = *(const LAS bf16x8h*)(ap + ks * 64), al = *(const LAS bf16x8h*)(ap + RT_LO + ks * 64);
                acc0 = __builtin_amdgcn_mfma_f32_16x16x32_bf16(al, wl[ks][0], acc0, 0, 0, 0); acc1 = __builtin_amdgcn_mfma_f32_16x16x32_bf16(al, wl[ks][1], acc1, 0, 0, 0);
                acc0 = __builtin_amdgcn_mfma_f32_16x16x32_bf16(al, wh[ks][0], acc0, 0, 0, 0); acc1 = __builtin_amdgcn_mfma_f32_16x16x32_bf16(al, wh[ks][1], acc1, 0, 0, 0);
                acc0 = __builtin_amdgcn_mfma_f32_16x16x32_bf16(ah, wl[ks][0], acc0, 0, 0, 0); acc1 = __builtin_amdgcn_mfma_f32_16x16x32_bf16(ah, wl[ks][1], acc1, 0, 0, 0);
                acc0 = __builtin_amdgcn_mfma_f32_16x16x32_bf16(ah, wh[ks][0], acc0, 0, 0, 0); acc1 = __builtin_amdgcn_mfma_f32_16x16x32_bf16(ah, wh[ks][1], acc1, 0, 0, 0); }
#pragma unroll
            for (int j = 0; j < 4; ++j) { LAS float* pp = part + ((F.wave * 16 + 4 * fq + j) * 32 + fr); pp[0] = acc0[j]; pp[16] = acc1[j]; }
        }
        __syncthreads();
        {
            const int trow = F.tid >> 5, e = lane & 31, half = lane >> 5, row = rb0 + rd * 16 + trow;
            float lg = rb[e];
#pragma unroll
            for (int w8 = 0; w8 < 8; ++w8) lg += part[(w8 * 16 + trow) * 32 + e];
            unsigned ub = __float_as_uint(lg); ub ^= (ub >> 31) ? 0xffffffffu : 0x80000000u;
            const unsigned key = (ub & ~31u) | (unsigned)(31 - e);
            int rank = 0;
#pragma unroll
            for (int j = 0; j < 32; ++j) { const unsigned ka = (unsigned)__builtin_amdgcn_readlane((int)key, j), kb = (unsigned)__builtin_amdgcn_readlane((int)key, 32 + j);
                const unsigned kj = half ? kb : ka; rank += (kj > key) ? 1 : 0; }
            float sv[4]; int si[4];
#pragma unroll
            for (int kk = 0; kk < 4; ++kk) { const unsigned long long m = __ballot(rank == kk);
                const int sa = __builtin_amdgcn_readfirstlane((int)__builtin_ctz((unsigned)m)), sb = __builtin_amdgcn_readfirstlane((int)__builtin_ctz((unsigned)(m >> 32)));
                const float va_ = __int_as_float(__builtin_amdgcn_readlane(__float_as_int(lg), sa)), vb_ = __int_as_float(__builtin_amdgcn_readlane(__float_as_int(lg), 32 + sb));
                si[kk] = half ? sb : sa; sv[kk] = half ? vb_ : va_; }
            const float e1 = __expf(sv[1] - sv[0]), e2 = __expf(sv[2] - sv[0]), e3 = __expf(sv[3] - sv[0]); const float inv = 1.0f / (1.0f + e1 + e2 + e3);
            if (e == 0 && row < rb1) {
                *(int4*)(RI + (size_t)row * 4) = make_int4(si[0], si[1], si[2], si[3]);
                *(f32x4*)(RW + (size_t)row * 4) = (f32x4){inv, e1 * inv, e2 * inv, e3 * inv};
                atomicAdd((unsigned*)(lcnt + si[0]), 1u); atomicAdd((unsigned*)(lcnt + si[1]), 1u); atomicAdd((unsigned*)(lcnt + si[2]), 1u); atomicAdd((unsigned*)(lcnt + si[3]), 1u);
            }
        }
    }
#undef LN_LOAD_PAIR
    __syncthreads();
    if (F.tid < 32) WSP(unsigned, WS_BC)[((size_t)LAYER * 1024 + F.bid) * 32 + F.tid] = lcnt[F.tid];
}

template <int LAYER>
DI void p8_assign(const Fr& F, int nrows) {
    unsigned* NT = WSP(unsigned, WS_CTL) + CW_NT + LAYER; const unsigned* BC = WSP(unsigned, WS_BC) + (size_t)LAYER * 1024 * 32;
    LAS int* offs = (LAS int*)F.lds;
    LAS unsigned* lcnt = (LAS unsigned*)(offs + 64);
    LAS int* lpos = (LAS int*)(offs + 192);
    { LAS unsigned* pt = (LAS unsigned*)(offs + 1024); const int e = F.tid & 31, sg = F.tid >> 5; unsigned tot = 0, pre = 0;
      for (int bb = sg; bb < F.G; bb += 16) { const unsigned c = BC[bb * 32 + e]; tot += c; pre += (bb < F.bid) ? c : 0u; }
      pt[sg * 32 + e] = tot; pt[512 + sg * 32 + e] = pre;
      __syncthreads();
      if (F.tid < 32) { unsigned t2 = 0, p2 = 0; for (int g = 0; g < 16; ++g) { t2 += pt[g * 32 + F.tid]; p2 += pt[512 + g * 32 + F.tid]; } lcnt[64 + F.tid] = t2; lcnt[32 + F.tid] = p2; lcnt[F.tid] = 0u; } }
    __syncthreads();
    if (F.tid == 0) { int o = 0; for (int e = 0; e < NEXP; ++e) { offs[e] = o; o += (int)((lcnt[64 + e] + 255u) & ~255u); } offs[32] = o; }
    __syncthreads();
    int* TILE_E = WSP(int, WS_TILEE); const int ntile = offs[32] >> 8;
    if (F.bid == 0) { for (int tl = F.tid; tl < ntile; tl += NTHR) { int e = 0; while (e < 31 && offs[e + 1] <= tl * 256) ++e; TILE_E[tl] = e; } if (F.tid == 0) *NT = (unsigned)ntile; }
    bf16_t* VBG = WSP(bf16_t, WS_VBG); const bf16_t* VB = WSP(bf16_t, WS_VB);
    constexpr bool F8 = (LAYER == 1) ? (MK_FP8_L1 != 0) : (MK_FP8_L0 != 0);
    constexpr bool GA = F8 && MK_GATHER; int* ROWTOK = WSP(int, WS_ROWTOK);
    unsigned char* VBG8 = WSP(unsigned char, WS_VBG);
    for (int e = F.bid; e < NEXP; e += F.G) { const int r0 = offs[e] + (int)lcnt[64 + e], r1 = offs[e + 1];
        if (GA) { for (int r = r0 + F.tid; r < r1; r += NTHR) ROWTOK[r] = 0; }
        else for (int r = r0 + F.wave; r < r1; r += 8) { u32x4 zz = (u32x4){0u, 0u, 0u, 0u};
            if (F8) *(u32x4*)(VBG8 + (size_t)r * DM + F.lane * 16) = zz;
            else { *(u32x4*)(VBG + (size_t)r * DM + F.lane * 8) = zz; *(u32x4*)(VBG + (size_t)r * DM + 512 + F.lane * 8) = zz; } } }
    const int* RI = WSP(int, WS_RI); int* SP = WSP(int, WS_SP);
    const int per = 2 * ((nrows / 2 + F.G - 1) / F.G), rb0 = (F.bid * per < nrows) ? F.bid * per : nrows, rb1 = (rb0 + per < nrows) ? rb0 + per : nrows; const int nslot = (rb1 > rb0 ? rb1 - rb0 : 0) * 4;
    if (F.tid < nslot) { const int my_e = RI[(size_t)rb0 * 4 + F.tid]; const int my_rank = (int)atomicAdd((unsigned*)(lcnt + my_e), 1u);
        const int pos = offs[my_e] + (int)lcnt[32 + my_e] + my_rank; lpos[F.tid] = pos; SP[(size_t)rb0 * 4 + F.tid] = pos; if (GA) ROWTOK[pos] = rb0 + (F.tid >> 2); }
    __syncthreads();
    if (!GA) for (int rl = F.wave; rl < rb1 - rb0; rl += 8) { const int row = rb0 + rl;
        const u32x4 v0 = *(const u32x4*)(VB + (size_t)row * DM + F.lane * 8), v1 = *(const u32x4*)(VB + (size_t)row * DM + 512 + F.lane * 8);
        u32x2 q0 = (u32x2){0u, 0u}, q1 = q0;
        if (F8) { q0.x = pk4_fp8(__uint_as_float(v0.x << 16), __uint_as_float(v0.x & 0xffff0000u), __uint_as_float(v0.y << 16), __uint_as_float(v0.y & 0xffff0000u));
                  q0.y = pk4_fp8(__uint_as_float(v0.z << 16), __uint_as_float(v0.z & 0xffff0000u), __uint_as_float(v0.w << 16), __uint_as_float(v0.w & 0xffff0000u));
                  q1.x = pk4_fp8(__uint_as_float(v1.x << 16), __uint_as_float(v1.x & 0xffff0000u), __uint_as_float(v1.y << 16), __uint_as_float(v1.y & 0xffff0000u));
                  q1.y = pk4_fp8(__uint_as_float(v1.z << 16), __uint_as_float(v1.z & 0xffff0000u), __uint_as_float(v1.w << 16), __uint_as_float(v1.w & 0xffff0000u)); }
#pragma unroll
        for (int k = 0; k < 4; ++k) { const int pos = lpos[rl * 4 + k];
            if (F8) { *(u32x2*)(VBG8 + (size_t)pos * DM + F.lane * 8) = q0; *(u32x2*)(VBG8 + (size_t)pos * DM + 512 + F.lane * 8) = q1; }
            else { *(u32x4*)(VBG + (size_t)pos * DM + F.lane * 8) = v0; *(u32x4*)(VBG + (size_t)pos * DM + 512 + F.lane * 8) = v1; } }
    }
    __syncthreads();
}

template <int LAYER>
DI void p11_combine(const Fr& F, int nrows, float* xout) {
    const float* MOD = WSP(float, WS_MOD) + (size_t)LAYER * 9 * 6144;
    const bf16_t* X1 = WSP(bf16_t, WS_X1); const bf16_t* YS = WSP(bf16_t, WS_YS);
    const int* SP = WSP(int, WS_SP); const float* RW = WSP(float, WS_RW);
    const float* lng = INP(6) + (size_t)(LAYER * 2 + 1) * DM; const float* lnb = INP(7) + (size_t)(LAYER * 2 + 1) * DM;
    const float* MODN = WSP(float, WS_MOD) + (size_t)1 * 9 * 6144; const float* POS = WSP(float, WS_POS); bf16_t* UN = WSP(bf16_t, A1_U);
    constexpr bool YF8 = MK_FP8_YS && ((LAYER == 0) ? (MK_FP8_L0 != 0) : (MK_FP8_L1 != 0));
    u32x2 ysq[4][4]; u32x2 x1q[4]; f32x4 posq[4]; int4 spn = make_int4(0, 0, 0, 0); f32x4 rwq = (f32x4){0.f, 0.f, 0.f, 0.f}, rwn = rwq;
#define CMB_LOAD_ROW(ROW, SPV) do { const int spa_[4] = {(SPV).x, (SPV).y, (SPV).z, (SPV).w}; \
        _Pragma("unroll") for (int i_ = 0; i_ < 4; ++i_) { const int k_ = i_ * 256 + F.lane * 4; x1q[i_] = *(const u32x2*)(X1 + (size_t)(ROW) * DM + k_); \
            if (LAYER == 0) posq[i_] = ((ROW) >= TL) ? (f32x4){0.f, 0.f, 0.f, 0.f} : *(const f32x4*)(POS + (size_t)((i_ < 2) ? (((ROW) & 2047) >> 6) : 32 + ((ROW) & 63)) * 512 + (k_ & 511)); \
            _Pragma("unroll") for (int j_ = 0; j_ < 4; ++j_) { if (YF8) ysq[j_][i_].x = *(const unsigned*)((const unsigned char*)YS + (size_t)spa_[j_] * DM + k_); else ysq[j_][i_] = *(const u32x2*)(YS + (size_t)spa_[j_] * DM + k_); } } } while (0)
    int row = F.gwave;
    if (row < nrows) { const int4 sp0 = *(const int4*)(SP + (size_t)row * 4); rwq = *(const f32x4*)(RW + (size_t)row * 4); CMB_LOAD_ROW(row, sp0);
        if (row + F.nwaves < nrows) { spn = *(const int4*)(SP + (size_t)(row + F.nwaves) * 4); rwn = *(const f32x4*)(RW + (size_t)(row + F.nwaves) * 4); } }
    for (; row < nrows; row += F.nwaves) {
        const bool isc = row >= TL; const int b = isc ? (row - TL) >> 8 : row >> 11;
        const float* md = MOD + (size_t)(isc ? 8 : b) * 6144;
        f32x4 y[4], pcur[4]; float s = 0.f;
#pragma unroll
        for (int i = 0; i < 4; ++i) { const int k = i * 256 + F.lane * 4; f32x4 f = (f32x4){0.f, 0.f, 0.f, 0.f};
#pragma unroll
            for (int j = 0; j < 4; ++j) { const u32x2 w = ysq[j][i];
                if (YF8) { const f32x2 lo = __builtin_amdgcn_cvt_pk_f32_fp8((int)w.x, false), hi = __builtin_amdgcn_cvt_pk_f32_fp8((int)w.x, true); f += (f32x4){lo.x, lo.y, hi.x, hi.y} * (rwq[j] * (1.0f / YS_F8S)); }
                else f += (f32x4){__uint_as_float(w.x << 16), __uint_as_float(w.x & 0xffff0000u), __uint_as_float(w.y << 16), __uint_as_float(w.y & 0xffff0000u)} * rwq[j]; }
            const f32x4 x1v = (f32x4){__uint_as_float(x1q[i].x << 16), __uint_as_float(x1q[i].x & 0xffff0000u), __uint_as_float(x1q[i].y << 16), __uint_as_float(x1q[i].y & 0xffff0000u)};
            y[i] = x1v * ALPHA + *(const f32x4*)(md + 5120 + k) * f; if (LAYER == 0) pcur[i] = posq[i];
            s += (y[i][0] + y[i][1]) + (y[i][2] + y[i][3]); }
        { const int rn = row + F.nwaves; if (rn < nrows) { const int4 spv = spn; rwq = rwn; CMB_LOAD_ROW(rn, spv);
              const int rn2 = rn + F.nwaves; if (rn2 < nrows) { spn = *(const int4*)(SP + (size_t)rn2 * 4); rwn = *(const f32x4*)(RW + (size_t)rn2 * 4); } } }
        const float mu = wsum(s) * (1.0f / 1024.0f); float q = 0.f;
#pragma unroll
        for (int i = 0; i < 4; ++i) { const f32x4 dd = y[i] - mu; q += (dd[0] * dd[0] + dd[1] * dd[1]) + (dd[2] * dd[2] + dd[3] * dd[3]); }
        const float rstd = rsqrtf(wsum(q) * (1.0f / 1024.0f) + LN_EPS);
#pragma unroll
        for (int i = 0; i < 4; ++i) { const int k = i * 256 + F.lane * 4;
            const f32x4 x2 = (y[i] - mu) * rstd * *(const f32x4*)(lng + k) + *(const f32x4*)(lnb + k);
            if (LAYER == 0) { u32x2 w2; w2.x = pk2(x2[0], x2[1]); w2.y = pk2(x2[2], x2[3]); *(u32x2*)((bf16_t*)xout + (size_t)row * DM + k) = w2; }
            else *(f32x4*)(xout + (size_t)row * DM + k) = x2;
            if (LAYER == 0) {
                const float* mn = MODN + (size_t)(isc ? 8 : b) * 6144;
                const f32x4 u = x2 * (*(const f32x4*)(mn + 1024 + k) + 1.0f) + *(const f32x4*)(mn + k) + pcur[i];
                u32x2 w; w.x = pk2(u[0], u[1]); w.y = pk2(u[2], u[3]);
                *(u32x2*)(UN + (size_t)row * DM + k) = w;
            } }
    }
#undef CMB_LOAD_ROW
}

DI void p13_lru_conv(const Fr& F) {
    const bf16_t* P1 = WSP(bf16_t, A1_P); bf16_t* XCB = WSP(bf16_t, A1_XCB); const float* cw = INP(25); const float* cb = INP(26);
    u32x2 pn[11];
#define CONV1_REQ(U) do { const int rt_ = (U) >> 2, c_ = ((U) & 3) * 256 + F.lane * 4, row0_ = rt_ * 64 + F.wave * 8; const bool isc_ = row0_ >= TL; const int L_ = isc_ ? CTXL : SEQ; \
        const int t0_ = isc_ ? ((row0_ - TL) & 255) : (row0_ & 2047); \
        _Pragma("unroll") for (int rr_ = 0; rr_ < 11; ++rr_) { const int tl_ = t0_ + rr_ - 2; pn[rr_] = (u32x2){0u, 0u}; if (tl_ >= 0 && tl_ < L_) pn[rr_] = *(const u32x2*)(P1 + (size_t)(row0_ + rr_ - 2) * 2048 + c_); } } while (0)
    if (F.bid < (TT / 64) * 4) CONV1_REQ(F.bid);
    for (int u = F.bid; u < (TT / 64) * 4; u += F.G) {
        const int rt = u >> 2, c = (u & 3) * 256 + F.lane * 4, row0 = rt * 64 + F.wave * 8;
        f32x4 w[4]; const f32x4 bv = *(const f32x4*)(cb + c);
#pragma unroll
        for (int i = 0; i < 4; ++i) w[i] = *(const f32x4*)(cw + i * DM + c);
        f32x4 p[11];
#pragma unroll
        for (int rr = 0; rr < 11; ++rr) { const u32x2 pv = pn[rr];
            p[rr] = (f32x4){__uint_as_float(pv.x << 16), __uint_as_float(pv.x & 0xffff0000u), __uint_as_float(pv.y << 16), __uint_as_float(pv.y & 0xffff0000u)}; }
        if (u + F.G < (TT / 64) * 4) CONV1_REQ(u + F.G);
#pragma unroll
        for (int j = 0; j < 8; ++j) { const f32x4 a = bv + w[0] * p[j] + w[1] * p[j + 1] + w[2] * p[j + 2] + w[3] * p[j + 3];
            u32x2 o; o.x = pk2(a[0], a[1]); o.y = pk2(a[2], a[3]); *(u32x2*)(XCB + (size_t)(row0 + j) * DM + c) = o; }
    }
#undef CONV1_REQ
}
#define LRU_SG(x) (x)
constexpr int LRU_AGG_OFF = LDS_CTL_OFF + 256;
template <int MODE>
DI void lru_pass(const unsigned* ab, const bf16_t* P1, bf16_t* HG, LAS unsigned* hbuf, int b, int d, int j, int pr, int col, float& h0, float& h1, float& As0, float& As1) {
    u32x2 nx[12]; unsigned gnx[12];
#define LRU_REQ(BI) do { _Pragma("unroll") for (int i_ = 0; i_ < 12; ++i_) { const int row_ = row_of(b, d, j * 72 + (BI) * 12 + i_); nx[i_] = *(const u32x2*)(ab + (size_t)row_ * 32); \
        if (MODE == 2) gnx[i_] = *(const unsigned*)(P1 + (size_t)row_ * 2048 + 1024 + col); } } while (0)
    LRU_REQ(0);
#pragma unroll 1
    for (int bi = 0; bi < 6; ++bi) {
        u32x2 cu[12]; unsigned gcu[12];
#pragma unroll
        for (int i = 0; i < 12; ++i) { cu[i] = nx[i]; if (MODE == 2) gcu[i] = gnx[i]; }
        if (bi + 1 < 6) LRU_REQ(bi + 1);
        asm volatile("" ::: "memory");
#pragma unroll
        for (int i = 0; i < 12; ++i) { const int p = j * 72 + bi * 12 + i; const u32x2 v = cu[i];
            const float la0 = __uint_as_float(v.x << 16), bc0 = __uint_as_float(v.x & 0xffff0000u), la1 = __uint_as_float(v.y << 16), bc1 = __uint_as_float(v.y & 0xffff0000u);
            const float a0 = __expf(la0), a1 = __expf(la1);
            h0 = a0 * h0 + __builtin_amdgcn_sqrtf(fmaxf(1.0f - a0 * a0, 0.f)) * bc0; h1 = a1 * h1 + __builtin_amdgcn_sqrtf(fmaxf(1.0f - a1 * a1, 0.f)) * bc1;
            if (MODE == 0) { As0 += la0; As1 += la1; }
            if (MODE == 1) { if (p >= CTXL) hbuf[(p - CTXL) * 16 + pr] = pk2(h0, h1); }
            if (MODE == 2) { if (p >= CTXL) { const int q = p - CTXL; const unsigned hf = hbuf[(SEQ - 1 - q) * 16 + pr]; const unsigned gt = gcu[i];
                    const float ha = __uint_as_float(hf << 16) + h0, hb2 = __uint_as_float(hf & 0xffff0000u) + h1;
                    *(unsigned*)(HG + (size_t)(b * SEQ + SEQ - 1 - q) * DM + col) = pk2(ha * gelu_tanh(__uint_as_float(gt << 16)), hb2 * gelu_tanh(__uint_as_float(gt & 0xffff0000u))); } }
        }
    }
#undef LRU_REQ
}
DI void p15_lru_scan(const Fr& F) {
    const unsigned* AB = WSP(unsigned, A1_RG); const bf16_t* P1 = WSP(bf16_t, A1_P); bf16_t* HG = WSP(bf16_t, A1_HG);
    LAS unsigned* hbuf = (LAS unsigned*)F.lds; LAS float* agg = (LAS float*)(F.lds + LRU_AGG_OFF);
    for (int u = F.bid; u < NB * 32; u += F.G) {
        const int cg = u & 31, b = u >> 5; const int pr = F.tid & 15, j = F.tid >> 4, col = cg * 32 + pr * 2;
#pragma unroll 1
        for (int d = 0; d < 2; ++d) {
            const unsigned* ab = AB + ((size_t)d * 32 + cg) * TT * 32 + pr * 2;
            float As0 = 0.f, As1 = 0.f, Bp0 = 0.f, Bp1 = 0.f;
            lru_pass<0>(ab, P1, HG, hbuf, b, d, j, pr, col, Bp0, Bp1, As0, As1);
            *(LAS f32x4*)(agg + (j * 16 + pr) * 4) = (f32x4){__expf(As0), Bp0, __expf(As1), Bp1};
            __syncthreads();
            float h0 = 0.f, h1 = 0.f;
            for (int m = 0; m < j; ++m) { const f32x4 g = *(const LAS f32x4*)(agg + (m * 16 + pr) * 4); h0 = g[0] * h0 + g[1]; h1 = g[2] * h1 + g[3]; }
            if (d == 0) lru_pass<1>(ab, P1, HG, hbuf, b, 0, j, pr, col, h0, h1, As0, As1);
            else lru_pass<2>(ab, P1, HG, hbuf, b, 1, j, pr, col, h0, h1, As0, As1);
            __syncthreads();
        }
    }
}
#ifndef MK_DIAG
#define MK_DIAG 0
#endif
#ifndef MK_DIAG_SUB
#define MK_DIAG_SUB 0
#endif
constexpr int CW_DIAG = 4096 + 256;
DI void diag_max(const Fr& F, float v) { if (v == v) atomicMax(WSP(unsigned, WS_CTL) + CW_DIAG, __float_as_uint(fabsf(v))); else atomicMax(WSP(unsigned, WS_CTL) + CW_DIAG, 0x7f000000u); }
DI void diag_lru_gates(const Fr& F) {
    const bf16_t* RG = WSP(bf16_t, A1_RG); const float* XC = WSP(float, A1_XC);
    for (int smp = F.bid * NTHR + F.tid; smp < 262144; smp += F.G * NTHR) {
        const unsigned hsh = (unsigned)smp * 2654435761u; const int row = (int)(hsh % (unsigned)TT); const int tcol = (int)((hsh >> 7) % 4096u);
        const int t = tcol >> 10, col = tcol & 1023, h = col >> 8, j = col & 255;
        const float* W = (t < 2 ? INP(27) : INP(29)) + (size_t)((t & 1) * 4 + h) * 65536 + j;
        float acc = (t < 2 ? INP(28) : INP(30))[(t & 1) * DM + col];
        for (int i = 0; i < 256; ++i) acc += XC[(size_t)row * DM + h * 256 + i] * W[(size_t)i * 256];
        const float df = sigm(acc) - LRU_SG(bf2f(RG[(size_t)row * 4096 + tcol]));
#if MK_DIAG_SUB == 0
        diag_max(F, df);
#elif MK_DIAG_SUB == 1
        if (!(fabsf(df) < 0.05f)) atomicAdd(WSP(unsigned, WS_CTL) + CW_DIAG + 1, 1u);
#elif MK_DIAG_SUB == 2
        if (!(fabsf(df) < 0.05f)) atomicMax(WSP(unsigned, WS_CTL) + CW_DIAG + 1, (unsigned)(tcol >> 8) + 1u);
#elif MK_DIAG_SUB == 3
        if (!(fabsf(df) < 0.05f)) atomicMax(WSP(unsigned, WS_CTL) + CW_DIAG + 1, (unsigned)(row >> 8) + 1u);
#elif MK_DIAG_SUB == 4
        if (!(fabsf(df) < 0.05f)) { const int uid = (row >> 8) * 16 + (tcol >> 8); atomicOr(WSP(unsigned, WS_CTL) + CW_DIAG + 8 + (uid >> 5), 1u << (uid & 31)); }
#elif MK_DIAG_SUB == 5
        if (!(fabsf(df) < 0.05f)) { const int uid = row & 255; atomicOr(WSP(unsigned, WS_CTL) + CW_DIAG + 8 + (uid >> 5), 1u << (uid & 31)); }
#elif MK_DIAG_SUB == 6
        if (!(fabsf(df) < 0.05f)) { const int uid = tcol & 255; atomicOr(WSP(unsigned, WS_CTL) + CW_DIAG + 8 + (uid >> 5), 1u << (uid & 31)); }
#endif
    }
}
DI void diag_lru_scan(const Fr& F) {
    const bf16_t* RG = WSP(bf16_t, A1_RG); const float* XC = WSP(float, A1_XC); const float* HS = WSP(float, A1_HS);
    for (int u = F.bid * NTHR + F.tid; u < NB * 2 * DM; u += F.G * NTHR) {
        const int col = u & 1023, d = (u >> 10) & 1, b = u >> 11; const float sp = softplus_(INP(31)[d * DM + col]);
        float hst = 0.f, md = 0.f;
        for (int p = 0; p < CTXL + SEQ; ++p) { const int row = row_of(b, d, p);
            const float r = LRU_SG(bf2f(RG[(size_t)row * 4096 + d * 1024 + col])), ig = LRU_SG(bf2f(RG[(size_t)row * 4096 + (2 + d) * 1024 + col])), x = XC[(size_t)row * DM + col];
            const float la = -8.0f * r * sp, a = expf(la), bc = sqrtf(fmaxf(-expm1f(2.0f * la), 0.f)) * (ig * x);
            hst = a * hst + bc;
            if (p >= CTXL) { const float df = fabsf(hst - HS[((size_t)d * TL + row) * DM + col]); md = (df > md || df != df) ? df : md; } }
        diag_max(F, md);
    }
}
DI void diag_hyena(const Fr& F) {
    for (int i = F.bid * NTHR + F.tid; i < 512 * TC + 262144; i += F.G * NTHR) {
        const bool lat = i >= 512 * TC; int c, b, t, L;
        if (!lat) { c = i / TC; b = (i % TC) >> 8; t = i & 255; L = CTXL; }
        else { const unsigned hsh = (unsigned)(i - 512 * TC) * 2654435761u; c = (int)(hsh % 512u); b = (int)((hsh >> 9) & 7u); t = (int)((hsh >> 12) % (unsigned)SEQ); L = SEQ; }
        const float* HFt = (lat ? WSP(float, WS_HFL) : WSP(float, WS_HFC)) + (size_t)c * L; const float* HBt = (lat ? WSP(float, WS_HBL) : WSP(float, WS_HBC)) + (size_t)c * L;
        const bf16_t* vx = lat ? WSP(bf16_t, A0_VXTL) + (size_t)c * TL + b * SEQ : WSP(bf16_t, A0_VXTC) + (size_t)c * TC + b * CTXL;
        float acc = 0.f;
        for (int s2 = 0; s2 < L; ++s2) { const float hh = (s2 <= t) ? HFt[t - s2] : HBt[s2 - t]; acc += hh * bf2f(vx[s2]); }
        const float got = lat ? WSP(float, A0_YHTL)[(size_t)c * TL + b * SEQ + t] : WSP(float, A0_YHTC)[(size_t)c * TC + b * CTXL + t];
#if MK_DIAG_SUB == 0
        if (!lat) diag_max(F, acc - got);
#elif MK_DIAG_SUB == 1
        if (!lat) diag_max(F, acc);
#elif MK_DIAG_SUB == 2
        if (lat) diag_max(F, acc - got);
#else
        if (lat) diag_max(F, acc);
#endif
    }
}
DI void diag_fill(const Fr& F, float* out) {
#if MK_DIAG_SUB == 0 || MK_DIAG == 3
    const float v = 1.0f + 1000.0f * __uint_as_float(WSP(unsigned, WS_CTL)[CW_DIAG]);
#elif MK_DIAG_SUB >= 4
    unsigned cntb = 0; for (int i = 0; i < 40; ++i) cntb += __popc(WSP(unsigned, WS_CTL)[CW_DIAG + 8 + i]);
    const float v = 1.0f + (float)cntb;
#else
    const float v = 1.0f + (float)WSP(unsigned, WS_CTL)[CW_DIAG + 1];
#endif
    for (int i = F.bid * NTHR + F.tid; i < TL * DM; i += F.G * NTHR) out[i] = v;
}
enum { PH_PRO = 0, PH_MOD0, PH_INPROJ0, PH_PREP0, PH_CORE0, PH_MIX0, PH_OUTPROJ0, PH_LN0, PH_ASG0, PH_MOE1_0, PH_MOE2_0, PH_CMB0,
       PH_INPROJ1, PH_CONV1, PH_GATES1, PH_SCAN1, PH_OUTPROJ1, PH_LN1, PH_ASG1, PH_MOE1_1, PH_MOE2_1, PH_CMB1, NPH };
__global__ void __launch_bounds__(NTHR, 2) mk_fwd(Args args) {
    extern __shared__ __attribute__((aligned(16))) unsigned char lds_raw[];
    Fr F;
    F.a = &args; F.lds = (LAS unsigned char*)lds_raw; F.ws = args.ws;
    F.tid = threadIdx.x; F.lane = F.tid & 63; F.wave = __builtin_amdgcn_readfirstlane(F.tid >> 6); F.G = gridDim.x; F.bid = blockIdx.x;
    F.gwave = F.bid * 8 + F.wave; F.nwaves = F.G * 8;
    volatile LAS unsigned* xbw = (volatile LAS unsigned*)(F.lds + LDS_CTL_OFF);
    if (F.tid < 4) xbw[F.tid] = 0u;
    __syncthreads();
#if MK_ONE_LAUNCH
    XcdBarrier bar = xcd_barrier_post(WSP(unsigned, WS_CTL) + CW_BAR, xbw);
#if MK_BG_CONV
#define GRID_BAR() xcd_barrier_work(bar, F)
#else
#define GRID_BAR() xcd_barrier(bar)
#endif
#else
#define GRID_BAR() do {} while (0)
#endif
    const int lo = args.ph_lo, hi = args.ph_hi;
#ifndef MK_PH_MASK
#define MK_PH_MASK 0xFFFFFFFFu
#endif
#define IN(k) (((MK_PH_MASK >> (k)) & 1u) && lo <= (k) && (k) < hi)
#ifndef MK_REPMASK
#define MK_REPMASK 0u
#endif
#define SEAM(k) do { if (IN((k) + 1) || rep_ + 1 < n_) { GRID_BAR(); } } while (0)
#define PHASE(k) _Pragma("unroll 1") for (int rep_ = 0, n_ = (IN(k) ? 1 + (int)((MK_REPMASK >> (k)) & 1u) : 0); rep_ < n_; ++rep_)
    LAS unsigned char* glds = F.lds;

    PHASE(PH_PRO) { p0_prologue(F); SEAM(PH_PRO); }
    PHASE(PH_MOD0) { p1_mod0(F); SEAM(PH_MOD0); }
    PHASE(PH_INPROJ0) {
        __syncthreads();
        pg8::Gemm g{WSP(bf16_t, A0_U), WSP(bf16_t, WS_WEVIN), TT, NP0, DM, DM}; pg8::StaticOrder S; S.init(TT, NP0, F.G, F.bid);
        pg8::EpiBf16 E{WSP(bf16_t, A0_P), NP0, nullptr, 0};
        pg8::gemm_phase(glds, g, S, E); SEAM(PH_INPROJ0);
    }
    PHASE(PH_PREP0) { p3_prep(F); SEAM(PH_PREP0); }
    PHASE(PH_CORE0) { __syncthreads(); p4_mix_core(F); SEAM(PH_CORE0); }
#if MK_DIAG == 3
    PHASE(PH_MIX0) { diag_hyena(F); p5_mix(F); SEAM(PH_MIX0); }
#else
    PHASE(PH_MIX0) { p5_mix(F); SEAM(PH_MIX0); }
#endif
    PHASE(PH_OUTPROJ0) {
        __syncthreads();
        pg8::Gemm g{WSP(bf16_t, A0_MIX), WSP(bf16_t, WS_WEVOUT), TT, DM, MIXW, MIXW}; pg8::StaticOrder S; S.init(TT, DM, F.G, F.bid);
        pg8::EpiBf16 E{WSP(bf16_t, A0_Y), DM, nullptr, 0};
        pg8::gemm_phase(glds, g, S, E);
        if (F.G == 256 && !MK_BG_CONV && F.bid >= 32) moe_w_l1_part(F, 0, 0, L1W1_A, F.bid - 32, 224);
        SEAM(PH_OUTPROJ0);
    }
    PHASE(PH_LN0) { __syncthreads(); (MK_ROUTE_MFMA ? p7m_ln_route<0>(F, INP(0), INP(2), WSP(bf16_t, A0_Y), TT) : p7_ln_route<0>(F, INP(0), INP(2), WSP(bf16_t, A0_Y), TT)); SEAM(PH_LN0); }
    PHASE(PH_ASG0) { __syncthreads(); p8_assign<0>(F, TT);
#if MK_BG_CONV
        conv_drain(F, TQ_PER_LAYER);
#endif
        SEAM(PH_ASG0); }
    PHASE(PH_MOE1_0) {
        __syncthreads();
        const int ntm = (int)WSP(unsigned, WS_CTL)[CW_NT + 0];
#if MK_FP8_L0
        pg8::Gemm g{MK_GATHER ? WSP(bf16_t, WS_VB) : WSP(bf16_t, WS_VBG), WSP(bf16_t, WS_WM1), ntm * 256, 2048, DM / 2, DM / 2, WSP(int, WS_ROWTOK)}; pg8::MoeOrder S{WSP(int, WS_TILEE), ntm, 8, F.G, F.bid};
        pg8::EpiSwigluF8 E{WSP(unsigned char, WS_ACT), DM, INP(37), 2048, 1.0f / W1_F8S};
        pg8::gemm_phase<pg8::EpiSwigluF8, pg8::MoeOrder, true, MK_GATHER != 0>(glds, g, S, E); SEAM(PH_MOE1_0);
#else
        pg8::Gemm g{WSP(bf16_t, WS_VBG), WSP(bf16_t, WS_WM1), ntm * 256, 2048, DM, DM}; pg8::MoeOrder S{WSP(int, WS_TILEE), ntm, 8, F.G, F.bid};
        pg8::EpiSwiglu E{WSP(bf16_t, WS_ACT), DM, INP(37), 2048};
        pg8::gemm_phase(glds, g, S, E); SEAM(PH_MOE1_0);
#endif
    }
    PHASE(PH_MOE2_0) {
        __syncthreads();
        const int ntm = (int)WSP(unsigned, WS_CTL)[CW_NT + 0];
#if MK_FP8_L0
        pg8::Gemm g{WSP(bf16_t, WS_ACT), WSP(bf16_t, WS_WM2), ntm * 256, DM, DM / 2, DM / 2}; pg8::MoeOrder S{WSP(int, WS_TILEE), ntm, 4, F.G, F.bid};
#if MK_FP8_YS
        pg8::EpiF8 E{WSP(unsigned char, WS_YS), DM, INP(39), DM, 1.0f / W2_F8S, YS_F8S};
        pg8::gemm_phase<pg8::EpiF8, pg8::MoeOrder, true>(glds, g, S, E); SEAM(PH_MOE2_0);
#else
        pg8::EpiBf16 E{WSP(bf16_t, WS_YS), DM, INP(39), DM, 1.0f / W2_F8S};
        pg8::gemm_phase<pg8::EpiBf16, pg8::MoeOrder, true>(glds, g, S, E); SEAM(PH_MOE2_0);
#endif
#else
        pg8::Gemm g{WSP(bf16_t, WS_ACT), WSP(bf16_t, WS_WM2), ntm * 256, DM, DM, DM}; pg8::MoeOrder S{WSP(int, WS_TILEE), ntm, 4, F.G, F.bid};
        pg8::EpiBf16 E{WSP(bf16_t, WS_YS), DM, INP(39), DM};
        pg8::gemm_phase(glds, g, S, E); SEAM(PH_MOE2_0);
#endif
    }
    PHASE(PH_CMB0) { p11_combine<0>(F, TT, WSP(float, WS_X2)); SEAM(PH_CMB0); }
    PHASE(PH_INPROJ1) {
        __syncthreads();
        pg8::Gemm g{WSP(bf16_t, A1_U), WSP(bf16_t, WS_WODIN), TT, 2048, DM, DM}; pg8::StaticOrder S; S.init(TT, 2048, F.G, F.bid);
        pg8::EpiBf16 E{WSP(bf16_t, A1_P), 2048, INP(24), 0};
        pg8::gemm_phase(glds, g, S, E);
        if (F.G == 256 && !MK_BG_CONV && F.bid >= 64) moe_w_l1_part(F, 0, L1W1_A, L1W1_B, F.bid - 64, 192);
        SEAM(PH_INPROJ1);
    }
    PHASE(PH_CONV1) { p13_lru_conv(F); SEAM(PH_CONV1); }
    PHASE(PH_GATES1) {
        __syncthreads();
        pg8::Gemm g{WSP(bf16_t, A1_XCB), WSP(bf16_t, WS_WLRU), TT, 4096, 256, DM}; pg8::LruOrder S; S.init(TT, 4096, F.G, F.bid);
        pg8::EpiLruAB E{WSP(unsigned, A1_RG), WSP(float, WS_BLRU), WSP(float, WS_BLRU) + 4096, WSP(bf16_t, A1_XCB), TT};
        pg8::gemm_phase(glds, g, S, E); SEAM(PH_GATES1);
    }
#if MK_DIAG == 1
    PHASE(PH_SCAN1) { diag_lru_gates(F); SEAM(PH_SCAN1); }
#else
    PHASE(PH_SCAN1) { __syncthreads(); p15_lru_scan(F); SEAM(PH_SCAN1); }
#endif
    PHASE(PH_OUTPROJ1) {
        __syncthreads();
        pg8::Gemm g{WSP(bf16_t, A1_HG), WSP(bf16_t, WS_WODOUT), TL, DM, DM, DM}; pg8::StaticOrder S; S.init(TL, DM, F.G, F.bid);
        pg8::EpiBf16 E{WSP(bf16_t, A1_Y), DM, INP(33), 0};
        pg8::gemm_phase(glds, g, S, E); SEAM(PH_OUTPROJ1);
    }
    PHASE(PH_LN1) { __syncthreads(); (MK_ROUTE_MFMA ? p7m_ln_route<1>(F, WSP(float, WS_X2), WSP(float, WS_X2) + (size_t)TL * DM, WSP(bf16_t, A1_Y), TL) : p7_ln_route<1>(F, WSP(float, WS_X2), WSP(float, WS_X2) + (size_t)TL * DM, WSP(bf16_t, A1_Y), TL)); SEAM(PH_LN1); }
    PHASE(PH_ASG1) { __syncthreads(); p8_assign<1>(F, TL);
#if MK_BG_CONV
        conv_drain(F, TQ_TOTAL);
#endif
        SEAM(PH_ASG1); }
    PHASE(PH_MOE1_1) {
        __syncthreads();
        const int ntm = (int)WSP(unsigned, WS_CTL)[CW_NT + 1];
#if MK_FP8_L1
        pg8::Gemm g{MK_GATHER ? WSP(bf16_t, WS_VB) : WSP(bf16_t, WS_VBG), (const bf16_t*)(WSP(unsigned char, WS_WM1) + (size_t)32 * 2048 * DM * 2), ntm * 256, 2048, DM / 2, DM / 2, WSP(int, WS_ROWTOK)}; pg8::MoeOrder S{WSP(int, WS_TILEE), ntm, 8, F.G, F.bid};
        pg8::EpiSwigluF8 E{WSP(unsigned char, WS_ACT), DM, INP(37) + (size_t)32 * 2048, 2048, 1.0f / W1_F8S};
        pg8::gemm_phase<pg8::EpiSwigluF8, pg8::MoeOrder, true, MK_GATHER != 0>(glds, g, S, E); SEAM(PH_MOE1_1);
#else
        pg8::Gemm g{WSP(bf16_t, WS_VBG), WSP(bf16_t, WS_WM1) + (size_t)32 * 2048 * DM, ntm * 256, 2048, DM, DM}; pg8::MoeOrder S{WSP(int, WS_TILEE), ntm, 8, F.G, F.bid};
        pg8::EpiSwiglu E{WSP(bf16_t, WS_ACT), DM, INP(37) + (size_t)32 * 2048, 2048};
        pg8::gemm_phase(glds, g, S, E); SEAM(PH_MOE1_1);
#endif
    }
    PHASE(PH_MOE2_1) {
        __syncthreads();
        const int ntm = (int)WSP(unsigned, WS_CTL)[CW_NT + 1];
#if MK_FP8_L1
        pg8::Gemm g{WSP(bf16_t, WS_ACT), (const bf16_t*)(WSP(unsigned char, WS_WM2) + (size_t)32 * DM * DM * 2), ntm * 256, DM, DM / 2, DM / 2}; pg8::MoeOrder S{WSP(int, WS_TILEE), ntm, 4, F.G, F.bid};
#if MK_FP8_YS
        pg8::EpiF8 E{WSP(unsigned char, WS_YS), DM, INP(39) + (size_t)32 * DM, DM, 1.0f / W2_F8S, YS_F8S};
        pg8::gemm_phase<pg8::EpiF8, pg8::MoeOrder, true>(glds, g, S, E); SEAM(PH_MOE2_1);
#else
        pg8::EpiBf16 E{WSP(bf16_t, WS_YS), DM, INP(39) + (size_t)32 * DM, DM, 1.0f / W2_F8S};
        pg8::gemm_phase<pg8::EpiBf16, pg8::MoeOrder, true>(glds, g, S, E); SEAM(PH_MOE2_1);
#endif
#else
        pg8::Gemm g{WSP(bf16_t, WS_ACT), WSP(bf16_t, WS_WM2) + (size_t)32 * DM * DM, ntm * 256, DM, DM, DM}; pg8::MoeOrder S{WSP(int, WS_TILEE), ntm, 4, F.G, F.bid};
        pg8::EpiBf16 E{WSP(bf16_t, WS_YS), DM, INP(39) + (size_t)32 * DM, DM};
        pg8::gemm_phase(glds, g, S, E); SEAM(PH_MOE2_1);
#endif
    }
#if MK_DIAG
    PHASE(PH_CMB1) { diag_fill(F, args.out); }
#else
    PHASE(PH_CMB1) { p11_combine<1>(F, TL, args.out); }
#endif
#undef IN
#undef SEAM
#undef PHASE
}

extern "C" void kernel_launch(void* const* d_in, const int* in_sizes, int n_in, void* d_out, int out_size, void* d_ws, size_t ws_size, hipStream_t stream) {
    static int grid = 0;
    if (grid == 0) {
        static const int exp_sizes[40] = {16777216, 8192, 2097152, 1024, 12582912, 12288, 4096, 4096, 3686400, 1048576, 6144, 8, 8, 128, 4608, 1536, 2112, 64, 8192, 128, 65536, 64, 512,
            2097152, 2048, 4096, 1024, 524288, 2048, 524288, 2048, 2048, 1048576, 1024, 65536, 64, 134217728, 131072, 67108864, 65536};
        bool ok_sizes = (n_in == 40);
        for (int i = 0; ok_sizes && i < 40; ++i) if (in_sizes[i] != exp_sizes[i]) { fprintf(stderr, "kernel_launch: input %d has %d elements, expected %d\n", i, in_sizes[i], exp_sizes[i]); ok_sizes = false; }
        if (!ok_sizes || out_size != TL * DM || ws_size < WS_END) { fprintf(stderr, "kernel_launch: unexpected shapes: n_in %d out %d ws %zu (need %zu)\n", n_in, out_size, ws_size, (size_t)WS_END); grid = -1; return; }
        int dev = 0, cus = 0, per_cu = 0;
        if (hipGetDevice(&dev) != hipSuccess || hipDeviceGetAttribute(&cus, hipDeviceAttributeMultiprocessorCount, dev) != hipSuccess) { grid = -1; return; }
        if (hipFuncSetAttribute((const void*)mk_fwd, hipFuncAttributeMaxDynamicSharedMemorySize, LDS_BYTES) != hipSuccess) { fprintf(stderr, "kernel_launch: hipFuncSetAttribute failed\n"); grid = -1; return; }
        if (hipOccupancyMaxActiveBlocksPerMultiprocessor(&per_cu, (const void*)mk_fwd, NTHR, LDS_BYTES) != hipSuccess || per_cu < 1) { fprintf(stderr, "kernel_launch: occupancy query says %d\n", per_cu); }
        (void)hipGetLastError();
        grid = cus;
    }
    if (grid < 0) return;
    (void)hipMemsetAsync((char*)d_ws + WS_CTL, 0, CTL_BYTES, stream);
    Args a{};
    for (int i = 0; i < 40; ++i) a.in[i] = (const float*)d_in[i];
    a.out = (float*)d_out; a.ws = (unsigned char*)d_ws;
#if MK_ONE_LAUNCH
    a.ph_lo = 0; a.ph_hi = NPH;
    hipLaunchKernelGGL(mk_fwd, dim3(grid), dim3(NTHR), LDS_BYTES, stream, a);
#else
#ifndef MK_MAXPH
#define MK_MAXPH NPH
#endif
#ifndef MK_REPEAT
#define MK_REPEAT -1
#endif
    for (int p = 0; p < MK_MAXPH; ++p) { a.ph_lo = p; a.ph_hi = p + 1; hipLaunchKernelGGL(mk_fwd, dim3(grid), dim3(NTHR), LDS_BYTES, stream, a);
        if (p == MK_REPEAT) { a.flags = 1; hipLaunchKernelGGL(mk_fwd, dim3(grid), dim3(NTHR), LDS_BYTES, stream, a); a.flags = 0; } }
#endif
}
```
